# Optimizing an MI355X kernel written in HIP

```python
import math
import jax, jax.numpy as jnp
from jax import lax
import numpy as np

D_MODEL = 1024
BATCH = 1
SEQ = 16384
DEPTH = 1
DEC_BATCH = 16
DEC_SEQ = 4096
PAST_LEN = 128

D_MIX = D_MODEL
D_FOURIER = D_MIX // 2
D_SSM = D_MIX - D_FOURIER
N_FOURIER_HEADS = 4
FOURIER_HEAD_DIM = D_FOURIER // N_FOURIER_HEADS
SSM_GROUP = 16
N_SSM_GROUPS = D_SSM // SSM_GROUP
SSM_STATE = 64
N_DIR = 2
D_FF = 4 * D_MODEL
N_MOD = 6
EPS = 1e-6
DT_MIN = 1e-3
DT_MAX = 1e-1
A_RE_MAX = -1e-4

kernel_name = "hymba_fnet_s5_adaln_encoder"


def rmsnorm(x, g):
    xf = x.astype(jnp.float32)
    y = xf * lax.rsqrt(jnp.mean(xf * xf, axis=-1, keepdims=True) + EPS)
    return (y * g.astype(jnp.float32)).astype(x.dtype)


def fourier_mixer(u, w_f, b_f):
    b, l, _ = u.shape
    z = jnp.fft.fft2(u.astype(jnp.float32), axes=(1, 2), norm="ortho").real.astype(u.dtype)
    z = z.reshape(b, l, N_FOURIER_HEADS, FOURIER_HEAD_DIM)
    y = jnp.einsum("blhd,hde->blhe", z, w_f).reshape(b, l, D_FOURIER)
    return y + b_f


def _scan_combine(left, right):
    a_l, b_l = left
    a_r, b_r = right
    return a_r * a_l, a_r * b_l + b_r


def s5_direction(u_c, a_re, a_im, log_dt, b_re, b_im, c_re, c_im, reverse):
    f32 = jnp.float32
    lam = lax.complex(jnp.minimum(a_re.astype(f32), A_RE_MAX), a_im.astype(f32))
    dt = jnp.exp(log_dt.astype(f32))[:, None]
    a_bar = jnp.exp(lam * dt)
    b_mat = lax.complex(b_re.astype(f32), b_im.astype(f32))
    b_bar = ((a_bar - 1.0) / lam)[..., None] * b_mat
    bu = jnp.einsum("blgh,gph->blgp", u_c, b_bar)
    a_seq = jnp.broadcast_to(a_bar, bu.shape)
    _, h = lax.associative_scan(_scan_combine, (a_seq, bu), axis=1, reverse=reverse)
    c_mat = lax.complex(c_re.astype(f32), c_im.astype(f32))
    return jnp.einsum("blgp,ghp->blgh", h, c_mat).real


def s5_mixer(u, a_re, a_im, log_dt, b_re, b_im, c_re, c_im, d_skip, w_glu, b_glu):
    b, l, _ = u.shape
    uf = u.astype(jnp.float32).reshape(b, l, N_SSM_GROUPS, SSM_GROUP)
    u_c = lax.complex(uf, jnp.zeros_like(uf))
    y_fwd = s5_direction(u_c, a_re[0], a_im[0], log_dt[0], b_re[0], b_im[0], c_re[0], c_im[0], False)
    y_bwd = s5_direction(u_c, a_re[1], a_im[1], log_dt[1], b_re[1], b_im[1], c_re[1], c_im[1], True)
    y = (y_fwd + y_bwd).reshape(b, l, D_SSM) + d_skip.astype(jnp.float32) * uf.reshape(b, l, D_SSM)
    g = jax.nn.gelu(y).astype(u.dtype)
    ab = g @ w_glu + b_glu
    val, gate = jnp.split(ab, 2, axis=-1)
    return val * jax.nn.sigmoid(gate)


def encoder_layer(x, c, w_ada, b_ada, g_mix_norm, w_in, w_fourier, b_fourier,
                  ssm_a_re, ssm_a_im, ssm_log_dt, ssm_b_re, ssm_b_im, ssm_c_re, ssm_c_im,
                  ssm_d, w_glu, b_glu, g_fourier_out, g_ssm_out, w_out,
                  g_mlp_norm, w_mlp_in, b_mlp_in, w_mlp_out, b_mlp_out):
    mod = (jax.nn.silu(c) @ w_ada + b_ada)[:, None, :]
    shift1, scale1, gate1, shift2, scale2, gate2 = jnp.split(mod, N_MOD, axis=-1)
    h = rmsnorm(x, g_mix_norm) * (1.0 + scale1) + shift1
    z = h @ w_in
    y_f = fourier_mixer(z[..., :D_FOURIER], w_fourier, b_fourier)
    y_s = s5_mixer(z[..., D_FOURIER:], ssm_a_re, ssm_a_im, ssm_log_dt, ssm_b_re, ssm_b_im,
                   ssm_c_re, ssm_c_im, ssm_d, w_glu, b_glu)
    merged = jnp.concatenate([rmsnorm(y_f, g_fourier_out), rmsnorm(y_s, g_ssm_out)], axis=-1)
    x = x + gate1 * (merged @ w_out)
    h = rmsnorm(x, g_mlp_norm) * (1.0 + scale2) + shift2
    ff = jnp.square(jax.nn.relu(h @ w_mlp_in + b_mlp_in)) @ w_mlp_out + b_mlp_out
    return x + gate2 * ff


def setup_inputs(seed: int = 0) -> dict:
    key = jax.random.key(seed)
    ks = jax.random.split(key, 32)
    f32 = jnp.float32
    nrm = lambda k, shape, s: (jax.random.normal(k, shape, f32) * s).astype(f32)
    G, P, H = N_SSM_GROUPS, SSM_STATE, SSM_GROUP
    a_im_base = jnp.pi * jnp.arange(P, dtype=f32)
    return {
        "x_prompt": nrm(ks[0], (BATCH, SEQ, D_MODEL), 1.0),
        "x_sample": nrm(ks[1], (DEC_BATCH, DEC_SEQ, D_MODEL), 1.0),
        "c_prompt": nrm(ks[2], (BATCH, D_MODEL), 1.0),
        "c_sample": nrm(ks[3], (DEC_BATCH, D_MODEL), 1.0),
        "w_ada": nrm(ks[4], (DEPTH, D_MODEL, N_MOD * D_MODEL), 0.5 * D_MODEL ** -0.5),
        "b_ada": nrm(ks[5], (DEPTH, N_MOD * D_MODEL), 0.02),
        "g_mix_norm": 1.0 + nrm(ks[6], (DEPTH, D_MODEL), 0.02),
        "w_in": nrm(ks[7], (DEPTH, D_MODEL, D_MIX), D_MODEL ** -0.5),
        "w_fourier": nrm(ks[8], (DEPTH, N_FOURIER_HEADS, FOURIER_HEAD_DIM, FOURIER_HEAD_DIM), FOURIER_HEAD_DIM ** -0.5),
        "b_fourier": nrm(ks[9], (DEPTH, D_FOURIER), 0.02),
        "ssm_a_re": -0.5 + nrm(ks[10], (DEPTH, N_DIR, G, P), 0.01),
        "ssm_a_im": a_im_base + nrm(ks[11], (DEPTH, N_DIR, G, P), 0.01),
        "ssm_log_dt": jax.random.uniform(ks[12], (DEPTH, N_DIR, G), f32, math.log(DT_MIN), math.log(DT_MAX)),
        "ssm_b_re": nrm(ks[13], (DEPTH, N_DIR, G, P, H), (2 * H) ** -0.5),
        "ssm_b_im": nrm(ks[14], (DEPTH, N_DIR, G, P, H), (2 * H) ** -0.5),
        "ssm_c_re": nrm(ks[15], (DEPTH, N_DIR, G, H, P), P ** -0.5),
        "ssm_c_im": nrm(ks[16], (DEPTH, N_DIR, G, H, P), P ** -0.5),
        "ssm_d": nrm(ks[17], (DEPTH, D_SSM), 0.5),
        "w_glu": nrm(ks[18], (DEPTH, D_SSM, 2 * D_SSM), D_SSM ** -0.5),
        "b_glu": nrm(ks[19], (DEPTH, 2 * D_SSM), 0.02),
        "g_fourier_out": 1.0 + nrm(ks[20], (DEPTH, D_FOURIER), 0.02),
        "g_ssm_out": 1.0 + nrm(ks[21], (DEPTH, D_SSM), 0.02),
        "w_out": nrm(ks[22], (DEPTH, D_MIX, D_MODEL), D_MIX ** -0.5),
        "g_mlp_norm": 1.0 + nrm(ks[23], (DEPTH, D_MODEL), 0.02),
        "w_mlp_in": nrm(ks[24], (DEPTH, D_MODEL, D_FF), D_MODEL ** -0.5),
        "b_mlp_in": nrm(ks[25], (DEPTH, D_FF), 0.02),
        "w_mlp_out": nrm(ks[26], (DEPTH, D_FF, D_MODEL), D_FF ** -0.5),
        "b_mlp_out": nrm(ks[27], (DEPTH, D_MODEL), 0.02),
        "g_final": 1.0 + nrm(ks[28], (D_MODEL,), 0.02),
    }


def reference(x_prompt, x_sample, c_prompt, c_sample, w_ada, b_ada, g_mix_norm, w_in,
              w_fourier, b_fourier, ssm_a_re, ssm_a_im, ssm_log_dt, ssm_b_re, ssm_b_im,
              ssm_c_re, ssm_c_im, ssm_d, w_glu, b_glu, g_fourier_out, g_ssm_out, w_out,
              g_mlp_norm, w_mlp_in, b_mlp_in, w_mlp_out, b_mlp_out, g_final):
    def trunk(x, c):
        for i in range(DEPTH):
            x = encoder_layer(x, c, w_ada[i], b_ada[i], g_mix_norm[i], w_in[i], w_fourier[i],
                              b_fourier[i], ssm_a_re[i], ssm_a_im[i], ssm_log_dt[i], ssm_b_re[i],
                              ssm_b_im[i], ssm_c_re[i], ssm_c_im[i], ssm_d[i], w_glu[i], b_glu[i],
                              g_fourier_out[i], g_ssm_out[i], w_out[i], g_mlp_norm[i],
                              w_mlp_in[i], b_mlp_in[i], w_mlp_out[i], b_mlp_out[i])
        return rmsnorm(x, g_final)

    y_prompt = trunk(x_prompt, c_prompt)
    y_sample = trunk(x_sample, c_sample)
    return (y_prompt, y_sample)
```

```cpp
#include <hip/hip_runtime.h>
#include <hip/hip_cooperative_groups.h>
#include <stdint.h>
#include <stdio.h>
namespace cg = cooperative_groups;

#ifndef ONE_LAUNCH
#define ONE_LAUNCH 0
#endif

#define DI __device__ __forceinline__
typedef unsigned short bf16_t;
typedef short bf16x8 __attribute__((ext_vector_type(8)));
typedef float f32x16 __attribute__((ext_vector_type(16)));
typedef float f32x4 __attribute__((ext_vector_type(4)));

constexpr int NTOK = 81920, LPR = 16384, LSM = 4096;
constexpr int BM = 128, BN = 128, BK = 64, LDSS = 72, TLD = 136;
constexpr int SMEM_BYTES = 2 * 2 * BM * LDSS * 2;
constexpr float EPSV = 1e-6f;

struct P {
  const float *xp, *xs, *cp, *cs, *w_ada, *b_ada, *g_mix, *w_in, *w_f, *b_f, *a_re, *a_im, *log_dt, *b_re, *b_im, *c_re, *c_im,
      *ssm_d, *w_glu, *b_glu, *g_fo, *g_so, *w_out, *g_mlp, *w1, *b1, *w2, *b2, *g_final;
  float* out;
  float *mod, *AT, *S, *ssf, *sss;
  float2 *twp, *tws;
  bf16_t *wint, *wglut, *woutt, *w1t, *w2t, *Mf, *F1p, *F1s, *F2p, *F2s, *Ktab, *Bs, *Co;
  bf16_t *hb, *zT, *zs, *Tt, *AF, *H, *yf, *gact, *ys, *hid;
};

typedef float f32x2v __attribute__((ext_vector_type(2)));
typedef __bf16 bf16x2v __attribute__((ext_vector_type(2)));
DI uint32_t pk2(float lo, float hi) { const f32x2v v = {lo, hi}; const bf16x2v r = __builtin_convertvector(v, bf16x2v); return __builtin_bit_cast(uint32_t, r); }
DI bf16_t f2bf(float f) { return (bf16_t)(pk2(f, 0.f) & 0xffffu); }
DI int batch_of(int tok) { return tok < LPR ? 0 : 1 + ((tok - LPR) >> 12); }
DI float wave_sum(float v) {
  v += __shfl_xor(v, 32); v += __shfl_xor(v, 16); v += __shfl_xor(v, 8); v += __shfl_xor(v, 4); v += __shfl_xor(v, 2); v += __shfl_xor(v, 1);
  return v;
}

template <bool SWAP, class AF, class BF, class HK>
DI void gemm_main(bf16_t* sm, int K, const AF& af, const BF& bf, const HK& hk, f32x16 (&acc)[2][2]) {
  const int tid = threadIdx.x, lane = tid & 63, wid = tid >> 6, wm = wid >> 1, wn = wid & 1;
  const int kc = (tid & 7) * 8, rb = tid >> 3;
  bf16_t* As = sm;
  bf16_t* Bs = sm + 2 * BM * LDSS;
  uint4 ra[4], rv[4];
#pragma unroll
  for (int i = 0; i < 2; i++)
#pragma unroll
    for (int j = 0; j < 2; j++)
#pragma unroll
      for (int e = 0; e < 16; e++) acc[i][j][e] = 0.f;
  __syncthreads();
#pragma unroll
  for (int i = 0; i < 4; i++) { ra[i] = *(const uint4*)af(rb + 32 * i, kc); rv[i] = *(const uint4*)bf(rb + 32 * i, kc); }
#pragma unroll
  for (int i = 0; i < 4; i++) { *(uint4*)(As + (rb + 32 * i) * LDSS + kc) = ra[i]; *(uint4*)(Bs + (rb + 32 * i) * LDSS + kc) = rv[i]; }
  __syncthreads();
  const int nk = K / BK;
  for (int t = 0; t < nk; t++) {
    const int cur = t & 1;
    if (t + 1 < nk) {
      const int k = (t + 1) * BK + kc;
#pragma unroll
      for (int i = 0; i < 4; i++) { ra[i] = *(const uint4*)af(rb + 32 * i, k); rv[i] = *(const uint4*)bf(rb + 32 * i, k); }
    }
    hk(t, acc);
    const bf16_t* Ab = As + cur * BM * LDSS + (wm * 64 + (lane & 31)) * LDSS + (lane >> 5) * 8;
    const bf16_t* Bb = Bs + cur * BN * LDSS + (wn * 64 + (lane & 31)) * LDSS + (lane >> 5) * 8;
#pragma unroll
    for (int ks = 0; ks < 4; ks++) {
      const bf16x8 a0 = *(const bf16x8*)(Ab + ks * 16), a1 = *(const bf16x8*)(Ab + 32 * LDSS + ks * 16);
      const bf16x8 b0 = *(const bf16x8*)(Bb + ks * 16), b1 = *(const bf16x8*)(Bb + 32 * LDSS + ks * 16);
      if (SWAP) {
        acc[0][0] = __builtin_amdgcn_mfma_f32_32x32x16_bf16(b0, a0, acc[0][0], 0, 0, 0);
        acc[0][1] = __builtin_amdgcn_mfma_f32_32x32x16_bf16(b1, a0, acc[0][1], 0, 0, 0);
        acc[1][0] = __builtin_amdgcn_mfma_f32_32x32x16_bf16(b0, a1, acc[1][0], 0, 0, 0);
        acc[1][1] = __builtin_amdgcn_mfma_f32_32x32x16_bf16(b1, a1, acc[1][1], 0, 0, 0);
      } else {
        acc[0][0] = __builtin_amdgcn_mfma_f32_32x32x16_bf16(a0, b0, acc[0][0], 0, 0, 0);
        acc[0][1] = __builtin_amdgcn_mfma_f32_32x32x16_bf16(a0, b1, acc[0][1], 0, 0, 0);
        acc[1][0] = __builtin_amdgcn_mfma_f32_32x32x16_bf16(a1, b0, acc[1][0], 0, 0, 0);
        acc[1][1] = __builtin_amdgcn_mfma_f32_32x32x16_bf16(a1, b1, acc[1][1], 0, 0, 0);
      }
    }
    if (t + 1 < nk) {
      const int nb = cur ^ 1;
#pragma unroll
      for (int i = 0; i < 4; i++) {
        *(uint4*)(As + nb * BM * LDSS + (rb + 32 * i) * LDSS + kc) = ra[i];
        *(uint4*)(Bs + nb * BN * LDSS + (rb + 32 * i) * LDSS + kc) = rv[i];
      }
    }
    __syncthreads();
  }
}
struct NoHook { DI void operator()(int, f32x16 (&)[2][2]) const {} };

template <class EW, class DST>
DI void epi_transposed(bf16_t* sm, f32x16 (&acc)[2][2], const EW& ew, const DST& dst) {
  const int tid = threadIdx.x, lane = tid & 63, wid = tid >> 6, wm = wid >> 1, wn = wid & 1;
#pragma unroll
  for (int mi = 0; mi < 2; mi++)
#pragma unroll
    for (int g = 0; g < 4; g++) {
      const int ml = wm * 64 + mi * 32 + 8 * g + 4 * (lane >> 5);
      float v0[4], v1[4];
#pragma unroll
      for (int e = 0; e < 4; e++) { v0[e] = acc[mi][0][4 * g + e]; v1[e] = acc[mi][1][4 * g + e]; ew(ml + e, v0[e], v1[e]); }
      const int nl = wn * 64 + (lane & 31);
      uint2 w0, w1;
      w0.x = pk2(v0[0], v0[1]); w0.y = pk2(v0[2], v0[3]); w1.x = pk2(v1[0], v1[1]); w1.y = pk2(v1[2], v1[3]);
      *(uint2*)(sm + nl * TLD + ml) = w0;
      *(uint2*)(sm + (nl + 32) * TLD + ml) = w1;
    }
  __syncthreads();
  {
    const int nl = tid >> 1, r = tid & 1;
    bf16_t* d = dst(nl, r);
    const bf16_t* s = sm + nl * TLD + 64 * r;
#pragma unroll
    for (int i = 0; i < 8; i++) *(uint4*)(d + 8 * i) = *(const uint4*)(s + 8 * i);
  }
}

DI void ssm_pow(const P& p, int g, int dir, int pp, int j, float& re, float& im) {
  const int ia = (dir * 32 + g) * 64 + pp;
  const float lr = fminf(p.a_re[ia], -1e-4f), li = p.a_im[ia], dt = expf(p.log_dt[dir * 32 + g]);
  const float mag = expf(lr * dt * (float)j);
  double t = (double)li * (double)dt * (double)j * 0.15915494309189535;
  t -= rint(t);
  const float ang = (float)(t * 6.283185307179586);
  float s, c; sincosf(ang, &s, &c);
  re = mag * c; im = mag * s;
}
DI void ssm_coef(const P& p, int g, int dir, int pp, float& cr, float& ci) {
  const int ia = (dir * 32 + g) * 64 + pp;
  const float lr = fminf(p.a_re[ia], -1e-4f), li = p.a_im[ia];
  float ar, ai; ssm_pow(p, g, dir, pp, 1, ar, ai);
  const float nr = ar - 1.f, ni = ai, den = 1.f / (lr * lr + li * li);
  cr = (nr * lr + ni * li) * den; ci = (ni * lr - nr * li) * den;
}

template <class CM>
DI void transpose_job(float* tile, int item, const float* in, int ld, int Kdim, bf16_t* out, const CM& colmap, const float* sc0, const float* sc1) {
  const int nkt = Kdim / 64, nt = item / nkt, kt = item % nkt, tid = threadIdx.x;
  __syncthreads();
  {
    const int c = tid & 31, kr = tid >> 5, col = colmap(nt * 32 + c);
#pragma unroll
    for (int i = 0; i < 8; i++) {
      const int kl = kr + 8 * i, k = kt * 64 + kl;
      float v = in[(size_t)k * ld + col];
      if (sc0) v *= (k < 512 ? sc0[k] : sc1[k - 512]);
      tile[kl * 33 + c] = v;
    }
  }
  __syncthreads();
  {
    const int nl = tid >> 3, kc = tid & 7;
    float v[8];
#pragma unroll
    for (int j = 0; j < 8; j++) v[j] = tile[(kc * 8 + j) * 33 + nl];
    uint4 w; w.x = pk2(v[0], v[1]); w.y = pk2(v[2], v[3]); w.z = pk2(v[4], v[5]); w.w = pk2(v[6], v[7]);
    *(uint4*)(out + (size_t)(nt * 32 + nl) * Kdim + kt * 64 + kc * 8) = w;
  }
}

DI void phase0(const P& p, unsigned char* smraw) {
  float* smf = (float*)smraw;
  const int tid = threadIdx.x, nb = gridDim.x, bid = blockIdx.x;
  for (int item = bid; item < 96; item += nb) {
    __syncthreads();
    for (int i = tid; i < 17 * 1024; i += 256) {
      const int b = i >> 10, k = i & 1023;
      const float c = b == 0 ? p.cp[k] : p.cs[(b - 1) * 1024 + k];
      smf[i] = c / (1.f + __expf(-c));
    }
    __syncthreads();
    const int col = tid & 63, kq = tid >> 6, j = item * 64 + col;
    float a[17];
#pragma unroll
    for (int b = 0; b < 17; b++) a[b] = 0.f;
    for (int k = kq * 256; k < kq * 256 + 256; k++) {
      const float w = p.w_ada[(size_t)k * 6144 + j];
#pragma unroll
      for (int b = 0; b < 17; b++) a[b] += smf[b * 1024 + k] * w;
    }
    __syncthreads();
#pragma unroll
    for (int b = 0; b < 17; b++) smf[(kq * 17 + b) * 64 + col] = a[b];
    __syncthreads();
    for (int i = tid; i < 17 * 64; i += 256) {
      const int b = i >> 6, c2 = i & 63;
      const float s = smf[(0 * 17 + b) * 64 + c2] + smf[(1 * 17 + b) * 64 + c2] + smf[(2 * 17 + b) * 64 + c2] + smf[(3 * 17 + b) * 64 + c2];
      p.mod[b * 6144 + item * 64 + c2] = s + p.b_ada[item * 64 + c2];
    }
  }
  {
    auto ident = [](int n) { return n; };
    auto glumap = [](int n) { return ((n >> 5) & 1) * 512 + (n >> 6) * 32 + (n & 31); };
    const int n0 = 512, n1 = n0 + 256, n2 = n1 + 512, n3 = n2 + 2048, n4 = n3 + 2048;
    for (int item = bid; item < n4; item += nb) {
      if (item < n0) transpose_job(smf, item, p.w_in, 1024, 1024, p.wint, ident, nullptr, nullptr);
      else if (item < n1) transpose_job(smf, item - n0, p.w_glu, 1024, 512, p.wglut, glumap, nullptr, nullptr);
      else if (item < n2) transpose_job(smf, item - n1, p.w_out, 1024, 1024, p.woutt, ident, p.g_fo, p.g_so);
      else if (item < n3) transpose_job(smf, item - n2, p.w1, 4096, 1024, p.w1t, ident, nullptr, nullptr);
      else transpose_job(smf, item - n3, p.w2, 1024, 4096, p.w2t, ident, nullptr, nullptr);
    }
  }
  {
    __syncthreads();
    float2* cs = (float2*)smraw;
    for (int i = tid; i < 512; i += 256) { float s, c; sincosf((float)i * (6.283185307179586f / 512.f), &s, &c); cs[i] = make_float2(c, s); }
    __syncthreads();
    for (int item = bid; item < 2048; item += nb) {
      const int idx = item * 256 + tid, n = idx >> 10, k = idx & 1023, h = n >> 7, e = n & 127, c = k & 511;
      const bool is_sin = k >= 512;
      const float* wf = p.w_f + (size_t)h * 128 * 128 + e;
      float a = 0.f;
      for (int d = 0; d < 128; d++) {
        const float2 t = cs[((h * 128 + d) * c) & 511];
        a += (is_sin ? t.y : t.x) * wf[d * 128];
      }
      p.Mf[idx] = f2bf(a);
    }
  }
  {
    const int gsz = nb * 256, gt = bid * 256 + tid;
    for (int i = gt; i < 256 * 128; i += gsz) {
      const int n = i >> 7, k = i & 127, k1 = (n >> 6) * 32 + (n & 31), part = (n >> 5) & 1;
      float s, c; sincosf((float)((k1 * k) & 127) * (6.283185307179586f / 128.f), &s, &c);
      p.F1p[i] = f2bf(part ? -s : c);
    }
    for (int i = gt; i < 128 * 64; i += gsz) {
      const int n = i >> 6, k = i & 63, k1 = (n >> 6) * 32 + (n & 31), part = (n >> 5) & 1;
      float s, c; sincosf((float)((k1 * k) & 63) * (6.283185307179586f / 64.f), &s, &c);
      p.F1s[i] = f2bf(part ? -s : c);
    }
    for (int i = gt; i < 256 * 256; i += gsz) {
      const int n = i >> 8, k = i & 255, part = n >> 7, k2 = n & 127, l2 = k & 127, ki = k >> 7;
      float s, c; sincosf((float)((k2 * l2) & 127) * (6.283185307179586f / 128.f), &s, &c);
      p.F2p[i] = f2bf(part == 0 ? (ki == 0 ? c : s) : (ki == 0 ? -s : c));
    }
    for (int i = gt; i < 128 * 128; i += gsz) {
      const int n = i >> 7, k = i & 127, part = n >> 6, k2 = n & 63, l2 = k & 63, ki = k >> 6;
      float s, c; sincosf((float)((k2 * l2) & 63) * (6.283185307179586f / 64.f), &s, &c);
      p.F2s[i] = f2bf(part == 0 ? (ki == 0 ? c : s) : (ki == 0 ? -s : c));
    }
    for (int i = gt; i < LPR; i += gsz) { float s, c; sincosf((float)i * (6.283185307179586f / 16384.f), &s, &c); p.twp[i] = make_float2(c, s); }
    for (int i = gt; i < LSM; i += gsz) { float s, c; sincosf((float)i * (6.283185307179586f / 4096.f), &s, &c); p.tws[i] = make_float2(c, s); }
    for (int i = gt; i < 32 * 2 * 64 * 64; i += gsz) {
      const int s = i & 63, pp = (i >> 6) & 63, dir = (i >> 12) & 1, g = i >> 13;
      float pr, pi, cr, ci; ssm_pow(p, g, dir, pp, dir == 0 ? 63 - s : s, pr, pi); ssm_coef(p, g, dir, pp, cr, ci);
      const float qr = pr * cr - pi * ci, qi = pr * ci + pi * cr;
      const int ib = ((dir * 32 + g) * 64 + pp) * 16;
      float vr[16], vi[16];
#pragma unroll
      for (int h = 0; h < 16; h++) { const float br = p.b_re[ib + h], bi = p.b_im[ib + h]; vr[h] = qr * br - qi * bi; vi[h] = qr * bi + qi * br; }
      bf16_t* d0 = p.Bs + ((size_t)(g * 256 + dir * 128 + pp)) * 1024 + s * 16;
      bf16_t* d1 = d0 + 64 * 1024;
      uint4 w;
      w.x = pk2(vr[0], vr[1]); w.y = pk2(vr[2], vr[3]); w.z = pk2(vr[4], vr[5]); w.w = pk2(vr[6], vr[7]); *(uint4*)d0 = w;
      w.x = pk2(vr[8], vr[9]); w.y = pk2(vr[10], vr[11]); w.z = pk2(vr[12], vr[13]); w.w = pk2(vr[14], vr[15]); *(uint4*)(d0 + 8) = w;
      w.x = pk2(vi[0], vi[1]); w.y = pk2(vi[2], vi[3]); w.z = pk2(vi[4], vi[5]); w.w = pk2(vi[6], vi[7]); *(uint4*)d1 = w;
      w.x = pk2(vi[8], vi[9]); w.y = pk2(vi[10], vi[11]); w.z = pk2(vi[12], vi[13]); w.w = pk2(vi[14], vi[15]); *(uint4*)(d1 + 8) = w;
    }
    for (int i = gt; i < 32 * 64 * 2 * 64; i += gsz) {
      const int pp = i & 63, dir = (i >> 6) & 1, t = (i >> 7) & 63, g = i >> 13;
      float pr, pi; ssm_pow(p, g, dir, pp, dir == 0 ? t + 1 : 64 - t, pr, pi);
#pragma unroll
      for (int h = 0; h < 16; h++) {
        const int ic = ((dir * 32 + g) * 16 + h) * 64 + pp;
        const float cr = p.c_re[ic], ci = p.c_im[ic];
        bf16_t* d = p.Co + ((size_t)(g * 1024 + t * 16 + h)) * 256 + dir * 128 + pp;
        d[0] = f2bf(cr * pr - ci * pi);
        d[64] = f2bf(-(cr * pi + ci * pr));
      }
    }
    for (int i = gt; i < 32 * 2 * 64; i += gsz) {
      const int pp = i & 63, dir = (i >> 6) & 1, g = i >> 7;
      float pr, pi; ssm_pow(p, g, dir, pp, 64, pr, pi);
      p.AT[i * 2] = pr; p.AT[i * 2 + 1] = pi;
    }
  }
  {
    float2* q = (float2*)smraw;
    for (int item = bid; item < 32 * 127; item += nb) {
      const int g = item / 127, jj = item % 127, lag = jj - 63;
      __syncthreads();
      if (tid < 128) {
        const int dir = tid >> 6, pp = tid & 63;
        float2 v = make_float2(0.f, 0.f);
        if ((dir == 0 && lag >= 0) || (dir == 1 && lag <= 0)) {
          float pr, pi, cr, ci; ssm_pow(p, g, dir, pp, lag < 0 ? -lag : lag, pr, pi); ssm_coef(p, g, dir, pp, cr, ci);
          v = make_float2(pr * cr - pi * ci, pr * ci + pi * cr);
        }
        q[tid] = v;
      }
      __syncthreads();
      const int hp = tid >> 4, h = tid & 15;
      float a = 0.f;
#pragma unroll
      for (int dir = 0; dir < 2; dir++) {
        if ((dir == 0 && lag < 0) || (dir == 1 && lag > 0)) continue;
        for (int pp = 0; pp < 64; pp++) {
          const int ic = ((dir * 32 + g) * 16 + hp) * 64 + pp, ib = ((dir * 32 + g) * 64 + pp) * 16 + h;
          const float cr = p.c_re[ic], ci = p.c_im[ic], br = p.b_re[ib], bi = p.b_im[ib];
          const float2 qq = q[dir * 64 + pp];
          const float er = cr * qq.x - ci * qq.y, ei = cr * qq.y + ci * qq.x;
          a += er * br - ei * bi;
        }
      }
      if (lag == 0 && hp == h) a += p.ssm_d[g * 16 + h];
      p.Ktab[(size_t)item * 256 + tid] = f2bf(a);
    }
  }
}

DI void rownorm_mod(const P& p, bool from_x, const float* g, int sh_off, int sc_off) {
  const int lane = threadIdx.x & 63, wv = blockIdx.x * 4 + (threadIdx.x >> 6), nw = gridDim.x * 4;
  for (int tok = wv; tok < NTOK; tok += nw) {
    const float* src = from_x ? (tok < LPR ? p.xp + (size_t)tok * 1024 : p.xs + (size_t)(tok - LPR) * 1024) : p.out + (size_t)tok * 1024;
    f32x4 v[4]; float ss = 0.f;
#pragma unroll
    for (int i = 0; i < 4; i++) { v[i] = *(const f32x4*)(src + (i * 64 + lane) * 4); ss += v[i][0] * v[i][0] + v[i][1] * v[i][1] + v[i][2] * v[i][2] + v[i][3] * v[i][3]; }
    ss = wave_sum(ss);
    const float r = rsqrtf(ss * (1.f / 1024.f) + EPSV);
    const float* md = p.mod + batch_of(tok) * 6144;
#pragma unroll
    for (int i = 0; i < 4; i++) {
      const int c = (i * 64 + lane) * 4;
      const f32x4 gg = *(const f32x4*)(g + c), sc = *(const f32x4*)(md + sc_off + c), sh = *(const f32x4*)(md + sh_off + c);
      float o[4];
#pragma unroll
      for (int e = 0; e < 4; e++) o[e] = v[i][e] * r * gg[e] * (1.f + sc[e]) + sh[e];
      uint2 w; w.x = pk2(o[0], o[1]); w.y = pk2(o[2], o[3]);
      *(uint2*)(p.hb + (size_t)tok * 1024 + c) = w;
    }
  }
}
DI void final_norm(const P& p) {
  const int lane = threadIdx.x & 63, wv = blockIdx.x * 4 + (threadIdx.x >> 6), nw = gridDim.x * 4;
  for (int tok = wv; tok < NTOK; tok += nw) {
    float* src = p.out + (size_t)tok * 1024;
    f32x4 v[4]; float ss = 0.f;
#pragma unroll
    for (int i = 0; i < 4; i++) { v[i] = *(const f32x4*)(src + (i * 64 + lane) * 4); ss += v[i][0] * v[i][0] + v[i][1] * v[i][1] + v[i][2] * v[i][2] + v[i][3] * v[i][3]; }
    ss = wave_sum(ss);
    const float r = rsqrtf(ss * (1.f / 1024.f) + EPSV);
#pragma unroll
    for (int i = 0; i < 4; i++) {
      const int c = (i * 64 + lane) * 4;
      const f32x4 gg = *(const f32x4*)(p.g_final + c);
      f32x4 o;
#pragma unroll
      for (int e = 0; e < 4; e++) o[e] = v[i][e] * r * gg[e];
      *(f32x4*)(src + c) = o;
    }
  }
}

#define GEO const int tid = threadIdx.x, lane = tid & 63, wid = tid >> 6, wm = wid >> 1, wn = wid & 1, l31 = lane & 31, lh = lane >> 5; (void)tid; (void)wm; (void)wn; (void)l31; (void)lh;

DI void phase2(const P& p, bf16_t* sm) {
  GEO
  for (int t = blockIdx.x; t < 640 * 8; t += gridDim.x) {
    const int tm = t >> 3, sub = t & 7, m0 = tm * 128;
    f32x16 acc[2][2];
    if (sub < 4) {
      const int n0 = sub * 128;
      auto af = [&](int r, int k) {
        const int v = m0 + r; int tok;
        if (v < LPR) tok = ((v & 127) << 7) | (v >> 7);
        else { const int vs = v - LPR, w = vs & 4095; tok = LPR + (vs & ~4095) + ((w & 63) << 6) + (w >> 6); }
        return p.hb + (size_t)tok * 1024 + k;
      };
      auto bf = [&](int r, int k) { return p.wint + (size_t)(n0 + r) * 1024 + k; };
      gemm_main<false>(sm, 1024, af, bf, NoHook(), acc);
      auto ew = [](int, float&, float&) {};
      auto dst = [&](int nl, int r) {
        const int c = n0 + nl;
        if (m0 < LPR) return p.zT + (size_t)c * LPR + m0 + 64 * r;
        const int vs0 = m0 - LPR, b = vs0 >> 12, vl0 = vs0 & 4095;
        return p.zT + (size_t)512 * LPR + ((size_t)(b * 512 + c)) * 4096 + vl0 + 64 * r;
      };
      epi_transposed(sm, acc, ew, dst);
    } else {
      const int n0 = 512 + (sub - 4) * 128;
      auto af = [&](int r, int k) { return p.hb + (size_t)(m0 + r) * 1024 + k; };
      auto bf = [&](int r, int k) { return p.wint + (size_t)(n0 + r) * 1024 + k; };
      gemm_main<true>(sm, 1024, af, bf, NoHook(), acc);
#pragma unroll
      for (int mi = 0; mi < 2; mi++)
#pragma unroll
        for (int ni = 0; ni < 2; ni++)
#pragma unroll
          for (int g = 0; g < 4; g++) {
            const int tok = m0 + wm * 64 + mi * 32 + l31, col = n0 - 512 + wn * 64 + ni * 32 + 8 * g + 4 * lh;
            uint2 w; w.x = pk2(acc[mi][ni][4 * g], acc[mi][ni][4 * g + 1]); w.y = pk2(acc[mi][ni][4 * g + 2], acc[mi][ni][4 * g + 3]);
            *(uint2*)(p.zs + ((size_t)(col >> 4) * NTOK + tok) * 16 + (col & 15)) = w;
          }
    }
  }
}

template <int R>
DI void fft1_tile(const P& p, bf16_t* sm, int tm, int tn) {
  GEO
  constexpr bool pr = (R == 128);
  f32x16 acc[2][2];
  const bf16_t* Abase = pr ? p.zT + (size_t)tm * 128 * 128 : p.zT + (size_t)512 * LPR + (size_t)tm * 128 * 64;
  const bf16_t* Bbase = pr ? p.F1p + (size_t)tn * 128 * 128 : p.F1s;
  auto af = [&](int r, int k) { return Abase + r * R + k; };
  auto bf = [&](int r, int k) { return Bbase + r * R + k; };
  gemm_main<false>(sm, R, af, bf, NoHook(), acc);
  const int k1 = (tn * 2 + wn) * 32 + l31;
  const float2* tw = pr ? p.twp : p.tws;
  constexpr int lmask = pr ? 16383 : 4095, l2mask = R - 1;
  auto ew = [&](int ml, float& re, float& im) {
    const float2 w = tw[(k1 * (ml & l2mask)) & lmask];
    const float a = re * w.x + im * w.y, b = im * w.x - re * w.y;
    re = a; im = b;
  };
  auto dst = [&](int nl, int r) {
    const int part = (nl >> 5) & 1, kk1 = (tn * 2 + (nl >> 6)) * 32 + (nl & 31);
    if (pr) return p.Tt + ((size_t)(tm * 128 + kk1)) * 256 + part * 128 + 64 * r;
    return p.Tt + (size_t)65536 * 256 + ((size_t)((tm * 2 + r) * 64 + kk1)) * 128 + part * 64;
  };
  epi_transposed(sm, acc, ew, dst);
}
DI void phase3(const P& p, bf16_t* sm) {
  GEO
  const int NA = 1024, NB_ = 4096, NC = 640;
  for (int t = blockIdx.x; t < NA + NB_ + NC; t += gridDim.x) {
    if (t < NA) fft1_tile<128>(p, sm, t >> 1, t & 1);
    else if (t < NA + NB_) fft1_tile<64>(p, sm, t - NA, 0);
    else {
      f32x16 acc[2][2];
      const int u = t - NA - NB_, g = u / 20, rem = u % 20, m0 = (rem >> 1) * 128, n0 = (rem & 1) * 128;
      auto af = [&](int r, int k) { return p.zs + (size_t)g * NTOK * 16 + (size_t)(m0 + r) * 1024 + k; };
      auto bf = [&](int r, int k) { return p.Bs + (size_t)(g * 256 + n0 + r) * 1024 + k; };
      gemm_main<true>(sm, 1024, af, bf, NoHook(), acc);
#pragma unroll
      for (int mi = 0; mi < 2; mi++)
#pragma unroll
        for (int ni = 0; ni < 2; ni++)
#pragma unroll
          for (int gg = 0; gg < 4; gg++) {
            const int ch = m0 + wm * 64 + mi * 32 + l31, col = n0 + wn * 64 + ni * 32 + 8 * gg + 4 * lh;
            f32x4 v = {acc[mi][ni][4 * gg], acc[mi][ni][4 * gg + 1], acc[mi][ni][4 * gg + 2], acc[mi][ni][4 * gg + 3]};
            *(f32x4*)(p.S + ((size_t)ch * 32 + g) * 256 + col) = v;
          }
    }
  }
}

template <int R>
DI void fft2_tile(const P& p, bf16_t* sm, int tm, int tn) {
  constexpr bool pr = (R == 128);
  constexpr int K = 2 * R;
  f32x16 acc[2][2];
  const int ct = tm & 3, k1 = pr ? (tm >> 2) : ((tm >> 2) & 63), b = pr ? 0 : (tm >> 8);
  const bf16_t* Abase = pr ? p.Tt + ((size_t)(ct * 128) * 128 + k1) * 256 : p.Tt + (size_t)65536 * 256 + ((size_t)(b * 512 + ct * 128) * 64 + k1) * 128;
  constexpr int rstride = R * K;
  const bf16_t* Bbase = pr ? p.F2p + (size_t)tn * 128 * 256 : p.F2s;
  auto af = [&](int r, int k) { return Abase + (size_t)r * rstride + k; };
  auto bf = [&](int r, int k) { return Bbase + r * K + k; };
  gemm_main<false>(sm, K, af, bf, NoHook(), acc);
  auto ew = [](int, float&, float&) {};
  auto dst = [&](int nl, int r) {
    const int n = tn * 128 + nl, part = pr ? (n >> 7) : (n >> 6), k2 = n & (R - 1);
    const int tok = (pr ? 0 : LPR + b * 4096) + k1 + R * k2;
    return p.AF + (size_t)tok * 1024 + part * 512 + ct * 128 + 64 * r;
  };
  epi_transposed(sm, acc, ew, dst);
}
DI void phase4(const P& p, bf16_t* sm) {
  GEO
  for (int idx = blockIdx.x * 256 + tid; idx < 17 * 4096; idx += gridDim.x * 256) {
    const int seq = idx >> 12, rem = idx & 4095, g = rem >> 7, dir = (rem >> 6) & 1, pp = rem & 63;
    const int c0 = seq == 0 ? 0 : 256 + (seq - 1) * 64, nc = seq == 0 ? 256 : 64;
    const float ar = p.AT[((g * 2 + dir) * 64 + pp) * 2], ai = p.AT[((g * 2 + dir) * 64 + pp) * 2 + 1];
    float hr = 0.f, hi = 0.f;
    const size_t off = (size_t)g * 256 + dir * 128 + pp;
    for (int i0 = 0; i0 < nc; i0 += 8) {
      float sr[8], si[8];
#pragma unroll
      for (int j = 0; j < 8; j++) {
        const int c = c0 + (dir == 0 ? i0 + j : nc - 1 - i0 - j);
        sr[j] = p.S[(size_t)c * 8192 + off]; si[j] = p.S[(size_t)c * 8192 + off + 64];
      }
#pragma unroll
      for (int j = 0; j < 8; j++) {
        const int c = c0 + (dir == 0 ? i0 + j : nc - 1 - i0 - j);
        p.H[(size_t)c * 8192 + off] = f2bf(hr); p.H[(size_t)c * 8192 + off + 64] = f2bf(hi);
        const float nr = ar * hr - ai * hi + sr[j], ni = ar * hi + ai * hr + si[j];
        hr = nr; hi = ni;
      }
    }
  }
  for (int t = blockIdx.x; t < 1024 + 4096; t += gridDim.x) {
    if (t < 1024) fft2_tile<128>(p, sm, t >> 1, t & 1);
    else fft2_tile<64>(p, sm, t - 1024, 0);
  }
}

DI float gelu_tanh(float x) {
  const float u = 0.7978845608028654f * (x + 0.044715f * x * x * x);
  return x / (1.f + __expf(-2.f * u));
}

DI void phase5(const P& p, bf16_t* sm) {
  GEO
  for (int t = blockIdx.x; t < 2560 + 2560; t += gridDim.x) {
    f32x16 acc[2][2];
    if (t < 2560) {
      const int tm = t >> 2, tn = t & 3, m0 = tm * 128, n0 = tn * 128;
      auto af = [&](int r, int k) { return p.AF + (size_t)(m0 + r) * 1024 + k; };
      auto bf = [&](int r, int k) { return p.Mf + (size_t)(n0 + r) * 1024 + k; };
      gemm_main<true>(sm, 1024, af, bf, NoHook(), acc);
#pragma unroll
      for (int mi = 0; mi < 2; mi++) {
        const int tok = m0 + wm * 64 + mi * 32 + l31;
        const float scale = tok < LPR ? 3.4526698300124393e-4f : 6.905339660024879e-4f;
        float ss = 0.f;
#pragma unroll
        for (int ni = 0; ni < 2; ni++)
#pragma unroll
          for (int g = 0; g < 4; g++) {
            const int col = n0 + wn * 64 + ni * 32 + 8 * g + 4 * lh;
            const f32x4 bb = *(const f32x4*)(p.b_f + col);
            float o[4];
#pragma unroll
            for (int e = 0; e < 4; e++) { o[e] = acc[mi][ni][4 * g + e] * scale + bb[e]; ss += o[e] * o[e]; }
            uint2 w; w.x = pk2(o[0], o[1]); w.y = pk2(o[2], o[3]);
            *(uint2*)(p.yf + (size_t)tok * 512 + col) = w;
          }
        ss += __shfl_xor(ss, 32);
        if (lh == 0) p.ssf[tok * 8 + tn * 2 + wn] = ss;
      }
    } else {
      const int u = t - 2560, g = u / 80, rem = u % 80, m0 = (rem >> 3) * 128, n0 = (rem & 7) * 128;
      const bf16_t* Ug = p.zs + (size_t)g * NTOK * 16;
      const bf16_t* Kg = p.Ktab + (size_t)g * 127 * 256;
      auto af = [&](int r, int k) { return k < 1024 ? Ug + (size_t)(m0 + r) * 1024 + k : p.H + ((size_t)(m0 + r) * 32 + g) * 256 + (k - 1024); };
      auto bf = [&](int r, int k) {
        const int n = n0 + r;
        return k < 1024 ? Kg + (((n >> 4) - (k >> 4) + 63) * 256 + (n & 15) * 16 + (k & 15)) : p.Co + ((size_t)(g * 1024 + n)) * 256 + (k - 1024);
      };
      gemm_main<true>(sm, 1280, af, bf, NoHook(), acc);
#pragma unroll
      for (int mi = 0; mi < 2; mi++)
#pragma unroll
        for (int ni = 0; ni < 2; ni++)
#pragma unroll
          for (int gg = 0; gg < 4; gg++) {
            const int ch = m0 + wm * 64 + mi * 32 + l31, n = n0 + wn * 64 + ni * 32 + 8 * gg + 4 * lh;
            const int tok = ch * 64 + (n >> 4);
            float o[4];
#pragma unroll
            for (int e = 0; e < 4; e++) o[e] = gelu_tanh(acc[mi][ni][4 * gg + e]);
            uint2 w; w.x = pk2(o[0], o[1]); w.y = pk2(o[2], o[3]);
            *(uint2*)(p.gact + (size_t)tok * 512 + g * 16 + (n & 15)) = w;
          }
    }
  }
}

DI void phase6(const P& p, bf16_t* sm) {
  GEO
  for (int t = blockIdx.x; t < 640 * 8; t += gridDim.x) {
    f32x16 acc[2][2];
    const int tm = t >> 3, tn = t & 7, m0 = tm * 128, n0 = tn * 128;
    auto af = [&](int r, int k) { return p.gact + (size_t)(m0 + r) * 512 + k; };
    auto bf = [&](int r, int k) { return p.wglut + (size_t)(n0 + r) * 512 + k; };
    gemm_main<true>(sm, 512, af, bf, NoHook(), acc);
#pragma unroll
    for (int mi = 0; mi < 2; mi++) {
      const int tok = m0 + wm * 64 + mi * 32 + l31;
      float ss = 0.f;
#pragma unroll
      for (int g = 0; g < 4; g++) {
        const int j = (tn * 2 + wn) * 32 + 8 * g + 4 * lh;
        const f32x4 bv = *(const f32x4*)(p.b_glu + j), bg = *(const f32x4*)(p.b_glu + 512 + j);
        float o[4];
#pragma unroll
        for (int e = 0; e < 4; e++) {
          const float val = acc[mi][0][4 * g + e] + bv[e], gate = acc[mi][1][4 * g + e] + bg[e];
          o[e] = val / (1.f + __expf(-gate)); ss += o[e] * o[e];
        }
        uint2 w; w.x = pk2(o[0], o[1]); w.y = pk2(o[2], o[3]);
        *(uint2*)(p.ys + (size_t)tok * 512 + j) = w;
      }
      ss += __shfl_xor(ss, 32);
      if (lh == 0) p.sss[tok * 16 + tn * 2 + wn] = ss;
    }
  }
}

DI void phase7(const P& p, bf16_t* sm) {
  GEO
  for (int t = blockIdx.x; t < 640 * 8; t += gridDim.x) {
    f32x16 acc[2][2];
    const int tm = t >> 3, tn = t & 7, m0 = tm * 128, n0 = tn * 128;
    float ratio[2], rs[2];
#pragma unroll
    for (int mi = 0; mi < 2; mi++) {
      const int tok = m0 + wm * 64 + mi * 32 + l31;
      float sf = 0.f, s2 = 0.f;
#pragma unroll
      for (int i = 0; i < 8; i++) sf += p.ssf[tok * 8 + i];
#pragma unroll
      for (int i = 0; i < 16; i++) s2 += p.sss[tok * 16 + i];
      const float rf = rsqrtf(sf * (1.f / 512.f) + EPSV);
      rs[mi] = rsqrtf(s2 * (1.f / 512.f) + EPSV);
      ratio[mi] = rf / rs[mi];
    }
    auto af = [&](int r, int k) { return k < 512 ? p.yf + (size_t)(m0 + r) * 512 + k : p.ys + (size_t)(m0 + r) * 512 + (k - 512); };
    auto bf = [&](int r, int k) { return p.woutt + (size_t)(n0 + r) * 1024 + k; };
    auto hk = [&](int kt, f32x16 (&a)[2][2]) {
      if (kt == 8) {
#pragma unroll
        for (int mi = 0; mi < 2; mi++)
#pragma unroll
          for (int ni = 0; ni < 2; ni++)
#pragma unroll
            for (int e = 0; e < 16; e++) a[mi][ni][e] *= ratio[mi];
      }
    };
    gemm_main<true>(sm, 1024, af, bf, hk, acc);
#pragma unroll
    for (int mi = 0; mi < 2; mi++) {
      const int tok = m0 + wm * 64 + mi * 32 + l31;
      const float* xr = tok < LPR ? p.xp + (size_t)tok * 1024 : p.xs + (size_t)(tok - LPR) * 1024;
      const float* g1 = p.mod + batch_of(tok) * 6144 + 2048;
#pragma unroll
      for (int ni = 0; ni < 2; ni++)
#pragma unroll
        for (int g = 0; g < 4; g++) {
          const int col = n0 + wn * 64 + ni * 32 + 8 * g + 4 * lh;
          const f32x4 xv = *(const f32x4*)(xr + col), gv = *(const f32x4*)(g1 + col);
          f32x4 o;
#pragma unroll
          for (int e = 0; e < 4; e++) o[e] = xv[e] + gv[e] * acc[mi][ni][4 * g + e] * rs[mi];
          *(f32x4*)(p.out + (size_t)tok * 1024 + col) = o;
        }
    }
  }
}

DI void phase8(const P& p, bf16_t* sm) {
  GEO
  for (int t = blockIdx.x; t < 640 * 32; t += gridDim.x) {
    f32x16 acc[2][2];
    const int tm = t >> 5, tn = t & 31, m0 = tm * 128, n0 = tn * 128;
    auto af = [&](int r, int k) { return p.hb + (size_t)(m0 + r) * 1024 + k; };
    auto bf = [&](int r, int k) { return p.w1t + (size_t)(n0 + r) * 1024 + k; };
    gemm_main<true>(sm, 1024, af, bf, NoHook(), acc);
#pragma unroll
    for (int mi = 0; mi < 2; mi++) {
      const int tok = m0 + wm * 64 + mi * 32 + l31;
#pragma unroll
      for (int ni = 0; ni < 2; ni++)
#pragma unroll
        for (int g = 0; g < 4; g++) {
          const int col = n0 + wn * 64 + ni * 32 + 8 * g + 4 * lh;
          const f32x4 bb = *(const f32x4*)(p.b1 + col);
          float o[4];
#pragma unroll
          for (int e = 0; e < 4; e++) { const float v = fmaxf(acc[mi][ni][4 * g + e] + bb[e], 0.f); o[e] = v * v; }
          uint2 w; w.x = pk2(o[0], o[1]); w.y = pk2(o[2], o[3]);
          *(uint2*)(p.hid + (size_t)tok * 4096 + col) = w;
        }
    }
  }
}

DI void phase9(const P& p, bf16_t* sm) {
  GEO
  for (int t = blockIdx.x; t < 640 * 8; t += gridDim.x) {
    f32x16 acc[2][2];
    const int tm = t >> 3, tn = t & 7, m0 = tm * 128, n0 = tn * 128;
    auto af = [&](int r, int k) { return p.hid + (size_t)(m0 + r) * 4096 + k; };
    auto bf = [&](int r, int k) { return p.w2t + (size_t)(n0 + r) * 4096 + k; };
    gemm_main<true>(sm, 4096, af, bf, NoHook(), acc);
#pragma unroll
    for (int mi = 0; mi < 2; mi++) {
      const int tok = m0 + wm * 64 + mi * 32 + l31;
      const float* g2 = p.mod + batch_of(tok) * 6144 + 5120;
      float* xr = p.out + (size_t)tok * 1024;
#pragma unroll
      for (int ni = 0; ni < 2; ni++)
#pragma unroll
        for (int g = 0; g < 4; g++) {
          const int col = n0 + wn * 64 + ni * 32 + 8 * g + 4 * lh;
          const f32x4 xv = *(const f32x4*)(xr + col), gv = *(const f32x4*)(g2 + col), bb = *(const f32x4*)(p.b2 + col);
          f32x4 o;
#pragma unroll
          for (int e = 0; e < 4; e++) o[e] = xv[e] + gv[e] * (acc[mi][ni][4 * g + e] + bb[e]);
          *(f32x4*)(xr + col) = o;
        }
    }
  }
}

template <int PH>
DI void run_phase(const P& p, unsigned char* smraw) {
  bf16_t* sm = (bf16_t*)smraw;
  if (PH == 0) phase0(p, smraw);
  else if (PH == 1) rownorm_mod(p, true, p.g_mix, 0, 1024);
  else if (PH == 2) phase2(p, sm);
  else if (PH == 3) phase3(p, sm);
  else if (PH == 4) phase4(p, sm);
  else if (PH == 5) phase5(p, sm);
  else if (PH == 6) phase6(p, sm);
  else if (PH == 7) phase7(p, sm);
  else if (PH == 8) rownorm_mod(p, false, p.g_mlp, 3072, 4096);
  else if (PH == 9) phase8(p, sm);
  else if (PH == 10) phase9(p, sm);
  else if (PH == 11) final_norm(p);
}

extern __shared__ __attribute__((aligned(16))) unsigned char dyn_smem[];

#if !ONE_LAUNCH
template <int PH>
__global__ void __launch_bounds__(256, 2) k_phase(P p) { run_phase<PH>(p, dyn_smem); }

#else
__global__ void __launch_bounds__(256, 2) k_mega(P p) {
  cg::grid_group grid = cg::this_grid();
  run_phase<0>(p, dyn_smem); grid.sync();
  run_phase<1>(p, dyn_smem); grid.sync();
  run_phase<2>(p, dyn_smem); grid.sync();
  run_phase<3>(p, dyn_smem); grid.sync();
  run_phase<4>(p, dyn_smem); grid.sync();
  run_phase<5>(p, dyn_smem); grid.sync();
  run_phase<6>(p, dyn_smem); grid.sync();
  run_phase<7>(p, dyn_smem); grid.sync();
  run_phase<8>(p, dyn_smem); grid.sync();
  run_phase<9>(p, dyn_smem); grid.sync();
  run_phase<10>(p, dyn_smem); grid.sync();
  run_phase<11>(p, dyn_smem);
}

#endif

#ifdef DBGCHK
__global__ void k_chk_bf16(const bf16_t* buf, size_t n, unsigned* flag) {
  bool bad = false;
  for (size_t i = (size_t)blockIdx.x * 256 + threadIdx.x; i < n; i += (size_t)gridDim.x * 256) { if ((buf[i] & 0x7f80u) == 0x7f80u) bad = true; }
  if (bad) atomicOr(flag, 1u);
}
__global__ void k_chk_f32(const float* buf, size_t n, unsigned* flag) {
  bool bad = false;
  for (size_t i = (size_t)blockIdx.x * 256 + threadIdx.x; i < n; i += (size_t)gridDim.x * 256) { if (!(fabsf(buf[i]) < 1e30f)) bad = true; }
  if (bad) atomicOr(flag, 1u);
}
__global__ void k_mag_bf16(const bf16_t* buf, size_t n, float lim, unsigned* flag) {
  bool bad = false;
  for (size_t i = (size_t)blockIdx.x * 256 + threadIdx.x; i < n; i += (size_t)gridDim.x * 256) { const float v = __uint_as_float((unsigned)buf[i] << 16); if (!(fabsf(v) < lim)) bad = true; }
  if (bad) atomicOr(flag, 1u);
}
__global__ void k_mag_f32(const float* buf, size_t n, float lim, unsigned* flag) {
  bool bad = false;
  for (size_t i = (size_t)blockIdx.x * 256 + threadIdx.x; i < n; i += (size_t)gridDim.x * 256) { if (!(fabsf(buf[i]) < lim)) bad = true; }
  if (bad) atomicOr(flag, 1u);
}
DI float bf2f(bf16_t v) { return __uint_as_float((unsigned)v << 16); }
__global__ void k_selftest(P p, unsigned* res) {
  const int s = blockIdx.x * 256 + threadIdx.x;
  const int tok = (int)(((long long)s * 2659 + 17) % NTOK), col = (s * 37 + 5) & 511;
  float r1 = 0.f, r2 = 0.f;
  for (int k = 0; k < 1024; k++) { const float h = bf2f(p.hb[(size_t)tok * 1024 + k]); r1 += h * bf2f(p.wint[(size_t)(512 + col) * 1024 + k]); r2 += h * bf2f(p.wint[(size_t)col * 1024 + k]); }
  const float g1 = bf2f(p.zs[((size_t)(col >> 4) * NTOK + tok) * 16 + (col & 15)]);
  float g2;
  if (tok < LPR) { const int l1 = tok >> 7, l2 = tok & 127; g2 = bf2f(p.zT[(size_t)col * LPR + l2 * 128 + l1]); }
  else { const int ts = tok - LPR, b = ts >> 12, w = ts & 4095, l1 = w >> 6, l2 = w & 63; g2 = bf2f(p.zT[(size_t)512 * LPR + ((size_t)(b * 512 + col)) * 4096 + l2 * 64 + l1]); }
  float d1 = fabsf(r1 - g1), d2 = fabsf(r2 - g2);
  if (!(d1 < 1e6f)) d1 = 1e6f;
  if (!(d2 < 1e6f)) d2 = 1e6f;
  atomicMax(res, __float_as_uint(d1)); atomicMax(res + 1, __float_as_uint(d2));
}
__global__ void k_report2(float* out, const unsigned* res) {
  const float d1 = __uint_as_float(res[0]), d2 = __uint_as_float(res[1]);
  for (size_t i = (size_t)blockIdx.x * 256 + threadIdx.x; i < (size_t)NTOK * 1024; i += (size_t)gridDim.x * 256) {
    float v = 0.f;
    if (i < (size_t)2560 * 1024) v = 10.f * (1.f + d2);
    if (i == (size_t)20000 * 1024) v = 1e4f * (1.f + d1);
    out[i] = v;
  }
}
__global__ void k_report(float* out, const unsigned* flags, int nflags) {
  const size_t seg = (size_t)NTOK * 1024 / 32;
  for (size_t i = (size_t)blockIdx.x * 256 + threadIdx.x; i < (size_t)NTOK * 1024; i += (size_t)gridDim.x * 256) {
    const int s = (int)(i / seg);
    float v = 0.f;
    if (s < nflags && flags[s]) { v = 1.f; for (int j = 0; j < nflags - s; j++) v *= 10.f; }
    out[i] = v;
  }
}
#endif
#if !ONE_LAUNCH
template <int PH>
static void launch_phase(const P& p, int grid, hipStream_t stream) {
  (void)hipFuncSetAttribute((const void*)k_phase<PH>, hipFuncAttributeMaxDynamicSharedMemorySize, SMEM_BYTES);
  hipLaunchKernelGGL(k_phase<PH>, dim3(grid), dim3(256), SMEM_BYTES, stream, p);
}

#endif
extern "C" void kernel_launch(void* const* d_in, const int* in_sizes, int n_in, void* d_out, int out_size, void* d_ws, size_t ws_size,
                              hipStream_t stream) {
  P p{};
  const float** f = (const float**)&p;
  for (int i = 0; i < 29; i++) f[i] = (const float*)d_in[i];
  p.out = (float*)d_out;
  size_t off = 0;
  auto alloc = [&](size_t bytes) { void* r = (char*)d_ws + off; off += (bytes + 255) & ~(size_t)255; return r; };
  p.mod = (float*)alloc(17 * 6144 * 4);
  p.AT = (float*)alloc(32 * 2 * 64 * 2 * 4);
  p.ssf = (float*)alloc((size_t)NTOK * 8 * 4);
  p.sss = (float*)alloc((size_t)NTOK * 16 * 4);
  p.twp = (float2*)alloc(LPR * 8);
  p.tws = (float2*)alloc(LSM * 8);
  p.wint = (bf16_t*)alloc(1024 * 1024 * 2);
  p.wglut = (bf16_t*)alloc(1024 * 512 * 2);
  p.woutt = (bf16_t*)alloc(1024 * 1024 * 2);
  p.w1t = (bf16_t*)alloc((size_t)4096 * 1024 * 2);
  p.w2t = (bf16_t*)alloc((size_t)4096 * 1024 * 2);
  p.Mf = (bf16_t*)alloc(512 * 1024 * 2);
  p.F1p = (bf16_t*)alloc(256 * 128 * 2);
  p.F1s = (bf16_t*)alloc(128 * 64 * 2);
  p.F2p = (bf16_t*)alloc(256 * 256 * 2);
  p.F2s = (bf16_t*)alloc(128 * 128 * 2);
  p.Ktab = (bf16_t*)alloc((size_t)32 * 127 * 256 * 2);
  p.Bs = (bf16_t*)alloc((size_t)32 * 256 * 1024 * 2);
  p.Co = (bf16_t*)alloc((size_t)32 * 1024 * 256 * 2);
  p.hb = (bf16_t*)alloc((size_t)NTOK * 1024 * 2);
  p.Tt = p.hb;
  const size_t rbase = off;
  p.zT = (bf16_t*)alloc((size_t)NTOK * 512 * 2);
  p.zs = (bf16_t*)alloc((size_t)NTOK * 512 * 2);
  p.AF = (bf16_t*)alloc((size_t)NTOK * 1024 * 2);
  p.S = (float*)alloc((size_t)1280 * 32 * 256 * 4);
  p.H = (bf16_t*)alloc((size_t)1280 * 32 * 256 * 2);
  p.yf = (bf16_t*)alloc((size_t)NTOK * 512 * 2);
  p.gact = (bf16_t*)alloc((size_t)NTOK * 512 * 2);
  p.ys = (bf16_t*)alloc((size_t)NTOK * 512 * 2);
  p.hid = (bf16_t*)((char*)d_ws + rbase);
  const size_t need = rbase + (size_t)NTOK * 4096 * 2;
  if (need + 256 > ws_size || off > ws_size) { fprintf(stderr, "workspace too small: need %zu have %zu\n", need > off ? need : off, ws_size); return; }

  static int grid_blocks = 0;
  if (!grid_blocks) {
    int dev = 0, cus = 0, per_cu = 0;
    (void)hipGetDevice(&dev);
    (void)hipDeviceGetAttribute(&cus, hipDeviceAttributeMultiprocessorCount, dev);
#if ONE_LAUNCH
    (void)hipFuncSetAttribute((const void*)k_mega, hipFuncAttributeMaxDynamicSharedMemorySize, SMEM_BYTES);
    (void)hipOccupancyMaxActiveBlocksPerMultiprocessor(&per_cu, k_mega, 256, SMEM_BYTES);
#else
    per_cu = 2;
#endif
    if (per_cu < 1) per_cu = 1;
    grid_blocks = cus * per_cu;
  }
#if ONE_LAUNCH
  void* args[] = {&p};
  hipError_t e = hipLaunchCooperativeKernel((void*)k_mega, dim3(grid_blocks), dim3(256), args, SMEM_BYTES, stream);
  if (e != hipSuccess) fprintf(stderr, "cooperative launch failed: %s (grid %d)\n", hipGetErrorString(e), grid_blocks);
#else
#ifdef DBGCHK
  unsigned* flags = (unsigned*)((char*)d_ws + need);
  (void)hipMemsetAsync(flags, 0, 256, stream);
  int nf = 0;
#define CHKB(ptr, n) hipLaunchKernelGGL(k_chk_bf16, dim3(1024), dim3(256), 0, stream, (const bf16_t*)(ptr), (size_t)(n), flags + nf); nf++;
#define CHKF(ptr, n) hipLaunchKernelGGL(k_chk_f32, dim3(1024), dim3(256), 0, stream, (const float*)(ptr), (size_t)(n), flags + nf); nf++;
#define MAGB(ptr, n, lim) hipLaunchKernelGGL(k_mag_bf16, dim3(1024), dim3(256), 0, stream, (const bf16_t*)(ptr), (size_t)(n), (float)(lim), flags + nf); nf++;
#define MAGF(ptr, n, lim) hipLaunchKernelGGL(k_mag_f32, dim3(1024), dim3(256), 0, stream, (const float*)(ptr), (size_t)(n), (float)(lim), flags + nf); nf++;
  launch_phase<0>(p, grid_blocks, stream);
  MAGF(p.mod, 17 * 6144, 20.f) MAGB(p.wint, 1024 * 1024, 2.f)
  launch_phase<1>(p, grid_blocks, stream);
  MAGB(p.hb, (size_t)NTOK * 1024, 200.f)
  launch_phase<2>(p, grid_blocks, stream);
  MAGB(p.zs, (size_t)NTOK * 512, 1000.f) MAGB(p.zT, (size_t)NTOK * 512, 1000.f)
  hipLaunchKernelGGL(k_selftest, dim3(16), dim3(256), 0, stream, p, flags + 32);
  hipLaunchKernelGGL(k_report2, dim3(2048), dim3(256), 0, stream, p.out, flags + 32);
#else
  launch_phase<0>(p, grid_blocks, stream);
  launch_phase<1>(p, grid_blocks, stream);
  launch_phase<2>(p, grid_blocks, stream);
  launch_phase<3>(p, grid_blocks, stream);
  launch_phase<4>(p, grid_blocks, stream);
  launch_phase<5>(p, grid_blocks, stream);
  launch_phase<6>(p, grid_blocks, stream);
  launch_phase<7>(p, grid_blocks, stream);
  launch_phase<8>(p, grid_blocks, stream);
  launch_phase<9>(p, grid_blocks, stream);
  launch_phase<10>(p, grid_blocks, stream);
  launch_phase<11>(p, grid_blocks, stream);
#endif
#endif
}
```

```cpp
#include <hip/hip_runtime.h>
#include <hip/hip_cooperative_groups.h>
#include <stdint.h>
#include <stdio.h>
namespace cg = cooperative_groups;

#ifndef ONE_LAUNCH
#define ONE_LAUNCH 1
#endif

#define DI __device__ __forceinline__
typedef unsigned short bf16_t;
typedef short bf16x8 __attribute__((ext_vector_type(8)));
typedef float f32x16 __attribute__((ext_vector_type(16)));
typedef float f32x4 __attribute__((ext_vector_type(4)));

constexpr int NTOK = 81920, LPR = 16384, LSM = 4096;
constexpr int BM = 128, BN = 128, BK = 64, LDSS = 72, TLD = 136;
constexpr int SMEM_BYTES = 2 * 2 * BM * LDSS * 2;
constexpr float EPSV = 1e-6f;

constexpr size_t al256(size_t x) { return (x + 255) & ~(size_t)255; }
constexpr size_t O_mod = 0;
constexpr size_t O_AT = O_mod + al256(17 * 6144 * 4);
constexpr size_t O_ssf = O_AT + al256(32 * 2 * 64 * 2 * 4);
constexpr size_t O_sss = O_ssf + al256((size_t)NTOK * 8 * 4);
constexpr size_t O_twp = O_sss + al256((size_t)NTOK * 16 * 4);
constexpr size_t O_tws = O_twp + al256(LPR * 8);
constexpr size_t O_wint = O_tws + al256(LSM * 8);
constexpr size_t O_wglut = O_wint + al256(1024 * 1024 * 2);
constexpr size_t O_woutt = O_wglut + al256(1024 * 512 * 2);
constexpr size_t O_w1t = O_woutt + al256(1024 * 1024 * 2);
constexpr size_t O_w2t = O_w1t + al256((size_t)4096 * 1024 * 2);
constexpr size_t O_Mf = O_w2t + al256((size_t)4096 * 1024 * 2);
constexpr size_t O_F1p = O_Mf + al256(512 * 1024 * 2);
constexpr size_t O_F1s = O_F1p + al256(256 * 128 * 2);
constexpr size_t O_F2p = O_F1s + al256(128 * 64 * 2);
constexpr size_t O_F2s = O_F2p + al256(256 * 256 * 2);
constexpr size_t O_Ktab = O_F2s + al256(128 * 128 * 2);
constexpr size_t O_Bs = O_Ktab + al256((size_t)32 * 127 * 256 * 2);
constexpr size_t O_Co = O_Bs + al256((size_t)32 * 256 * 1024 * 2);
constexpr size_t O_hb = O_Co + al256((size_t)32 * 1024 * 256 * 2);
constexpr size_t O_zT = O_hb + al256((size_t)NTOK * 1024 * 2);
constexpr size_t O_zs = O_zT + al256((size_t)NTOK * 512 * 2);
constexpr size_t O_AF = O_zs + al256((size_t)NTOK * 512 * 2);
constexpr size_t O_S = O_AF + al256((size_t)NTOK * 1024 * 2);
constexpr size_t O_H = O_S + al256((size_t)1280 * 32 * 256 * 4);
constexpr size_t O_yf = O_H + al256((size_t)1280 * 32 * 256 * 2);
constexpr size_t O_gact = O_yf + al256((size_t)NTOK * 512 * 2);
constexpr size_t O_ys = O_gact + al256((size_t)NTOK * 512 * 2);
constexpr size_t O_END = O_ys + al256((size_t)NTOK * 512 * 2);
constexpr size_t O_Tt = O_hb;
constexpr size_t O_hid = O_zT;
constexpr size_t WS_NEED = (O_hid + (size_t)NTOK * 4096 * 2 > O_END ? O_hid + (size_t)NTOK * 4096 * 2 : O_END);
struct P {
  const float *xp, *xs, *cp, *cs, *w_ada, *b_ada, *g_mix, *w_in, *w_f, *b_f, *a_re, *a_im, *log_dt, *b_re, *b_im, *c_re, *c_im,
      *ssm_d, *w_glu, *b_glu, *g_fo, *g_so, *w_out, *g_mlp, *w1, *b1, *w2, *b2, *g_final;
  float* out;
  char* ws;
  __device__ __forceinline__ float* mod() const { return (float*)(ws + O_mod); }
  __device__ __forceinline__ float* AT() const { return (float*)(ws + O_AT); }
  __device__ __forceinline__ float* ssf() const { return (float*)(ws + O_ssf); }
  __device__ __forceinline__ float* sss() const { return (float*)(ws + O_sss); }
  __device__ __forceinline__ float2* twp() const { return (float2*)(ws + O_twp); }
  __device__ __forceinline__ float2* tws() const { return (float2*)(ws + O_tws); }
  __device__ __forceinline__ bf16_t* wint() const { return (bf16_t*)(ws + O_wint); }
  __device__ __forceinline__ bf16_t* wglut() const { return (bf16_t*)(ws + O_wglut); }
  __device__ __forceinline__ bf16_t* woutt() const { return (bf16_t*)(ws + O_woutt); }
  __device__ __forceinline__ bf16_t* w1t() const { return (bf16_t*)(ws + O_w1t); }
  __device__ __forceinline__ bf16_t* w2t() const { return (bf16_t*)(ws + O_w2t); }
  __device__ __forceinline__ bf16_t* Mf() const { return (bf16_t*)(ws + O_Mf); }
  __device__ __forceinline__ bf16_t* F1p() const { return (bf16_t*)(ws + O_F1p); }
  __device__ __forceinline__ bf16_t* F1s() const { return (bf16_t*)(ws + O_F1s); }
  __device__ __forceinline__ bf16_t* F2p() const { return (bf16_t*)(ws + O_F2p); }
  __device__ __forceinline__ bf16_t* F2s() const { return (bf16_t*)(ws + O_F2s); }
  __device__ __forceinline__ bf16_t* Ktab() const { return (bf16_t*)(ws + O_Ktab); }
  __device__ __forceinline__ bf16_t* Bs() const { return (bf16_t*)(ws + O_Bs); }
  __device__ __forceinline__ bf16_t* Co() const { return (bf16_t*)(ws + O_Co); }
  __device__ __forceinline__ bf16_t* hb() const { return (bf16_t*)(ws + O_hb); }
  __device__ __forceinline__ bf16_t* zT() const { return (bf16_t*)(ws + O_zT); }
  __device__ __forceinline__ bf16_t* zs() const { return (bf16_t*)(ws + O_zs); }
  __device__ __forceinline__ bf16_t* AF() const { return (bf16_t*)(ws + O_AF); }
  __device__ __forceinline__ float* S() const { return (float*)(ws + O_S); }
  __device__ __forceinline__ bf16_t* H() const { return (bf16_t*)(ws + O_H); }
  __device__ __forceinline__ bf16_t* yf() const { return (bf16_t*)(ws + O_yf); }
  __device__ __forceinline__ bf16_t* gact() const { return (bf16_t*)(ws + O_gact); }
  __device__ __forceinline__ bf16_t* ys() const { return (bf16_t*)(ws + O_ys); }
  __device__ __forceinline__ bf16_t* Tt() const { return (bf16_t*)(ws + O_Tt); }
  __device__ __forceinline__ bf16_t* hid() const { return (bf16_t*)(ws + O_hid); }
};

typedef float f32x2v __attribute__((ext_vector_type(2)));
typedef __bf16 bf16x2v __attribute__((ext_vector_type(2)));
DI uint32_t pk2(float lo, float hi) { const f32x2v v = {lo, hi}; const bf16x2v r = __builtin_convertvector(v, bf16x2v); return __builtin_bit_cast(uint32_t, r); }
DI bf16_t f2bf(float f) { return (bf16_t)(pk2(f, 0.f) & 0xffffu); }
DI int batch_of(int tok) { return tok < LPR ? 0 : 1 + ((tok - LPR) >> 12); }
DI float wave_sum(float v) {
  v += __shfl_xor(v, 32); v += __shfl_xor(v, 16); v += __shfl_xor(v, 8); v += __shfl_xor(v, 4); v += __shfl_xor(v, 2); v += __shfl_xor(v, 1);
  return v;
}

template <bool SWAP, class AF, class BF, class HK>
DI void gemm_main(bf16_t* sm, int K, const AF& af, const BF& bf, const HK& hk, f32x16 (&acc)[2][2]) {
  const int tid = threadIdx.x, lane = tid & 63, wid = tid >> 6, wm = wid >> 1, wn = wid & 1;
  const int kc = (tid & 7) * 8, rb = tid >> 3;
  bf16_t* As = sm;
  bf16_t* Bs = sm + 2 * BM * LDSS;
  uint4 ra[4], rv[4];
#pragma unroll
  for (int i = 0; i < 2; i++)
#pragma unroll
    for (int j = 0; j < 2; j++)
#pragma unroll
      for (int e = 0; e < 16; e++) acc[i][j][e] = 0.f;
  __syncthreads();
#pragma unroll
  for (int i = 0; i < 4; i++) { ra[i] = *(const uint4*)af(rb + 32 * i, kc); rv[i] = *(const uint4*)bf(rb + 32 * i, kc); }
#pragma unroll
  for (int i = 0; i < 4; i++) { *(uint4*)(As + (rb + 32 * i) * LDSS + kc) = ra[i]; *(uint4*)(Bs + (rb + 32 * i) * LDSS + kc) = rv[i]; }
  __syncthreads();
  const int nk = K / BK;
  for (int t = 0; t < nk; t++) {
    const int cur = t & 1;
    if (t + 1 < nk) {
      const int k = (t + 1) * BK + kc;
#pragma unroll
      for (int i = 0; i < 4; i++) { ra[i] = *(const uint4*)af(rb + 32 * i, k); rv[i] = *(const uint4*)bf(rb + 32 * i, k); }
    }
    hk(t, acc);
    const bf16_t* Ab = As + cur * BM * LDSS + (wm * 64 + (lane & 31)) * LDSS + (lane >> 5) * 8;
    const bf16_t* Bb = Bs + cur * BN * LDSS + (wn * 64 + (lane & 31)) * LDSS + (lane >> 5) * 8;
#pragma unroll
    for (int ks = 0; ks < 4; ks++) {
      const bf16x8 a0 = *(const bf16x8*)(Ab + ks * 16), a1 = *(const bf16x8*)(Ab + 32 * LDSS + ks * 16);
      const bf16x8 b0 = *(const bf16x8*)(Bb + ks * 16), b1 = *(const bf16x8*)(Bb + 32 * LDSS + ks * 16);
      if (SWAP) {
        acc[0][0] = __builtin_amdgcn_mfma_f32_32x32x16_bf16(b0, a0, acc[0][0], 0, 0, 0);
        acc[0][1] = __builtin_amdgcn_mfma_f32_32x32x16_bf16(b1, a0, acc[0][1], 0, 0, 0);
        acc[1][0] = __builtin_amdgcn_mfma_f32_32x32x16_bf16(b0, a1, acc[1][0], 0, 0, 0);
        acc[1][1] = __builtin_amdgcn_mfma_f32_32x32x16_bf16(b1, a1, acc[1][1], 0, 0, 0);
      } else {
        acc[0][0] = __builtin_amdgcn_mfma_f32_32x32x16_bf16(a0, b0, acc[0][0], 0, 0, 0);
        acc[0][1] = __builtin_amdgcn_mfma_f32_32x32x16_bf16(a0, b1, acc[0][1], 0, 0, 0);
        acc[1][0] = __builtin_amdgcn_mfma_f32_32x32x16_bf16(a1, b0, acc[1][0], 0, 0, 0);
        acc[1][1] = __builtin_amdgcn_mfma_f32_32x32x16_bf16(a1, b1, acc[1][1], 0, 0, 0);
      }
    }
    if (t + 1 < nk) {
      const int nb = cur ^ 1;
#pragma unroll
      for (int i = 0; i < 4; i++) {
        *(uint4*)(As + nb * BM * LDSS + (rb + 32 * i) * LDSS + kc) = ra[i];
        *(uint4*)(Bs + nb * BN * LDSS + (rb + 32 * i) * LDSS + kc) = rv[i];
      }
    }
    __syncthreads();
  }
}
struct NoHook { DI void operator()(int, f32x16 (&)[2][2]) const {} };

template <class EW, class DST>
DI void epi_transposed(bf16_t* sm, f32x16 (&acc)[2][2], const EW& ew, const DST& dst) {
  const int tid = threadIdx.x, lane = tid & 63, wid = tid >> 6, wm = wid >> 1, wn = wid & 1;
#pragma unroll
  for (int mi = 0; mi < 2; mi++)
#pragma unroll
    for (int g = 0; g < 4; g++) {
      const int ml = wm * 64 + mi * 32 + 8 * g + 4 * (lane >> 5);
      float v0[4], v1[4];
#pragma unroll
      for (int e = 0; e < 4; e++) { v0[e] = acc[mi][0][4 * g + e]; v1[e] = acc[mi][1][4 * g + e]; ew(ml + e, v0[e], v1[e]); }
      const int nl = wn * 64 + (lane & 31);
      uint2 w0, w1;
      w0.x = pk2(v0[0], v0[1]); w0.y = pk2(v0[2], v0[3]); w1.x = pk2(v1[0], v1[1]); w1.y = pk2(v1[2], v1[3]);
      *(uint2*)(sm + nl * TLD + ml) = w0;
      *(uint2*)(sm + (nl + 32) * TLD + ml) = w1;
    }
  __syncthreads();
  {
    const int nl = tid >> 1, r = tid & 1;
    bf16_t* d = dst(nl, r);
    const bf16_t* s = sm + nl * TLD + 64 * r;
#pragma unroll
    for (int i = 0; i < 8; i++) *(uint4*)(d + 8 * i) = *(const uint4*)(s + 8 * i);
  }
}

DI void ssm_pow(const P& p, int g, int dir, int pp, int j, float& re, float& im) {
  const int ia = (dir * 32 + g) * 64 + pp;
  const float lr = fminf(p.a_re[ia], -1e-4f), li = p.a_im[ia], dt = expf(p.log_dt[dir * 32 + g]);
  const float mag = expf(lr * dt * (float)j);
  double t = (double)li * (double)dt * (double)j * 0.15915494309189535;
  t -= rint(t);
  const float ang = (float)(t * 6.283185307179586);
  float s, c; sincosf(ang, &s, &c);
  re = mag * c; im = mag * s;
}
DI void ssm_coef(const P& p, int g, int dir, int pp, float& cr, float& ci) {
  const int ia = (dir * 32 + g) * 64 + pp;
  const float lr = fminf(p.a_re[ia], -1e-4f), li = p.a_im[ia];
  float ar, ai; ssm_pow(p, g, dir, pp, 1, ar, ai);
  const float nr = ar - 1.f, ni = ai, den = 1.f / (lr * lr + li * li);
  cr = (nr * lr + ni * li) * den; ci = (ni * lr - nr * li) * den;
}

template <class CM>
DI void transpose_job(float* tile, int item, const float* in, int ld, int Kdim, bf16_t* out, const CM& colmap, const float* sc0, const float* sc1) {
  const int nkt = Kdim / 64, nt = item / nkt, kt = item % nkt, tid = threadIdx.x;
  __syncthreads();
  {
    const int c = tid & 31, kr = tid >> 5, col = colmap(nt * 32 + c);
#pragma unroll
    for (int i = 0; i < 8; i++) {
      const int kl = kr + 8 * i, k = kt * 64 + kl;
      float v = in[(size_t)k * ld + col];
      if (sc0) v *= (k < 512 ? sc0[k] : sc1[k - 512]);
      tile[kl * 33 + c] = v;
    }
  }
  __syncthreads();
  {
    const int nl = tid >> 3, kc = tid & 7;
    float v[8];
#pragma unroll
    for (int j = 0; j < 8; j++) v[j] = tile[(kc * 8 + j) * 33 + nl];
    uint4 w; w.x = pk2(v[0], v[1]); w.y = pk2(v[2], v[3]); w.z = pk2(v[4], v[5]); w.w = pk2(v[6], v[7]);
    *(uint4*)(out + (size_t)(nt * 32 + nl) * Kdim + kt * 64 + kc * 8) = w;
  }
}

DI void phase0(const P& p, unsigned char* smraw) {
  float* smf = (float*)smraw;
  const int tid = threadIdx.x, nb = gridDim.x, bid = blockIdx.x;
  for (int item = bid; item < 96; item += nb) {
    __syncthreads();
    for (int i = tid; i < 17 * 1024; i += 256) {
      const int b = i >> 10, k = i & 1023;
      const float c = b == 0 ? p.cp[k] : p.cs[(b - 1) * 1024 + k];
      smf[i] = c / (1.f + __expf(-c));
    }
    __syncthreads();
    const int col = tid & 63, kq = tid >> 6, j = item * 64 + col;
    float a[17];
#pragma unroll
    for (int b = 0; b < 17; b++) a[b] = 0.f;
    for (int k = kq * 256; k < kq * 256 + 256; k++) {
      const float w = p.w_ada[(size_t)k * 6144 + j];
#pragma unroll
      for (int b = 0; b < 17; b++) a[b] += smf[b * 1024 + k] * w;
    }
    __syncthreads();
#pragma unroll
    for (int b = 0; b < 17; b++) smf[(kq * 17 + b) * 64 + col] = a[b];
    __syncthreads();
    for (int i = tid; i < 17 * 64; i += 256) {
      const int b = i >> 6, c2 = i & 63;
      const float s = smf[(0 * 17 + b) * 64 + c2] + smf[(1 * 17 + b) * 64 + c2] + smf[(2 * 17 + b) * 64 + c2] + smf[(3 * 17 + b) * 64 + c2];
      p.mod()[b * 6144 + item * 64 + c2] = s + p.b_ada[item * 64 + c2];
    }
  }
  {
    auto ident = [](int n) { return n; };
    auto glumap = [](int n) { return ((n >> 5) & 1) * 512 + (n >> 6) * 32 + (n & 31); };
    const int n0 = 512, n1 = n0 + 256, n2 = n1 + 512, n3 = n2 + 2048, n4 = n3 + 2048;
    for (int item = bid; item < n4; item += nb) {
      if (item < n0) transpose_job(smf, item, p.w_in, 1024, 1024, p.wint(), ident, nullptr, nullptr);
      else if (item < n1) transpose_job(smf, item - n0, p.w_glu, 1024, 512, p.wglut(), glumap, nullptr, nullptr);
      else if (item < n2) transpose_job(smf, item - n1, p.w_out, 1024, 1024, p.woutt(), ident, p.g_fo, p.g_so);
      else if (item < n3) transpose_job(smf, item - n2, p.w1, 4096, 1024, p.w1t(), ident, nullptr, nullptr);
      else transpose_job(smf, item - n3, p.w2, 1024, 4096, p.w2t(), ident, nullptr, nullptr);
    }
  }
  {
    __syncthreads();
    float2* cs = (float2*)smraw;
    for (int i = tid; i < 512; i += 256) { float s, c; sincosf((float)i * (6.283185307179586f / 512.f), &s, &c); cs[i] = make_float2(c, s); }
    __syncthreads();
    for (int item = bid; item < 2048; item += nb) {
      const int idx = item * 256 + tid, n = idx >> 10, k = idx & 1023, h = n >> 7, e = n & 127, c = k & 511;
      const bool is_sin = k >= 512;
      const float* wf = p.w_f + (size_t)h * 128 * 128 + e;
      float a = 0.f;
      for (int d = 0; d < 128; d++) {
        const float2 t = cs[((h * 128 + d) * c) & 511];
        a += (is_sin ? t.y : t.x) * wf[d * 128];
      }
      p.Mf()[idx] = f2bf(a);
    }
  }
  {
    const int gsz = nb * 256, gt = bid * 256 + tid;
    for (int i = gt; i < 256 * 128; i += gsz) {
      const int n = i >> 7, k = i & 127, k1 = (n >> 6) * 32 + (n & 31), part = (n >> 5) & 1;
      float s, c; sincosf((float)((k1 * k) & 127) * (6.283185307179586f / 128.f), &s, &c);
      p.F1p()[i] = f2bf(part ? -s : c);
    }
    for (int i = gt; i < 128 * 64; i += gsz) {
      const int n = i >> 6, k = i & 63, k1 = (n >> 6) * 32 + (n & 31), part = (n >> 5) & 1;
      float s, c; sincosf((float)((k1 * k) & 63) * (6.283185307179586f / 64.f), &s, &c);
      p.F1s()[i] = f2bf(part ? -s : c);
    }
    for (int i = gt; i < 256 * 256; i += gsz) {
      const int n = i >> 8, k = i & 255, part = n >> 7, k2 = n & 127, l2 = k & 127, ki = k >> 7;
      float s, c; sincosf((float)((k2 * l2) & 127) * (6.283185307179586f / 128.f), &s, &c);
      p.F2p()[i] = f2bf(part == 0 ? (ki == 0 ? c : s) : (ki == 0 ? -s : c));
    }
    for (int i = gt; i < 128 * 128; i += gsz) {
      const int n = i >> 7, k = i & 127, part = n >> 6, k2 = n & 63, l2 = k & 63, ki = k >> 6;
      float s, c; sincosf((float)((k2 * l2) & 63) * (6.283185307179586f / 64.f), &s, &c);
      p.F2s()[i] = f2bf(part == 0 ? (ki == 0 ? c : s) : (ki == 0 ? -s : c));
    }
    for (int i = gt; i < LPR; i += gsz) { float s, c; sincosf((float)i * (6.283185307179586f / 16384.f), &s, &c); p.twp()[i] = make_float2(c, s); }
    for (int i = gt; i < LSM; i += gsz) { float s, c; sincosf((float)i * (6.283185307179586f / 4096.f), &s, &c); p.tws()[i] = make_float2(c, s); }
    for (int i = gt; i < 32 * 2 * 64 * 64; i += gsz) {
      const int s = i & 63, pp = (i >> 6) & 63, dir = (i >> 12) & 1, g = i >> 13;
      float pr, pi, cr, ci; ssm_pow(p, g, dir, pp, dir == 0 ? 63 - s : s, pr, pi); ssm_coef(p, g, dir, pp, cr, ci);
      const float qr = pr * cr - pi * ci, qi = pr * ci + pi * cr;
      const int ib = ((dir * 32 + g) * 64 + pp) * 16;
      float vr[16], vi[16];
#pragma unroll
      for (int h = 0; h < 16; h++) { const float br = p.b_re[ib + h], bi = p.b_im[ib + h]; vr[h] = qr * br - qi * bi; vi[h] = qr * bi + qi * br; }
      bf16_t* d0 = p.Bs() + ((size_t)(g * 256 + dir * 128 + pp)) * 1024 + s * 16;
      bf16_t* d1 = d0 + 64 * 1024;
      uint4 w;
      w.x = pk2(vr[0], vr[1]); w.y = pk2(vr[2], vr[3]); w.z = pk2(vr[4], vr[5]); w.w = pk2(vr[6], vr[7]); *(uint4*)d0 = w;
      w.x = pk2(vr[8], vr[9]); w.y = pk2(vr[10], vr[11]); w.z = pk2(vr[12], vr[13]); w.w = pk2(vr[14], vr[15]); *(uint4*)(d0 + 8) = w;
      w.x = pk2(vi[0], vi[1]); w.y = pk2(vi[2], vi[3]); w.z = pk2(vi[4], vi[5]); w.w = pk2(vi[6], vi[7]); *(uint4*)d1 = w;
      w.x = pk2(vi[8], vi[9]); w.y = pk2(vi[10], vi[11]); w.z = pk2(vi[12], vi[13]); w.w = pk2(vi[14], vi[15]); *(uint4*)(d1 + 8) = w;
    }
    for (int i = gt; i < 32 * 64 * 2 * 64; i += gsz) {
      const int pp = i & 63, dir = (i >> 6) & 1, t = (i >> 7) & 63, g = i >> 13;
      float pr, pi; ssm_pow(p, g, dir, pp, dir == 0 ? t + 1 : 64 - t, pr, pi);
#pragma unroll
      for (int h = 0; h < 16; h++) {
        const int ic = ((dir * 32 + g) * 16 + h) * 64 + pp;
        const float cr = p.c_re[ic], ci = p.c_im[ic];
        bf16_t* d = p.Co() + ((size_t)(g * 1024 + t * 16 + h)) * 256 + dir * 128 + pp;
        d[0] = f2bf(cr * pr - ci * pi);
        d[64] = f2bf(-(cr * pi + ci * pr));
      }
    }
    for (int i = gt; i < 32 * 2 * 64; i += gsz) {
      const int pp = i & 63, dir = (i >> 6) & 1, g = i >> 7;
      float pr, pi; ssm_pow(p, g, dir, pp, 64, pr, pi);
      p.AT()[i * 2] = pr; p.AT()[i * 2 + 1] = pi;
    }
  }
  {
    float2* q = (float2*)smraw;
    for (int item = bid; item < 32 * 127; item += nb) {
      const int g = item / 127, jj = item % 127, lag = jj - 63;
      __syncthreads();
      if (tid < 128) {
        const int dir = tid >> 6, pp = tid & 63;
        float2 v = make_float2(0.f, 0.f);
        if ((dir == 0 && lag >= 0) || (dir == 1 && lag <= 0)) {
          float pr, pi, cr, ci; ssm_pow(p, g, dir, pp, lag < 0 ? -lag : lag, pr, pi); ssm_coef(p, g, dir, pp, cr, ci);
          v = make_float2(pr * cr - pi * ci, pr * ci + pi * cr);
        }
        q[tid] = v;
      }
      __syncthreads();
      const int hp = tid >> 4, h = tid & 15;
      float a = 0.f;
#pragma unroll
      for (int dir = 0; dir < 2; dir++) {
        if ((dir == 0 && lag < 0) || (dir == 1 && lag > 0)) continue;
        for (int pp = 0; pp < 64; pp++) {
          const int ic = ((dir * 32 + g) * 16 + hp) * 64 + pp, ib = ((dir * 32 + g) * 64 + pp) * 16 + h;
          const float cr = p.c_re[ic], ci = p.c_im[ic], br = p.b_re[ib], bi = p.b_im[ib];
          const float2 qq = q[dir * 64 + pp];
          const float er = cr * qq.x - ci * qq.y, ei = cr * qq.y + ci * qq.x;
          a += er * br - ei * bi;
        }
      }
      if (lag == 0 && hp == h) a += p.ssm_d[g * 16 + h];
      p.Ktab()[(size_t)item * 256 + tid] = f2bf(a);
    }
  }
}

DI void rownorm_mod(const P& p, bool from_x, const float* g, int sh_off, int sc_off) {
  const int lane = threadIdx.x & 63, wv = blockIdx.x * 4 + (threadIdx.x >> 6), nw = gridDim.x * 4;
  for (int tok = wv; tok < NTOK; tok += nw) {
    const float* src = from_x ? (tok < LPR ? p.xp + (size_t)tok * 1024 : p.xs + (size_t)(tok - LPR) * 1024) : p.out + (size_t)tok * 1024;
    f32x4 v[4]; float ss = 0.f;
#pragma unroll
    for (int i = 0; i < 4; i++) { v[i] = *(const f32x4*)(src + (i * 64 + lane) * 4); ss += v[i][0] * v[i][0] + v[i][1] * v[i][1] + v[i][2] * v[i][2] + v[i][3] * v[i][3]; }
    ss = wave_sum(ss);
    const float r = rsqrtf(ss * (1.f / 1024.f) + EPSV);
    const float* md = p.mod() + batch_of(tok) * 6144;
#pragma unroll
    for (int i = 0; i < 4; i++) {
      const int c = (i * 64 + lane) * 4;
      const f32x4 gg = *(const f32x4*)(g + c), sc = *(const f32x4*)(md + sc_off + c), sh = *(const f32x4*)(md + sh_off + c);
      float o[4];
#pragma unroll
      for (int e = 0; e < 4; e++) o[e] = v[i][e] * r * gg[e] * (1.f + sc[e]) + sh[e];
      uint2 w; w.x = pk2(o[0], o[1]); w.y = pk2(o[2], o[3]);
      *(uint2*)(p.hb() + (size_t)tok * 1024 + c) = w;
    }
  }
}
DI void final_norm(const P& p) {
  const int lane = threadIdx.x & 63, wv = blockIdx.x * 4 + (threadIdx.x >> 6), nw = gridDim.x * 4;
  for (int tok = wv; tok < NTOK; tok += nw) {
    float* src = p.out + (size_t)tok * 1024;
    f32x4 v[4]; float ss = 0.f;
#pragma unroll
    for (int i = 0; i < 4; i++) { v[i] = *(const f32x4*)(src + (i * 64 + lane) * 4); ss += v[i][0] * v[i][0] + v[i][1] * v[i][1] + v[i][2] * v[i][2] + v[i][3] * v[i][3]; }
    ss = wave_sum(ss);
    const float r = rsqrtf(ss * (1.f / 1024.f) + EPSV);
#pragma unroll
    for (int i = 0; i < 4; i++) {
      const int c = (i * 64 + lane) * 4;
      const f32x4 gg = *(const f32x4*)(p.g_final + c);
      f32x4 o;
#pragma unroll
      for (int e = 0; e < 4; e++) o[e] = v[i][e] * r * gg[e];
      *(f32x4*)(src + c) = o;
    }
  }
}

#define GEO const int tid = threadIdx.x, lane = tid & 63, wid = tid >> 6, wm = wid >> 1, wn = wid & 1, l31 = lane & 31, lh = lane >> 5; (void)tid; (void)wm; (void)wn; (void)l31; (void)lh;

DI void phase2(const P& p, bf16_t* sm) {
  GEO
  for (int t = blockIdx.x; t < 640 * 8; t += gridDim.x) {
    const int tm = t >> 3, sub = t & 7, m0 = tm * 128;
    f32x16 acc[2][2];
    if (sub < 4) {
      const int n0 = sub * 128;
      auto af = [&](int r, int k) {
        const int v = m0 + r; int tok;
        if (v < LPR) tok = ((v & 127) << 7) | (v >> 7);
        else { const int vs = v - LPR, w = vs & 4095; tok = LPR + (vs & ~4095) + ((w & 63) << 6) + (w >> 6); }
        return p.hb() + (size_t)tok * 1024 + k;
      };
      auto bf = [&](int r, int k) { return p.wint() + (size_t)(n0 + r) * 1024 + k; };
      gemm_main<false>(sm, 1024, af, bf, NoHook(), acc);
      auto ew = [](int, float&, float&) {};
      auto dst = [&](int nl, int r) {
        const int c = n0 + nl;
        if (m0 < LPR) return p.zT() + (size_t)c * LPR + m0 + 64 * r;
        const int vs0 = m0 - LPR, b = vs0 >> 12, vl0 = vs0 & 4095;
        return p.zT() + (size_t)512 * LPR + ((size_t)(b * 512 + c)) * 4096 + vl0 + 64 * r;
      };
      epi_transposed(sm, acc, ew, dst);
    } else {
      const int n0 = 512 + (sub - 4) * 128;
      auto af = [&](int r, int k) { return p.hb() + (size_t)(m0 + r) * 1024 + k; };
      auto bf = [&](int r, int k) { return p.wint() + (size_t)(n0 + r) * 1024 + k; };
      gemm_main<true>(sm, 1024, af, bf, NoHook(), acc);
#pragma unroll
      for (int mi = 0; mi < 2; mi++)
#pragma unroll
        for (int ni = 0; ni < 2; ni++)
#pragma unroll
          for (int g = 0; g < 4; g++) {
            const int tok = m0 + wm * 64 + mi * 32 + l31, col = n0 - 512 + wn * 64 + ni * 32 + 8 * g + 4 * lh;
            uint2 w; w.x = pk2(acc[mi][ni][4 * g], acc[mi][ni][4 * g + 1]); w.y = pk2(acc[mi][ni][4 * g + 2], acc[mi][ni][4 * g + 3]);
            *(uint2*)(p.zs() + ((size_t)(col >> 4) * NTOK + tok) * 16 + (col & 15)) = w;
          }
    }
  }
}

template <int R>
DI void fft1_tile(const P& p, bf16_t* sm, int tm, int tn) {
  GEO
  constexpr bool pr = (R == 128);
  f32x16 acc[2][2];
  const bf16_t* Abase = pr ? p.zT() + (size_t)tm * 128 * 128 : p.zT() + (size_t)512 * LPR + (size_t)tm * 128 * 64;
  const bf16_t* Bbase = pr ? p.F1p() + (size_t)tn * 128 * 128 : p.F1s();
  auto af = [&](int r, int k) { return Abase + r * R + k; };
  auto bf = [&](int r, int k) { return Bbase + r * R + k; };
  gemm_main<false>(sm, R, af, bf, NoHook(), acc);
  const int k1 = (tn * 2 + wn) * 32 + l31;
  const float2* tw = pr ? p.twp() : p.tws();
  constexpr int lmask = pr ? 16383 : 4095, l2mask = R - 1;
  auto ew = [&](int ml, float& re, float& im) {
    const float2 w = tw[(k1 * (ml & l2mask)) & lmask];
    const float a = re * w.x + im * w.y, b = im * w.x - re * w.y;
    re = a; im = b;
  };
  auto dst = [&](int nl, int r) {
    const int part = (nl >> 5) & 1, kk1 = (tn * 2 + (nl >> 6)) * 32 + (nl & 31);
    if (pr) return p.Tt() + ((size_t)(tm * 128 + kk1)) * 256 + part * 128 + 64 * r;
    return p.Tt() + (size_t)65536 * 256 + ((size_t)((tm * 2 + r) * 64 + kk1)) * 128 + part * 64;
  };
  epi_transposed(sm, acc, ew, dst);
}
DI void phase3(const P& p, bf16_t* sm) {
  GEO
  const int NA = 1024, NB_ = 4096, NC = 640;
  for (int t = blockIdx.x; t < NA + NB_ + NC; t += gridDim.x) {
    if (t < NA) fft1_tile<128>(p, sm, t >> 1, t & 1);
    else if (t < NA + NB_) fft1_tile<64>(p, sm, t - NA, 0);
    else {
      f32x16 acc[2][2];
      const int u = t - NA - NB_, g = u / 20, rem = u % 20, m0 = (rem >> 1) * 128, n0 = (rem & 1) * 128;
      auto af = [&](int r, int k) { return p.zs() + (size_t)g * NTOK * 16 + (size_t)(m0 + r) * 1024 + k; };
      auto bf = [&](int r, int k) { return p.Bs() + (size_t)(g * 256 + n0 + r) * 1024 + k; };
      gemm_main<true>(sm, 1024, af, bf, NoHook(), acc);
#pragma unroll
      for (int mi = 0; mi < 2; mi++)
#pragma unroll
        for (int ni = 0; ni < 2; ni++)
#pragma unroll
          for (int gg = 0; gg < 4; gg++) {
            const int ch = m0 + wm * 64 + mi * 32 + l31, col = n0 + wn * 64 + ni * 32 + 8 * gg + 4 * lh;
            f32x4 v = {acc[mi][ni][4 * gg], acc[mi][ni][4 * gg + 1], acc[mi][ni][4 * gg + 2], acc[mi][ni][4 * gg + 3]};
            *(f32x4*)(p.S() + ((size_t)ch * 32 + g) * 256 + col) = v;
          }
    }
  }
}

template <int R>
DI void fft2_tile(const P& p, bf16_t* sm, int tm, int tn) {
  constexpr bool pr = (R == 128);
  constexpr int K = 2 * R;
  f32x16 acc[2][2];
  const int ct = tm & 3, k1 = pr ? (tm >> 2) : ((tm >> 2) & 63), b = pr ? 0 : (tm >> 8);
  const bf16_t* Abase = pr ? p.Tt() + ((size_t)(ct * 128) * 128 + k1) * 256 : p.Tt() + (size_t)65536 * 256 + ((size_t)(b * 512 + ct * 128) * 64 + k1) * 128;
  constexpr int rstride = R * K;
  const bf16_t* Bbase = pr ? p.F2p() + (size_t)tn * 128 * 256 : p.F2s();
  auto af = [&](int r, int k) { return Abase + (size_t)r * rstride + k; };
  auto bf = [&](int r, int k) { return Bbase + r * K + k; };
  gemm_main<false>(sm, K, af, bf, NoHook(), acc);
  auto ew = [](int, float&, float&) {};
  auto dst = [&](int nl, int r) {
    const int n = tn * 128 + nl, part = pr ? (n >> 7) : (n >> 6), k2 = n & (R - 1);
    const int tok = (pr ? 0 : LPR + b * 4096) + k1 + R * k2;
    return p.AF() + (size_t)tok * 1024 + part * 512 + ct * 128 + 64 * r;
  };
  epi_transposed(sm, acc, ew, dst);
}
DI void phase4(const P& p, bf16_t* sm) {
  GEO
  for (int idx = blockIdx.x * 256 + tid; idx < 17 * 4096; idx += gridDim.x * 256) {
    const int seq = idx >> 12, rem = idx & 4095, g = rem >> 7, dir = (rem >> 6) & 1, pp = rem & 63;
    const int c0 = seq == 0 ? 0 : 256 + (seq - 1) * 64, nc = seq == 0 ? 256 : 64;
    const float ar = p.AT()[((g * 2 + dir) * 64 + pp) * 2], ai = p.AT()[((g * 2 + dir) * 64 + pp) * 2 + 1];
    float hr = 0.f, hi = 0.f;
    const size_t off = (size_t)g * 256 + dir * 128 + pp;
    for (int i0 = 0; i0 < nc; i0 += 8) {
      float sr[8], si[8];
#pragma unroll
      for (int j = 0; j < 8; j++) {
        const int c = c0 + (dir == 0 ? i0 + j : nc - 1 - i0 - j);
        sr[j] = p.S()[(size_t)c * 8192 + off]; si[j] = p.S()[(size_t)c * 8192 + off + 64];
      }
#pragma unroll
      for (int j = 0; j < 8; j++) {
        const int c = c0 + (dir == 0 ? i0 + j : nc - 1 - i0 - j);
        p.H()[(size_t)c * 8192 + off] = f2bf(hr); p.H()[(size_t)c * 8192 + off + 64] = f2bf(hi);
        const float nr = ar * hr - ai * hi + sr[j], ni = ar * hi + ai * hr + si[j];
        hr = nr; hi = ni;
      }
    }
  }
  for (int t = blockIdx.x; t < 1024 + 4096; t += gridDim.x) {
    if (t < 1024) fft2_tile<128>(p, sm, t >> 1, t & 1);
    else fft2_tile<64>(p, sm, t - 1024, 0);
  }
}

DI float gelu_tanh(float x) {
  const float u = 0.7978845608028654f * (x + 0.044715f * x * x * x);
  return x / (1.f + __expf(-2.f * u));
}

DI void phase5(const P& p, bf16_t* sm) {
  GEO
  for (int t = blockIdx.x; t < 2560 + 2560; t += gridDim.x) {
    f32x16 acc[2][2];
    if (t < 2560) {
      const int tm = t >> 2, tn = t & 3, m0 = tm * 128, n0 = tn * 128;
      auto af = [&](int r, int k) { return p.AF() + (size_t)(m0 + r) * 1024 + k; };
      auto bf = [&](int r, int k) { return p.Mf() + (size_t)(n0 + r) * 1024 + k; };
      gemm_main<true>(sm, 1024, af, bf, NoHook(), acc);
#pragma unroll
      for (int mi = 0; mi < 2; mi++) {
        const int tok = m0 + wm * 64 + mi * 32 + l31;
        const float scale = tok < LPR ? 3.4526698300124393e-4f : 6.905339660024879e-4f;
        float ss = 0.f;
#pragma unroll
        for (int ni = 0; ni < 2; ni++)
#pragma unroll
          for (int g = 0; g < 4; g++) {
            const int col = n0 + wn * 64 + ni * 32 + 8 * g + 4 * lh;
            const f32x4 bb = *(const f32x4*)(p.b_f + col);
            float o[4];
#pragma unroll
            for (int e = 0; e < 4; e++) { o[e] = acc[mi][ni][4 * g + e] * scale + bb[e]; ss += o[e] * o[e]; }
            uint2 w; w.x = pk2(o[0], o[1]); w.y = pk2(o[2], o[3]);
            *(uint2*)(p.yf() + (size_t)tok * 512 + col) = w;
          }
        ss += __shfl_xor(ss, 32);
        if (lh == 0) p.ssf()[tok * 8 + tn * 2 + wn] = ss;
      }
    } else {
      const int u = t - 2560, g = u / 80, rem = u % 80, m0 = (rem >> 3) * 128, n0 = (rem & 7) * 128;
      const bf16_t* Ug = p.zs() + (size_t)g * NTOK * 16;
      const bf16_t* Kg = p.Ktab() + (size_t)g * 127 * 256;
      auto af = [&](int r, int k) { return k < 1024 ? Ug + (size_t)(m0 + r) * 1024 + k : p.H() + ((size_t)(m0 + r) * 32 + g) * 256 + (k - 1024); };
      auto bf = [&](int r, int k) {
        const int n = n0 + r;
        return k < 1024 ? Kg + (((n >> 4) - (k >> 4) + 63) * 256 + (n & 15) * 16 + (k & 15)) : p.Co() + ((size_t)(g * 1024 + n)) * 256 + (k - 1024);
      };
      gemm_main<true>(sm, 1280, af, bf, NoHook(), acc);
#pragma unroll
      for (int mi = 0; mi < 2; mi++)
#pragma unroll
        for (int ni = 0; ni < 2; ni++)
#pragma unroll
          for (int gg = 0; gg < 4; gg++) {
            const int ch = m0 + wm * 64 + mi * 32 + l31, n = n0 + wn * 64 + ni * 32 + 8 * gg + 4 * lh;
            const int tok = ch * 64 + (n >> 4);
            float o[4];
#pragma unroll
            for (int e = 0; e < 4; e++) o[e] = gelu_tanh(acc[mi][ni][4 * gg + e]);
            uint2 w; w.x = pk2(o[0], o[1]); w.y = pk2(o[2], o[3]);
            *(uint2*)(p.gact() + (size_t)tok * 512 + g * 16 + (n & 15)) = w;
          }
    }
  }
}

DI void phase6(const P& p, bf16_t* sm) {
  GEO
  for (int t = blockIdx.x; t < 640 * 8; t += gridDim.x) {
    f32x16 acc[2][2];
    const int tm = t >> 3, tn = t & 7, m0 = tm * 128, n0 = tn * 128;
    auto af = [&](int r, int k) { return p.gact() + (size_t)(m0 + r) * 512 + k; };
    auto bf = [&](int r, int k) { return p.wglut() + (size_t)(n0 + r) * 512 + k; };
    gemm_main<true>(sm, 512, af, bf, NoHook(), acc);
#pragma unroll
    for (int mi = 0; mi < 2; mi++) {
      const int tok = m0 + wm * 64 + mi * 32 + l31;
      float ss = 0.f;
#pragma unroll
      for (int g = 0; g < 4; g++) {
        const int j = (tn * 2 + wn) * 32 + 8 * g + 4 * lh;
        const f32x4 bv = *(const f32x4*)(p.b_glu + j), bg = *(const f32x4*)(p.b_glu + 512 + j);
        float o[4];
#pragma unroll
        for (int e = 0; e < 4; e++) {
          const float val = acc[mi][0][4 * g + e] + bv[e], gate = acc[mi][1][4 * g + e] + bg[e];
          o[e] = val / (1.f + __expf(-gate)); ss += o[e] * o[e];
        }
        uint2 w; w.x = pk2(o[0], o[1]); w.y = pk2(o[2], o[3]);
        *(uint2*)(p.ys() + (size_t)tok * 512 + j) = w;
      }
      ss += __shfl_xor(ss, 32);
      if (lh == 0) p.sss()[tok * 16 + tn * 2 + wn] = ss;
    }
  }
}

DI void phase7(const P& p, bf16_t* sm) {
  GEO
  for (int t = blockIdx.x; t < 640 * 8; t += gridDim.x) {
    f32x16 acc[2][2];
    const int tm = t >> 3, tn = t & 7, m0 = tm * 128, n0 = tn * 128;
    float ratio[2], rs[2];
#pragma unroll
    for (int mi = 0; mi < 2; mi++) {
      const int tok = m0 + wm * 64 + mi * 32 + l31;
      float sf = 0.f, s2 = 0.f;
#pragma unroll
      for (int i = 0; i < 8; i++) sf += p.ssf()[tok * 8 + i];
#pragma unroll
      for (int i = 0; i < 16; i++) s2 += p.sss()[tok * 16 + i];
      const float rf = rsqrtf(sf * (1.f / 512.f) + EPSV);
      rs[mi] = rsqrtf(s2 * (1.f / 512.f) + EPSV);
      ratio[mi] = rf / rs[mi];
    }
    auto af = [&](int r, int k) { return k < 512 ? p.yf() + (size_t)(m0 + r) * 512 + k : p.ys() + (size_t)(m0 + r) * 512 + (k - 512); };
    auto bf = [&](int r, int k) { return p.woutt() + (size_t)(n0 + r) * 1024 + k; };
    auto hk = [&](int kt, f32x16 (&a)[2][2]) {
      if (kt == 8) {
#pragma unroll
        for (int mi = 0; mi < 2; mi++)
#pragma unroll
          for (int ni = 0; ni < 2; ni++)
#pragma unroll
            for (int e = 0; e < 16; e++) a[mi][ni][e] *= ratio[mi];
      }
    };
    gemm_main<true>(sm, 1024, af, bf, hk, acc);
#pragma unroll
    for (int mi = 0; mi < 2; mi++) {
      const int tok = m0 + wm * 64 + mi * 32 + l31;
      const float* xr = tok < LPR ? p.xp + (size_t)tok * 1024 : p.xs + (size_t)(tok - LPR) * 1024;
      const float* g1 = p.mod() + batch_of(tok) * 6144 + 2048;
#pragma unroll
      for (int ni = 0; ni < 2; ni++)
#pragma unroll
        for (int g = 0; g < 4; g++) {
          const int col = n0 + wn * 64 + ni * 32 + 8 * g + 4 * lh;
          const f32x4 xv = *(const f32x4*)(xr + col), gv = *(const f32x4*)(g1 + col);
          f32x4 o;
#pragma unroll
          for (int e = 0; e < 4; e++) o[e] = xv[e] + gv[e] * acc[mi][ni][4 * g + e] * rs[mi];
          *(f32x4*)(p.out + (size_t)tok * 1024 + col) = o;
        }
    }
  }
}

DI void phase8(const P& p, bf16_t* sm) {
  GEO
  for (int t = blockIdx.x; t < 640 * 32; t += gridDim.x) {
    f32x16 acc[2][2];
    const int tm = t >> 5, tn = t & 31, m0 = tm * 128, n0 = tn * 128;
    auto af = [&](int r, int k) { return p.hb() + (size_t)(m0 + r) * 1024 + k; };
    auto bf = [&](int r, int k) { return p.w1t() + (size_t)(n0 + r) * 1024 + k; };
    gemm_main<true>(sm, 1024, af, bf, NoHook(), acc);
#pragma unroll
    for (int mi = 0; mi < 2; mi++) {
      const int tok = m0 + wm * 64 + mi * 32 + l31;
#pragma unroll
      for (int ni = 0; ni < 2; ni++)
#pragma unroll
        for (int g = 0; g < 4; g++) {
          const int col = n0 + wn * 64 + ni * 32 + 8 * g + 4 * lh;
          const f32x4 bb = *(const f32x4*)(p.b1 + col);
          float o[4];
#pragma unroll
          for (int e = 0; e < 4; e++) { const float v = fmaxf(acc[mi][ni][4 * g + e] + bb[e], 0.f); o[e] = v * v; }
          uint2 w; w.x = pk2(o[0], o[1]); w.y = pk2(o[2], o[3]);
          *(uint2*)(p.hid() + (size_t)tok * 4096 + col) = w;
        }
    }
  }
}

DI void phase9(const P& p, bf16_t* sm) {
  GEO
  for (int t = blockIdx.x; t < 640 * 8; t += gridDim.x) {
    f32x16 acc[2][2];
    const int tm = t >> 3, tn = t & 7, m0 = tm * 128, n0 = tn * 128;
    auto af = [&](int r, int k) { return p.hid() + (size_t)(m0 + r) * 4096 + k; };
    auto bf = [&](int r, int k) { return p.w2t() + (size_t)(n0 + r) * 4096 + k; };
    gemm_main<true>(sm, 4096, af, bf, NoHook(), acc);
#pragma unroll
    for (int mi = 0; mi < 2; mi++) {
      const int tok = m0 + wm * 64 + mi * 32 + l31;
      const float* g2 = p.mod() + batch_of(tok) * 6144 + 5120;
      float* xr = p.out + (size_t)tok * 1024;
#pragma unroll
      for (int ni = 0; ni < 2; ni++)
#pragma unroll
        for (int g = 0; g < 4; g++) {
          const int col = n0 + wn * 64 + ni * 32 + 8 * g + 4 * lh;
          const f32x4 xv = *(const f32x4*)(xr + col), gv = *(const f32x4*)(g2 + col), bb = *(const f32x4*)(p.b2 + col);
          f32x4 o;
#pragma unroll
          for (int e = 0; e < 4; e++) o[e] = xv[e] + gv[e] * (acc[mi][ni][4 * g + e] + bb[e]);
          *(f32x4*)(xr + col) = o;
        }
    }
  }
}

template <int PH>
DI void run_phase(const P& p, unsigned char* smraw) {
  bf16_t* sm = (bf16_t*)smraw;
  if (PH == 0) phase0(p, smraw);
  else if (PH == 1) rownorm_mod(p, true, p.g_mix, 0, 1024);
  else if (PH == 2) phase2(p, sm);
  else if (PH == 3) phase3(p, sm);
  else if (PH == 4) phase4(p, sm);
  else if (PH == 5) phase5(p, sm);
  else if (PH == 6) phase6(p, sm);
  else if (PH == 7) phase7(p, sm);
  else if (PH == 8) rownorm_mod(p, false, p.g_mlp, 3072, 4096);
  else if (PH == 9) phase8(p, sm);
  else if (PH == 10) phase9(p, sm);
  else if (PH == 11) final_norm(p);
}

extern __shared__ __attribute__((aligned(16))) unsigned char dyn_smem[];

#if !ONE_LAUNCH
template <int PH>
__global__ void __launch_bounds__(256, 2) k_phase(P p) { run_phase<PH>(p, dyn_smem); }

#else
__global__ void __launch_bounds__(256, 2) k_mega(P p) {
  cg::grid_group grid = cg::this_grid();
  run_phase<0>(p, dyn_smem); grid.sync();
  run_phase<1>(p, dyn_smem); grid.sync();
  run_phase<2>(p, dyn_smem); grid.sync();
  run_phase<3>(p, dyn_smem); grid.sync();
  run_phase<4>(p, dyn_smem); grid.sync();
  run_phase<5>(p, dyn_smem); grid.sync();
  run_phase<6>(p, dyn_smem); grid.sync();
  run_phase<7>(p, dyn_smem); grid.sync();
  run_phase<8>(p, dyn_smem); grid.sync();
  run_phase<9>(p, dyn_smem); grid.sync();
  run_phase<10>(p, dyn_smem); grid.sync();
  run_phase<11>(p, dyn_smem);
}

#endif

#ifdef DBGCHK
__global__ void k_chk_bf16(const bf16_t* buf, size_t n, unsigned* flag) {
  bool bad = false;
  for (size_t i = (size_t)blockIdx.x * 256 + threadIdx.x; i < n; i += (size_t)gridDim.x * 256) { if ((buf[i] & 0x7f80u) == 0x7f80u) bad = true; }
  if (bad) atomicOr(flag, 1u);
}
__global__ void k_chk_f32(const float* buf, size_t n, unsigned* flag) {
  bool bad = false;
  for (size_t i = (size_t)blockIdx.x * 256 + threadIdx.x; i < n; i += (size_t)gridDim.x * 256) { if (!(fabsf(buf[i]) < 1e30f)) bad = true; }
  if (bad) atomicOr(flag, 1u);
}
__global__ void k_mag_bf16(const bf16_t* buf, size_t n, float lim, unsigned* flag) {
  bool bad = false;
  for (size_t i = (size_t)blockIdx.x * 256 + threadIdx.x; i < n; i += (size_t)gridDim.x * 256) { const float v = __uint_as_float((unsigned)buf[i] << 16); if (!(fabsf(v) < lim)) bad = true; }
  if (bad) atomicOr(flag, 1u);
}
__global__ void k_mag_f32(const float* buf, size_t n, float lim, unsigned* flag) {
  bool bad = false;
  for (size_t i = (size_t)blockIdx.x * 256 + threadIdx.x; i < n; i += (size_t)gridDim.x * 256) { if (!(fabsf(buf[i]) < lim)) bad = true; }
  if (bad) atomicOr(flag, 1u);
}
DI float bf2f(bf16_t v) { return __uint_as_float((unsigned)v << 16); }
__global__ void k_selftest(P p, unsigned* res) {
  const int s = blockIdx.x * 256 + threadIdx.x;
  const int tok = (int)(((long long)s * 2659 + 17) % NTOK), col = (s * 37 + 5) & 511;
  float r1 = 0.f, r2 = 0.f;
  for (int k = 0; k < 1024; k++) { const float h = bf2f(p.hb()[(size_t)tok * 1024 + k]); r1 += h * bf2f(p.wint()[(size_t)(512 + col) * 1024 + k]); r2 += h * bf2f(p.wint()[(size_t)col * 1024 + k]); }
  const float g1 = bf2f(p.zs()[((size_t)(col >> 4) * NTOK + tok) * 16 + (col & 15)]);
  float g2;
  if (tok < LPR) { const int l1 = tok >> 7, l2 = tok & 127; g2 = bf2f(p.zT()[(size_t)col * LPR + l2 * 128 + l1]); }
  else { const int ts = tok - LPR, b = ts >> 12, w = ts & 4095, l1 = w >> 6, l2 = w & 63; g2 = bf2f(p.zT()[(size_t)512 * LPR + ((size_t)(b * 512 + col)) * 4096 + l2 * 64 + l1]); }
  float d1 = fabsf(r1 - g1), d2 = fabsf(r2 - g2);
  if (!(d1 < 1e6f)) d1 = 1e6f;
  if (!(d2 < 1e6f)) d2 = 1e6f;
  atomicMax(res, __float_as_uint(d1)); atomicMax(res + 1, __float_as_uint(d2));
}
__global__ void k_report2(float* out, const unsigned* res) {
  const float d1 = __uint_as_float(res[0]), d2 = __uint_as_float(res[1]);
  for (size_t i = (size_t)blockIdx.x * 256 + threadIdx.x; i < (size_t)NTOK * 1024; i += (size_t)gridDim.x * 256) {
    float v = 0.f;
    if (i < (size_t)2560 * 1024) v = 10.f * (1.f + d2);
    if (i == (size_t)20000 * 1024) v = 1e4f * (1.f + d1);
    out[i] = v;
  }
}
__global__ void k_report(float* out, const unsigned* flags, int nflags) {
  const size_t seg = (size_t)NTOK * 1024 / 32;
  for (size_t i = (size_t)blockIdx.x * 256 + threadIdx.x; i < (size_t)NTOK * 1024; i += (size_t)gridDim.x * 256) {
    const int s = (int)(i / seg);
    float v = 0.f;
    if (s < nflags && flags[s]) { v = 1.f; for (int j = 0; j < nflags - s; j++) v *= 10.f; }
    out[i] = v;
  }
}
#endif
#if !ONE_LAUNCH
template <int PH>
static void launch_phase(const P& p, int grid, hipStream_t stream) {
  (void)hipFuncSetAttribute((const void*)k_phase<PH>, hipFuncAttributeMaxDynamicSharedMemorySize, SMEM_BYTES);
  hipLaunchKernelGGL(k_phase<PH>, dim3(grid), dim3(256), SMEM_BYTES, stream, p);
}

#endif
extern "C" void kernel_launch(void* const* d_in, const int* in_sizes, int n_in, void* d_out, int out_size, void* d_ws, size_t ws_size,
                              hipStream_t stream) {
  P p{};
  const float** f = (const float**)&p;
  for (int i = 0; i < 29; i++) f[i] = (const float*)d_in[i];
  p.out = (float*)d_out;
  p.ws = (char*)d_ws;
  const size_t need = WS_NEED;
  if (need + 256 > ws_size) { fprintf(stderr, "workspace too small: need %zu have %zu\n", need, ws_size); return; }

  static int grid_blocks = 0;
  if (!grid_blocks) {
    int dev = 0, cus = 0, per_cu = 0;
    (void)hipGetDevice(&dev);
    (void)hipDeviceGetAttribute(&cus, hipDeviceAttributeMultiprocessorCount, dev);
#if ONE_LAUNCH
    (void)hipFuncSetAttribute((const void*)k_mega, hipFuncAttributeMaxDynamicSharedMemorySize, SMEM_BYTES);
    (void)hipOccupancyMaxActiveBlocksPerMultiprocessor(&per_cu, k_mega, 256, SMEM_BYTES);
#else
    per_cu = 2;
#endif
    if (per_cu < 1) per_cu = 1;
    grid_blocks = cus * per_cu;
  }
#if ONE_LAUNCH
  void* args[] = {&p};
  hipError_t e = hipLaunchCooperativeKernel((void*)k_mega, dim3(grid_blocks), dim3(256), args, SMEM_BYTES, stream);
  if (e != hipSuccess) fprintf(stderr, "cooperative launch failed: %s (grid %d)\n", hipGetErrorString(e), grid_blocks);
#else
#ifdef DBGCHK
  unsigned* flags = (unsigned*)((char*)d_ws + need);
  (void)hipMemsetAsync(flags, 0, 256, stream);
  int nf = 0;
#define CHKB(ptr, n) hipLaunchKernelGGL(k_chk_bf16, dim3(1024), dim3(256), 0, stream, (const bf16_t*)(ptr), (size_t)(n), flags + nf); nf++;
#define CHKF(ptr, n) hipLaunchKernelGGL(k_chk_f32, dim3(1024), dim3(256), 0, stream, (const float*)(ptr), (size_t)(n), flags + nf); nf++;
#define MAGB(ptr, n, lim) hipLaunchKernelGGL(k_mag_bf16, dim3(1024), dim3(256), 0, stream, (const bf16_t*)(ptr), (size_t)(n), (float)(lim), flags + nf); nf++;
#define MAGF(ptr, n, lim) hipLaunchKernelGGL(k_mag_f32, dim3(1024), dim3(256), 0, stream, (const float*)(ptr), (size_t)(n), (float)(lim), flags + nf); nf++;
  launch_phase<0>(p, grid_blocks, stream);
  MAGF(p.mod(), 17 * 6144, 20.f) MAGB(p.wint(), 1024 * 1024, 2.f)
  launch_phase<1>(p, grid_blocks, stream);
  MAGB(p.hb(), (size_t)NTOK * 1024, 200.f)
  launch_phase<2>(p, grid_blocks, stream);
  MAGB(p.zs(), (size_t)NTOK * 512, 1000.f) MAGB(p.zT(), (size_t)NTOK * 512, 1000.f)
  hipLaunchKernelGGL(k_selftest, dim3(16), dim3(256), 0, stream, p, flags + 32);
  hipLaunchKernelGGL(k_report2, dim3(2048), dim3(256), 0, stream, p.out, flags + 32);
#else
  launch_phase<0>(p, grid_blocks, stream);
  launch_phase<1>(p, grid_blocks, stream);
  launch_phase<2>(p, grid_blocks, stream);
  launch_phase<3>(p, grid_blocks, stream);
  launch_phase<4>(p, grid_blocks, stream);
  launch_phase<5>(p, grid_blocks, stream);
  launch_phase<6>(p, grid_blocks, stream);
  launch_phase<7>(p, grid_blocks, stream);
  launch_phase<8>(p, grid_blocks, stream);
  launch_phase<9>(p, grid_blocks, stream);
  launch_phase<10>(p, grid_blocks, stream);
  launch_phase<11>(p, grid_blocks, stream);
#endif
#endif
}
```

```cpp
#include <hip/hip_runtime.h>
#include <hip/hip_cooperative_groups.h>
#include <stdint.h>
#include <stdio.h>
namespace cg = cooperative_groups;


#define DI __device__ __forceinline__
typedef unsigned short bf16_t;
typedef short bf16x8 __attribute__((ext_vector_type(8)));
typedef float f32x16 __attribute__((ext_vector_type(16)));
typedef float f32x4 __attribute__((ext_vector_type(4)));

constexpr int NTOK = 81920, LPR = 16384, LSM = 4096;
constexpr int BM = 128, BN = 128, BK = 64, LDSS = 72, TLD = 136;
constexpr int SMEM_HALF = 2 * 2 * BM * LDSS * 2;
constexpr int SMEM_BYTES = 2 * SMEM_HALF;
constexpr float EPSV = 1e-6f;

constexpr size_t al256(size_t x) { return (x + 255) & ~(size_t)255; }
constexpr size_t O_mod = 0;
constexpr size_t O_AT = O_mod + al256(17 * 6144 * 4);
constexpr size_t O_ssf = O_AT + al256(32 * 2 * 64 * 2 * 4);
constexpr size_t O_sss = O_ssf + al256((size_t)NTOK * 8 * 4);
constexpr size_t O_twp = O_sss + al256((size_t)NTOK * 16 * 4);
constexpr size_t O_tws = O_twp + al256(LPR * 8);
constexpr size_t O_wint = O_tws + al256(LSM * 8);
constexpr size_t O_wglut = O_wint + al256(1024 * 1024 * 2);
constexpr size_t O_woutt = O_wglut + al256(1024 * 512 * 2);
constexpr size_t O_w1t = O_woutt + al256(1024 * 1024 * 2);
constexpr size_t O_w2t = O_w1t + al256((size_t)4096 * 1024 * 2);
constexpr size_t O_Mf = O_w2t + al256((size_t)4096 * 1024 * 2);
constexpr size_t O_F1p = O_Mf + al256(512 * 1024 * 2);
constexpr size_t O_F1s = O_F1p + al256(256 * 128 * 2);
constexpr size_t O_F2p = O_F1s + al256(128 * 64 * 2);
constexpr size_t O_F2s = O_F2p + al256(256 * 256 * 2);
constexpr size_t O_Ktab = O_F2s + al256(128 * 128 * 2);
constexpr size_t O_Bs = O_Ktab + al256((size_t)32 * 127 * 256 * 2);
constexpr size_t O_Co = O_Bs + al256((size_t)32 * 256 * 1024 * 2);
constexpr size_t O_hb = O_Co + al256((size_t)32 * 1024 * 256 * 2);
constexpr size_t O_zT = O_hb + al256((size_t)NTOK * 1024 * 2);
constexpr size_t O_zs = O_zT + al256((size_t)NTOK * 512 * 2);
constexpr size_t O_AF = O_zs + al256((size_t)NTOK * 512 * 2);
constexpr size_t O_S = O_AF + al256((size_t)NTOK * 1024 * 2);
constexpr size_t O_H = O_S + al256((size_t)1280 * 32 * 256 * 4);
constexpr size_t O_yf = O_H + al256((size_t)1280 * 32 * 256 * 2);
constexpr size_t O_gact = O_yf + al256((size_t)NTOK * 512 * 2);
constexpr size_t O_ys = O_gact + al256((size_t)NTOK * 512 * 2);
constexpr size_t O_END = O_ys + al256((size_t)NTOK * 512 * 2);
constexpr size_t O_Tt = O_hb;
constexpr size_t O_hid = O_zT;
constexpr size_t WS_NEED = (O_hid + (size_t)NTOK * 4096 * 2 > O_END ? O_hid + (size_t)NTOK * 4096 * 2 : O_END);
struct P {
  const float *xp, *xs, *cp, *cs, *w_ada, *b_ada, *g_mix, *w_in, *w_f, *b_f, *a_re, *a_im, *log_dt, *b_re, *b_im, *c_re, *c_im,
      *ssm_d, *w_glu, *b_glu, *g_fo, *g_so, *w_out, *g_mlp, *w1, *b1, *w2, *b2, *g_final;
  float* out;
  char* ws;
  __device__ __forceinline__ float* mod() const { return (float*)(ws + O_mod); }
  __device__ __forceinline__ float* AT() const { return (float*)(ws + O_AT); }
  __device__ __forceinline__ float* ssf() const { return (float*)(ws + O_ssf); }
  __device__ __forceinline__ float* sss() const { return (float*)(ws + O_sss); }
  __device__ __forceinline__ float2* twp() const { return (float2*)(ws + O_twp); }
  __device__ __forceinline__ float2* tws() const { return (float2*)(ws + O_tws); }
  __device__ __forceinline__ bf16_t* wint() const { return (bf16_t*)(ws + O_wint); }
  __device__ __forceinline__ bf16_t* wglut() const { return (bf16_t*)(ws + O_wglut); }
  __device__ __forceinline__ bf16_t* woutt() const { return (bf16_t*)(ws + O_woutt); }
  __device__ __forceinline__ bf16_t* w1t() const { return (bf16_t*)(ws + O_w1t); }
  __device__ __forceinline__ bf16_t* w2t() const { return (bf16_t*)(ws + O_w2t); }
  __device__ __forceinline__ bf16_t* Mf() const { return (bf16_t*)(ws + O_Mf); }
  __device__ __forceinline__ bf16_t* F1p() const { return (bf16_t*)(ws + O_F1p); }
  __device__ __forceinline__ bf16_t* F1s() const { return (bf16_t*)(ws + O_F1s); }
  __device__ __forceinline__ bf16_t* F2p() const { return (bf16_t*)(ws + O_F2p); }
  __device__ __forceinline__ bf16_t* F2s() const { return (bf16_t*)(ws + O_F2s); }
  __device__ __forceinline__ bf16_t* Ktab() const { return (bf16_t*)(ws + O_Ktab); }
  __device__ __forceinline__ bf16_t* Bs() const { return (bf16_t*)(ws + O_Bs); }
  __device__ __forceinline__ bf16_t* Co() const { return (bf16_t*)(ws + O_Co); }
  __device__ __forceinline__ bf16_t* hb() const { return (bf16_t*)(ws + O_hb); }
  __device__ __forceinline__ bf16_t* zT() const { return (bf16_t*)(ws + O_zT); }
  __device__ __forceinline__ bf16_t* zs() const { return (bf16_t*)(ws + O_zs); }
  __device__ __forceinline__ bf16_t* AF() const { return (bf16_t*)(ws + O_AF); }
  __device__ __forceinline__ float* S() const { return (float*)(ws + O_S); }
  __device__ __forceinline__ bf16_t* H() const { return (bf16_t*)(ws + O_H); }
  __device__ __forceinline__ bf16_t* yf() const { return (bf16_t*)(ws + O_yf); }
  __device__ __forceinline__ bf16_t* gact() const { return (bf16_t*)(ws + O_gact); }
  __device__ __forceinline__ bf16_t* ys() const { return (bf16_t*)(ws + O_ys); }
  __device__ __forceinline__ bf16_t* Tt() const { return (bf16_t*)(ws + O_Tt); }
  __device__ __forceinline__ bf16_t* hid() const { return (bf16_t*)(ws + O_hid); }
};

typedef float f32x2v __attribute__((ext_vector_type(2)));
typedef __bf16 bf16x2v __attribute__((ext_vector_type(2)));
DI uint32_t pk2(float lo, float hi) { const f32x2v v = {lo, hi}; const bf16x2v r = __builtin_convertvector(v, bf16x2v); return __builtin_bit_cast(uint32_t, r); }
DI bf16_t f2bf(float f) { return (bf16_t)(pk2(f, 0.f) & 0xffffu); }
DI int batch_of(int tok) { return tok < LPR ? 0 : 1 + ((tok - LPR) >> 12); }
DI float wave_sum(float v) {
  v += __shfl_xor(v, 32); v += __shfl_xor(v, 16); v += __shfl_xor(v, 8); v += __shfl_xor(v, 4); v += __shfl_xor(v, 2); v += __shfl_xor(v, 1);
  return v;
}

template <bool SWAP, class AF, class BF, class HK>
DI void gemm_main(bf16_t* sm, int K, const AF& af, const BF& bf, const HK& hk, f32x16 (&acc)[2][2]) {
  const int tid = threadIdx.x & 255, lane = tid & 63, wid = tid >> 6, wm = wid >> 1, wn = wid & 1;
  const int kc = (tid & 7) * 8, rb = tid >> 3;
  bf16_t* As = sm;
  bf16_t* Bs = sm + 2 * BM * LDSS;
  uint4 ra[4], rv[4];
#pragma unroll
  for (int i = 0; i < 2; i++)
#pragma unroll
    for (int j = 0; j < 2; j++)
#pragma unroll
      for (int e = 0; e < 16; e++) acc[i][j][e] = 0.f;
  __syncthreads();
#pragma unroll
  for (int i = 0; i < 4; i++) { ra[i] = *(const uint4*)af(rb + 32 * i, kc); rv[i] = *(const uint4*)bf(rb + 32 * i, kc); }
#pragma unroll
  for (int i = 0; i < 4; i++) { *(uint4*)(As + (rb + 32 * i) * LDSS + kc) = ra[i]; *(uint4*)(Bs + (rb + 32 * i) * LDSS + kc) = rv[i]; }
  __syncthreads();
  const int nk = K / BK;
  for (int t = 0; t < nk; t++) {
    const int cur = t & 1;
    if (t + 1 < nk) {
      const int k = (t + 1) * BK + kc;
#pragma unroll
      for (int i = 0; i < 4; i++) { ra[i] = *(const uint4*)af(rb + 32 * i, k); rv[i] = *(const uint4*)bf(rb + 32 * i, k); }
    }
    hk(t, acc);
    const bf16_t* Ab = As + cur * BM * LDSS + (wm * 64 + (lane & 31)) * LDSS + (lane >> 5) * 8;
    const bf16_t* Bb = Bs + cur * BN * LDSS + (wn * 64 + (lane & 31)) * LDSS + (lane >> 5) * 8;
#pragma unroll
    for (int ks = 0; ks < 4; ks++) {
      const bf16x8 a0 = *(const bf16x8*)(Ab + ks * 16), a1 = *(const bf16x8*)(Ab + 32 * LDSS + ks * 16);
      const bf16x8 b0 = *(const bf16x8*)(Bb + ks * 16), b1 = *(const bf16x8*)(Bb + 32 * LDSS + ks * 16);
      if (SWAP) {
        acc[0][0] = __builtin_amdgcn_mfma_f32_32x32x16_bf16(b0, a0, acc[0][0], 0, 0, 0);
        acc[0][1] = __builtin_amdgcn_mfma_f32_32x32x16_bf16(b1, a0, acc[0][1], 0, 0, 0);
        acc[1][0] = __builtin_amdgcn_mfma_f32_32x32x16_bf16(b0, a1, acc[1][0], 0, 0, 0);
        acc[1][1] = __builtin_amdgcn_mfma_f32_32x32x16_bf16(b1, a1, acc[1][1], 0, 0, 0);
      } else {
        acc[0][0] = __builtin_amdgcn_mfma_f32_32x32x16_bf16(a0, b0, acc[0][0], 0, 0, 0);
        acc[0][1] = __builtin_amdgcn_mfma_f32_32x32x16_bf16(a0, b1, acc[0][1], 0, 0, 0);
        acc[1][0] = __builtin_amdgcn_mfma_f32_32x32x16_bf16(a1, b0, acc[1][0], 0, 0, 0);
        acc[1][1] = __builtin_amdgcn_mfma_f32_32x32x16_bf16(a1, b1, acc[1][1], 0, 0, 0);
      }
    }
    if (t + 1 < nk) {
      const int nb = cur ^ 1;
#pragma unroll
      for (int i = 0; i < 4; i++) {
        *(uint4*)(As + nb * BM * LDSS + (rb + 32 * i) * LDSS + kc) = ra[i];
        *(uint4*)(Bs + nb * BN * LDSS + (rb + 32 * i) * LDSS + kc) = rv[i];
      }
    }
    __syncthreads();
  }
}
struct NoHook { DI void operator()(int, f32x16 (&)[2][2]) const {} };

template <class EW, class DST>
DI void epi_transposed(bf16_t* sm, f32x16 (&acc)[2][2], const EW& ew, const DST& dst) {
  const int tid = threadIdx.x & 255, lane = tid & 63, wid = tid >> 6, wm = wid >> 1, wn = wid & 1;
#pragma unroll
  for (int mi = 0; mi < 2; mi++)
#pragma unroll
    for (int g = 0; g < 4; g++) {
      const int ml = wm * 64 + mi * 32 + 8 * g + 4 * (lane >> 5);
      float v0[4], v1[4];
#pragma unroll
      for (int e = 0; e < 4; e++) { v0[e] = acc[mi][0][4 * g + e]; v1[e] = acc[mi][1][4 * g + e]; ew(mi, g, e, v0[e], v1[e]); }
      const int nl = wn * 64 + (lane & 31);
      uint2 w0, w1;
      w0.x = pk2(v0[0], v0[1]); w0.y = pk2(v0[2], v0[3]); w1.x = pk2(v1[0], v1[1]); w1.y = pk2(v1[2], v1[3]);
      *(uint2*)(sm + nl * TLD + ml) = w0;
      *(uint2*)(sm + (nl + 32) * TLD + ml) = w1;
    }
  __syncthreads();
  {
    const int nl = tid >> 1, r = tid & 1;
    bf16_t* d = dst(nl, r);
    const bf16_t* s = sm + nl * TLD + 64 * r;
#pragma unroll
    for (int i = 0; i < 8; i++) *(uint4*)(d + 8 * i) = *(const uint4*)(s + 8 * i);
  }
}

DI void ssm_pow(const P& p, int g, int dir, int pp, int j, float& re, float& im) {
  const int ia = (dir * 32 + g) * 64 + pp;
  const float lr = fminf(p.a_re[ia], -1e-4f), li = p.a_im[ia], dt = expf(p.log_dt[dir * 32 + g]);
  const float mag = expf(lr * dt * (float)j);
  double t = (double)li * (double)dt * (double)j * 0.15915494309189535;
  t -= rint(t);
  const float ang = (float)(t * 6.283185307179586);
  float s, c; sincosf(ang, &s, &c);
  re = mag * c; im = mag * s;
}
DI void ssm_coef(const P& p, int g, int dir, int pp, float& cr, float& ci) {
  const int ia = (dir * 32 + g) * 64 + pp;
  const float lr = fminf(p.a_re[ia], -1e-4f), li = p.a_im[ia];
  float ar, ai; ssm_pow(p, g, dir, pp, 1, ar, ai);
  const float nr = ar - 1.f, ni = ai, den = 1.f / (lr * lr + li * li);
  cr = (nr * lr + ni * li) * den; ci = (ni * lr - nr * li) * den;
}

template <class CM>
DI void transpose_job(float* tile, bool act, int item, const float* in, int ld, int Kdim, bf16_t* out, const CM& colmap, const float* sc0, const float* sc1) {
  const int nkt = Kdim / 64, nt = item / nkt, kt = item % nkt, tid = threadIdx.x & 255;
  __syncthreads();
  if (act) {
    const int c = tid & 31, kr = tid >> 5, col = colmap(nt * 32 + c);
#pragma unroll
    for (int i = 0; i < 8; i++) {
      const int kl = kr + 8 * i, k = kt * 64 + kl;
      float v = in[(size_t)k * ld + col];
      if (sc0) v *= (k < 512 ? sc0[k] : sc1[k - 512]);
      tile[kl * 33 + c] = v;
    }
  }
  __syncthreads();
  if (act) {
    const int nl = tid >> 3, kc = tid & 7;
    float v[8];
#pragma unroll
    for (int j = 0; j < 8; j++) v[j] = tile[(kc * 8 + j) * 33 + nl];
    uint4 w; w.x = pk2(v[0], v[1]); w.y = pk2(v[2], v[3]); w.z = pk2(v[4], v[5]); w.w = pk2(v[6], v[7]);
    *(uint4*)(out + (size_t)(nt * 32 + nl) * Kdim + kt * 64 + kc * 8) = w;
  }
}

DI void phase0(const P& p, unsigned char* smraw) {
  float* smf = (float*)smraw;
  const int tid = threadIdx.x & 255, nb = gridDim.x * 2, bid = blockIdx.x * 2 + (threadIdx.x >> 8);
  for (int base = 0; base < 96; base += nb) {
    const int item = base + bid; const bool act = item < 96;
    __syncthreads();
    if (act)
      for (int i = tid; i < 17 * 1024; i += 256) {
        const int b = i >> 10, k = i & 1023;
        const float c = b == 0 ? p.cp[k] : p.cs[(b - 1) * 1024 + k];
        smf[i] = c / (1.f + __expf(-c));
      }
    __syncthreads();
    const int col = tid & 63, kq = tid >> 6, j = item * 64 + col;
    float a[17];
#pragma unroll
    for (int b = 0; b < 17; b++) a[b] = 0.f;
    if (act)
      for (int k = kq * 256; k < kq * 256 + 256; k++) {
        const float w = p.w_ada[(size_t)k * 6144 + j];
#pragma unroll
        for (int b = 0; b < 17; b++) a[b] += smf[b * 1024 + k] * w;
      }
    __syncthreads();
#pragma unroll
    for (int b = 0; b < 17; b++) smf[(kq * 17 + b) * 64 + col] = a[b];
    __syncthreads();
    if (act)
      for (int i = tid; i < 17 * 64; i += 256) {
        const int b = i >> 6, c2 = i & 63;
        const float s = smf[(0 * 17 + b) * 64 + c2] + smf[(1 * 17 + b) * 64 + c2] + smf[(2 * 17 + b) * 64 + c2] + smf[(3 * 17 + b) * 64 + c2];
        p.mod()[b * 6144 + item * 64 + c2] = s + p.b_ada[item * 64 + c2];
      }
  }
  {
    auto ident = [](int n) { return n; };
    auto glumap = [](int n) { return ((n >> 5) & 1) * 512 + (n >> 6) * 32 + (n & 31); };
    const int n0 = 512, n1 = n0 + 256, n2 = n1 + 512, n3 = n2 + 2048, n4 = n3 + 2048;
    for (int base = 0; base < n4; base += nb) {
      const int item = base + bid; const bool act = item < n4;
      if (item < n0) transpose_job(smf, act, item, p.w_in, 1024, 1024, p.wint(), ident, nullptr, nullptr);
      else if (item < n1) transpose_job(smf, act, item - n0, p.w_glu, 1024, 512, p.wglut(), glumap, nullptr, nullptr);
      else if (item < n2) transpose_job(smf, act, item - n1, p.w_out, 1024, 1024, p.woutt(), ident, p.g_fo, p.g_so);
      else if (item < n3) transpose_job(smf, act, item - n2, p.w1, 4096, 1024, p.w1t(), ident, nullptr, nullptr);
      else transpose_job(smf, act, item - n3, p.w2, 1024, 4096, p.w2t(), ident, nullptr, nullptr);
    }
  }
  {
    __syncthreads();
    float2* cs = (float2*)smraw;
    for (int i = tid; i < 512; i += 256) { float s, c; sincosf((float)i * (6.283185307179586f / 512.f), &s, &c); cs[i] = make_float2(c, s); }
    __syncthreads();
    for (int item = bid; item < 2048; item += nb) {
      const int idx = item * 256 + tid, n = idx >> 10, k = idx & 1023, h = n >> 7, e = n & 127, c = k & 511;
      const bool is_sin = k >= 512;
      const float* wf = p.w_f + (size_t)h * 128 * 128 + e;
      float a = 0.f;
      for (int d = 0; d < 128; d++) {
        const float2 t = cs[((h * 128 + d) * c) & 511];
        a += (is_sin ? t.y : t.x) * wf[d * 128];
      }
      p.Mf()[idx] = f2bf(a);
    }
  }
  {
    const int gsz = nb * 256, gt = bid * 256 + tid;
    for (int i = gt; i < 256 * 128; i += gsz) {
      const int n = i >> 7, k = i & 127, k1 = (n >> 6) * 32 + (n & 31), part = (n >> 5) & 1;
      float s, c; sincosf((float)((k1 * k) & 127) * (6.283185307179586f / 128.f), &s, &c);
      p.F1p()[i] = f2bf(part ? -s : c);
    }
    for (int i = gt; i < 128 * 64; i += gsz) {
      const int n = i >> 6, k = i & 63, k1 = (n >> 6) * 32 + (n & 31), part = (n >> 5) & 1;
      float s, c; sincosf((float)((k1 * k) & 63) * (6.283185307179586f / 64.f), &s, &c);
      p.F1s()[i] = f2bf(part ? -s : c);
    }
    for (int i = gt; i < 256 * 256; i += gsz) {
      const int n = i >> 8, k = i & 255, part = n >> 7, k2 = n & 127, l2 = k & 127, ki = k >> 7;
      float s, c; sincosf((float)((k2 * l2) & 127) * (6.283185307179586f / 128.f), &s, &c);
      p.F2p()[i] = f2bf(part == 0 ? (ki == 0 ? c : s) : (ki == 0 ? -s : c));
    }
    for (int i = gt; i < 128 * 128; i += gsz) {
      const int n = i >> 7, k = i & 127, part = n >> 6, k2 = n & 63, l2 = k & 63, ki = k >> 6;
      float s, c; sincosf((float)((k2 * l2) & 63) * (6.283185307179586f / 64.f), &s, &c);
      p.F2s()[i] = f2bf(part == 0 ? (ki == 0 ? c : s) : (ki == 0 ? -s : c));
    }
    for (int i = gt; i < LPR; i += gsz) { float s, c; sincosf((float)i * (6.283185307179586f / 16384.f), &s, &c); p.twp()[i] = make_float2(c, s); }
    for (int i = gt; i < LSM; i += gsz) { float s, c; sincosf((float)i * (6.283185307179586f / 4096.f), &s, &c); p.tws()[i] = make_float2(c, s); }
    for (int i = gt; i < 32 * 2 * 64 * 64; i += gsz) {
      const int s = i & 63, pp = (i >> 6) & 63, dir = (i >> 12) & 1, g = i >> 13;
      float pr, pi, cr, ci; ssm_pow(p, g, dir, pp, dir == 0 ? 63 - s : s, pr, pi); ssm_coef(p, g, dir, pp, cr, ci);
      const float qr = pr * cr - pi * ci, qi = pr * ci + pi * cr;
      const int ib = ((dir * 32 + g) * 64 + pp) * 16;
      float vr[16], vi[16];
#pragma unroll
      for (int h = 0; h < 16; h++) { const float br = p.b_re[ib + h], bi = p.b_im[ib + h]; vr[h] = qr * br - qi * bi; vi[h] = qr * bi + qi * br; }
      bf16_t* d0 = p.Bs() + ((size_t)(g * 256 + dir * 128 + pp)) * 1024 + s * 16;
      bf16_t* d1 = d0 + 64 * 1024;
      uint4 w;
      w.x = pk2(vr[0], vr[1]); w.y = pk2(vr[2], vr[3]); w.z = pk2(vr[4], vr[5]); w.w = pk2(vr[6], vr[7]); *(uint4*)d0 = w;
      w.x = pk2(vr[8], vr[9]); w.y = pk2(vr[10], vr[11]); w.z = pk2(vr[12], vr[13]); w.w = pk2(vr[14], vr[15]); *(uint4*)(d0 + 8) = w;
      w.x = pk2(vi[0], vi[1]); w.y = pk2(vi[2], vi[3]); w.z = pk2(vi[4], vi[5]); w.w = pk2(vi[6], vi[7]); *(uint4*)d1 = w;
      w.x = pk2(vi[8], vi[9]); w.y = pk2(vi[10], vi[11]); w.z = pk2(vi[12], vi[13]); w.w = pk2(vi[14], vi[15]); *(uint4*)(d1 + 8) = w;
    }
    for (int i = gt; i < 32 * 64 * 2 * 64; i += gsz) {
      const int pp = i & 63, dir = (i >> 6) & 1, t = (i >> 7) & 63, g = i >> 13;
      float pr, pi; ssm_pow(p, g, dir, pp, dir == 0 ? t + 1 : 64 - t, pr, pi);
#pragma unroll
      for (int h = 0; h < 16; h++) {
        const int ic = ((dir * 32 + g) * 16 + h) * 64 + pp;
        const float cr = p.c_re[ic], ci = p.c_im[ic];
        bf16_t* d = p.Co() + ((size_t)(g * 1024 + t * 16 + h)) * 256 + dir * 128 + pp;
        d[0] = f2bf(cr * pr - ci * pi);
        d[64] = f2bf(-(cr * pi + ci * pr));
      }
    }
    for (int i = gt; i < 32 * 2 * 64; i += gsz) {
      const int pp = i & 63, dir = (i >> 6) & 1, g = i >> 7;
      float pr, pi; ssm_pow(p, g, dir, pp, 64, pr, pi);
      p.AT()[i * 2] = pr; p.AT()[i * 2 + 1] = pi;
    }
  }
  {
    float2* q = (float2*)smraw;
    for (int base = 0; base < 32 * 127; base += nb) {
      const int item = base + bid; const bool act = item < 32 * 127;
      const int g = act ? item / 127 : 0, jj = act ? item % 127 : 0, lag = jj - 63;
      __syncthreads();
      if (tid < 128) {
        const int dir = tid >> 6, pp = tid & 63;
        float2 v = make_float2(0.f, 0.f);
        if ((dir == 0 && lag >= 0) || (dir == 1 && lag <= 0)) {
          float pr, pi, cr, ci; ssm_pow(p, g, dir, pp, lag < 0 ? -lag : lag, pr, pi); ssm_coef(p, g, dir, pp, cr, ci);
          v = make_float2(pr * cr - pi * ci, pr * ci + pi * cr);
        }
        q[tid] = v;
      }
      __syncthreads();
      const int hp = tid >> 4, h = tid & 15;
      float a = 0.f;
#pragma unroll
      for (int dir = 0; dir < 2; dir++) {
        if ((dir == 0 && lag < 0) || (dir == 1 && lag > 0)) continue;
        for (int pp = 0; pp < 64; pp++) {
          const int ic = ((dir * 32 + g) * 16 + hp) * 64 + pp, ib = ((dir * 32 + g) * 64 + pp) * 16 + h;
          const float cr = p.c_re[ic], ci = p.c_im[ic], br = p.b_re[ib], bi = p.b_im[ib];
          const float2 qq = q[dir * 64 + pp];
          const float er = cr * qq.x - ci * qq.y, ei = cr * qq.y + ci * qq.x;
          a += er * br - ei * bi;
        }
      }
      if (lag == 0 && hp == h) a += p.ssm_d[g * 16 + h];
      if (act) p.Ktab()[(size_t)item * 256 + tid] = f2bf(a);
    }
  }
}

DI void rownorm_mod(const P& p, bool from_x, const float* g, int sh_off, int sc_off) {
  const int lane = threadIdx.x & 63, wv = blockIdx.x * 8 + (threadIdx.x >> 6), nw = gridDim.x * 8;
  for (int tok = wv; tok < NTOK; tok += nw) {
    const float* src = from_x ? (tok < LPR ? p.xp + (size_t)tok * 1024 : p.xs + (size_t)(tok - LPR) * 1024) : p.out + (size_t)tok * 1024;
    f32x4 v[4]; float ss = 0.f;
#pragma unroll
    for (int i = 0; i < 4; i++) { v[i] = *(const f32x4*)(src + (i * 64 + lane) * 4); ss += v[i][0] * v[i][0] + v[i][1] * v[i][1] + v[i][2] * v[i][2] + v[i][3] * v[i][3]; }
    ss = wave_sum(ss);
    const float r = rsqrtf(ss * (1.f / 1024.f) + EPSV);
    const float* md = p.mod() + batch_of(tok) * 6144;
#pragma unroll
    for (int i = 0; i < 4; i++) {
      const int c = (i * 64 + lane) * 4;
      const f32x4 gg = *(const f32x4*)(g + c), sc = *(const f32x4*)(md + sc_off + c), sh = *(const f32x4*)(md + sh_off + c);
      float o[4];
#pragma unroll
      for (int e = 0; e < 4; e++) o[e] = v[i][e] * r * gg[e] * (1.f + sc[e]) + sh[e];
      uint2 w; w.x = pk2(o[0], o[1]); w.y = pk2(o[2], o[3]);
      *(uint2*)(p.hb() + (size_t)tok * 1024 + c) = w;
    }
  }
}
DI void final_norm(const P& p) {
  const int lane = threadIdx.x & 63, wv = blockIdx.x * 8 + (threadIdx.x >> 6), nw = gridDim.x * 8;
  for (int tok = wv; tok < NTOK; tok += nw) {
    float* src = p.out + (size_t)tok * 1024;
    f32x4 v[4]; float ss = 0.f;
#pragma unroll
    for (int i = 0; i < 4; i++) { v[i] = *(const f32x4*)(src + (i * 64 + lane) * 4); ss += v[i][0] * v[i][0] + v[i][1] * v[i][1] + v[i][2] * v[i][2] + v[i][3] * v[i][3]; }
    ss = wave_sum(ss);
    const float r = rsqrtf(ss * (1.f / 1024.f) + EPSV);
#pragma unroll
    for (int i = 0; i < 4; i++) {
      const int c = (i * 64 + lane) * 4;
      const f32x4 gg = *(const f32x4*)(p.g_final + c);
      f32x4 o;
#pragma unroll
      for (int e = 0; e < 4; e++) o[e] = v[i][e] * r * gg[e];
      *(f32x4*)(src + c) = o;
    }
  }
}

#define GEO const int half = threadIdx.x >> 8, tid = threadIdx.x & 255, lane = tid & 63, wid = tid >> 6, wm = wid >> 1, wn = wid & 1, l31 = lane & 31, lh = lane >> 5; (void)half; (void)tid; (void)wm; (void)wn; (void)l31; (void)lh;

DI void phase2(const P& p, bf16_t* sm) {
  GEO
  for (int q = blockIdx.x; q < 640 * 8 / 2; q += gridDim.x) {
    const int t = 2 * q + half;
    const int tm = t >> 3, sub = t & 7, m0 = tm * 128;
    f32x16 acc[2][2];
    if (sub < 4) {
      const int n0 = sub * 128;
      auto af = [&](int r, int k) {
        const int v = m0 + r; int tok;
        if (v < LPR) tok = ((v & 127) << 7) | (v >> 7);
        else { const int vs = v - LPR, w = vs & 4095; tok = LPR + (vs & ~4095) + ((w & 63) << 6) + (w >> 6); }
        return p.hb() + (size_t)tok * 1024 + k;
      };
      auto bf = [&](int r, int k) { return p.wint() + (size_t)(n0 + r) * 1024 + k; };
      gemm_main<false>(sm, 1024, af, bf, NoHook(), acc);
      auto ew = [](int, int, int, float&, float&) {};
      auto dst = [&](int nl, int r) {
        const int c = n0 + nl;
        if (m0 < LPR) return p.zT() + (size_t)c * LPR + m0 + 64 * r;
        const int vs0 = m0 - LPR, b = vs0 >> 12, vl0 = vs0 & 4095;
        return p.zT() + (size_t)512 * LPR + ((size_t)(b * 512 + c)) * 4096 + vl0 + 64 * r;
      };
      epi_transposed(sm, acc, ew, dst);
    } else {
      const int n0 = 512 + (sub - 4) * 128;
      auto af = [&](int r, int k) { return p.hb() + (size_t)(m0 + r) * 1024 + k; };
      auto bf = [&](int r, int k) { return p.wint() + (size_t)(n0 + r) * 1024 + k; };
      gemm_main<true>(sm, 1024, af, bf, NoHook(), acc);
#pragma unroll
      for (int mi = 0; mi < 2; mi++)
#pragma unroll
        for (int ni = 0; ni < 2; ni++)
#pragma unroll
          for (int g = 0; g < 4; g++) {
            const int tok = m0 + wm * 64 + mi * 32 + l31, col = n0 - 512 + wn * 64 + ni * 32 + 8 * g + 4 * lh;
            uint2 w; w.x = pk2(acc[mi][ni][4 * g], acc[mi][ni][4 * g + 1]); w.y = pk2(acc[mi][ni][4 * g + 2], acc[mi][ni][4 * g + 3]);
            *(uint2*)(p.zs() + ((size_t)(col >> 4) * NTOK + tok) * 16 + (col & 15)) = w;
          }
    }
  }
}

template <int R>
DI void fft1_tile(const P& p, bf16_t* sm, int tm, int tn) {
  GEO
  constexpr bool pr = (R == 128);
  f32x16 acc[2][2];
  const bf16_t* Abase = pr ? p.zT() + (size_t)tm * 128 * 128 : p.zT() + (size_t)512 * LPR + (size_t)tm * 128 * 64;
  const bf16_t* Bbase = pr ? p.F1p() + (size_t)tn * 128 * 128 : p.F1s();
  auto af = [&](int r, int k) { return Abase + r * R + k; };
  auto bf = [&](int r, int k) { return Bbase + r * R + k; };
  gemm_main<false>(sm, R, af, bf, NoHook(), acc);
  const int k1 = (tn * 2 + wn) * 32 + l31;
  const float2* tw = pr ? p.twp() : p.tws();
  constexpr int lmask = pr ? 16383 : 4095, l2mask = R - 1;
  const float2 tb = tw[(unsigned)((k1 * ((wm * 64 + 4 * lh) & l2mask)) & lmask)], t1 = tw[(unsigned)(k1 & lmask)], t8 = tw[(unsigned)((k1 * 8) & lmask)],
               t32 = tw[(unsigned)((k1 * (32 & l2mask)) & lmask)];
  float2 wt[2][4][4];
#pragma unroll
  for (int mi = 0; mi < 2; mi++) {
    float2 w = tb;
    if (mi) w = make_float2(tb.x * t32.x - tb.y * t32.y, tb.y * t32.x + tb.x * t32.y);
#pragma unroll
    for (int g = 0; g < 4; g++) {
      float2 u = w;
#pragma unroll
      for (int e = 0; e < 4; e++) {
        wt[mi][g][e] = u;
        u = make_float2(u.x * t1.x - u.y * t1.y, u.y * t1.x + u.x * t1.y);
      }
      w = make_float2(w.x * t8.x - w.y * t8.y, w.y * t8.x + w.x * t8.y);
    }
  }
  auto ew = [&](int mi, int g, int e, float& re, float& im) {
    const float2 w = wt[mi][g][e];
    const float a = re * w.x + im * w.y, b = im * w.x - re * w.y;
    re = a; im = b;
  };
  auto dst = [&](int nl, int r) {
    const int part = (nl >> 5) & 1, kk1 = (tn * 2 + (nl >> 6)) * 32 + (nl & 31);
    if (pr) return p.Tt() + ((size_t)(tm * 128 + kk1)) * 256 + part * 128 + 64 * r;
    return p.Tt() + (size_t)65536 * 256 + ((size_t)((tm * 2 + r) * 64 + kk1)) * 128 + part * 64;
  };
  epi_transposed(sm, acc, ew, dst);
}
DI void phase3(const P& p, bf16_t* sm) {
  GEO
  const int NA = 1024, NB_ = 4096, NC = 640;
  for (int q = blockIdx.x; q < (NA + NB_ + NC) / 2; q += gridDim.x) {
    const int t = 2 * q + half;
    if (t < NA) fft1_tile<128>(p, sm, t >> 1, t & 1);
    else if (t < NA + NB_) fft1_tile<64>(p, sm, t - NA, 0);
    else {
      f32x16 acc[2][2];
      const int u = t - NA - NB_, g = u / 20, rem = u % 20, m0 = (rem >> 1) * 128, n0 = (rem & 1) * 128;
      auto af = [&](int r, int k) { return p.zs() + (size_t)g * NTOK * 16 + (size_t)(m0 + r) * 1024 + k; };
      auto bf = [&](int r, int k) { return p.Bs() + (size_t)(g * 256 + n0 + r) * 1024 + k; };
      gemm_main<true>(sm, 1024, af, bf, NoHook(), acc);
#pragma unroll
      for (int mi = 0; mi < 2; mi++)
#pragma unroll
        for (int ni = 0; ni < 2; ni++)
#pragma unroll
          for (int gg = 0; gg < 4; gg++) {
            const int ch = m0 + wm * 64 + mi * 32 + l31, col = n0 + wn * 64 + ni * 32 + 8 * gg + 4 * lh;
            f32x4 v = {acc[mi][ni][4 * gg], acc[mi][ni][4 * gg + 1], acc[mi][ni][4 * gg + 2], acc[mi][ni][4 * gg + 3]};
            *(f32x4*)(p.S() + ((size_t)ch * 32 + g) * 256 + col) = v;
          }
    }
  }
}

template <int R>
DI void fft2_tile(const P& p, bf16_t* sm, int tm, int tn) {
  constexpr bool pr = (R == 128);
  constexpr int K = 2 * R;
  f32x16 acc[2][2];
  const int ct = tm & 3, k1 = pr ? (tm >> 2) : ((tm >> 2) & 63), b = pr ? 0 : (tm >> 8);
  const bf16_t* Abase = pr ? p.Tt() + ((size_t)(ct * 128) * 128 + k1) * 256 : p.Tt() + (size_t)65536 * 256 + ((size_t)(b * 512 + ct * 128) * 64 + k1) * 128;
  constexpr int rstride = R * K;
  const bf16_t* Bbase = pr ? p.F2p() + (size_t)tn * 128 * 256 : p.F2s();
  auto af = [&](int r, int k) { return Abase + (size_t)r * rstride + k; };
  auto bf = [&](int r, int k) { return Bbase + r * K + k; };
  gemm_main<false>(sm, K, af, bf, NoHook(), acc);
  auto ew = [](int, int, int, float&, float&) {};
  auto dst = [&](int nl, int r) {
    const int n = tn * 128 + nl, part = pr ? (n >> 7) : (n >> 6), k2 = n & (R - 1);
    const int tok = (pr ? 0 : LPR + b * 4096) + k1 + R * k2;
    return p.AF() + (size_t)tok * 1024 + part * 512 + ct * 128 + 64 * r;
  };
  epi_transposed(sm, acc, ew, dst);
}
DI void phase4(const P& p, bf16_t* sm) {
  GEO
  for (int idx = blockIdx.x * 512 + threadIdx.x; idx < 17 * 4096; idx += gridDim.x * 512) {
    const int seq = idx >> 12, rem = idx & 4095, g = rem >> 7, dir = (rem >> 6) & 1, pp = rem & 63;
    const int c0 = seq == 0 ? 0 : 256 + (seq - 1) * 64, nc = seq == 0 ? 256 : 64;
    const float ar = p.AT()[((g * 2 + dir) * 64 + pp) * 2], ai = p.AT()[((g * 2 + dir) * 64 + pp) * 2 + 1];
    float hr = 0.f, hi = 0.f;
    const size_t off = (size_t)g * 256 + dir * 128 + pp;
    for (int i0 = 0; i0 < nc; i0 += 8) {
      float sr[8], si[8];
#pragma unroll
      for (int j = 0; j < 8; j++) {
        const int c = c0 + (dir == 0 ? i0 + j : nc - 1 - i0 - j);
        sr[j] = p.S()[(size_t)c * 8192 + off]; si[j] = p.S()[(size_t)c * 8192 + off + 64];
      }
#pragma unroll
      for (int j = 0; j < 8; j++) {
        const int c = c0 + (dir == 0 ? i0 + j : nc - 1 - i0 - j);
        p.H()[(size_t)c * 8192 + off] = f2bf(hr); p.H()[(size_t)c * 8192 + off + 64] = f2bf(hi);
        const float nr = ar * hr - ai * hi + sr[j], ni = ar * hi + ai * hr + si[j];
        hr = nr; hi = ni;
      }
    }
  }
  for (int q = blockIdx.x; q < (1024 + 4096) / 2; q += gridDim.x) {
    const int t = 2 * q + half;
    if (t < 1024) fft2_tile<128>(p, sm, t >> 1, t & 1);
    else fft2_tile<64>(p, sm, t - 1024, 0);
  }
}

DI float gelu_tanh(float x) {
  const float u = 0.7978845608028654f * (x + 0.044715f * x * x * x);
  return x / (1.f + __expf(-2.f * u));
}

DI void phase5(const P& p, bf16_t* sm) {
  GEO
  for (int q = blockIdx.x; q < (2560 + 2560) / 2; q += gridDim.x) {
    const int t = 2 * q + half;
    f32x16 acc[2][2];
    if (t < 2560) {
      const int tm = t >> 2, tn = t & 3, m0 = tm * 128, n0 = tn * 128;
      auto af = [&](int r, int k) { return p.AF() + (size_t)(m0 + r) * 1024 + k; };
      auto bf = [&](int r, int k) { return p.Mf() + (size_t)(n0 + r) * 1024 + k; };
      gemm_main<true>(sm, 1024, af, bf, NoHook(), acc);
#pragma unroll
      for (int mi = 0; mi < 2; mi++) {
        const int tok = m0 + wm * 64 + mi * 32 + l31;
        const float scale = tok < LPR ? 3.4526698300124393e-4f : 6.905339660024879e-4f;
        float ss = 0.f;
#pragma unroll
        for (int ni = 0; ni < 2; ni++)
#pragma unroll
          for (int g = 0; g < 4; g++) {
            const int col = n0 + wn * 64 + ni * 32 + 8 * g + 4 * lh;
            const f32x4 bb = *(const f32x4*)(p.b_f + col);
            float o[4];
#pragma unroll
            for (int e = 0; e < 4; e++) { o[e] = acc[mi][ni][4 * g + e] * scale + bb[e]; ss += o[e] * o[e]; }
            uint2 w; w.x = pk2(o[0], o[1]); w.y = pk2(o[2], o[3]);
            *(uint2*)(p.yf() + (size_t)tok * 512 + col) = w;
          }
        ss += __shfl_xor(ss, 32);
        if (lh == 0) p.ssf()[tok * 8 + tn * 2 + wn] = ss;
      }
    } else {
      const int u = t - 2560, g = u / 80, rem = u % 80, m0 = (rem >> 3) * 128, n0 = (rem & 7) * 128;
      const bf16_t* Ug = p.zs() + (size_t)g * NTOK * 16;
      const bf16_t* Kg = p.Ktab() + (size_t)g * 127 * 256;
      auto af = [&](int r, int k) { return k < 1024 ? Ug + (size_t)(m0 + r) * 1024 + k : p.H() + ((size_t)(m0 + r) * 32 + g) * 256 + (k - 1024); };
      auto bf = [&](int r, int k) {
        const int n = n0 + r;
        return k < 1024 ? Kg + (((n >> 4) - (k >> 4) + 63) * 256 + (n & 15) * 16 + (k & 15)) : p.Co() + ((size_t)(g * 1024 + n)) * 256 + (k - 1024);
      };
      gemm_main<true>(sm, 1280, af, bf, NoHook(), acc);
#pragma unroll
      for (int mi = 0; mi < 2; mi++)
#pragma unroll
        for (int ni = 0; ni < 2; ni++)
#pragma unroll
          for (int gg = 0; gg < 4; gg++) {
            const int ch = m0 + wm * 64 + mi * 32 + l31, n = n0 + wn * 64 + ni * 32 + 8 * gg + 4 * lh;
            const int tok = ch * 64 + (n >> 4);
            float o[4];
#pragma unroll
            for (int e = 0; e < 4; e++) o[e] = gelu_tanh(acc[mi][ni][4 * gg + e]);
            uint2 w; w.x = pk2(o[0], o[1]); w.y = pk2(o[2], o[3]);
            *(uint2*)(p.gact() + (size_t)tok * 512 + g * 16 + (n & 15)) = w;
          }
    }
  }
}

DI void phase6(const P& p, bf16_t* sm) {
  GEO
  for (int q = blockIdx.x; q < 640 * 8 / 2; q += gridDim.x) {
    const int t = 2 * q + half;
    f32x16 acc[2][2];
    const int tm = t >> 3, tn = t & 7, m0 = tm * 128, n0 = tn * 128;
    auto af = [&](int r, int k) { return p.gact() + (size_t)(m0 + r) * 512 + k; };
    auto bf = [&](int r, int k) { return p.wglut() + (size_t)(n0 + r) * 512 + k; };
    gemm_main<true>(sm, 512, af, bf, NoHook(), acc);
#pragma unroll
    for (int mi = 0; mi < 2; mi++) {
      const int tok = m0 + wm * 64 + mi * 32 + l31;
      float ss = 0.f;
#pragma unroll
      for (int g = 0; g < 4; g++) {
        const int j = (tn * 2 + wn) * 32 + 8 * g + 4 * lh;
        const f32x4 bv = *(const f32x4*)(p.b_glu + j), bg = *(const f32x4*)(p.b_glu + 512 + j);
        float o[4];
#pragma unroll
        for (int e = 0; e < 4; e++) {
          const float val = acc[mi][0][4 * g + e] + bv[e], gate = acc[mi][1][4 * g + e] + bg[e];
          o[e] = val / (1.f + __expf(-gate)); ss += o[e] * o[e];
        }
        uint2 w; w.x = pk2(o[0], o[1]); w.y = pk2(o[2], o[3]);
        *(uint2*)(p.ys() + (size_t)tok * 512 + j) = w;
      }
      ss += __shfl_xor(ss, 32);
      if (lh == 0) p.sss()[tok * 16 + tn * 2 + wn] = ss;
    }
  }
}

DI void phase7(const P& p, bf16_t* sm) {
  GEO
  for (int q = blockIdx.x; q < 640 * 8 / 2; q += gridDim.x) {
    const int t = 2 * q + half;
    f32x16 acc[2][2];
    const int tm = t >> 3, tn = t & 7, m0 = tm * 128, n0 = tn * 128;
    float ratio[2], rs[2];
#pragma unroll
    for (int mi = 0; mi < 2; mi++) {
      const int tok = m0 + wm * 64 + mi * 32 + l31;
      float sf = 0.f, s2 = 0.f;
#pragma unroll
      for (int i = 0; i < 8; i++) sf += p.ssf()[tok * 8 + i];
#pragma unroll
      for (int i = 0; i < 16; i++) s2 += p.sss()[tok * 16 + i];
      const float rf = rsqrtf(sf * (1.f / 512.f) + EPSV);
      rs[mi] = rsqrtf(s2 * (1.f / 512.f) + EPSV);
      ratio[mi] = rf / rs[mi];
    }
    auto af = [&](int r, int k) { return k < 512 ? p.yf() + (size_t)(m0 + r) * 512 + k : p.ys() + (size_t)(m0 + r) * 512 + (k - 512); };
    auto bf = [&](int r, int k) { return p.woutt() + (size_t)(n0 + r) * 1024 + k; };
    auto hk = [&](int kt, f32x16 (&a)[2][2]) {
      if (kt == 8) {
#pragma unroll
        for (int mi = 0; mi < 2; mi++)
#pragma unroll
          for (int ni = 0; ni < 2; ni++)
#pragma unroll
            for (int e = 0; e < 16; e++) a[mi][ni][e] *= ratio[mi];
      }
    };
    gemm_main<true>(sm, 1024, af, bf, hk, acc);
#pragma unroll
    for (int mi = 0; mi < 2; mi++) {
      const int tok = m0 + wm * 64 + mi * 32 + l31;
      const float* xr = tok < LPR ? p.xp + (size_t)tok * 1024 : p.xs + (size_t)(tok - LPR) * 1024;
      const float* g1 = p.mod() + batch_of(tok) * 6144 + 2048;
#pragma unroll
      for (int ni = 0; ni < 2; ni++)
#pragma unroll
        for (int g = 0; g < 4; g++) {
          const int col = n0 + wn * 64 + ni * 32 + 8 * g + 4 * lh;
          const f32x4 xv = *(const f32x4*)(xr + col), gv = *(const f32x4*)(g1 + col);
          f32x4 o;
#pragma unroll
          for (int e = 0; e < 4; e++) o[e] = xv[e] + gv[e] * acc[mi][ni][4 * g + e] * rs[mi];
          *(f32x4*)(p.out + (size_t)tok * 1024 + col) = o;
        }
    }
  }
}

namespace pg8 {
#define PG8_LAS __attribute__((address_space(3)))
typedef unsigned short bf16_t;
typedef short bf16x8 __attribute__((ext_vector_type(8)));
typedef float f32x4 __attribute__((ext_vector_type(4)));
typedef unsigned u32x4 __attribute__((ext_vector_type(4)));
constexpr int BM = 256, BK = 64, HALF = 128, HTB = HALF * BK * 2  , STAGE_BYTES = 8 * HTB, NXCD = 8, WGM = 8;

__host__ __device__ __forceinline__ int lds_byte(int r, int c) { const int st = (r >> 4) * 2 + (c >> 5), rr = r & 15, cc = c & 31, ob = rr * 64 + cc * 2; return st * 1024 + (ob ^ (((ob >> 9) & 1) << 5)); }
__host__ __device__ __forceinline__ void stage_rc(int b, int& R, int& C) { const int st = b / 1024, sb = b % 1024, swz = sb ^ (((sb >> 9) & 1) << 5); R = (st >> 1) * 16 + swz / 64; C = (st & 1) * 32 + (swz % 64) / 2; }
__host__ __device__ __forceinline__ int perm32(int rho) { const int n = rho >> 4, i = rho & 15; return 8 * (i >> 2) + 4 * n + (i & 3); }

struct Unit { int pm, pn; };
struct Gemm { const bf16_t* A; const bf16_t* Bt; int M, N, K; };

struct StaticOrder {
    int nM, nN, nwg, G, c;
    __host__ __device__ void init(int M, int N, int G_, int c_) { nM = M / BM; nN = N / BM; nwg = nM * nN; G = G_; c = c_; }
    __host__ __device__ bool next(int i, Unit& u) const {
        const long L = (long)i * G + c; if (L >= nwg) return false;
        int wgid = (int)L; { const int q = nwg / NXCD, r = nwg % NXCD, xcd = wgid % NXCD, off = wgid / NXCD; wgid = (xcd < r ? xcd * (q + 1) : r * (q + 1) + (xcd - r) * q) + off; }
        const int nig = WGM * nN, gid = wgid / nig, fm = gid * WGM, gsz = (nM - fm) < WGM ? (nM - fm) : WGM;
        u.pm = fm + ((wgid % nig) % gsz); u.pn = (wgid % nig) / gsz; return true;
    }
    __device__ __forceinline__ void a_ready(const Unit&) const {}
    __device__ __forceinline__ void done(const Unit&) const {}
};

template <class Epi, class Sched, bool ALIGN_EPI = false, bool SP2 = false>
__device__ __forceinline__ void gemm_phase(PG8_LAS unsigned char* lds, const Gemm g, const Sched& S, const Epi& E) {
    const int tid = threadIdx.x, wid = __builtin_amdgcn_readfirstlane(tid >> 6), lane = tid & 63, wr = wid >> 2, wc = wid & 3, fr = lane & 15, fq = lane >> 4;
    const int K = g.K, nt = K / BK;
    unsigned voffA[2], voffB[2];
#pragma unroll
    for (int i = 0; i < 2; ++i) { int R, C; stage_rc(tid * 16 + i * 8192, R, C); const int Rb = Epi::PERM ? ((R & ~31) + perm32(R & 31)) : R;
        voffA[i] = (unsigned)(R * K + C) * 2u; voffB[i] = (unsigned)(Rb * K + C) * 2u; }
    const size_t kstep = (size_t)(BK * 2);
    const size_t hstep = (size_t)HALF * K * 2;
    const size_t tstep = 2 * hstep;
    const unsigned ldsw = (unsigned)wid * 1024u;
    const int aoff = lds_byte(wr * 64 + fr, fq * 8), boff = lds_byte(wc * 32 + fr, fq * 8);
#define PG8_SA(b, h) (((b) * 2 + (h)) * HTB)
#define PG8_SB(b, h) ((4 + (b) * 2 + (h)) * HTB)
#define PG8_STAGE(bufoff, gbase, voff) do { _Pragma("unroll") for (int _i = 0; _i < 2; ++_i) \
        __builtin_amdgcn_global_load_lds((const unsigned*)((const char*)(gbase) + (voff)[_i]), (PG8_LAS unsigned*)(lds + (bufoff) + ldsw + _i * 8192), 16, 0, 0); } while (0)
#define PG8_LDA(dst, b, h) do { _Pragma("unroll") for (int m = 0; m < 4; ++m) _Pragma("unroll") for (int k = 0; k < 2; ++k) dst[m][k] = *(const PG8_LAS bf16x8*)(lds + PG8_SA(b, h) + aoff + m * 2048 + k * 1024); } while (0)
#define PG8_LDB(dst, b, h) do { _Pragma("unroll") for (int n = 0; n < 2; ++n) _Pragma("unroll") for (int k = 0; k < 2; ++k) dst[n][k] = *(const PG8_LAS bf16x8*)(lds + PG8_SB(b, h) + boff + n * 2048 + k * 1024); } while (0)
#define PG8_MMA(ai, bj, At, Bt) do { __builtin_amdgcn_s_setprio(1); _Pragma("unroll") for (int m = 0; m < 4; ++m) _Pragma("unroll") for (int n = 0; n < 2; ++n) _Pragma("unroll") for (int k = 0; k < 2; ++k) \
        acc[ai][bj][m][n] = __builtin_amdgcn_mfma_f32_16x16x32_bf16(Bt[n][k], At[m][k], acc[ai][bj][m][n], 0, 0, 0); __builtin_amdgcn_s_setprio(0); } while (0)
#define PG8_WAIT_V(n) asm volatile("s_waitcnt vmcnt(" #n ")" ::: "memory")
#define PG8_WAIT_L(n) asm volatile("s_waitcnt lgkmcnt(" #n ")" ::: "memory")
#define PG8_BAR __builtin_amdgcn_s_barrier()
#define PG8_SCHED __builtin_amdgcn_sched_barrier(0)
    Unit cur, nxt; int ui = 0;
    if (!S.next(0, cur)) return;
    f32x4 acc[2][2][4][2];
#pragma unroll
    for (int a = 0; a < 2; ++a)
#pragma unroll
        for (int b = 0; b < 2; ++b)
#pragma unroll
            for (int m = 0; m < 4; ++m)
#pragma unroll
                for (int n = 0; n < 2; ++n) acc[a][b][m][n] = (f32x4){0.f, 0.f, 0.f, 0.f};
    bf16x8 At[4][2], B0[2][2], B1[2][2];
    const char* cA = (const char*)g.A + (size_t)cur.pm * tstep; const char* cB = (const char*)g.Bt + (size_t)cur.pn * tstep;
    S.a_ready(cur);
    if constexpr (SP2) {
        PG8_STAGE(PG8_SB(0, 0), cB, voffB); PG8_STAGE(PG8_SB(0, 1), cB + hstep, voffB); PG8_STAGE(PG8_SA(0, 0), cA, voffA); PG8_STAGE(PG8_SA(0, 1), cA + hstep, voffA);
        if (wr == 1) PG8_BAR;
        PG8_WAIT_V(2); PG8_BAR;
        PG8_STAGE(PG8_SB(1, 0), cB + kstep, voffB); PG8_STAGE(PG8_SA(1, 0), cA + kstep, voffA); PG8_STAGE(PG8_SB(1, 1), cB + hstep + kstep, voffB);
        PG8_WAIT_V(6); PG8_BAR;
    } else {
        PG8_STAGE(PG8_SB(0, 0), cB, voffB); PG8_STAGE(PG8_SA(0, 0), cA, voffA); PG8_STAGE(PG8_SB(0, 1), cB + hstep, voffB); PG8_STAGE(PG8_SA(0, 1), cA + hstep, voffA);
        if (wr == 1) PG8_BAR;
        PG8_WAIT_V(4); PG8_BAR;
        PG8_STAGE(PG8_SB(1, 0), cB + kstep, voffB); PG8_STAGE(PG8_SA(1, 0), cA + kstep, voffA); PG8_STAGE(PG8_SB(1, 1), cB + hstep + kstep, voffB);
        PG8_WAIT_V(6); PG8_BAR;
    }
    for (;;) {
        const bool has_next = S.next(ui + 1, nxt);
        const char* nA = has_next ? (const char*)g.A + (size_t)nxt.pm * tstep : cA; const char* nB = has_next ? (const char*)g.Bt + (size_t)nxt.pn * tstep : cB;
        for (int t = 0; t < nt; t += 2) {
            const bool last = (t == nt - 2);
            const char* a1 = cA + (size_t)(t + 1) * kstep;
            const char* a2 = last ? nA : cA + (size_t)(t + 2) * kstep; const char* b2 = last ? nB : cB + (size_t)(t + 2) * kstep;
            const char* a3 = a2 + kstep; const char* b3 = b2 + kstep;
            if (last && has_next) S.a_ready(nxt);
            if constexpr (SP2) {
            PG8_LDB(B0, 0, 0); PG8_LDB(B1, 0, 1); PG8_SCHED; PG8_LDA(At, 0, 0); PG8_STAGE(PG8_SA(1, 1), a1 + hstep, voffA);
            PG8_WAIT_V(8); PG8_WAIT_L(0); PG8_BAR; PG8_MMA(0, 0, At, B0); PG8_MMA(0, 1, At, B1); PG8_BAR; PG8_SCHED;
            PG8_LDA(At, 0, 1); PG8_STAGE(PG8_SB(0, 0), b2, voffB); PG8_STAGE(PG8_SB(0, 1), b2 + hstep, voffB); PG8_STAGE(PG8_SA(0, 0), a2, voffA);
            PG8_WAIT_V(8); PG8_WAIT_L(0); PG8_BAR; PG8_MMA(1, 0, At, B0); PG8_MMA(1, 1, At, B1); PG8_BAR; PG8_SCHED;
            PG8_LDB(B0, 1, 0); PG8_LDB(B1, 1, 1); PG8_SCHED; PG8_LDA(At, 1, 0); PG8_STAGE(PG8_SA(0, 1), a2 + hstep, voffA);
            PG8_WAIT_V(8); PG8_WAIT_L(0); PG8_BAR; PG8_MMA(0, 0, At, B0); PG8_MMA(0, 1, At, B1); PG8_BAR; PG8_SCHED;
            PG8_LDA(At, 1, 1); PG8_STAGE(PG8_SB(1, 0), b3, voffB); PG8_STAGE(PG8_SB(1, 1), b3 + hstep, voffB); PG8_STAGE(PG8_SA(1, 0), a3, voffA);
            PG8_WAIT_V(8); PG8_WAIT_L(0); PG8_BAR; PG8_MMA(1, 0, At, B0); PG8_MMA(1, 1, At, B1); PG8_BAR; PG8_SCHED;
            } else {
            PG8_LDB(B0, 0, 0); PG8_SCHED; PG8_LDA(At, 0, 0); PG8_STAGE(PG8_SA(1, 1), a1 + hstep, voffA);
            PG8_WAIT_L(8); PG8_BAR; PG8_WAIT_L(0); PG8_MMA(0, 0, At, B0); PG8_BAR; PG8_SCHED;
            PG8_LDB(B1, 0, 1); PG8_STAGE(PG8_SB(0, 0), b2, voffB);
            PG8_BAR; PG8_WAIT_L(0); PG8_MMA(0, 1, At, B1); PG8_BAR;
            PG8_LDA(At, 0, 1); PG8_STAGE(PG8_SA(0, 0), a2, voffA);
            PG8_BAR; PG8_WAIT_L(0); PG8_MMA(1, 0, At, B0); PG8_BAR; PG8_SCHED;
            PG8_STAGE(PG8_SB(0, 1), b2 + hstep, voffB);
            PG8_WAIT_V(6); PG8_BAR; PG8_MMA(1, 1, At, B1); PG8_BAR;
            PG8_LDB(B0, 1, 0); PG8_SCHED; PG8_LDA(At, 1, 0); PG8_STAGE(PG8_SA(0, 1), a2 + hstep, voffA);
            PG8_WAIT_L(8); PG8_BAR; PG8_WAIT_L(0); PG8_MMA(0, 0, At, B0); PG8_BAR; PG8_SCHED;
            PG8_LDB(B1, 1, 1); PG8_STAGE(PG8_SB(1, 0), b3, voffB);
            PG8_BAR; PG8_WAIT_L(0); PG8_MMA(0, 1, At, B1); PG8_BAR;
            PG8_LDA(At, 1, 1); PG8_STAGE(PG8_SA(1, 0), a3, voffA);
            PG8_BAR; PG8_WAIT_L(0); PG8_MMA(1, 0, At, B0); PG8_BAR; PG8_SCHED;
            PG8_STAGE(PG8_SB(1, 1), b3 + hstep, voffB);
            PG8_WAIT_V(6); PG8_BAR; PG8_MMA(1, 1, At, B1); PG8_BAR;
            }
        }
        if constexpr (ALIGN_EPI) { if (wr == 0) PG8_BAR; }
        if constexpr (!Epi::AFTER_DRAIN) { E(acc, cur, wr, wc, fr, fq); S.done(cur); }
        if (!has_next) break;
#pragma unroll
        for (int a = 0; a < 2; ++a)
#pragma unroll
            for (int b = 0; b < 2; ++b)
#pragma unroll
                for (int m = 0; m < 4; ++m)
#pragma unroll
                    for (int n = 0; n < 2; ++n) acc[a][b][m][n] = (f32x4){0.f, 0.f, 0.f, 0.f};
        cur = nxt; cA = nA; cB = nB; ++ui;
        if constexpr (ALIGN_EPI) { if (wr == 1) PG8_BAR; }
    }
    PG8_WAIT_V(0);
    if constexpr (!ALIGN_EPI) { if (wr == 0) PG8_BAR; }
    PG8_BAR;
    if constexpr (Epi::AFTER_DRAIN) { E.fused(acc, cur, wr, wc, fr, fq, lds, wid, lane); S.done(cur); }
#undef PG8_SA
#undef PG8_SB
#undef PG8_STAGE
#undef PG8_LDA
#undef PG8_LDB
#undef PG8_MMA
#undef PG8_WAIT_V
#undef PG8_WAIT_L
#undef PG8_BAR
#undef PG8_SCHED
}
}

namespace pg8 {
struct EpiMlpIn {
  static constexpr bool PERM = true, AFTER_DRAIN = false;
  ::bf16_t* O; const float* bias;
  __device__ __forceinline__ void operator()(const f32x4 (&acc)[2][2][4][2], const Unit& u, int wr, int wc, int fr, int fq) const {
    const int row0 = u.pm * BM + wr * 64 + fr, col0 = u.pn * BM + wc * 32 + 8 * fq;
    f32x4 bv[2][2];
#pragma unroll
    for (int bj = 0; bj < 2; ++bj)
#pragma unroll
      for (int n = 0; n < 2; ++n) bv[bj][n] = *(const f32x4*)(bias + col0 + bj * HALF + 4 * n);
#pragma unroll
    for (int ai = 0; ai < 2; ++ai)
#pragma unroll
      for (int m = 0; m < 4; ++m) {
        ::bf16_t* rowp = O + (size_t)(row0 + ai * HALF + m * 16) * 4096 + col0;
#pragma unroll
        for (int bj = 0; bj < 2; ++bj) {
          f32x4 v0 = acc[ai][bj][m][0] + bv[bj][0], v1 = acc[ai][bj][m][1] + bv[bj][1];
#pragma unroll
          for (int e = 0; e < 4; ++e) { const float a = fmaxf(v0[e], 0.f), b = fmaxf(v1[e], 0.f); v0[e] = a * a; v1[e] = b * b; }
          u32x4 w; w.x = pk2(v0[0], v0[1]); w.y = pk2(v0[2], v0[3]); w.z = pk2(v1[0], v1[1]); w.w = pk2(v1[2], v1[3]);
          *(u32x4*)(rowp + bj * HALF) = w;
        }
      }
  }
};
struct EpiMlpOut {
  static constexpr bool PERM = false, AFTER_DRAIN = false;
  float* out; const float* mod; const float* bias;
  __device__ __forceinline__ void operator()(const f32x4 (&acc)[2][2][4][2], const Unit& u, int wr, int wc, int fr, int fq) const {
    const int col0 = u.pn * BM + wc * 32 + 4 * fq;
#pragma unroll
    for (int ai = 0; ai < 2; ++ai)
#pragma unroll
      for (int m = 0; m < 4; ++m) {
        const int row = u.pm * BM + ai * HALF + wr * 64 + m * 16 + fr;
        const float* g2 = mod + batch_of(row) * 6144 + 5120;
        float* xr = out + (size_t)row * 1024;
#pragma unroll
        for (int bj = 0; bj < 2; ++bj)
#pragma unroll
          for (int n = 0; n < 2; ++n) {
            const int col = col0 + bj * HALF + n * 16;
            const f32x4 xv = *(const f32x4*)(xr + col), gv = *(const f32x4*)(g2 + col), bb = *(const f32x4*)(bias + col);
            *(f32x4*)(xr + col) = xv + gv * (acc[ai][bj][m][n] + bb);
          }
      }
  }
};
}

extern __shared__ __attribute__((aligned(16))) unsigned char dyn_smem[];

DI void phase8(const P& p) {
  const pg8::Gemm g{p.hb(), p.w1t(), NTOK, 4096, 1024};
  pg8::StaticOrder S; S.init(NTOK, 4096, (int)gridDim.x, (int)blockIdx.x);
  const pg8::EpiMlpIn E{p.hid(), p.b1};
  pg8::gemm_phase<pg8::EpiMlpIn, pg8::StaticOrder, true, true>((PG8_LAS unsigned char*)dyn_smem, g, S, E);
}
DI void phase9(const P& p) {
  const pg8::Gemm g{p.hid(), p.w2t(), NTOK, 1024, 4096};
  pg8::StaticOrder S; S.init(NTOK, 1024, (int)gridDim.x, (int)blockIdx.x);
  const pg8::EpiMlpOut E{p.out, p.mod(), p.b2};
  pg8::gemm_phase<pg8::EpiMlpOut, pg8::StaticOrder, true, true>((PG8_LAS unsigned char*)dyn_smem, g, S, E);
}

__global__ void __launch_bounds__(512, 2) k_mega(P p) {
  cg::grid_group grid = cg::this_grid();
  unsigned char* smh = dyn_smem + (threadIdx.x >> 8) * SMEM_HALF;
  bf16_t* sm = (bf16_t*)smh;
  phase0(p, smh); grid.sync();
  rownorm_mod(p, true, p.g_mix, 0, 1024); grid.sync();
  phase2(p, sm); grid.sync();
  phase3(p, sm); grid.sync();
  phase4(p, sm); grid.sync();
  phase5(p, sm); grid.sync();
  phase6(p, sm); grid.sync();
  phase7(p, sm); grid.sync();
  rownorm_mod(p, false, p.g_mlp, 3072, 4096); grid.sync();
  phase8(p); grid.sync();
  phase9(p); grid.sync();
  final_norm(p);
}

extern "C" void kernel_launch(void* const* d_in, const int* in_sizes, int n_in, void* d_out, int out_size, void* d_ws, size_t ws_size,
                              hipStream_t stream) {
  P p{};
  const float** f = (const float**)&p;
  for (int i = 0; i < 29; i++) f[i] = (const float*)d_in[i];
  p.out = (float*)d_out;
  p.ws = (char*)d_ws;
  if (WS_NEED > ws_size) { fprintf(stderr, "workspace too small: need %zu have %zu\n", (size_t)WS_NEED, ws_size); return; }
  static int grid_blocks = 0;
  if (!grid_blocks) {
    int dev = 0, cus = 0, per_cu = 0;
    (void)hipGetDevice(&dev);
    (void)hipDeviceGetAttribute(&cus, hipDeviceAttributeMultiprocessorCount, dev);
    (void)hipFuncSetAttribute((const void*)k_mega, hipFuncAttributeMaxDynamicSharedMemorySize, SMEM_BYTES);
    (void)hipOccupancyMaxActiveBlocksPerMultiprocessor(&per_cu, k_mega, 512, SMEM_BYTES);
    if (per_cu < 1) per_cu = 1;
    grid_blocks = cus * per_cu;
  }
  void* args[] = {&p};
  hipError_t e = hipLaunchCooperativeKernel((void*)k_mega, dim3(grid_blocks), dim3(512), args, SMEM_BYTES, stream);
  if (e != hipSuccess) fprintf(stderr, "cooperative launch failed: %s (grid %d)\n", hipGetErrorString(e), grid_blocks);
}
```

```cpp
#include <hip/hip_runtime.h>
#include <hip/hip_cooperative_groups.h>
#include <stdint.h>
#include <stdio.h>
namespace cg = cooperative_groups;


#define DI __device__ __forceinline__
typedef unsigned short bf16_t;
typedef short bf16x8 __attribute__((ext_vector_type(8)));
typedef float f32x16 __attribute__((ext_vector_type(16)));
typedef float f32x4 __attribute__((ext_vector_type(4)));

constexpr int NTOK = 81920, LPR = 16384, LSM = 4096;
constexpr int BM = 128, BN = 128, BK = 64, LDSS = 72, TLD = 136;
constexpr int SMEM_HALF = 2 * 2 * BM * LDSS * 2;
constexpr int SMEM_BYTES = 2 * SMEM_HALF;
constexpr float EPSV = 1e-6f;

constexpr size_t al256(size_t x) { return (x + 255) & ~(size_t)255; }
constexpr size_t O_mod = 0;
constexpr size_t O_AT = O_mod + al256(17 * 6144 * 4);
constexpr size_t O_ssf = O_AT + al256(32 * 2 * 64 * 2 * 4);
constexpr size_t O_sss = O_ssf + al256((size_t)NTOK * 8 * 4);
constexpr size_t O_twp = O_sss + al256((size_t)NTOK * 16 * 4);
constexpr size_t O_tws = O_twp + al256(LPR * 8);
constexpr size_t O_wint = O_tws + al256(LSM * 8);
constexpr size_t O_wglut = O_wint + al256(1024 * 1024 * 2);
constexpr size_t O_woutt = O_wglut + al256(1024 * 512 * 2);
constexpr size_t O_w1t = O_woutt + al256(1024 * 1024 * 2);
constexpr size_t O_w2t = O_w1t + al256((size_t)4096 * 1024 * 2);
constexpr size_t O_Mf = O_w2t + al256((size_t)4096 * 1024 * 2);
constexpr size_t O_F1p = O_Mf + al256(512 * 1024 * 2);
constexpr size_t O_F1s = O_F1p + al256(256 * 128 * 2);
constexpr size_t O_F2p = O_F1s + al256(128 * 64 * 2);
constexpr size_t O_F2s = O_F2p + al256(256 * 256 * 2);
constexpr size_t O_Ktab = O_F2s + al256(128 * 128 * 2);
constexpr size_t O_Bs = O_Ktab + al256((size_t)32 * 127 * 256 * 2);
constexpr size_t O_Co = O_Bs + al256((size_t)32 * 256 * 1024 * 2);
constexpr size_t O_hb = O_Co + al256((size_t)32 * 1024 * 256 * 2);
constexpr size_t O_zT = O_hb + al256((size_t)NTOK * 1024 * 2);
constexpr size_t O_zs = O_zT + al256((size_t)NTOK * 512 * 2);
constexpr size_t O_AF = O_zs + al256((size_t)NTOK * 512 * 2);
constexpr size_t O_S = O_AF + al256((size_t)NTOK * 1024 * 2);
constexpr size_t O_H = O_S + al256((size_t)1280 * 32 * 256 * 4);
constexpr size_t O_gact = O_H + al256((size_t)1280 * 32 * 256 * 2);
constexpr size_t O_mg = O_gact + al256((size_t)NTOK * 512 * 2);
constexpr size_t O_END = O_mg + al256((size_t)NTOK * 1024 * 2);
constexpr size_t O_Tt = O_hb;
constexpr size_t O_hid = O_zT;
constexpr size_t WS_NEED = (O_hid + (size_t)NTOK * 4096 * 2 > O_END ? O_hid + (size_t)NTOK * 4096 * 2 : O_END);
struct P {
  const float *xp, *xs, *cp, *cs, *w_ada, *b_ada, *g_mix, *w_in, *w_f, *b_f, *a_re, *a_im, *log_dt, *b_re, *b_im, *c_re, *c_im,
      *ssm_d, *w_glu, *b_glu, *g_fo, *g_so, *w_out, *g_mlp, *w1, *b1, *w2, *b2, *g_final;
  float* out;
  char* ws;
  __device__ __forceinline__ float* mod() const { return (float*)(ws + O_mod); }
  __device__ __forceinline__ float* AT() const { return (float*)(ws + O_AT); }
  __device__ __forceinline__ float* ssf() const { return (float*)(ws + O_ssf); }
  __device__ __forceinline__ float* sss() const { return (float*)(ws + O_sss); }
  __device__ __forceinline__ float2* twp() const { return (float2*)(ws + O_twp); }
  __device__ __forceinline__ float2* tws() const { return (float2*)(ws + O_tws); }
  __device__ __forceinline__ bf16_t* wint() const { return (bf16_t*)(ws + O_wint); }
  __device__ __forceinline__ bf16_t* wglut() const { return (bf16_t*)(ws + O_wglut); }
  __device__ __forceinline__ bf16_t* woutt() const { return (bf16_t*)(ws + O_woutt); }
  __device__ __forceinline__ bf16_t* w1t() const { return (bf16_t*)(ws + O_w1t); }
  __device__ __forceinline__ bf16_t* w2t() const { return (bf16_t*)(ws + O_w2t); }
  __device__ __forceinline__ bf16_t* Mf() const { return (bf16_t*)(ws + O_Mf); }
  __device__ __forceinline__ bf16_t* F1p() const { return (bf16_t*)(ws + O_F1p); }
  __device__ __forceinline__ bf16_t* F1s() const { return (bf16_t*)(ws + O_F1s); }
  __device__ __forceinline__ bf16_t* F2p() const { return (bf16_t*)(ws + O_F2p); }
  __device__ __forceinline__ bf16_t* F2s() const { return (bf16_t*)(ws + O_F2s); }
  __device__ __forceinline__ bf16_t* Ktab() const { return (bf16_t*)(ws + O_Ktab); }
  __device__ __forceinline__ bf16_t* Bs() const { return (bf16_t*)(ws + O_Bs); }
  __device__ __forceinline__ bf16_t* Co() const { return (bf16_t*)(ws + O_Co); }
  __device__ __forceinline__ bf16_t* hb() const { return (bf16_t*)(ws + O_hb); }
  __device__ __forceinline__ bf16_t* zT() const { return (bf16_t*)(ws + O_zT); }
  __device__ __forceinline__ bf16_t* zs() const { return (bf16_t*)(ws + O_zs); }
  __device__ __forceinline__ bf16_t* AF() const { return (bf16_t*)(ws + O_AF); }
  __device__ __forceinline__ float* S() const { return (float*)(ws + O_S); }
  __device__ __forceinline__ bf16_t* H() const { return (bf16_t*)(ws + O_H); }
  __device__ __forceinline__ bf16_t* mg() const { return (bf16_t*)(ws + O_mg); }
  __device__ __forceinline__ bf16_t* gact() const { return (bf16_t*)(ws + O_gact); }
  __device__ __forceinline__ bf16_t* Tt() const { return (bf16_t*)(ws + O_Tt); }
  __device__ __forceinline__ bf16_t* hid() const { return (bf16_t*)(ws + O_hid); }
};

typedef float f32x2v __attribute__((ext_vector_type(2)));
typedef __bf16 bf16x2v __attribute__((ext_vector_type(2)));
DI uint32_t pk2(float lo, float hi) { const f32x2v v = {lo, hi}; const bf16x2v r = __builtin_convertvector(v, bf16x2v); return __builtin_bit_cast(uint32_t, r); }
DI bf16_t f2bf(float f) { return (bf16_t)(pk2(f, 0.f) & 0xffffu); }
extern __shared__ __attribute__((aligned(16))) unsigned char dyn_smem[];
DI int otid() { int t = (int)threadIdx.x; asm volatile("" : "+v"(t)); return t; }
DI int batch_of(int tok) { return tok < LPR ? 0 : 1 + ((tok - LPR) >> 12); }
DI float wave_sum(float v) {
  v += __shfl_xor(v, 32); v += __shfl_xor(v, 16); v += __shfl_xor(v, 8); v += __shfl_xor(v, 4); v += __shfl_xor(v, 2); v += __shfl_xor(v, 1);
  return v;
}

template <bool SWAP, class AF, class BF, class HK>
DI void gemm_main(bf16_t* sm, const int tid, int K, const AF& af, const BF& bf, const HK& hk, f32x16 (&acc)[2][2]) {
  const int lane = tid & 63, wid = tid >> 6, wm = wid >> 1, wn = wid & 1;
  const int kc = (tid & 7) * 8, rb = tid >> 3;
  bf16_t* As = sm;
  bf16_t* Bs = sm + 2 * BM * LDSS;
  uint4 ra[4], rv[4];
#pragma unroll
  for (int i = 0; i < 2; i++)
#pragma unroll
    for (int j = 0; j < 2; j++)
#pragma unroll
      for (int e = 0; e < 16; e++) acc[i][j][e] = 0.f;
  __syncthreads();
#pragma unroll
  for (int i = 0; i < 4; i++) { ra[i] = *(const uint4*)af(rb + 32 * i, kc); rv[i] = *(const uint4*)bf(rb + 32 * i, kc); }
#pragma unroll
  for (int i = 0; i < 4; i++) { *(uint4*)(As + (rb + 32 * i) * LDSS + kc) = ra[i]; *(uint4*)(Bs + (rb + 32 * i) * LDSS + kc) = rv[i]; }
  __syncthreads();
  const int nk = K / BK;
  for (int t = 0; t < nk; t++) {
    const int cur = t & 1;
    if (t + 1 < nk) {
      const int k = (t + 1) * BK + kc;
#pragma unroll
      for (int i = 0; i < 4; i++) { ra[i] = *(const uint4*)af(rb + 32 * i, k); rv[i] = *(const uint4*)bf(rb + 32 * i, k); }
    }
    hk(t, acc);
    const bf16_t* Ab = As + cur * BM * LDSS + (wm * 64 + (lane & 31)) * LDSS + (lane >> 5) * 8;
    const bf16_t* Bb = Bs + cur * BN * LDSS + (wn * 64 + (lane & 31)) * LDSS + (lane >> 5) * 8;
#pragma unroll
    for (int ks = 0; ks < 4; ks++) {
      const bf16x8 a0 = *(const bf16x8*)(Ab + ks * 16), a1 = *(const bf16x8*)(Ab + 32 * LDSS + ks * 16);
      const bf16x8 b0 = *(const bf16x8*)(Bb + ks * 16), b1 = *(const bf16x8*)(Bb + 32 * LDSS + ks * 16);
      if (SWAP) {
        acc[0][0] = __builtin_amdgcn_mfma_f32_32x32x16_bf16(b0, a0, acc[0][0], 0, 0, 0);
        acc[0][1] = __builtin_amdgcn_mfma_f32_32x32x16_bf16(b1, a0, acc[0][1], 0, 0, 0);
        acc[1][0] = __builtin_amdgcn_mfma_f32_32x32x16_bf16(b0, a1, acc[1][0], 0, 0, 0);
        acc[1][1] = __builtin_amdgcn_mfma_f32_32x32x16_bf16(b1, a1, acc[1][1], 0, 0, 0);
      } else {
        acc[0][0] = __builtin_amdgcn_mfma_f32_32x32x16_bf16(a0, b0, acc[0][0], 0, 0, 0);
        acc[0][1] = __builtin_amdgcn_mfma_f32_32x32x16_bf16(a0, b1, acc[0][1], 0, 0, 0);
        acc[1][0] = __builtin_amdgcn_mfma_f32_32x32x16_bf16(a1, b0, acc[1][0], 0, 0, 0);
        acc[1][1] = __builtin_amdgcn_mfma_f32_32x32x16_bf16(a1, b1, acc[1][1], 0, 0, 0);
      }
    }
    if (t + 1 < nk) {
      const int nb = cur ^ 1;
#pragma unroll
      for (int i = 0; i < 4; i++) {
        *(uint4*)(As + nb * BM * LDSS + (rb + 32 * i) * LDSS + kc) = ra[i];
        *(uint4*)(Bs + nb * BN * LDSS + (rb + 32 * i) * LDSS + kc) = rv[i];
      }
    }
    __syncthreads();
  }
}
struct NoHook { DI void operator()(int, f32x16 (&)[2][2]) const {} };

template <class EW, class DST>
DI void epi_transposed(bf16_t* sm, const int tid, f32x16 (&acc)[2][2], const EW& ew, const DST& dst) {
  const int lane = tid & 63, wid = tid >> 6, wm = wid >> 1, wn = wid & 1;
#pragma unroll
  for (int mi = 0; mi < 2; mi++)
#pragma unroll
    for (int g = 0; g < 4; g++) {
      const int ml = wm * 64 + mi * 32 + 8 * g + 4 * (lane >> 5);
      float v0[4], v1[4];
#pragma unroll
      for (int e = 0; e < 4; e++) { v0[e] = acc[mi][0][4 * g + e]; v1[e] = acc[mi][1][4 * g + e]; ew(mi, g, e, v0[e], v1[e]); }
      const int nl = wn * 64 + (lane & 31);
      uint2 w0, w1;
      w0.x = pk2(v0[0], v0[1]); w0.y = pk2(v0[2], v0[3]); w1.x = pk2(v1[0], v1[1]); w1.y = pk2(v1[2], v1[3]);
      *(uint2*)(sm + nl * TLD + ml) = w0;
      *(uint2*)(sm + (nl + 32) * TLD + ml) = w1;
    }
  __syncthreads();
  {
    const int nl = tid >> 1, r = tid & 1;
    bf16_t* d = dst(nl, r);
    const bf16_t* s = sm + nl * TLD + 64 * r;
#pragma unroll
    for (int i = 0; i < 8; i++) *(uint4*)(d + 8 * i) = *(const uint4*)(s + 8 * i);
  }
}

DI void ssm_pow(const P& p, int g, int dir, int pp, int j, float& re, float& im) {
  const int ia = (dir * 32 + g) * 64 + pp;
  const float lr = fminf(p.a_re[ia], -1e-4f), li = p.a_im[ia], dt = expf(p.log_dt[dir * 32 + g]);
  const float mag = expf(lr * dt * (float)j);
  double t = (double)li * (double)dt * (double)j * 0.15915494309189535;
  t -= rint(t);
  const float ang = (float)(t * 6.283185307179586);
  float s, c; sincosf(ang, &s, &c);
  re = mag * c; im = mag * s;
}
DI void ssm_coef(const P& p, int g, int dir, int pp, float& cr, float& ci) {
  const int ia = (dir * 32 + g) * 64 + pp;
  const float lr = fminf(p.a_re[ia], -1e-4f), li = p.a_im[ia];
  float ar, ai; ssm_pow(p, g, dir, pp, 1, ar, ai);
  const float nr = ar - 1.f, ni = ai, den = 1.f / (lr * lr + li * li);
  cr = (nr * lr + ni * li) * den; ci = (ni * lr - nr * li) * den;
}

template <class CM>
DI void transpose_job(float* tile, const int tid, bool act, int item, const float* in, int ld, int Kdim, bf16_t* out, const CM& colmap, const float* sc0, const float* sc1) {
  const int nkt = Kdim / 64, nt = item / nkt, kt = item % nkt;
  __syncthreads();
  if (act) {
    const int c = tid & 31, kr = tid >> 5, col = colmap(nt * 32 + c);
#pragma unroll
    for (int i = 0; i < 8; i++) {
      const int kl = kr + 8 * i, k = kt * 64 + kl;
      float v = in[(size_t)k * ld + col];
      if (sc0) v *= (k < 512 ? sc0[k] : sc1[k - 512]);
      tile[kl * 33 + c] = v;
    }
  }
  __syncthreads();
  if (act) {
    const int nl = tid >> 3, kc = tid & 7;
    float v[8];
#pragma unroll
    for (int j = 0; j < 8; j++) v[j] = tile[(kc * 8 + j) * 33 + nl];
    uint4 w; w.x = pk2(v[0], v[1]); w.y = pk2(v[2], v[3]); w.z = pk2(v[4], v[5]); w.w = pk2(v[6], v[7]);
    *(uint4*)(out + (size_t)(nt * 32 + nl) * Kdim + kt * 64 + kc * 8) = w;
  }
}

DI void phase0(const P& p) {
  const int tix = otid();
  unsigned char* smraw = dyn_smem + (tix >> 8) * SMEM_HALF;
  float* smf = (float*)smraw;
  const int tid = tix & 255, nb = gridDim.x * 2, bid = blockIdx.x * 2 + (tix >> 8);
  for (int base = 0; base < 96; base += nb) {
    const int item = base + bid; const bool act = item < 96;
    __syncthreads();
    if (act)
      for (int i = tid; i < 17 * 1024; i += 256) {
        const int b = i >> 10, k = i & 1023;
        const float c = b == 0 ? p.cp[k] : p.cs[(b - 1) * 1024 + k];
        smf[i] = c / (1.f + __expf(-c));
      }
    __syncthreads();
    const int col = tid & 63, kq = tid >> 6, j = item * 64 + col;
    float a[17];
#pragma unroll
    for (int b = 0; b < 17; b++) a[b] = 0.f;
    if (act)
      for (int k = kq * 256; k < kq * 256 + 256; k++) {
        const float w = p.w_ada[(size_t)k * 6144 + j];
#pragma unroll
        for (int b = 0; b < 17; b++) a[b] += smf[b * 1024 + k] * w;
      }
    __syncthreads();
#pragma unroll
    for (int b = 0; b < 17; b++) smf[(kq * 17 + b) * 64 + col] = a[b];
    __syncthreads();
    if (act)
      for (int i = tid; i < 17 * 64; i += 256) {
        const int b = i >> 6, c2 = i & 63;
        const float s = smf[(0 * 17 + b) * 64 + c2] + smf[(1 * 17 + b) * 64 + c2] + smf[(2 * 17 + b) * 64 + c2] + smf[(3 * 17 + b) * 64 + c2];
        p.mod()[b * 6144 + item * 64 + c2] = s + p.b_ada[item * 64 + c2];
      }
  }
  {
    auto ident = [](int n) { return n; };
    auto glumap = [](int n) { return ((n >> 7) & 1) * 512 + (n >> 8) * 128 + (n & 127); };
    const int n0 = 512, n1 = n0 + 256, n2 = n1 + 512, n3 = n2 + 2048, n4 = n3 + 2048;
    for (int base = 0; base < n4; base += nb) {
      const int item = base + bid; const bool act = item < n4;
      if (item < n0) transpose_job(smf, tid, act, item, p.w_in, 1024, 1024, p.wint(), ident, nullptr, nullptr);
      else if (item < n1) transpose_job(smf, tid, act, item - n0, p.w_glu, 1024, 512, p.wglut(), glumap, nullptr, nullptr);
      else if (item < n2) transpose_job(smf, tid, act, item - n1, p.w_out, 1024, 1024, p.woutt(), ident, p.g_fo, p.g_so);
      else if (item < n3) transpose_job(smf, tid, act, item - n2, p.w1, 4096, 1024, p.w1t(), ident, nullptr, nullptr);
      else transpose_job(smf, tid, act, item - n3, p.w2, 1024, 4096, p.w2t(), ident, nullptr, nullptr);
    }
  }
  {
    __syncthreads();
    float2* cs = (float2*)smraw;
    for (int i = tid; i < 512; i += 256) { float s, c; sincosf((float)i * (6.283185307179586f / 512.f), &s, &c); cs[i] = make_float2(c, s); }
    __syncthreads();
    for (int item = bid; item < 2048; item += nb) {
      const int idx = item * 256 + tid, n = idx >> 10, k = idx & 1023, h = n >> 7, e = n & 127, c = k & 511;
      const bool is_sin = k >= 512;
      const float* wf = p.w_f + (size_t)h * 128 * 128 + e;
      float a = 0.f;
      for (int d = 0; d < 128; d++) {
        const float2 t = cs[((h * 128 + d) * c) & 511];
        a += (is_sin ? t.y : t.x) * wf[d * 128];
      }
      p.Mf()[idx] = f2bf(a);
    }
  }
  {
    const int gsz = nb * 256, gt = bid * 256 + tid;
    for (int i = gt; i < 256 * 128; i += gsz) {
      const int n = i >> 7, k = i & 127, k1 = (n >> 6) * 32 + (n & 31), part = (n >> 5) & 1;
      float s, c; sincosf((float)((k1 * k) & 127) * (6.283185307179586f / 128.f), &s, &c);
      p.F1p()[i] = f2bf(part ? -s : c);
    }
    for (int i = gt; i < 128 * 64; i += gsz) {
      const int n = i >> 6, k = i & 63, k1 = (n >> 6) * 32 + (n & 31), part = (n >> 5) & 1;
      float s, c; sincosf((float)((k1 * k) & 63) * (6.283185307179586f / 64.f), &s, &c);
      p.F1s()[i] = f2bf(part ? -s : c);
    }
    for (int i = gt; i < 256 * 256; i += gsz) {
      const int n = i >> 8, k = i & 255, part = n >> 7, k2 = n & 127, l2 = k & 127, ki = k >> 7;
      float s, c; sincosf((float)((k2 * l2) & 127) * (6.283185307179586f / 128.f), &s, &c);
      p.F2p()[i] = f2bf(part == 0 ? (ki == 0 ? c : s) : (ki == 0 ? -s : c));
    }
    for (int i = gt; i < 128 * 128; i += gsz) {
      const int n = i >> 7, k = i & 127, part = n >> 6, k2 = n & 63, l2 = k & 63, ki = k >> 6;
      float s, c; sincosf((float)((k2 * l2) & 63) * (6.283185307179586f / 64.f), &s, &c);
      p.F2s()[i] = f2bf(part == 0 ? (ki == 0 ? c : s) : (ki == 0 ? -s : c));
    }
    for (int i = gt; i < LPR; i += gsz) { float s, c; sincosf((float)i * (6.283185307179586f / 16384.f), &s, &c); p.twp()[i] = make_float2(c, s); }
    for (int i = gt; i < LSM; i += gsz) { float s, c; sincosf((float)i * (6.283185307179586f / 4096.f), &s, &c); p.tws()[i] = make_float2(c, s); }
    for (int i = gt; i < 32 * 2 * 64 * 64; i += gsz) {
      const int s = i & 63, pp = (i >> 6) & 63, dir = (i >> 12) & 1, g = i >> 13;
      float pr, pi, cr, ci; ssm_pow(p, g, dir, pp, dir == 0 ? 63 - s : s, pr, pi); ssm_coef(p, g, dir, pp, cr, ci);
      const float qr = pr * cr - pi * ci, qi = pr * ci + pi * cr;
      const int ib = ((dir * 32 + g) * 64 + pp) * 16;
      float vr[16], vi[16];
#pragma unroll
      for (int h = 0; h < 16; h++) { const float br = p.b_re[ib + h], bi = p.b_im[ib + h]; vr[h] = qr * br - qi * bi; vi[h] = qr * bi + qi * br; }
      bf16_t* d0 = p.Bs() + ((size_t)(g * 256 + dir * 128 + pp)) * 1024 + s * 16;
      bf16_t* d1 = d0 + 64 * 1024;
      uint4 w;
      w.x = pk2(vr[0], vr[1]); w.y = pk2(vr[2], vr[3]); w.z = pk2(vr[4], vr[5]); w.w = pk2(vr[6], vr[7]); *(uint4*)d0 = w;
      w.x = pk2(vr[8], vr[9]); w.y = pk2(vr[10], vr[11]); w.z = pk2(vr[12], vr[13]); w.w = pk2(vr[14], vr[15]); *(uint4*)(d0 + 8) = w;
      w.x = pk2(vi[0], vi[1]); w.y = pk2(vi[2], vi[3]); w.z = pk2(vi[4], vi[5]); w.w = pk2(vi[6], vi[7]); *(uint4*)d1 = w;
      w.x = pk2(vi[8], vi[9]); w.y = pk2(vi[10], vi[11]); w.z = pk2(vi[12], vi[13]); w.w = pk2(vi[14], vi[15]); *(uint4*)(d1 + 8) = w;
    }
    for (int i = gt; i < 32 * 64 * 2 * 64; i += gsz) {
      const int pp = i & 63, dir = (i >> 6) & 1, t = (i >> 7) & 63, g = i >> 13;
      float pr, pi; ssm_pow(p, g, dir, pp, dir == 0 ? t + 1 : 64 - t, pr, pi);
#pragma unroll
      for (int h = 0; h < 16; h++) {
        const int ic = ((dir * 32 + g) * 16 + h) * 64 + pp;
        const float cr = p.c_re[ic], ci = p.c_im[ic];
        bf16_t* d = p.Co() + ((size_t)(g * 1024 + t * 16 + h)) * 256 + dir * 128 + pp;
        d[0] = f2bf(cr * pr - ci * pi);
        d[64] = f2bf(-(cr * pi + ci * pr));
      }
    }
    for (int i = gt; i < 32 * 2 * 64; i += gsz) {
      const int pp = i & 63, dir = (i >> 6) & 1, g = i >> 7;
      float pr, pi; ssm_pow(p, g, dir, pp, 64, pr, pi);
      p.AT()[i * 2] = pr; p.AT()[i * 2 + 1] = pi;
    }
  }
  {
    float2* q = (float2*)smraw;
    for (int base = 0; base < 32 * 127; base += nb) {
      const int item = base + bid; const bool act = item < 32 * 127;
      const int g = act ? item / 127 : 0, jj = act ? item % 127 : 0, lag = jj - 63;
      __syncthreads();
      if (tid < 128) {
        const int dir = tid >> 6, pp = tid & 63;
        float2 v = make_float2(0.f, 0.f);
        if ((dir == 0 && lag >= 0) || (dir == 1 && lag <= 0)) {
          float pr, pi, cr, ci; ssm_pow(p, g, dir, pp, lag < 0 ? -lag : lag, pr, pi); ssm_coef(p, g, dir, pp, cr, ci);
          v = make_float2(pr * cr - pi * ci, pr * ci + pi * cr);
        }
        q[tid] = v;
      }
      __syncthreads();
      const int hp = tid >> 4, h = tid & 15;
      float a = 0.f;
#pragma unroll
      for (int dir = 0; dir < 2; dir++) {
        if ((dir == 0 && lag < 0) || (dir == 1 && lag > 0)) continue;
        for (int pp = 0; pp < 64; pp++) {
          const int ic = ((dir * 32 + g) * 16 + hp) * 64 + pp, ib = ((dir * 32 + g) * 64 + pp) * 16 + h;
          const float cr = p.c_re[ic], ci = p.c_im[ic], br = p.b_re[ib], bi = p.b_im[ib];
          const float2 qq = q[dir * 64 + pp];
          const float er = cr * qq.x - ci * qq.y, ei = cr * qq.y + ci * qq.x;
          a += er * br - ei * bi;
        }
      }
      if (lag == 0 && hp == h) a += p.ssm_d[g * 16 + h];
      if (act) p.Ktab()[(size_t)item * 256 + tid] = f2bf(a);
    }
  }
}

DI void rownorm_mod(const P& p, bool from_x, const float* g, int sh_off, int sc_off) {
  const int tix = otid(), lane = tix & 63, wv = blockIdx.x * 8 + (tix >> 6), nw = gridDim.x * 8;
  for (int tok = wv; tok < NTOK; tok += nw) {
    const float* src = from_x ? (tok < LPR ? p.xp + (size_t)tok * 1024 : p.xs + (size_t)(tok - LPR) * 1024) : p.out + (size_t)tok * 1024;
    f32x4 v[4]; float ss = 0.f;
#pragma unroll
    for (int i = 0; i < 4; i++) { v[i] = *(const f32x4*)(src + (i * 64 + lane) * 4); ss += v[i][0] * v[i][0] + v[i][1] * v[i][1] + v[i][2] * v[i][2] + v[i][3] * v[i][3]; }
    ss = wave_sum(ss);
    const float r = rsqrtf(ss * (1.f / 1024.f) + EPSV);
    const float* md = p.mod() + batch_of(tok) * 6144;
#pragma unroll
    for (int i = 0; i < 4; i++) {
      const int c = (i * 64 + lane) * 4;
      const f32x4 gg = *(const f32x4*)(g + c), sc = *(const f32x4*)(md + sc_off + c), sh = *(const f32x4*)(md + sh_off + c);
      float o[4];
#pragma unroll
      for (int e = 0; e < 4; e++) o[e] = v[i][e] * r * gg[e] * (1.f + sc[e]) + sh[e];
      uint2 w; w.x = pk2(o[0], o[1]); w.y = pk2(o[2], o[3]);
      *(uint2*)(p.hb() + (size_t)tok * 1024 + c) = w;
    }
  }
}
DI void final_norm(const P& p) {
  const int tix = otid(), lane = tix & 63, wv = blockIdx.x * 8 + (tix >> 6), nw = gridDim.x * 8;
  for (int tok = wv; tok < NTOK; tok += nw) {
    float* src = p.out + (size_t)tok * 1024;
    f32x4 v[4]; float ss = 0.f;
#pragma unroll
    for (int i = 0; i < 4; i++) { v[i] = *(const f32x4*)(src + (i * 64 + lane) * 4); ss += v[i][0] * v[i][0] + v[i][1] * v[i][1] + v[i][2] * v[i][2] + v[i][3] * v[i][3]; }
    ss = wave_sum(ss);
    const float r = rsqrtf(ss * (1.f / 1024.f) + EPSV);
#pragma unroll
    for (int i = 0; i < 4; i++) {
      const int c = (i * 64 + lane) * 4;
      const f32x4 gg = *(const f32x4*)(p.g_final + c);
      f32x4 o;
#pragma unroll
      for (int e = 0; e < 4; e++) o[e] = v[i][e] * r * gg[e];
      *(f32x4*)(src + c) = o;
    }
  }
}

#define GEO const int tix = otid(), half = tix >> 8, tid = tix & 255, lane = tid & 63, wid = tid >> 6, wm = wid >> 1, wn = wid & 1, l31 = lane & 31, lh = lane >> 5; (void)tix; (void)half; (void)tid; (void)wm; (void)wn; (void)l31; (void)lh;

DI void phase2(const P& p) {
  GEO
  bf16_t* sm = (bf16_t*)(dyn_smem + half * SMEM_HALF);
  for (int q = blockIdx.x; q < 640 * 8 / 2; q += gridDim.x) {
    const int t = 2 * q + half;
    const int tm = t >> 3, sub = t & 7, m0 = tm * 128;
    f32x16 acc[2][2];
    if (sub < 4) {
      const int n0 = sub * 128;
      auto af = [&](int r, int k) {
        const int v = m0 + r; int tok;
        if (v < LPR) tok = ((v & 127) << 7) | (v >> 7);
        else { const int vs = v - LPR, w = vs & 4095; tok = LPR + (vs & ~4095) + ((w & 63) << 6) + (w >> 6); }
        return p.hb() + (size_t)tok * 1024 + k;
      };
      auto bf = [&](int r, int k) { return p.wint() + (size_t)(n0 + r) * 1024 + k; };
      gemm_main<false>(sm, tid, 1024, af, bf, NoHook(), acc);
      auto ew = [](int, int, int, float&, float&) {};
      auto dst = [&](int nl, int r) {
        const int c = n0 + nl;
        if (m0 < LPR) return p.zT() + (size_t)c * LPR + m0 + 64 * r;
        const int vs0 = m0 - LPR, b = vs0 >> 12, vl0 = vs0 & 4095;
        return p.zT() + (size_t)512 * LPR + ((size_t)(b * 512 + c)) * 4096 + vl0 + 64 * r;
      };
      epi_transposed(sm, tid, acc, ew, dst);
    } else {
      const int n0 = 512 + (sub - 4) * 128;
      auto af = [&](int r, int k) { return p.hb() + (size_t)(m0 + r) * 1024 + k; };
      auto bf = [&](int r, int k) { return p.wint() + (size_t)(n0 + r) * 1024 + k; };
      gemm_main<true>(sm, tid, 1024, af, bf, NoHook(), acc);
#pragma unroll
      for (int mi = 0; mi < 2; mi++)
#pragma unroll
        for (int ni = 0; ni < 2; ni++)
#pragma unroll
          for (int g = 0; g < 4; g++) {
            const int tok = m0 + wm * 64 + mi * 32 + l31, col = n0 - 512 + wn * 64 + ni * 32 + 8 * g + 4 * lh;
            uint2 w; w.x = pk2(acc[mi][ni][4 * g], acc[mi][ni][4 * g + 1]); w.y = pk2(acc[mi][ni][4 * g + 2], acc[mi][ni][4 * g + 3]);
            *(uint2*)(p.zs() + ((size_t)(col >> 4) * NTOK + tok) * 16 + (col & 15)) = w;
          }
    }
  }
}

template <int R>
DI void fft1_tile(const P& p, bf16_t* sm, int tm, int tn) {
  GEO
  constexpr bool pr = (R == 128);
  f32x16 acc[2][2];
  const bf16_t* Abase = pr ? p.zT() + (size_t)tm * 128 * 128 : p.zT() + (size_t)512 * LPR + (size_t)tm * 128 * 64;
  const bf16_t* Bbase = pr ? p.F1p() + (size_t)tn * 128 * 128 : p.F1s();
  auto af = [&](int r, int k) { return Abase + r * R + k; };
  auto bf = [&](int r, int k) { return Bbase + r * R + k; };
  gemm_main<false>(sm, tid, R, af, bf, NoHook(), acc);
  const int k1 = (tn * 2 + wn) * 32 + l31;
  const float2* tw = pr ? p.twp() : p.tws();
  constexpr int lmask = pr ? 16383 : 4095, l2mask = R - 1;
  const float2 tb = tw[(unsigned)((k1 * ((wm * 64 + 4 * lh) & l2mask)) & lmask)], t1 = tw[(unsigned)(k1 & lmask)], t8 = tw[(unsigned)((k1 * 8) & lmask)],
               t32 = tw[(unsigned)((k1 * (32 & l2mask)) & lmask)];
  float2 wt[2][4][4];
#pragma unroll
  for (int mi = 0; mi < 2; mi++) {
    float2 w = tb;
    if (mi) w = make_float2(tb.x * t32.x - tb.y * t32.y, tb.y * t32.x + tb.x * t32.y);
#pragma unroll
    for (int g = 0; g < 4; g++) {
      float2 u = w;
#pragma unroll
      for (int e = 0; e < 4; e++) {
        wt[mi][g][e] = u;
        u = make_float2(u.x * t1.x - u.y * t1.y, u.y * t1.x + u.x * t1.y);
      }
      w = make_float2(w.x * t8.x - w.y * t8.y, w.y * t8.x + w.x * t8.y);
    }
  }
  auto ew = [&](int mi, int g, int e, float& re, float& im) {
    const float2 w = wt[mi][g][e];
    const float a = re * w.x + im * w.y, b = im * w.x - re * w.y;
    re = a; im = b;
  };
  auto dst = [&](int nl, int r) {
    const int part = (nl >> 5) & 1, kk1 = (tn * 2 + (nl >> 6)) * 32 + (nl & 31);
    if (pr) return p.Tt() + ((size_t)(tm * 128 + kk1)) * 256 + part * 128 + 64 * r;
    return p.Tt() + (size_t)65536 * 256 + ((size_t)((tm * 2 + r) * 64 + kk1)) * 128 + part * 64;
  };
  epi_transposed(sm, tid, acc, ew, dst);
}
DI void phase3(const P& p) {
  GEO
  bf16_t* sm = (bf16_t*)(dyn_smem + half * SMEM_HALF);
  const int NA = 1024, NB_ = 4096, NC = 640;
  for (int q = blockIdx.x; q < (NA + NB_ + NC) / 2; q += gridDim.x) {
    const int t = 2 * q + half;
    if (t < NA) fft1_tile<128>(p, sm, t >> 1, t & 1);
    else if (t < NA + NB_) fft1_tile<64>(p, sm, t - NA, 0);
    else {
      f32x16 acc[2][2];
      const int u = t - NA - NB_, g = u / 20, rem = u % 20, m0 = (rem >> 1) * 128, n0 = (rem & 1) * 128;
      auto af = [&](int r, int k) { return p.zs() + (size_t)g * NTOK * 16 + (size_t)(m0 + r) * 1024 + k; };
      auto bf = [&](int r, int k) { return p.Bs() + (size_t)(g * 256 + n0 + r) * 1024 + k; };
      gemm_main<true>(sm, tid, 1024, af, bf, NoHook(), acc);
#pragma unroll
      for (int mi = 0; mi < 2; mi++)
#pragma unroll
        for (int ni = 0; ni < 2; ni++)
#pragma unroll
          for (int gg = 0; gg < 4; gg++) {
            const int ch = m0 + wm * 64 + mi * 32 + l31, col = n0 + wn * 64 + ni * 32 + 8 * gg + 4 * lh;
            f32x4 v = {acc[mi][ni][4 * gg], acc[mi][ni][4 * gg + 1], acc[mi][ni][4 * gg + 2], acc[mi][ni][4 * gg + 3]};
            *(f32x4*)(p.S() + ((size_t)ch * 32 + g) * 256 + col) = v;
          }
    }
  }
}

template <int R>
DI void fft2_tile(const P& p, bf16_t* sm, int tm, int tn) {
  GEO
  constexpr bool pr = (R == 128);
  constexpr int K = 2 * R;
  f32x16 acc[2][2];
  const int ct = tm & 3, k1 = pr ? (tm >> 2) : ((tm >> 2) & 63), b = pr ? 0 : (tm >> 8);
  const bf16_t* Abase = pr ? p.Tt() + ((size_t)(ct * 128) * 128 + k1) * 256 : p.Tt() + (size_t)65536 * 256 + ((size_t)(b * 512 + ct * 128) * 64 + k1) * 128;
  constexpr int rstride = R * K;
  const bf16_t* Bbase = pr ? p.F2p() + (size_t)tn * 128 * 256 : p.F2s();
  auto af = [&](int r, int k) { return Abase + (size_t)r * rstride + k; };
  auto bf = [&](int r, int k) { return Bbase + r * K + k; };
  gemm_main<false>(sm, tid, K, af, bf, NoHook(), acc);
  auto ew = [](int, int, int, float&, float&) {};
  auto dst = [&](int nl, int r) {
    const int n = tn * 128 + nl, part = pr ? (n >> 7) : (n >> 6), k2 = n & (R - 1);
    const int tok = (pr ? 0 : LPR + b * 4096) + k1 + R * k2;
    return p.AF() + (size_t)tok * 1024 + part * 512 + ct * 128 + 64 * r;
  };
  epi_transposed(sm, tid, acc, ew, dst);
}
DI void phase4(const P& p) {
  GEO
  bf16_t* sm = (bf16_t*)(dyn_smem + half * SMEM_HALF);
  for (int idx = blockIdx.x * 512 + tix; idx < 17 * 4096; idx += gridDim.x * 512) {
    const int seq = idx >> 12, rem = idx & 4095, g = rem >> 7, dir = (rem >> 6) & 1, pp = rem & 63;
    const int c0 = seq == 0 ? 0 : 256 + (seq - 1) * 64, nc = seq == 0 ? 256 : 64;
    const float ar = p.AT()[((g * 2 + dir) * 64 + pp) * 2], ai = p.AT()[((g * 2 + dir) * 64 + pp) * 2 + 1];
    float hr = 0.f, hi = 0.f;
    const size_t off = (size_t)g * 256 + dir * 128 + pp;
    for (int i0 = 0; i0 < nc; i0 += 8) {
      float sr[8], si[8];
#pragma unroll
      for (int j = 0; j < 8; j++) {
        const int c = c0 + (dir == 0 ? i0 + j : nc - 1 - i0 - j);
        sr[j] = p.S()[(size_t)c * 8192 + off]; si[j] = p.S()[(size_t)c * 8192 + off + 64];
      }
#pragma unroll
      for (int j = 0; j < 8; j++) {
        const int c = c0 + (dir == 0 ? i0 + j : nc - 1 - i0 - j);
        p.H()[(size_t)c * 8192 + off] = f2bf(hr); p.H()[(size_t)c * 8192 + off + 64] = f2bf(hi);
        const float nr = ar * hr - ai * hi + sr[j], ni = ar * hi + ai * hr + si[j];
        hr = nr; hi = ni;
      }
    }
  }
  for (int q = blockIdx.x; q < (1024 + 4096) / 2; q += gridDim.x) {
    const int t = 2 * q + half;
    if (t < 1024) fft2_tile<128>(p, sm, t >> 1, t & 1);
    else fft2_tile<64>(p, sm, t - 1024, 0);
  }
}

DI float gelu_tanh(float x) {
  const float u = 0.7978845608028654f * (x + 0.044715f * x * x * x);
  return x / (1.f + __expf(-2.f * u));
}

DI void phase5(const P& p) {
  GEO
  bf16_t* sm = (bf16_t*)(dyn_smem + half * SMEM_HALF);
  for (int q = blockIdx.x; q < 2560 / 2; q += gridDim.x) {
    const int t = 2 * q + half;
    f32x16 acc[2][2];
    const int g = t / 80, rem = t % 80, m0 = (rem >> 3) * 128, n0 = (rem & 7) * 128;
    const bf16_t* Ug = p.zs() + (size_t)g * NTOK * 16;
    const bf16_t* Kg = p.Ktab() + (size_t)g * 127 * 256;
    auto af = [&](int r, int k) { return k < 1024 ? Ug + (size_t)(m0 + r) * 1024 + k : p.H() + ((size_t)(m0 + r) * 32 + g) * 256 + (k - 1024); };
    auto bf = [&](int r, int k) {
      const int n = n0 + r;
      return k < 1024 ? Kg + (((n >> 4) - (k >> 4) + 63) * 256 + (n & 15) * 16 + (k & 15)) : p.Co() + ((size_t)(g * 1024 + n)) * 256 + (k - 1024);
    };
    gemm_main<true>(sm, tid, 1280, af, bf, NoHook(), acc);
#pragma unroll
    for (int mi = 0; mi < 2; mi++)
#pragma unroll
      for (int ni = 0; ni < 2; ni++)
#pragma unroll
        for (int gg = 0; gg < 4; gg++) {
          const int ch = m0 + wm * 64 + mi * 32 + l31, n = n0 + wn * 64 + ni * 32 + 8 * gg + 4 * lh;
          const int tok = ch * 64 + (n >> 4);
          float o[4];
#pragma unroll
          for (int e = 0; e < 4; e++) o[e] = gelu_tanh(acc[mi][ni][4 * gg + e]);
          uint2 w; w.x = pk2(o[0], o[1]); w.y = pk2(o[2], o[3]);
          *(uint2*)(p.gact() + (size_t)tok * 512 + g * 16 + (n & 15)) = w;
        }
  }
}

namespace pg8 {
#define PG8_LAS __attribute__((address_space(3)))
typedef unsigned short bf16_t;
typedef short bf16x8 __attribute__((ext_vector_type(8)));
typedef float f32x4 __attribute__((ext_vector_type(4)));
typedef unsigned u32x4 __attribute__((ext_vector_type(4)));
constexpr int BM = 256, BK = 64, HALF = 128, HTB = HALF * BK * 2  , STAGE_BYTES = 8 * HTB, NXCD = 8, WGM = 8;

__host__ __device__ __forceinline__ int lds_byte(int r, int c) { const int st = (r >> 4) * 2 + (c >> 5), rr = r & 15, cc = c & 31, ob = rr * 64 + cc * 2; return st * 1024 + (ob ^ (((ob >> 9) & 1) << 5)); }
__host__ __device__ __forceinline__ void stage_rc(int b, int& R, int& C) { const int st = b / 1024, sb = b % 1024, swz = sb ^ (((sb >> 9) & 1) << 5); R = (st >> 1) * 16 + swz / 64; C = (st & 1) * 32 + (swz % 64) / 2; }
__host__ __device__ __forceinline__ int perm32(int rho) { const int n = rho >> 4, i = rho & 15; return 8 * (i >> 2) + 4 * n + (i & 3); }

struct Unit { int pm, pn; };
struct Gemm { const bf16_t* A; const bf16_t* Bt; int M, N, K; };

struct StaticOrder {
    int nM, nN, nwg, G, c;
    __host__ __device__ void init(int M, int N, int G_, int c_) { nM = M / BM; nN = N / BM; nwg = nM * nN; G = G_; c = c_; }
    __host__ __device__ bool next(int i, Unit& u) const {
        const long L = (long)i * G + c; if (L >= nwg) return false;
        int wgid = (int)L; { const int q = nwg / NXCD, r = nwg % NXCD, xcd = wgid % NXCD, off = wgid / NXCD; wgid = (xcd < r ? xcd * (q + 1) : r * (q + 1) + (xcd - r) * q) + off; }
        const int nig = WGM * nN, gid = wgid / nig, fm = gid * WGM, gsz = (nM - fm) < WGM ? (nM - fm) : WGM;
        u.pm = fm + ((wgid % nig) % gsz); u.pn = (wgid % nig) / gsz; return true;
    }
    __device__ __forceinline__ void a_ready(const Unit&) const {}
    __device__ __forceinline__ void done(const Unit&) const {}
};

template <class Epi, class Sched, bool ALIGN_EPI = false, bool SP2 = false>
__device__ __forceinline__ void gemm_phase(PG8_LAS unsigned char* lds, const int tix, const Gemm g, const Sched& S, const Epi& E) {
    const int tid = tix, wid = __builtin_amdgcn_readfirstlane(tid >> 6), lane = tid & 63, wr = wid >> 2, wc = wid & 3, fr = lane & 15, fq = lane >> 4;
    const int K = g.K, nt = K / BK;
    unsigned voffA[2], voffB[2];
#pragma unroll
    for (int i = 0; i < 2; ++i) { int R, C; stage_rc(tid * 16 + i * 8192, R, C); const int Rb = Epi::PERM ? ((R & ~31) + perm32(R & 31)) : R;
        voffA[i] = (unsigned)(R * K + C) * 2u; voffB[i] = (unsigned)(Rb * K + C) * 2u; }
    const size_t kstep = (size_t)(BK * 2);
    const size_t hstep = (size_t)HALF * K * 2;
    const size_t tstep = 2 * hstep;
    const unsigned ldsw = (unsigned)wid * 1024u;
    const int aoff = lds_byte(wr * 64 + fr, fq * 8), boff = lds_byte(wc * 32 + fr, fq * 8);
#define PG8_SA(b, h) (((b) * 2 + (h)) * HTB)
#define PG8_SB(b, h) ((4 + (b) * 2 + (h)) * HTB)
#define PG8_STAGE(bufoff, gbase, voff) do { _Pragma("unroll") for (int _i = 0; _i < 2; ++_i) \
        __builtin_amdgcn_global_load_lds((const unsigned*)((const char*)(gbase) + (voff)[_i]), (PG8_LAS unsigned*)(lds + (bufoff) + ldsw + _i * 8192), 16, 0, 0); } while (0)
#define PG8_LDA(dst, b, h) do { _Pragma("unroll") for (int m = 0; m < 4; ++m) _Pragma("unroll") for (int k = 0; k < 2; ++k) dst[m][k] = *(const PG8_LAS bf16x8*)(lds + PG8_SA(b, h) + aoff + m * 2048 + k * 1024); } while (0)
#define PG8_LDB(dst, b, h) do { _Pragma("unroll") for (int n = 0; n < 2; ++n) _Pragma("unroll") for (int k = 0; k < 2; ++k) dst[n][k] = *(const PG8_LAS bf16x8*)(lds + PG8_SB(b, h) + boff + n * 2048 + k * 1024); } while (0)
#define PG8_MMA(ai, bj, At, Bt) do { __builtin_amdgcn_s_setprio(1); _Pragma("unroll") for (int m = 0; m < 4; ++m) _Pragma("unroll") for (int n = 0; n < 2; ++n) _Pragma("unroll") for (int k = 0; k < 2; ++k) \
        acc[ai][bj][m][n] = __builtin_amdgcn_mfma_f32_16x16x32_bf16(Bt[n][k], At[m][k], acc[ai][bj][m][n], 0, 0, 0); __builtin_amdgcn_s_setprio(0); } while (0)
#define PG8_WAIT_V(n) asm volatile("s_waitcnt vmcnt(" #n ")" ::: "memory")
#define PG8_WAIT_L(n) asm volatile("s_waitcnt lgkmcnt(" #n ")" ::: "memory")
#define PG8_BAR __builtin_amdgcn_s_barrier()
#define PG8_SCHED __builtin_amdgcn_sched_barrier(0)
    Unit cur, nxt; int ui = 0;
    if (!S.next(0, cur)) return;
    f32x4 acc[2][2][4][2];
#pragma unroll
    for (int a = 0; a < 2; ++a)
#pragma unroll
        for (int b = 0; b < 2; ++b)
#pragma unroll
            for (int m = 0; m < 4; ++m)
#pragma unroll
                for (int n = 0; n < 2; ++n) acc[a][b][m][n] = (f32x4){0.f, 0.f, 0.f, 0.f};
    bf16x8 At[4][2], B0[2][2], B1[2][2];
    const char* cA = (const char*)g.A + (size_t)cur.pm * tstep; const char* cB = (const char*)g.Bt + (size_t)cur.pn * tstep;
    S.a_ready(cur);
    if constexpr (SP2) {
        PG8_STAGE(PG8_SB(0, 0), cB, voffB); PG8_STAGE(PG8_SB(0, 1), cB + hstep, voffB); PG8_STAGE(PG8_SA(0, 0), cA, voffA); PG8_STAGE(PG8_SA(0, 1), cA + hstep, voffA);
        if (wr == 1) PG8_BAR;
        PG8_WAIT_V(2); PG8_BAR;
        PG8_STAGE(PG8_SB(1, 0), cB + kstep, voffB); PG8_STAGE(PG8_SA(1, 0), cA + kstep, voffA); PG8_STAGE(PG8_SB(1, 1), cB + hstep + kstep, voffB);
        PG8_WAIT_V(6); PG8_BAR;
    } else {
        PG8_STAGE(PG8_SB(0, 0), cB, voffB); PG8_STAGE(PG8_SA(0, 0), cA, voffA); PG8_STAGE(PG8_SB(0, 1), cB + hstep, voffB); PG8_STAGE(PG8_SA(0, 1), cA + hstep, voffA);
        if (wr == 1) PG8_BAR;
        PG8_WAIT_V(4); PG8_BAR;
        PG8_STAGE(PG8_SB(1, 0), cB + kstep, voffB); PG8_STAGE(PG8_SA(1, 0), cA + kstep, voffA); PG8_STAGE(PG8_SB(1, 1), cB + hstep + kstep, voffB);
        PG8_WAIT_V(6); PG8_BAR;
    }
    for (;;) {
        const bool has_next = S.next(ui + 1, nxt);
        const char* nA = has_next ? (const char*)g.A + (size_t)nxt.pm * tstep : cA; const char* nB = has_next ? (const char*)g.Bt + (size_t)nxt.pn * tstep : cB;
        for (int t = 0; t < nt; t += 2) {
            if constexpr (Epi::KHOOK) { if (t == Epi::KH_T) E.khook(acc, ui, wr, fr, lds); }
            const bool last = (t == nt - 2);
            const char* a1 = cA + (size_t)(t + 1) * kstep;
            const char* a2 = last ? nA : cA + (size_t)(t + 2) * kstep; const char* b2 = last ? nB : cB + (size_t)(t + 2) * kstep;
            const char* a3 = a2 + kstep; const char* b3 = b2 + kstep;
            if (last && has_next) S.a_ready(nxt);
            if constexpr (SP2) {
            PG8_LDB(B0, 0, 0); PG8_LDB(B1, 0, 1); PG8_SCHED; PG8_LDA(At, 0, 0); PG8_STAGE(PG8_SA(1, 1), a1 + hstep, voffA);
            PG8_WAIT_V(8); PG8_WAIT_L(0); PG8_BAR; PG8_MMA(0, 0, At, B0); PG8_MMA(0, 1, At, B1); PG8_BAR; PG8_SCHED;
            PG8_LDA(At, 0, 1); PG8_STAGE(PG8_SB(0, 0), b2, voffB); PG8_STAGE(PG8_SB(0, 1), b2 + hstep, voffB); PG8_STAGE(PG8_SA(0, 0), a2, voffA);
            PG8_WAIT_V(8); PG8_WAIT_L(0); PG8_BAR; PG8_MMA(1, 0, At, B0); PG8_MMA(1, 1, At, B1); PG8_BAR; PG8_SCHED;
            PG8_LDB(B0, 1, 0); PG8_LDB(B1, 1, 1); PG8_SCHED; PG8_LDA(At, 1, 0); PG8_STAGE(PG8_SA(0, 1), a2 + hstep, voffA);
            PG8_WAIT_V(8); PG8_WAIT_L(0); PG8_BAR; PG8_MMA(0, 0, At, B0); PG8_MMA(0, 1, At, B1); PG8_BAR; PG8_SCHED;
            PG8_LDA(At, 1, 1); PG8_STAGE(PG8_SB(1, 0), b3, voffB); PG8_STAGE(PG8_SB(1, 1), b3 + hstep, voffB); PG8_STAGE(PG8_SA(1, 0), a3, voffA);
            PG8_WAIT_V(8); PG8_WAIT_L(0); PG8_BAR; PG8_MMA(1, 0, At, B0); PG8_MMA(1, 1, At, B1); PG8_BAR; PG8_SCHED;
            } else {
            PG8_LDB(B0, 0, 0); PG8_SCHED; PG8_LDA(At, 0, 0); PG8_STAGE(PG8_SA(1, 1), a1 + hstep, voffA);
            PG8_WAIT_L(8); PG8_BAR; PG8_WAIT_L(0); PG8_MMA(0, 0, At, B0); PG8_BAR; PG8_SCHED;
            PG8_LDB(B1, 0, 1); PG8_STAGE(PG8_SB(0, 0), b2, voffB);
            PG8_BAR; PG8_WAIT_L(0); PG8_MMA(0, 1, At, B1); PG8_BAR;
            PG8_LDA(At, 0, 1); PG8_STAGE(PG8_SA(0, 0), a2, voffA);
            PG8_BAR; PG8_WAIT_L(0); PG8_MMA(1, 0, At, B0); PG8_BAR; PG8_SCHED;
            PG8_STAGE(PG8_SB(0, 1), b2 + hstep, voffB);
            PG8_WAIT_V(6); PG8_BAR; PG8_MMA(1, 1, At, B1); PG8_BAR;
            PG8_LDB(B0, 1, 0); PG8_SCHED; PG8_LDA(At, 1, 0); PG8_STAGE(PG8_SA(0, 1), a2 + hstep, voffA);
            PG8_WAIT_L(8); PG8_BAR; PG8_WAIT_L(0); PG8_MMA(0, 0, At, B0); PG8_BAR; PG8_SCHED;
            PG8_LDB(B1, 1, 1); PG8_STAGE(PG8_SB(1, 0), b3, voffB);
            PG8_BAR; PG8_WAIT_L(0); PG8_MMA(0, 1, At, B1); PG8_BAR;
            PG8_LDA(At, 1, 1); PG8_STAGE(PG8_SA(1, 0), a3, voffA);
            PG8_BAR; PG8_WAIT_L(0); PG8_MMA(1, 0, At, B0); PG8_BAR; PG8_SCHED;
            PG8_STAGE(PG8_SB(1, 1), b3 + hstep, voffB);
            PG8_WAIT_V(6); PG8_BAR; PG8_MMA(1, 1, At, B1); PG8_BAR;
            }
        }
        if constexpr (ALIGN_EPI) { if (wr == 0) PG8_BAR; }
        if constexpr (!Epi::AFTER_DRAIN) { E(acc, cur, wr, wc, fr, fq, ui); S.done(cur); }
        if (!has_next) break;
#pragma unroll
        for (int a = 0; a < 2; ++a)
#pragma unroll
            for (int b = 0; b < 2; ++b)
#pragma unroll
                for (int m = 0; m < 4; ++m)
#pragma unroll
                    for (int n = 0; n < 2; ++n) acc[a][b][m][n] = (f32x4){0.f, 0.f, 0.f, 0.f};
        cur = nxt; cA = nA; cB = nB; ++ui;
        if constexpr (ALIGN_EPI) { if (wr == 1) PG8_BAR; }
    }
    PG8_WAIT_V(0);
    if constexpr (!ALIGN_EPI) { if (wr == 0) PG8_BAR; }
    PG8_BAR;
    if constexpr (Epi::AFTER_DRAIN) { E.fused(acc, cur, wr, wc, fr, fq, lds, wid, lane); S.done(cur); }
#undef PG8_SA
#undef PG8_SB
#undef PG8_STAGE
#undef PG8_LDA
#undef PG8_LDB
#undef PG8_MMA
#undef PG8_WAIT_V
#undef PG8_WAIT_L
#undef PG8_BAR
#undef PG8_SCHED
}
}

namespace pg8 {
struct EpiMlpIn {
  static constexpr bool PERM = true, AFTER_DRAIN = false, KHOOK = false; static constexpr int KH_T = 0;
  ::bf16_t* O; const float* bias;
  __device__ __forceinline__ void operator()(const f32x4 (&acc)[2][2][4][2], const Unit& u, int wr, int wc, int fr, int fq, int) const {
    const int row0 = u.pm * BM + wr * 64 + fr, col0 = u.pn * BM + wc * 32 + 8 * fq;
    f32x4 bv[2][2];
#pragma unroll
    for (int bj = 0; bj < 2; ++bj)
#pragma unroll
      for (int n = 0; n < 2; ++n) bv[bj][n] = *(const f32x4*)(bias + col0 + bj * HALF + 4 * n);
#pragma unroll
    for (int ai = 0; ai < 2; ++ai)
#pragma unroll
      for (int m = 0; m < 4; ++m) {
        ::bf16_t* rowp = O + (size_t)(row0 + ai * HALF + m * 16) * 4096 + col0;
#pragma unroll
        for (int bj = 0; bj < 2; ++bj) {
          f32x4 v0 = acc[ai][bj][m][0] + bv[bj][0], v1 = acc[ai][bj][m][1] + bv[bj][1];
#pragma unroll
          for (int e = 0; e < 4; ++e) { const float a = fmaxf(v0[e], 0.f), b = fmaxf(v1[e], 0.f); v0[e] = a * a; v1[e] = b * b; }
          u32x4 w; w.x = pk2(v0[0], v0[1]); w.y = pk2(v0[2], v0[3]); w.z = pk2(v1[0], v1[1]); w.w = pk2(v1[2], v1[3]);
          *(u32x4*)(rowp + bj * HALF) = w;
        }
      }
  }
};
struct EpiMlpOut {
  static constexpr bool PERM = false, AFTER_DRAIN = false, KHOOK = false; static constexpr int KH_T = 0;
  float* out; const float* mod; const float* bias;
  __device__ __forceinline__ void operator()(const f32x4 (&acc)[2][2][4][2], const Unit& u, int wr, int wc, int fr, int fq, int) const {
    const int col0 = u.pn * BM + wc * 32 + 4 * fq;
#pragma unroll
    for (int ai = 0; ai < 2; ++ai)
#pragma unroll
      for (int m = 0; m < 4; ++m) {
        const int row = u.pm * BM + ai * HALF + wr * 64 + m * 16 + fr;
        const float* g2 = mod + batch_of(row) * 6144 + 5120;
        float* xr = out + (size_t)row * 1024;
#pragma unroll
        for (int bj = 0; bj < 2; ++bj)
#pragma unroll
          for (int n = 0; n < 2; ++n) {
            const int col = col0 + bj * HALF + n * 16;
            const f32x4 xv = *(const f32x4*)(xr + col), gv = *(const f32x4*)(g2 + col), bb = *(const f32x4*)(bias + col);
            *(f32x4*)(xr + col) = xv + gv * (acc[ai][bj][m][n] + bb);
          }
      }
  }
};
struct EpiYf {
  static constexpr bool PERM = true, AFTER_DRAIN = false, KHOOK = false; static constexpr int KH_T = 0;
  ::bf16_t* O; const float* bias; float* ss;
  __device__ __forceinline__ void operator()(const f32x4 (&acc)[2][2][4][2], const Unit& u, int wr, int wc, int fr, int fq, int) const {
    const int row0 = u.pm * BM + wr * 64 + fr, col0 = u.pn * BM + wc * 32 + 8 * fq;
    f32x4 bv[2][2];
#pragma unroll
    for (int bj = 0; bj < 2; ++bj)
#pragma unroll
      for (int n = 0; n < 2; ++n) bv[bj][n] = *(const f32x4*)(bias + col0 + bj * HALF + 4 * n);
#pragma unroll
    for (int ai = 0; ai < 2; ++ai)
#pragma unroll
      for (int m = 0; m < 4; ++m) {
        const int row = row0 + ai * HALF + m * 16;
        const float scale = row < LPR ? 3.4526698300124393e-4f : 6.905339660024879e-4f;
        ::bf16_t* rowp = O + (size_t)row * 1024 + col0;
        float s = 0.f;
#pragma unroll
        for (int bj = 0; bj < 2; ++bj) {
          const f32x4 v0 = acc[ai][bj][m][0] * scale + bv[bj][0], v1 = acc[ai][bj][m][1] * scale + bv[bj][1];
          s += (v0[0] * v0[0] + v0[1] * v0[1]) + (v0[2] * v0[2] + v0[3] * v0[3]) + (v1[0] * v1[0] + v1[1] * v1[1]) + (v1[2] * v1[2] + v1[3] * v1[3]);
          u32x4 w; w.x = pk2(v0[0], v0[1]); w.y = pk2(v0[2], v0[3]); w.z = pk2(v1[0], v1[1]); w.w = pk2(v1[2], v1[3]);
          *(u32x4*)(rowp + bj * HALF) = w;
        }
        s += __shfl_xor(s, 16); s += __shfl_xor(s, 32);
        if (fq == 0) ss[row * 8 + u.pn * 4 + wc] = s;
      }
  }
};
struct EpiGlu {
  static constexpr bool PERM = true, AFTER_DRAIN = false, KHOOK = false; static constexpr int KH_T = 0;
  ::bf16_t* O; const float* bias; float* ss;
  __device__ __forceinline__ void operator()(const f32x4 (&acc)[2][2][4][2], const Unit& u, int wr, int wc, int fr, int fq, int) const {
    const int row0 = u.pm * BM + wr * 64 + fr, j0 = u.pn * 128 + wc * 32 + 8 * fq;
    f32x4 bv[2][2];
#pragma unroll
    for (int bj = 0; bj < 2; ++bj)
#pragma unroll
      for (int n = 0; n < 2; ++n) bv[bj][n] = *(const f32x4*)(bias + bj * 512 + j0 + 4 * n);
#pragma unroll
    for (int ai = 0; ai < 2; ++ai)
#pragma unroll
      for (int m = 0; m < 4; ++m) {
        const int row = row0 + ai * HALF + m * 16;
        float o[8], s = 0.f;
#pragma unroll
        for (int n = 0; n < 2; ++n)
#pragma unroll
          for (int e = 0; e < 4; ++e) {
            const float val = acc[ai][0][m][n][e] + bv[0][n][e], gate = acc[ai][1][m][n][e] + bv[1][n][e];
            const float y = val / (1.f + __expf(-gate));
            o[4 * n + e] = y; s += y * y;
          }
        u32x4 w; w.x = pk2(o[0], o[1]); w.y = pk2(o[2], o[3]); w.z = pk2(o[4], o[5]); w.w = pk2(o[6], o[7]);
        *(u32x4*)(O + (size_t)row * 1024 + 512 + j0) = w;
        s += __shfl_xor(s, 16); s += __shfl_xor(s, 32);
        if (fq == 0) ss[row * 16 + u.pn * 4 + wc] = s;
      }
  }
};
struct EpiWout {
  static constexpr bool PERM = false, AFTER_DRAIN = false, KHOOK = true; static constexpr int KH_T = 8;
  float* out; const float* xp; const float* xs; const float* mod;
  __device__ __forceinline__ void khook(f32x4 (&acc)[2][2][4][2], int ui, int wr, int fr, PG8_LAS unsigned char* lds) const {
    typedef float f32x2t __attribute__((ext_vector_type(2)));
    const PG8_LAS f32x2t* tab = (const PG8_LAS f32x2t*)(lds + 131072) + ui * 256;
#pragma unroll
    for (int ai = 0; ai < 2; ++ai)
#pragma unroll
      for (int m = 0; m < 4; ++m) {
        const float r = tab[ai * HALF + wr * 64 + m * 16 + fr].x;
#pragma unroll
        for (int bj = 0; bj < 2; ++bj)
#pragma unroll
          for (int n = 0; n < 2; ++n) acc[ai][bj][m][n] *= r;
      }
  }
  __device__ __forceinline__ void operator()(const f32x4 (&acc)[2][2][4][2], const Unit& u, int wr, int wc, int fr, int fq, int ui) const {
    typedef float f32x2t __attribute__((ext_vector_type(2)));
    const PG8_LAS f32x2t* tab = (const PG8_LAS f32x2t*)((PG8_LAS unsigned char*)dyn_smem + 131072) + ui * 256;
    const int col0 = u.pn * BM + wc * 32 + 4 * fq;
#pragma unroll
    for (int ai = 0; ai < 2; ++ai)
#pragma unroll
      for (int m = 0; m < 4; ++m) {
        const int rl = ai * HALF + wr * 64 + m * 16 + fr, row = u.pm * BM + rl;
        const float rs = tab[rl].y;
        const float* g1 = mod + batch_of(row) * 6144 + 2048;
        const float* xr = row < LPR ? xp + (size_t)row * 1024 : xs + (size_t)(row - LPR) * 1024;
        float* orow = out + (size_t)row * 1024;
#pragma unroll
        for (int bj = 0; bj < 2; ++bj)
#pragma unroll
          for (int n = 0; n < 2; ++n) {
            const int col = col0 + bj * HALF + n * 16;
            const f32x4 xv = *(const f32x4*)(xr + col), gv = *(const f32x4*)(g1 + col);
            *(f32x4*)(orow + col) = xv + gv * (acc[ai][bj][m][n] * rs);
          }
      }
  }
};
}

DI void phase6(const P& p) {
  {
    const pg8::Gemm g{p.AF(), p.Mf(), NTOK, 512, 1024};
    pg8::StaticOrder S; S.init(NTOK, 512, (int)gridDim.x, (int)blockIdx.x);
    const pg8::EpiYf E{p.mg(), p.b_f, p.ssf()};
    pg8::gemm_phase<pg8::EpiYf, pg8::StaticOrder, true, true>((PG8_LAS unsigned char*)dyn_smem, otid(), g, S, E);
  }
  {
    const pg8::Gemm g{p.gact(), p.wglut(), NTOK, 1024, 512};
    pg8::StaticOrder S; S.init(NTOK, 1024, (int)gridDim.x, (int)(gridDim.x - 1 - blockIdx.x));
    const pg8::EpiGlu E{p.mg(), p.b_glu, p.sss()};
    pg8::gemm_phase<pg8::EpiGlu, pg8::StaticOrder, true, true>((PG8_LAS unsigned char*)dyn_smem, otid(), g, S, E);
  }
}
DI void phase7(const P& p) {
  const pg8::Gemm g{p.mg(), p.woutt(), NTOK, 1024, 1024};
  pg8::StaticOrder S; S.init(NTOK, 1024, (int)gridDim.x, (int)blockIdx.x);
  {
    typedef float f32x2t __attribute__((ext_vector_type(2)));
    PG8_LAS f32x2t* tab = (PG8_LAS f32x2t*)((PG8_LAS unsigned char*)dyn_smem + 131072);
    const int tix7 = otid();
    pg8::Unit u;
    for (int i = 0; i < 8 && S.next(i, u); ++i) {
      if (tix7 < 256) {
        const int tok = u.pm * 256 + tix7;
        float sf = 0.f, s2 = 0.f;
#pragma unroll
        for (int j = 0; j < 8; j++) sf += p.ssf()[tok * 8 + j];
#pragma unroll
        for (int j = 0; j < 16; j++) s2 += p.sss()[tok * 16 + j];
        const float rf = rsqrtf(sf * (1.f / 512.f) + EPSV), rs = rsqrtf(s2 * (1.f / 512.f) + EPSV);
        tab[i * 256 + tix7] = (f32x2t){rf / rs, rs};
      }
    }
    __syncthreads();
  }
  const pg8::EpiWout E{p.out, p.xp, p.xs, p.mod()};
  pg8::gemm_phase<pg8::EpiWout, pg8::StaticOrder, true, true>((PG8_LAS unsigned char*)dyn_smem, otid(), g, S, E);
}
DI void phase8(const P& p) {
  const pg8::Gemm g{p.hb(), p.w1t(), NTOK, 4096, 1024};
  pg8::StaticOrder S; S.init(NTOK, 4096, (int)gridDim.x, (int)blockIdx.x);
  const pg8::EpiMlpIn E{p.hid(), p.b1};
  pg8::gemm_phase<pg8::EpiMlpIn, pg8::StaticOrder, true, true>((PG8_LAS unsigned char*)dyn_smem, otid(), g, S, E);
}
DI void phase9(const P& p) {
  const pg8::Gemm g{p.hid(), p.w2t(), NTOK, 1024, 4096};
  pg8::StaticOrder S; S.init(NTOK, 1024, (int)gridDim.x, (int)blockIdx.x);
  const pg8::EpiMlpOut E{p.out, p.mod(), p.b2};
  pg8::gemm_phase<pg8::EpiMlpOut, pg8::StaticOrder, true, true>((PG8_LAS unsigned char*)dyn_smem, otid(), g, S, E);
}

__global__ void __launch_bounds__(512, 2) k_mega(P p) {
  cg::grid_group grid = cg::this_grid();
  phase0(p); grid.sync();
  rownorm_mod(p, true, p.g_mix, 0, 1024); grid.sync();
  phase2(p); grid.sync();
  phase3(p); grid.sync();
  phase4(p); grid.sync();
  phase5(p); grid.sync();
  phase6(p); grid.sync();
  phase7(p); grid.sync();
  rownorm_mod(p, false, p.g_mlp, 3072, 4096); grid.sync();
  phase8(p); grid.sync();
  phase9(p); grid.sync();
  final_norm(p);
}

extern "C" void kernel_launch(void* const* d_in, const int* in_sizes, int n_in, void* d_out, int out_size, void* d_ws, size_t ws_size,
                              hipStream_t stream) {
  P p{};
  const float** f = (const float**)&p;
  for (int i = 0; i < 29; i++) f[i] = (const float*)d_in[i];
  p.out = (float*)d_out;
  p.ws = (char*)d_ws;
  if (WS_NEED > ws_size) { fprintf(stderr, "workspace too small: need %zu have %zu\n", (size_t)WS_NEED, ws_size); return; }
  static int grid_blocks = 0;
  if (!grid_blocks) {
    int dev = 0, cus = 0, per_cu = 0;
    (void)hipGetDevice(&dev);
    (void)hipDeviceGetAttribute(&cus, hipDeviceAttributeMultiprocessorCount, dev);
    (void)hipFuncSetAttribute((const void*)k_mega, hipFuncAttributeMaxDynamicSharedMemorySize, SMEM_BYTES);
    (void)hipOccupancyMaxActiveBlocksPerMultiprocessor(&per_cu, k_mega, 512, SMEM_BYTES);
    if (per_cu < 1) per_cu = 1;
    grid_blocks = cus * per_cu;
  }
  void* args[] = {&p};
  hipError_t e = hipLaunchCooperativeKernel((void*)k_mega, dim3(grid_blocks), dim3(512), args, SMEM_BYTES, stream);
  if (e != hipSuccess) fprintf(stderr, "cooperative launch failed: %s (grid %d)\n", hipGetErrorString(e), grid_blocks);
}
```

```cpp
#include <hip/hip_runtime.h>
#include <hip/hip_cooperative_groups.h>
#include <stdint.h>
#include <stdio.h>
namespace cg = cooperative_groups;


#define DI __device__ __forceinline__
typedef unsigned short bf16_t;
typedef short bf16x8 __attribute__((ext_vector_type(8)));
typedef float f32x16 __attribute__((ext_vector_type(16)));
typedef float f32x4 __attribute__((ext_vector_type(4)));

constexpr int NTOK = 81920, LPR = 16384, LSM = 4096;
constexpr int BM = 128, BN = 128, BK = 64, LDSS = 72, TLD = 136;
constexpr int SMEM_HALF = 2 * 2 * BM * LDSS * 2;
constexpr int SMEM_BYTES = 2 * SMEM_HALF;
constexpr float EPSV = 1e-6f;

constexpr size_t al256(size_t x) { return (x + 255) & ~(size_t)255; }
constexpr size_t O_mod = 0;
constexpr size_t O_AT = O_mod + al256(17 * 6144 * 4);
constexpr size_t O_ssf = O_AT + al256(32 * 2 * 64 * 2 * 4);
constexpr size_t O_sss = O_ssf + al256((size_t)NTOK * 8 * 4);
constexpr size_t O_twp = O_sss + al256((size_t)NTOK * 16 * 4);
constexpr size_t O_tws = O_twp + al256(LPR * 8);
constexpr size_t O_wint = O_tws + al256(LSM * 8);
constexpr size_t O_wglut = O_wint + al256(1024 * 1024 * 2);
constexpr size_t O_woutt = O_wglut + al256(1024 * 512 * 2);
constexpr size_t O_w1t = O_woutt + al256(1024 * 1024 * 2);
constexpr size_t O_w2t = O_w1t + al256((size_t)4096 * 1024 * 2);
constexpr size_t O_Mf = O_w2t + al256((size_t)4096 * 1024 * 2);
constexpr size_t O_F1p = O_Mf + al256(512 * 1024 * 2);
constexpr size_t O_F1s = O_F1p + al256(256 * 128 * 2);
constexpr size_t O_F2p = O_F1s + al256(128 * 64 * 2);
constexpr size_t O_F2s = O_F2p + al256(256 * 256 * 2);
constexpr size_t O_Ktab = O_F2s + al256(128 * 128 * 2);
constexpr size_t O_Bs = O_Ktab + al256((size_t)32 * 127 * 256 * 2);
constexpr size_t O_Co = O_Bs + al256((size_t)32 * 256 * 1024 * 2);
constexpr size_t O_hb = O_Co + al256((size_t)32 * 1024 * 256 * 2);
constexpr size_t O_zT = O_hb + al256((size_t)NTOK * 1024 * 2);
constexpr size_t O_zs = O_zT + al256((size_t)NTOK * 512 * 2);
constexpr size_t O_AF = O_zs + al256((size_t)NTOK * 512 * 2);
constexpr size_t O_S = O_AF + al256((size_t)NTOK * 1024 * 2);
constexpr size_t O_H = O_S + al256((size_t)1280 * 32 * 256 * 4);
constexpr size_t O_gact = O_H + al256((size_t)1280 * 32 * 256 * 2);
constexpr size_t O_mg = O_gact + al256((size_t)NTOK * 512 * 2);
constexpr size_t O_END = O_mg + al256((size_t)NTOK * 1024 * 2);
constexpr size_t O_Tt = O_hb;
constexpr size_t O_hid = O_zT;
constexpr size_t WS_NEED = (O_hid + (size_t)NTOK * 4096 * 2 > O_END ? O_hid + (size_t)NTOK * 4096 * 2 : O_END);
struct P {
  const float *xp, *xs, *cp, *cs, *w_ada, *b_ada, *g_mix, *w_in, *w_f, *b_f, *a_re, *a_im, *log_dt, *b_re, *b_im, *c_re, *c_im,
      *ssm_d, *w_glu, *b_glu, *g_fo, *g_so, *w_out, *g_mlp, *w1, *b1, *w2, *b2, *g_final;
  float* out;
  char* ws;
  __device__ __forceinline__ float* mod() const { return (float*)(ws + O_mod); }
  __device__ __forceinline__ float* AT() const { return (float*)(ws + O_AT); }
  __device__ __forceinline__ float* ssf() const { return (float*)(ws + O_ssf); }
  __device__ __forceinline__ float* sss() const { return (float*)(ws + O_sss); }
  __device__ __forceinline__ float2* twp() const { return (float2*)(ws + O_twp); }
  __device__ __forceinline__ float2* tws() const { return (float2*)(ws + O_tws); }
  __device__ __forceinline__ bf16_t* wint() const { return (bf16_t*)(ws + O_wint); }
  __device__ __forceinline__ bf16_t* wglut() const { return (bf16_t*)(ws + O_wglut); }
  __device__ __forceinline__ bf16_t* woutt() const { return (bf16_t*)(ws + O_woutt); }
  __device__ __forceinline__ bf16_t* w1t() const { return (bf16_t*)(ws + O_w1t); }
  __device__ __forceinline__ bf16_t* w2t() const { return (bf16_t*)(ws + O_w2t); }
  __device__ __forceinline__ bf16_t* Mf() const { return (bf16_t*)(ws + O_Mf); }
  __device__ __forceinline__ bf16_t* F1p() const { return (bf16_t*)(ws + O_F1p); }
  __device__ __forceinline__ bf16_t* F1s() const { return (bf16_t*)(ws + O_F1s); }
  __device__ __forceinline__ bf16_t* F2p() const { return (bf16_t*)(ws + O_F2p); }
  __device__ __forceinline__ bf16_t* F2s() const { return (bf16_t*)(ws + O_F2s); }
  __device__ __forceinline__ bf16_t* Ktab() const { return (bf16_t*)(ws + O_Ktab); }
  __device__ __forceinline__ bf16_t* Bs() const { return (bf16_t*)(ws + O_Bs); }
  __device__ __forceinline__ bf16_t* Co() const { return (bf16_t*)(ws + O_Co); }
  __device__ __forceinline__ bf16_t* hb() const { return (bf16_t*)(ws + O_hb); }
  __device__ __forceinline__ bf16_t* zT() const { return (bf16_t*)(ws + O_zT); }
  __device__ __forceinline__ bf16_t* zs() const { return (bf16_t*)(ws + O_zs); }
  __device__ __forceinline__ bf16_t* AF() const { return (bf16_t*)(ws + O_AF); }
  __device__ __forceinline__ float* S() const { return (float*)(ws + O_S); }
  __device__ __forceinline__ bf16_t* H() const { return (bf16_t*)(ws + O_H); }
  __device__ __forceinline__ bf16_t* mg() const { return (bf16_t*)(ws + O_mg); }
  __device__ __forceinline__ bf16_t* gact() const { return (bf16_t*)(ws + O_gact); }
  __device__ __forceinline__ bf16_t* Tt() const { return (bf16_t*)(ws + O_Tt); }
  __device__ __forceinline__ bf16_t* hid() const { return (bf16_t*)(ws + O_hid); }
};

typedef float f32x2v __attribute__((ext_vector_type(2)));
typedef __bf16 bf16x2v __attribute__((ext_vector_type(2)));
DI uint32_t pk2(float lo, float hi) { const f32x2v v = {lo, hi}; const bf16x2v r = __builtin_convertvector(v, bf16x2v); return __builtin_bit_cast(uint32_t, r); }
DI bf16_t f2bf(float f) { return (bf16_t)(pk2(f, 0.f) & 0xffffu); }
extern __shared__ __attribute__((aligned(16))) unsigned char dyn_smem[];
DI int otid() { int t = (int)threadIdx.x; asm volatile("" : "+v"(t)); return t; }
DI int permtok(int v) {
  if (v < LPR) return ((v & 127) << 7) | (v >> 7);
  const int vs = v - LPR, w = vs & 4095;
  return LPR + (vs & ~4095) + ((w & 63) << 6) + (w >> 6);
}
DI int batch_of(int tok) { return tok < LPR ? 0 : 1 + ((tok - LPR) >> 12); }
DI float wave_sum(float v) {
  v += __shfl_xor(v, 32); v += __shfl_xor(v, 16); v += __shfl_xor(v, 8); v += __shfl_xor(v, 4); v += __shfl_xor(v, 2); v += __shfl_xor(v, 1);
  return v;
}

template <bool SWAP, class AF, class BF, class HK>
DI void gemm_main(bf16_t* sm, const int tid, int K, const AF& af, const BF& bf, const HK& hk, f32x16 (&acc)[2][2]) {
  const int lane = tid & 63, wid = tid >> 6, wm = wid >> 1, wn = wid & 1;
  const int kc = (tid & 7) * 8, rb = tid >> 3;
  bf16_t* As = sm;
  bf16_t* Bs = sm + 2 * BM * LDSS;
  uint4 ra[4], rv[4];
#pragma unroll
  for (int i = 0; i < 2; i++)
#pragma unroll
    for (int j = 0; j < 2; j++)
#pragma unroll
      for (int e = 0; e < 16; e++) acc[i][j][e] = 0.f;
  __syncthreads();
#pragma unroll
  for (int i = 0; i < 4; i++) { ra[i] = *(const uint4*)af(rb + 32 * i, kc); rv[i] = *(const uint4*)bf(rb + 32 * i, kc); }
#pragma unroll
  for (int i = 0; i < 4; i++) { *(uint4*)(As + (rb + 32 * i) * LDSS + kc) = ra[i]; *(uint4*)(Bs + (rb + 32 * i) * LDSS + kc) = rv[i]; }
  __syncthreads();
  const int nk = K / BK;
  for (int t = 0; t < nk; t++) {
    const int cur = t & 1;
    if (t + 1 < nk) {
      const int k = (t + 1) * BK + kc;
#pragma unroll
      for (int i = 0; i < 4; i++) { ra[i] = *(const uint4*)af(rb + 32 * i, k); rv[i] = *(const uint4*)bf(rb + 32 * i, k); }
    }
    hk(t, acc);
    const bf16_t* Ab = As + cur * BM * LDSS + (wm * 64 + (lane & 31)) * LDSS + (lane >> 5) * 8;
    const bf16_t* Bb = Bs + cur * BN * LDSS + (wn * 64 + (lane & 31)) * LDSS + (lane >> 5) * 8;
#pragma unroll
    for (int ks = 0; ks < 4; ks++) {
      const bf16x8 a0 = *(const bf16x8*)(Ab + ks * 16), a1 = *(const bf16x8*)(Ab + 32 * LDSS + ks * 16);
      const bf16x8 b0 = *(const bf16x8*)(Bb + ks * 16), b1 = *(const bf16x8*)(Bb + 32 * LDSS + ks * 16);
      if (SWAP) {
        acc[0][0] = __builtin_amdgcn_mfma_f32_32x32x16_bf16(b0, a0, acc[0][0], 0, 0, 0);
        acc[0][1] = __builtin_amdgcn_mfma_f32_32x32x16_bf16(b1, a0, acc[0][1], 0, 0, 0);
        acc[1][0] = __builtin_amdgcn_mfma_f32_32x32x16_bf16(b0, a1, acc[1][0], 0, 0, 0);
        acc[1][1] = __builtin_amdgcn_mfma_f32_32x32x16_bf16(b1, a1, acc[1][1], 0, 0, 0);
      } else {
        acc[0][0] = __builtin_amdgcn_mfma_f32_32x32x16_bf16(a0, b0, acc[0][0], 0, 0, 0);
        acc[0][1] = __builtin_amdgcn_mfma_f32_32x32x16_bf16(a0, b1, acc[0][1], 0, 0, 0);
        acc[1][0] = __builtin_amdgcn_mfma_f32_32x32x16_bf16(a1, b0, acc[1][0], 0, 0, 0);
        acc[1][1] = __builtin_amdgcn_mfma_f32_32x32x16_bf16(a1, b1, acc[1][1], 0, 0, 0);
      }
    }
    if (t + 1 < nk) {
      const int nb = cur ^ 1;
#pragma unroll
      for (int i = 0; i < 4; i++) {
        *(uint4*)(As + nb * BM * LDSS + (rb + 32 * i) * LDSS + kc) = ra[i];
        *(uint4*)(Bs + nb * BN * LDSS + (rb + 32 * i) * LDSS + kc) = rv[i];
      }
    }
    __syncthreads();
  }
}
struct NoHook { DI void operator()(int, f32x16 (&)[2][2]) const {} };

template <class EW, class DST>
DI void epi_transposed(bf16_t* sm, const int tid, f32x16 (&acc)[2][2], const EW& ew, const DST& dst) {
  const int lane = tid & 63, wid = tid >> 6, wm = wid >> 1, wn = wid & 1;
#pragma unroll
  for (int mi = 0; mi < 2; mi++)
#pragma unroll
    for (int g = 0; g < 4; g++) {
      const int ml = wm * 64 + mi * 32 + 8 * g + 4 * (lane >> 5);
      float v0[4], v1[4];
#pragma unroll
      for (int e = 0; e < 4; e++) { v0[e] = acc[mi][0][4 * g + e]; v1[e] = acc[mi][1][4 * g + e]; ew(mi, g, e, v0[e], v1[e]); }
      const int nl = wn * 64 + (lane & 31);
      uint2 w0, w1;
      w0.x = pk2(v0[0], v0[1]); w0.y = pk2(v0[2], v0[3]); w1.x = pk2(v1[0], v1[1]); w1.y = pk2(v1[2], v1[3]);
      *(uint2*)(sm + nl * TLD + ml) = w0;
      *(uint2*)(sm + (nl + 32) * TLD + ml) = w1;
    }
  __syncthreads();
  {
    const int nl = tid >> 1, r = tid & 1;
    bf16_t* d = dst(nl, r);
    const bf16_t* s = sm + nl * TLD + 64 * r;
#pragma unroll
    for (int i = 0; i < 8; i++) *(uint4*)(d + 8 * i) = *(const uint4*)(s + 8 * i);
  }
}

DI void ssm_pow(const P& p, int g, int dir, int pp, int j, float& re, float& im) {
  const int ia = (dir * 32 + g) * 64 + pp;
  const float lr = fminf(p.a_re[ia], -1e-4f), li = p.a_im[ia], dt = expf(p.log_dt[dir * 32 + g]);
  const float mag = expf(lr * dt * (float)j);
  double t = (double)li * (double)dt * (double)j * 0.15915494309189535;
  t -= rint(t);
  const float ang = (float)(t * 6.283185307179586);
  float s, c; sincosf(ang, &s, &c);
  re = mag * c; im = mag * s;
}
DI void ssm_coef(const P& p, int g, int dir, int pp, float& cr, float& ci) {
  const int ia = (dir * 32 + g) * 64 + pp;
  const float lr = fminf(p.a_re[ia], -1e-4f), li = p.a_im[ia];
  float ar, ai; ssm_pow(p, g, dir, pp, 1, ar, ai);
  const float nr = ar - 1.f, ni = ai, den = 1.f / (lr * lr + li * li);
  cr = (nr * lr + ni * li) * den; ci = (ni * lr - nr * li) * den;
}

template <class CM>
DI void transpose_job(float* tile, const int tid, bool act, int item, const float* in, int ld, int Kdim, bf16_t* out, const CM& colmap, const float* sc0, const float* sc1) {
  const int nkt = Kdim / 64, nt = item / nkt, kt = item % nkt;
  __syncthreads();
  if (act) {
    const int c = tid & 31, kr = tid >> 5, col = colmap(nt * 32 + c);
#pragma unroll
    for (int i = 0; i < 8; i++) {
      const int kl = kr + 8 * i, k = kt * 64 + kl;
      float v = in[(size_t)k * ld + col];
      if (sc0) v *= (k < 512 ? sc0[k] : sc1[k - 512]);
      tile[kl * 33 + c] = v;
    }
  }
  __syncthreads();
  if (act) {
    const int nl = tid >> 3, kc = tid & 7;
    float v[8];
#pragma unroll
    for (int j = 0; j < 8; j++) v[j] = tile[(kc * 8 + j) * 33 + nl];
    uint4 w; w.x = pk2(v[0], v[1]); w.y = pk2(v[2], v[3]); w.z = pk2(v[4], v[5]); w.w = pk2(v[6], v[7]);
    *(uint4*)(out + (size_t)(nt * 32 + nl) * Kdim + kt * 64 + kc * 8) = w;
  }
}

DI void phase0(const P& p) {
  const int tix = otid();
  unsigned char* smraw = dyn_smem + (tix >> 8) * SMEM_HALF;
  float* smf = (float*)smraw;
  const int tid = tix & 255, nb = gridDim.x * 2, bid = blockIdx.x * 2 + (tix >> 8);
  for (int base = 0; base < 96; base += nb) {
    const int item = base + bid; const bool act = item < 96;
    __syncthreads();
    if (act)
      for (int i = tid; i < 17 * 1024; i += 256) {
        const int b = i >> 10, k = i & 1023;
        const float c = b == 0 ? p.cp[k] : p.cs[(b - 1) * 1024 + k];
        smf[i] = c / (1.f + __expf(-c));
      }
    __syncthreads();
    const int col = tid & 63, kq = tid >> 6, j = item * 64 + col;
    float a[17];
#pragma unroll
    for (int b = 0; b < 17; b++) a[b] = 0.f;
    if (act)
      for (int k = kq * 256; k < kq * 256 + 256; k++) {
        const float w = p.w_ada[(size_t)k * 6144 + j];
#pragma unroll
        for (int b = 0; b < 17; b++) a[b] += smf[b * 1024 + k] * w;
      }
    __syncthreads();
#pragma unroll
    for (int b = 0; b < 17; b++) smf[(kq * 17 + b) * 64 + col] = a[b];
    __syncthreads();
    if (act)
      for (int i = tid; i < 17 * 64; i += 256) {
        const int b = i >> 6, c2 = i & 63;
        const float s = smf[(0 * 17 + b) * 64 + c2] + smf[(1 * 17 + b) * 64 + c2] + smf[(2 * 17 + b) * 64 + c2] + smf[(3 * 17 + b) * 64 + c2];
        p.mod()[b * 6144 + item * 64 + c2] = s + p.b_ada[item * 64 + c2];
      }
  }
  {
    auto ident = [](int n) { return n; };
    auto glumap = [](int n) { return ((n >> 7) & 1) * 512 + (n >> 8) * 128 + (n & 127); };
    const int n0 = 512, n1 = n0 + 256, n2 = n1 + 512, n3 = n2 + 2048, n4 = n3 + 2048;
    for (int base = 0; base < n4; base += nb) {
      const int item = base + bid; const bool act = item < n4;
      if (item < n0) transpose_job(smf, tid, act, item, p.w_in, 1024, 1024, p.wint(), ident, nullptr, nullptr);
      else if (item < n1) transpose_job(smf, tid, act, item - n0, p.w_glu, 1024, 512, p.wglut(), glumap, nullptr, nullptr);
      else if (item < n2) transpose_job(smf, tid, act, item - n1, p.w_out, 1024, 1024, p.woutt(), ident, p.g_fo, p.g_so);
      else if (item < n3) transpose_job(smf, tid, act, item - n2, p.w1, 4096, 1024, p.w1t(), ident, nullptr, nullptr);
      else transpose_job(smf, tid, act, item - n3, p.w2, 1024, 4096, p.w2t(), ident, nullptr, nullptr);
    }
  }
  {
    __syncthreads();
    float2* cs = (float2*)smraw;
    for (int i = tid; i < 512; i += 256) { float s, c; sincosf((float)i * (6.283185307179586f / 512.f), &s, &c); cs[i] = make_float2(c, s); }
    __syncthreads();
    for (int item = bid; item < 2048; item += nb) {
      const int idx = item * 256 + tid, n = idx >> 10, k = idx & 1023, h = n >> 7, e = n & 127, c = k & 511;
      const bool is_sin = k >= 512;
      const float* wf = p.w_f + (size_t)h * 128 * 128 + e;
      float a = 0.f;
      for (int d = 0; d < 128; d++) {
        const float2 t = cs[((h * 128 + d) * c) & 511];
        a += (is_sin ? t.y : t.x) * wf[d * 128];
      }
      p.Mf()[idx] = f2bf(a);
    }
  }
  {
    const int gsz = nb * 256, gt = bid * 256 + tid;
    for (int i = gt; i < 256 * 128; i += gsz) {
      const int n = i >> 7, k = i & 127, k1 = (n >> 6) * 32 + (n & 31), part = (n >> 5) & 1;
      float s, c; sincosf((float)((k1 * k) & 127) * (6.283185307179586f / 128.f), &s, &c);
      p.F1p()[i] = f2bf(part ? -s : c);
    }
    for (int i = gt; i < 128 * 64; i += gsz) {
      const int n = i >> 6, k = i & 63, k1 = (n >> 6) * 32 + (n & 31), part = (n >> 5) & 1;
      float s, c; sincosf((float)((k1 * k) & 63) * (6.283185307179586f / 64.f), &s, &c);
      p.F1s()[i] = f2bf(part ? -s : c);
    }
    for (int i = gt; i < 256 * 256; i += gsz) {
      const int n = i >> 8, k = i & 255, part = n >> 7, k2 = n & 127, l2 = k & 127, ki = k >> 7;
      float s, c; sincosf((float)((k2 * l2) & 127) * (6.283185307179586f / 128.f), &s, &c);
      p.F2p()[i] = f2bf(part == 0 ? (ki == 0 ? c : s) : (ki == 0 ? -s : c));
    }
    for (int i = gt; i < 128 * 128; i += gsz) {
      const int n = i >> 7, k = i & 127, part = n >> 6, k2 = n & 63, l2 = k & 63, ki = k >> 6;
      float s, c; sincosf((float)((k2 * l2) & 63) * (6.283185307179586f / 64.f), &s, &c);
      p.F2s()[i] = f2bf(part == 0 ? (ki == 0 ? c : s) : (ki == 0 ? -s : c));
    }
    for (int i = gt; i < LPR; i += gsz) { float s, c; sincosf((float)i * (6.283185307179586f / 16384.f), &s, &c); p.twp()[i] = make_float2(c, s); }
    for (int i = gt; i < LSM; i += gsz) { float s, c; sincosf((float)i * (6.283185307179586f / 4096.f), &s, &c); p.tws()[i] = make_float2(c, s); }
    for (int i = gt; i < 32 * 2 * 64 * 64; i += gsz) {
      const int s = i & 63, pp = (i >> 6) & 63, dir = (i >> 12) & 1, g = i >> 13;
      float pr, pi, cr, ci; ssm_pow(p, g, dir, pp, dir == 0 ? 63 - s : s, pr, pi); ssm_coef(p, g, dir, pp, cr, ci);
      const float qr = pr * cr - pi * ci, qi = pr * ci + pi * cr;
      const int ib = ((dir * 32 + g) * 64 + pp) * 16;
      float vr[16], vi[16];
#pragma unroll
      for (int h = 0; h < 16; h++) { const float br = p.b_re[ib + h], bi = p.b_im[ib + h]; vr[h] = qr * br - qi * bi; vi[h] = qr * bi + qi * br; }
      bf16_t* d0 = p.Bs() + ((size_t)(g * 256 + dir * 128 + pp)) * 1024 + s * 16;
      bf16_t* d1 = d0 + 64 * 1024;
      uint4 w;
      w.x = pk2(vr[0], vr[1]); w.y = pk2(vr[2], vr[3]); w.z = pk2(vr[4], vr[5]); w.w = pk2(vr[6], vr[7]); *(uint4*)d0 = w;
      w.x = pk2(vr[8], vr[9]); w.y = pk2(vr[10], vr[11]); w.z = pk2(vr[12], vr[13]); w.w = pk2(vr[14], vr[15]); *(uint4*)(d0 + 8) = w;
      w.x = pk2(vi[0], vi[1]); w.y = pk2(vi[2], vi[3]); w.z = pk2(vi[4], vi[5]); w.w = pk2(vi[6], vi[7]); *(uint4*)d1 = w;
      w.x = pk2(vi[8], vi[9]); w.y = pk2(vi[10], vi[11]); w.z = pk2(vi[12], vi[13]); w.w = pk2(vi[14], vi[15]); *(uint4*)(d1 + 8) = w;
    }
    for (int i = gt; i < 32 * 64 * 2 * 64; i += gsz) {
      const int pp = i & 63, dir = (i >> 6) & 1, t = (i >> 7) & 63, g = i >> 13;
      float pr, pi; ssm_pow(p, g, dir, pp, dir == 0 ? t + 1 : 64 - t, pr, pi);
#pragma unroll
      for (int h = 0; h < 16; h++) {
        const int ic = ((dir * 32 + g) * 16 + h) * 64 + pp;
        const float cr = p.c_re[ic], ci = p.c_im[ic];
        bf16_t* d = p.Co() + ((size_t)(g * 1024 + t * 16 + h)) * 256 + dir * 128 + pp;
        d[0] = f2bf(cr * pr - ci * pi);
        d[64] = f2bf(-(cr * pi + ci * pr));
      }
    }
    for (int i = gt; i < 32 * 2 * 64; i += gsz) {
      const int pp = i & 63, dir = (i >> 6) & 1, g = i >> 7;
      float pr, pi; ssm_pow(p, g, dir, pp, 64, pr, pi);
      p.AT()[i * 2] = pr; p.AT()[i * 2 + 1] = pi;
    }
  }
  {
    float2* q = (float2*)smraw;
    for (int base = 0; base < 32 * 127; base += nb) {
      const int item = base + bid; const bool act = item < 32 * 127;
      const int g = act ? item / 127 : 0, jj = act ? item % 127 : 0, lag = jj - 63;
      __syncthreads();
      if (tid < 128) {
        const int dir = tid >> 6, pp = tid & 63;
        float2 v = make_float2(0.f, 0.f);
        if ((dir == 0 && lag >= 0) || (dir == 1 && lag <= 0)) {
          float pr, pi, cr, ci; ssm_pow(p, g, dir, pp, lag < 0 ? -lag : lag, pr, pi); ssm_coef(p, g, dir, pp, cr, ci);
          v = make_float2(pr * cr - pi * ci, pr * ci + pi * cr);
        }
        q[tid] = v;
      }
      __syncthreads();
      const int hp = tid >> 4, h = tid & 15;
      float a = 0.f;
#pragma unroll
      for (int dir = 0; dir < 2; dir++) {
        if ((dir == 0 && lag < 0) || (dir == 1 && lag > 0)) continue;
        for (int pp = 0; pp < 64; pp++) {
          const int ic = ((dir * 32 + g) * 16 + hp) * 64 + pp, ib = ((dir * 32 + g) * 64 + pp) * 16 + h;
          const float cr = p.c_re[ic], ci = p.c_im[ic], br = p.b_re[ib], bi = p.b_im[ib];
          const float2 qq = q[dir * 64 + pp];
          const float er = cr * qq.x - ci * qq.y, ei = cr * qq.y + ci * qq.x;
          a += er * br - ei * bi;
        }
      }
      if (lag == 0 && hp == h) a += p.ssm_d[g * 16 + h];
      if (act) p.Ktab()[(size_t)item * 256 + tid] = f2bf(a);
    }
  }
}

DI void rownorm_mod(const P& p, bool from_x, const float* g, int sh_off, int sc_off) {
  const int tix = otid(), lane = tix & 63, wv = blockIdx.x * 8 + (tix >> 6), nw = gridDim.x * 8;
  for (int tok = wv; tok < NTOK; tok += nw) {
    const float* src = from_x ? (tok < LPR ? p.xp + (size_t)tok * 1024 : p.xs + (size_t)(tok - LPR) * 1024) : p.out + (size_t)tok * 1024;
    f32x4 v[4]; float ss = 0.f;
#pragma unroll
    for (int i = 0; i < 4; i++) { v[i] = *(const f32x4*)(src + (i * 64 + lane) * 4); ss += v[i][0] * v[i][0] + v[i][1] * v[i][1] + v[i][2] * v[i][2] + v[i][3] * v[i][3]; }
    ss = wave_sum(ss);
    const float r = rsqrtf(ss * (1.f / 1024.f) + EPSV);
    const float* md = p.mod() + batch_of(tok) * 6144;
#pragma unroll
    for (int i = 0; i < 4; i++) {
      const int c = (i * 64 + lane) * 4;
      const f32x4 gg = *(const f32x4*)(g + c), sc = *(const f32x4*)(md + sc_off + c), sh = *(const f32x4*)(md + sh_off + c);
      float o[4];
#pragma unroll
      for (int e = 0; e < 4; e++) o[e] = v[i][e] * r * gg[e] * (1.f + sc[e]) + sh[e];
      uint2 w; w.x = pk2(o[0], o[1]); w.y = pk2(o[2], o[3]);
      *(uint2*)(p.hb() + (size_t)(from_x ? permtok(tok) : tok) * 1024 + c) = w;
    }
  }
}
DI void final_norm(const P& p) {
  const int tix = otid(), lane = tix & 63, wv = blockIdx.x * 8 + (tix >> 6), nw = gridDim.x * 8;
  for (int tok = wv; tok < NTOK; tok += nw) {
    float* src = p.out + (size_t)tok * 1024;
    f32x4 v[4]; float ss = 0.f;
#pragma unroll
    for (int i = 0; i < 4; i++) { v[i] = *(const f32x4*)(src + (i * 64 + lane) * 4); ss += v[i][0] * v[i][0] + v[i][1] * v[i][1] + v[i][2] * v[i][2] + v[i][3] * v[i][3]; }
    ss = wave_sum(ss);
    const float r = rsqrtf(ss * (1.f / 1024.f) + EPSV);
#pragma unroll
    for (int i = 0; i < 4; i++) {
      const int c = (i * 64 + lane) * 4;
      const f32x4 gg = *(const f32x4*)(p.g_final + c);
      f32x4 o;
#pragma unroll
      for (int e = 0; e < 4; e++) o[e] = v[i][e] * r * gg[e];
      *(f32x4*)(src + c) = o;
    }
  }
}

#define GEO const int tix = otid(), half = tix >> 8, tid = tix & 255, lane = tid & 63, wid = tid >> 6, wm = wid >> 1, wn = wid & 1, l31 = lane & 31, lh = lane >> 5; (void)tix; (void)half; (void)tid; (void)wm; (void)wn; (void)l31; (void)lh;

template <int R>
DI void fft1_tile(const P& p, bf16_t* sm, int tm, int tn) {
  GEO
  constexpr bool pr = (R == 128);
  f32x16 acc[2][2];
  const bf16_t* Abase = pr ? p.zT() + (size_t)tm * 128 * 128 : p.zT() + (size_t)512 * LPR + (size_t)tm * 128 * 64;
  const bf16_t* Bbase = pr ? p.F1p() + (size_t)tn * 128 * 128 : p.F1s();
  auto af = [&](int r, int k) { return Abase + r * R + k; };
  auto bf = [&](int r, int k) { return Bbase + r * R + k; };
  gemm_main<false>(sm, tid, R, af, bf, NoHook(), acc);
  const int k1 = (tn * 2 + wn) * 32 + l31;
  const float2* tw = pr ? p.twp() : p.tws();
  constexpr int lmask = pr ? 16383 : 4095, l2mask = R - 1;
  const float2 tb = tw[(unsigned)((k1 * ((wm * 64 + 4 * lh) & l2mask)) & lmask)], t1 = tw[(unsigned)(k1 & lmask)], t8 = tw[(unsigned)((k1 * 8) & lmask)],
               t32 = tw[(unsigned)((k1 * (32 & l2mask)) & lmask)];
  float2 wt[2][4][4];
#pragma unroll
  for (int mi = 0; mi < 2; mi++) {
    float2 w = tb;
    if (mi) w = make_float2(tb.x * t32.x - tb.y * t32.y, tb.y * t32.x + tb.x * t32.y);
#pragma unroll
    for (int g = 0; g < 4; g++) {
      float2 u = w;
#pragma unroll
      for (int e = 0; e < 4; e++) {
        wt[mi][g][e] = u;
        u = make_float2(u.x * t1.x - u.y * t1.y, u.y * t1.x + u.x * t1.y);
      }
      w = make_float2(w.x * t8.x - w.y * t8.y, w.y * t8.x + w.x * t8.y);
    }
  }
  auto ew = [&](int mi, int g, int e, float& re, float& im) {
    const float2 w = wt[mi][g][e];
    const float a = re * w.x + im * w.y, b = im * w.x - re * w.y;
    re = a; im = b;
  };
  auto dst = [&](int nl, int r) {
    const int part = (nl >> 5) & 1, kk1 = (tn * 2 + (nl >> 6)) * 32 + (nl & 31);
    if (pr) return p.Tt() + ((size_t)(tm * 128 + kk1)) * 256 + part * 128 + 64 * r;
    return p.Tt() + (size_t)65536 * 256 + ((size_t)((tm * 2 + r) * 64 + kk1)) * 128 + part * 64;
  };
  epi_transposed(sm, tid, acc, ew, dst);
}
DI void phase3(const P& p) {
  GEO
  bf16_t* sm = (bf16_t*)(dyn_smem + half * SMEM_HALF);
  const int NA = 1024, NB_ = 4096, NC = 640;
  for (int q = blockIdx.x; q < (NA + NB_ + NC) / 2; q += gridDim.x) {
    const int t = 2 * q + half;
    if (t < NA) fft1_tile<128>(p, sm, t >> 1, t & 1);
    else if (t < NA + NB_) fft1_tile<64>(p, sm, t - NA, 0);
    else {
      f32x16 acc[2][2];
      const int u = t - NA - NB_, g = u / 20, rem = u % 20, m0 = (rem >> 1) * 128, n0 = (rem & 1) * 128;
      auto af = [&](int r, int k) { return p.zs() + (size_t)g * NTOK * 16 + (size_t)(m0 + r) * 1024 + k; };
      auto bf = [&](int r, int k) { return p.Bs() + (size_t)(g * 256 + n0 + r) * 1024 + k; };
      gemm_main<true>(sm, tid, 1024, af, bf, NoHook(), acc);
#pragma unroll
      for (int mi = 0; mi < 2; mi++)
#pragma unroll
        for (int ni = 0; ni < 2; ni++)
#pragma unroll
          for (int gg = 0; gg < 4; gg++) {
            const int ch = m0 + wm * 64 + mi * 32 + l31, col = n0 + wn * 64 + ni * 32 + 8 * gg + 4 * lh;
            f32x4 v = {acc[mi][ni][4 * gg], acc[mi][ni][4 * gg + 1], acc[mi][ni][4 * gg + 2], acc[mi][ni][4 * gg + 3]};
            *(f32x4*)(p.S() + ((size_t)ch * 32 + g) * 256 + col) = v;
          }
    }
  }
}

template <int R>
DI void fft2_tile(const P& p, bf16_t* sm, int tm, int tn) {
  GEO
  constexpr bool pr = (R == 128);
  constexpr int K = 2 * R;
  f32x16 acc[2][2];
  const int ct = tm & 3, k1 = pr ? (tm >> 2) : ((tm >> 2) & 63), b = pr ? 0 : (tm >> 8);
  const bf16_t* Abase = pr ? p.Tt() + ((size_t)(ct * 128) * 128 + k1) * 256 : p.Tt() + (size_t)65536 * 256 + ((size_t)(b * 512 + ct * 128) * 64 + k1) * 128;
  constexpr int rstride = R * K;
  const bf16_t* Bbase = pr ? p.F2p() + (size_t)tn * 128 * 256 : p.F2s();
  auto af = [&](int r, int k) { return Abase + (size_t)r * rstride + k; };
  auto bf = [&](int r, int k) { return Bbase + r * K + k; };
  gemm_main<false>(sm, tid, K, af, bf, NoHook(), acc);
  auto ew = [](int, int, int, float&, float&) {};
  auto dst = [&](int nl, int r) {
    const int n = tn * 128 + nl, part = pr ? (n >> 7) : (n >> 6), k2 = n & (R - 1);
    const int tok = (pr ? 0 : LPR + b * 4096) + k1 + R * k2;
    return p.AF() + (size_t)tok * 1024 + part * 512 + ct * 128 + 64 * r;
  };
  epi_transposed(sm, tid, acc, ew, dst);
}
DI void phase4(const P& p) {
  GEO
  bf16_t* sm = (bf16_t*)(dyn_smem + half * SMEM_HALF);
  for (int idx = blockIdx.x * 512 + tix; idx < 17 * 4096; idx += gridDim.x * 512) {
    const int seq = idx >> 12, rem = idx & 4095, g = rem >> 7, dir = (rem >> 6) & 1, pp = rem & 63;
    const int c0 = seq == 0 ? 0 : 256 + (seq - 1) * 64, nc = seq == 0 ? 256 : 64;
    const float ar = p.AT()[((g * 2 + dir) * 64 + pp) * 2], ai = p.AT()[((g * 2 + dir) * 64 + pp) * 2 + 1];
    float hr = 0.f, hi = 0.f;
    const size_t off = (size_t)g * 256 + dir * 128 + pp;
    for (int i0 = 0; i0 < nc; i0 += 8) {
      float sr[8], si[8];
#pragma unroll
      for (int j = 0; j < 8; j++) {
        const int c = c0 + (dir == 0 ? i0 + j : nc - 1 - i0 - j);
        sr[j] = p.S()[(size_t)c * 8192 + off]; si[j] = p.S()[(size_t)c * 8192 + off + 64];
      }
#pragma unroll
      for (int j = 0; j < 8; j++) {
        const int c = c0 + (dir == 0 ? i0 + j : nc - 1 - i0 - j);
        p.H()[(size_t)c * 8192 + off] = f2bf(hr); p.H()[(size_t)c * 8192 + off + 64] = f2bf(hi);
        const float nr = ar * hr - ai * hi + sr[j], ni = ar * hi + ai * hr + si[j];
        hr = nr; hi = ni;
      }
    }
  }
  for (int q = blockIdx.x; q < (1024 + 4096) / 2; q += gridDim.x) {
    const int t = 2 * q + half;
    if (t < 1024) fft2_tile<128>(p, sm, t >> 1, t & 1);
    else fft2_tile<64>(p, sm, t - 1024, 0);
  }
}

DI float gelu_tanh(float x) {
  const float u = 0.7978845608028654f * (x + 0.044715f * x * x * x);
  return x / (1.f + __expf(-2.f * u));
}

DI void phase5(const P& p) {
  GEO
  bf16_t* sm = (bf16_t*)(dyn_smem + half * SMEM_HALF);
  for (int q = blockIdx.x; q < 2560 / 2; q += gridDim.x) {
    const int t = 2 * q + half;
    f32x16 acc[2][2];
    const int g = t / 80, rem = t % 80, m0 = (rem >> 3) * 128, n0 = (rem & 7) * 128;
    const bf16_t* Ug = p.zs() + (size_t)g * NTOK * 16;
    const bf16_t* Kg = p.Ktab() + (size_t)g * 127 * 256;
    auto af = [&](int r, int k) { return k < 1024 ? Ug + (size_t)(m0 + r) * 1024 + k : p.H() + ((size_t)(m0 + r) * 32 + g) * 256 + (k - 1024); };
    auto bf = [&](int r, int k) {
      const int n = n0 + r;
      return k < 1024 ? Kg + (((n >> 4) - (k >> 4) + 63) * 256 + (n & 15) * 16 + (k & 15)) : p.Co() + ((size_t)(g * 1024 + n)) * 256 + (k - 1024);
    };
    gemm_main<true>(sm, tid, 1280, af, bf, NoHook(), acc);
#pragma unroll
    for (int mi = 0; mi < 2; mi++)
#pragma unroll
      for (int ni = 0; ni < 2; ni++)
#pragma unroll
        for (int gg = 0; gg < 4; gg++) {
          const int ch = m0 + wm * 64 + mi * 32 + l31, n = n0 + wn * 64 + ni * 32 + 8 * gg + 4 * lh;
          const int tok = ch * 64 + (n >> 4);
          float o[4];
#pragma unroll
          for (int e = 0; e < 4; e++) o[e] = gelu_tanh(acc[mi][ni][4 * gg + e]);
          uint2 w; w.x = pk2(o[0], o[1]); w.y = pk2(o[2], o[3]);
          *(uint2*)(p.gact() + (size_t)tok * 512 + g * 16 + (n & 15)) = w;
        }
  }
}

namespace pg8 {
#define PG8_LAS __attribute__((address_space(3)))
typedef unsigned short bf16_t;
typedef short bf16x8 __attribute__((ext_vector_type(8)));
typedef float f32x4 __attribute__((ext_vector_type(4)));
typedef unsigned u32x4 __attribute__((ext_vector_type(4)));
constexpr int BM = 256, BK = 64, HALF = 128, HTB = HALF * BK * 2  , STAGE_BYTES = 8 * HTB, NXCD = 8, WGM = 8;

__host__ __device__ __forceinline__ int lds_byte(int r, int c) { const int st = (r >> 4) * 2 + (c >> 5), rr = r & 15, cc = c & 31, ob = rr * 64 + cc * 2; return st * 1024 + (ob ^ (((ob >> 9) & 1) << 5)); }
__host__ __device__ __forceinline__ void stage_rc(int b, int& R, int& C) { const int st = b / 1024, sb = b % 1024, swz = sb ^ (((sb >> 9) & 1) << 5); R = (st >> 1) * 16 + swz / 64; C = (st & 1) * 32 + (swz % 64) / 2; }
__host__ __device__ __forceinline__ int perm32(int rho) { const int n = rho >> 4, i = rho & 15; return 8 * (i >> 2) + 4 * n + (i & 3); }

struct Unit { int pm, pn; };
struct Gemm { const bf16_t* A; const bf16_t* Bt; int M, N, K; };

struct StaticOrder {
    int nM, nN, nwg, G, c;
    __host__ __device__ void init(int M, int N, int G_, int c_) { nM = M / BM; nN = N / BM; nwg = nM * nN; G = G_; c = c_; }
    __host__ __device__ bool next(int i, Unit& u) const {
        const long L = (long)i * G + c; if (L >= nwg) return false;
        int wgid = (int)L; { const int q = nwg / NXCD, r = nwg % NXCD, xcd = wgid % NXCD, off = wgid / NXCD; wgid = (xcd < r ? xcd * (q + 1) : r * (q + 1) + (xcd - r) * q) + off; }
        const int nig = WGM * nN, gid = wgid / nig, fm = gid * WGM, gsz = (nM - fm) < WGM ? (nM - fm) : WGM;
        u.pm = fm + ((wgid % nig) % gsz); u.pn = (wgid % nig) / gsz; return true;
    }
    __device__ __forceinline__ void a_ready(const Unit&) const {}
    __device__ __forceinline__ void done(const Unit&) const {}
};

template <class Epi, class Sched, bool ALIGN_EPI = false, bool SP2 = false>
__device__ __forceinline__ void gemm_phase(PG8_LAS unsigned char* lds, const int tix, const Gemm g, const Sched& S, const Epi& E) {
    const int tid = tix, wid = __builtin_amdgcn_readfirstlane(tid >> 6), lane = tid & 63, wr = wid >> 2, wc = wid & 3, fr = lane & 15, fq = lane >> 4;
    const int K = g.K, nt = K / BK;
    unsigned voffA[2], voffB[2];
#pragma unroll
    for (int i = 0; i < 2; ++i) { int R, C; stage_rc(tid * 16 + i * 8192, R, C); const int Rb = Epi::PERM ? ((R & ~31) + perm32(R & 31)) : R;
        voffA[i] = (unsigned)(R * K + C) * 2u; voffB[i] = (unsigned)(Rb * K + C) * 2u; }
    const size_t kstep = (size_t)(BK * 2);
    const size_t hstep = (size_t)HALF * K * 2;
    const size_t tstep = 2 * hstep;
    const unsigned ldsw = (unsigned)wid * 1024u;
    const int aoff = lds_byte(wr * 64 + fr, fq * 8), boff = lds_byte(wc * 32 + fr, fq * 8);
#define PG8_SA(b, h) (((b) * 2 + (h)) * HTB)
#define PG8_SB(b, h) ((4 + (b) * 2 + (h)) * HTB)
#define PG8_STAGE(bufoff, gbase, voff) do { _Pragma("unroll") for (int _i = 0; _i < 2; ++_i) \
        __builtin_amdgcn_global_load_lds((const unsigned*)((const char*)(gbase) + (voff)[_i]), (PG8_LAS unsigned*)(lds + (bufoff) + ldsw + _i * 8192), 16, 0, 0); } while (0)
#define PG8_LDA(dst, b, h) do { _Pragma("unroll") for (int m = 0; m < 4; ++m) _Pragma("unroll") for (int k = 0; k < 2; ++k) dst[m][k] = *(const PG8_LAS bf16x8*)(lds + PG8_SA(b, h) + aoff + m * 2048 + k * 1024); } while (0)
#define PG8_LDB(dst, b, h) do { _Pragma("unroll") for (int n = 0; n < 2; ++n) _Pragma("unroll") for (int k = 0; k < 2; ++k) dst[n][k] = *(const PG8_LAS bf16x8*)(lds + PG8_SB(b, h) + boff + n * 2048 + k * 1024); } while (0)
#define PG8_MMA(ai, bj, At, Bt) do { __builtin_amdgcn_s_setprio(1); _Pragma("unroll") for (int m = 0; m < 4; ++m) _Pragma("unroll") for (int n = 0; n < 2; ++n) _Pragma("unroll") for (int k = 0; k < 2; ++k) \
        acc[ai][bj][m][n] = __builtin_amdgcn_mfma_f32_16x16x32_bf16(Bt[n][k], At[m][k], acc[ai][bj][m][n], 0, 0, 0); __builtin_amdgcn_s_setprio(0); } while (0)
#define PG8_WAIT_V(n) asm volatile("s_waitcnt vmcnt(" #n ")" ::: "memory")
#define PG8_WAIT_L(n) asm volatile("s_waitcnt lgkmcnt(" #n ")" ::: "memory")
#define PG8_BAR __builtin_amdgcn_s_barrier()
#define PG8_SCHED __builtin_amdgcn_sched_barrier(0)
    Unit cur, nxt; int ui = 0;
    if (!S.next(0, cur)) return;
    f32x4 acc[2][2][4][2];
#pragma unroll
    for (int a = 0; a < 2; ++a)
#pragma unroll
        for (int b = 0; b < 2; ++b)
#pragma unroll
            for (int m = 0; m < 4; ++m)
#pragma unroll
                for (int n = 0; n < 2; ++n) acc[a][b][m][n] = (f32x4){0.f, 0.f, 0.f, 0.f};
    bf16x8 At[4][2], B0[2][2], B1[2][2];
    const char* cA = (const char*)g.A + (size_t)cur.pm * tstep; const char* cB = (const char*)g.Bt + (size_t)cur.pn * tstep;
    S.a_ready(cur);
    if constexpr (SP2) {
        PG8_STAGE(PG8_SB(0, 0), cB, voffB); PG8_STAGE(PG8_SB(0, 1), cB + hstep, voffB); PG8_STAGE(PG8_SA(0, 0), cA, voffA); PG8_STAGE(PG8_SA(0, 1), cA + hstep, voffA);
        if (wr == 1) PG8_BAR;
        PG8_WAIT_V(2); PG8_BAR;
        PG8_STAGE(PG8_SB(1, 0), cB + kstep, voffB); PG8_STAGE(PG8_SA(1, 0), cA + kstep, voffA); PG8_STAGE(PG8_SB(1, 1), cB + hstep + kstep, voffB);
        PG8_WAIT_V(6); PG8_BAR;
    } else {
        PG8_STAGE(PG8_SB(0, 0), cB, voffB); PG8_STAGE(PG8_SA(0, 0), cA, voffA); PG8_STAGE(PG8_SB(0, 1), cB + hstep, voffB); PG8_STAGE(PG8_SA(0, 1), cA + hstep, voffA);
        if (wr == 1) PG8_BAR;
        PG8_WAIT_V(4); PG8_BAR;
        PG8_STAGE(PG8_SB(1, 0), cB + kstep, voffB); PG8_STAGE(PG8_SA(1, 0), cA + kstep, voffA); PG8_STAGE(PG8_SB(1, 1), cB + hstep + kstep, voffB);
        PG8_WAIT_V(6); PG8_BAR;
    }
    for (;;) {
        const bool has_next = S.next(ui + 1, nxt);
        const char* nA = has_next ? (const char*)g.A + (size_t)nxt.pm * tstep : cA; const char* nB = has_next ? (const char*)g.Bt + (size_t)nxt.pn * tstep : cB;
        for (int t = 0; t < nt; t += 2) {
            if constexpr (Epi::KHOOK) { if (t == Epi::KH_T) E.khook(acc, ui, wr, fr, lds); }
            const bool last = (t == nt - 2);
            const char* a1 = cA + (size_t)(t + 1) * kstep;
            const char* a2 = last ? nA : cA + (size_t)(t + 2) * kstep; const char* b2 = last ? nB : cB + (size_t)(t + 2) * kstep;
            const char* a3 = a2 + kstep; const char* b3 = b2 + kstep;
            if (last && has_next) S.a_ready(nxt);
            if constexpr (SP2) {
            PG8_LDB(B0, 0, 0); PG8_LDB(B1, 0, 1); PG8_SCHED; PG8_LDA(At, 0, 0); PG8_STAGE(PG8_SA(1, 1), a1 + hstep, voffA);
            PG8_WAIT_V(8); PG8_WAIT_L(0); PG8_BAR; PG8_MMA(0, 0, At, B0); PG8_MMA(0, 1, At, B1); PG8_BAR; PG8_SCHED;
            PG8_LDA(At, 0, 1); PG8_STAGE(PG8_SB(0, 0), b2, voffB); PG8_STAGE(PG8_SB(0, 1), b2 + hstep, voffB); PG8_STAGE(PG8_SA(0, 0), a2, voffA);
            PG8_WAIT_V(8); PG8_WAIT_L(0); PG8_BAR; PG8_MMA(1, 0, At, B0); PG8_MMA(1, 1, At, B1); PG8_BAR; PG8_SCHED;
            PG8_LDB(B0, 1, 0); PG8_LDB(B1, 1, 1); PG8_SCHED; PG8_LDA(At, 1, 0); PG8_STAGE(PG8_SA(0, 1), a2 + hstep, voffA);
            PG8_WAIT_V(8); PG8_WAIT_L(0); PG8_BAR; PG8_MMA(0, 0, At, B0); PG8_MMA(0, 1, At, B1); PG8_BAR; PG8_SCHED;
            PG8_LDA(At, 1, 1); PG8_STAGE(PG8_SB(1, 0), b3, voffB); PG8_STAGE(PG8_SB(1, 1), b3 + hstep, voffB); PG8_STAGE(PG8_SA(1, 0), a3, voffA);
            PG8_WAIT_V(8); PG8_WAIT_L(0); PG8_BAR; PG8_MMA(1, 0, At, B0); PG8_MMA(1, 1, At, B1); PG8_BAR; PG8_SCHED;
            } else {
            PG8_LDB(B0, 0, 0); PG8_SCHED; PG8_LDA(At, 0, 0); PG8_STAGE(PG8_SA(1, 1), a1 + hstep, voffA);
            PG8_WAIT_L(8); PG8_BAR; PG8_WAIT_L(0); PG8_MMA(0, 0, At, B0); PG8_BAR; PG8_SCHED;
            PG8_LDB(B1, 0, 1); PG8_STAGE(PG8_SB(0, 0), b2, voffB);
            PG8_BAR; PG8_WAIT_L(0); PG8_MMA(0, 1, At, B1); PG8_BAR;
            PG8_LDA(At, 0, 1); PG8_STAGE(PG8_SA(0, 0), a2, voffA);
            PG8_BAR; PG8_WAIT_L(0); PG8_MMA(1, 0, At, B0); PG8_BAR; PG8_SCHED;
            PG8_STAGE(PG8_SB(0, 1), b2 + hstep, voffB);
            PG8_WAIT_V(6); PG8_BAR; PG8_MMA(1, 1, At, B1); PG8_BAR;
            PG8_LDB(B0, 1, 0); PG8_SCHED; PG8_LDA(At, 1, 0); PG8_STAGE(PG8_SA(0, 1), a2 + hstep, voffA);
            PG8_WAIT_L(8); PG8_BAR; PG8_WAIT_L(0); PG8_MMA(0, 0, At, B0); PG8_BAR; PG8_SCHED;
            PG8_LDB(B1, 1, 1); PG8_STAGE(PG8_SB(1, 0), b3, voffB);
            PG8_BAR; PG8_WAIT_L(0); PG8_MMA(0, 1, At, B1); PG8_BAR;
            PG8_LDA(At, 1, 1); PG8_STAGE(PG8_SA(1, 0), a3, voffA);
            PG8_BAR; PG8_WAIT_L(0); PG8_MMA(1, 0, At, B0); PG8_BAR; PG8_SCHED;
            PG8_STAGE(PG8_SB(1, 1), b3 + hstep, voffB);
            PG8_WAIT_V(6); PG8_BAR; PG8_MMA(1, 1, At, B1); PG8_BAR;
            }
        }
        if constexpr (ALIGN_EPI) { if (wr == 0) PG8_BAR; }
        if constexpr (!Epi::AFTER_DRAIN) { E(acc, cur, wr, wc, fr, fq, ui); S.done(cur); }
        if (!has_next) break;
#pragma unroll
        for (int a = 0; a < 2; ++a)
#pragma unroll
            for (int b = 0; b < 2; ++b)
#pragma unroll
                for (int m = 0; m < 4; ++m)
#pragma unroll
                    for (int n = 0; n < 2; ++n) acc[a][b][m][n] = (f32x4){0.f, 0.f, 0.f, 0.f};
        cur = nxt; cA = nA; cB = nB; ++ui;
        if constexpr (ALIGN_EPI) { if (wr == 1) PG8_BAR; }
    }
    PG8_WAIT_V(0);
    if constexpr (!ALIGN_EPI) { if (wr == 0) PG8_BAR; }
    PG8_BAR;
    if constexpr (Epi::AFTER_DRAIN) { E.fused(acc, cur, wr, wc, fr, fq, lds, wid, lane); S.done(cur); }
#undef PG8_SA
#undef PG8_SB
#undef PG8_STAGE
#undef PG8_LDA
#undef PG8_LDB
#undef PG8_MMA
#undef PG8_WAIT_V
#undef PG8_WAIT_L
#undef PG8_BAR
#undef PG8_SCHED
}
}

namespace pg8 {
struct EpiMlpIn {
  static constexpr bool PERM = true, AFTER_DRAIN = false, KHOOK = false; static constexpr int KH_T = 0;
  ::bf16_t* O; const float* bias;
  __device__ __forceinline__ void operator()(const f32x4 (&acc)[2][2][4][2], const Unit& u, int wr, int wc, int fr, int fq, int) const {
    const int row0 = u.pm * BM + wr * 64 + fr, col0 = u.pn * BM + wc * 32 + 8 * fq;
    f32x4 bv[2][2];
#pragma unroll
    for (int bj = 0; bj < 2; ++bj)
#pragma unroll
      for (int n = 0; n < 2; ++n) bv[bj][n] = *(const f32x4*)(bias + col0 + bj * HALF + 4 * n);
#pragma unroll
    for (int ai = 0; ai < 2; ++ai)
#pragma unroll
      for (int m = 0; m < 4; ++m) {
        ::bf16_t* rowp = O + (size_t)(row0 + ai * HALF + m * 16) * 4096 + col0;
#pragma unroll
        for (int bj = 0; bj < 2; ++bj) {
          f32x4 v0 = acc[ai][bj][m][0] + bv[bj][0], v1 = acc[ai][bj][m][1] + bv[bj][1];
#pragma unroll
          for (int e = 0; e < 4; ++e) { const float a = fmaxf(v0[e], 0.f), b = fmaxf(v1[e], 0.f); v0[e] = a * a; v1[e] = b * b; }
          u32x4 w; w.x = pk2(v0[0], v0[1]); w.y = pk2(v0[2], v0[3]); w.z = pk2(v1[0], v1[1]); w.w = pk2(v1[2], v1[3]);
          *(u32x4*)(rowp + bj * HALF) = w;
        }
      }
  }
};
struct EpiMlpOut {
  static constexpr bool PERM = false, AFTER_DRAIN = false, KHOOK = false; static constexpr int KH_T = 0;
  float* out; const float* mod; const float* bias;
  __device__ __forceinline__ void operator()(const f32x4 (&acc)[2][2][4][2], const Unit& u, int wr, int wc, int fr, int fq, int) const {
    const int col0 = u.pn * BM + wc * 32 + 4 * fq;
#pragma unroll
    for (int ai = 0; ai < 2; ++ai)
#pragma unroll
      for (int m = 0; m < 4; ++m) {
        const int row = u.pm * BM + ai * HALF + wr * 64 + m * 16 + fr;
        const float* g2 = mod + batch_of(row) * 6144 + 5120;
        float* xr = out + (size_t)row * 1024;
#pragma unroll
        for (int bj = 0; bj < 2; ++bj)
#pragma unroll
          for (int n = 0; n < 2; ++n) {
            const int col = col0 + bj * HALF + n * 16;
            const f32x4 xv = *(const f32x4*)(xr + col), gv = *(const f32x4*)(g2 + col), bb = *(const f32x4*)(bias + col);
            *(f32x4*)(xr + col) = xv + gv * (acc[ai][bj][m][n] + bb);
          }
      }
  }
};
struct EpiYf {
  static constexpr bool PERM = true, AFTER_DRAIN = false, KHOOK = false; static constexpr int KH_T = 0;
  ::bf16_t* O; const float* bias; float* ss;
  __device__ __forceinline__ void operator()(const f32x4 (&acc)[2][2][4][2], const Unit& u, int wr, int wc, int fr, int fq, int) const {
    const int row0 = u.pm * BM + wr * 64 + fr, col0 = u.pn * BM + wc * 32 + 8 * fq;
    f32x4 bv[2][2];
#pragma unroll
    for (int bj = 0; bj < 2; ++bj)
#pragma unroll
      for (int n = 0; n < 2; ++n) bv[bj][n] = *(const f32x4*)(bias + col0 + bj * HALF + 4 * n);
#pragma unroll
    for (int ai = 0; ai < 2; ++ai)
#pragma unroll
      for (int m = 0; m < 4; ++m) {
        const int row = row0 + ai * HALF + m * 16;
        const float scale = row < LPR ? 3.4526698300124393e-4f : 6.905339660024879e-4f;
        ::bf16_t* rowp = O + (size_t)row * 1024 + col0;
        float s = 0.f;
#pragma unroll
        for (int bj = 0; bj < 2; ++bj) {
          const f32x4 v0 = acc[ai][bj][m][0] * scale + bv[bj][0], v1 = acc[ai][bj][m][1] * scale + bv[bj][1];
          s += (v0[0] * v0[0] + v0[1] * v0[1]) + (v0[2] * v0[2] + v0[3] * v0[3]) + (v1[0] * v1[0] + v1[1] * v1[1]) + (v1[2] * v1[2] + v1[3] * v1[3]);
          u32x4 w; w.x = pk2(v0[0], v0[1]); w.y = pk2(v0[2], v0[3]); w.z = pk2(v1[0], v1[1]); w.w = pk2(v1[2], v1[3]);
          *(u32x4*)(rowp + bj * HALF) = w;
        }
        s += __shfl_xor(s, 16); s += __shfl_xor(s, 32);
        if (fq == 0) ss[row * 8 + u.pn * 4 + wc] = s;
      }
  }
};
struct EpiGlu {
  static constexpr bool PERM = true, AFTER_DRAIN = false, KHOOK = false; static constexpr int KH_T = 0;
  ::bf16_t* O; const float* bias; float* ss;
  __device__ __forceinline__ void operator()(const f32x4 (&acc)[2][2][4][2], const Unit& u, int wr, int wc, int fr, int fq, int) const {
    const int row0 = u.pm * BM + wr * 64 + fr, j0 = u.pn * 128 + wc * 32 + 8 * fq;
    f32x4 bv[2][2];
#pragma unroll
    for (int bj = 0; bj < 2; ++bj)
#pragma unroll
      for (int n = 0; n < 2; ++n) bv[bj][n] = *(const f32x4*)(bias + bj * 512 + j0 + 4 * n);
#pragma unroll
    for (int ai = 0; ai < 2; ++ai)
#pragma unroll
      for (int m = 0; m < 4; ++m) {
        const int row = row0 + ai * HALF + m * 16;
        float o[8], s = 0.f;
#pragma unroll
        for (int n = 0; n < 2; ++n)
#pragma unroll
          for (int e = 0; e < 4; ++e) {
            const float val = acc[ai][0][m][n][e] + bv[0][n][e], gate = acc[ai][1][m][n][e] + bv[1][n][e];
            const float y = val / (1.f + __expf(-gate));
            o[4 * n + e] = y; s += y * y;
          }
        u32x4 w; w.x = pk2(o[0], o[1]); w.y = pk2(o[2], o[3]); w.z = pk2(o[4], o[5]); w.w = pk2(o[6], o[7]);
        *(u32x4*)(O + (size_t)row * 1024 + 512 + j0) = w;
        s += __shfl_xor(s, 16); s += __shfl_xor(s, 32);
        if (fq == 0) ss[row * 16 + u.pn * 4 + wc] = s;
      }
  }
};
struct EpiZt {
  static constexpr bool PERM = true, AFTER_DRAIN = false, KHOOK = false; static constexpr int KH_T = 0;
  ::bf16_t* O;
  __device__ __forceinline__ void operator()(const f32x4 (&acc)[2][2][4][2], const Unit& u, int wr, int wc, int fr, int fq, int) const {
    const int v0 = u.pn * BM;
    ::bf16_t* base; size_t ld;
    if (v0 < LPR) { base = O + v0; ld = LPR; }
    else { const int vs = v0 - LPR; base = O + (size_t)512 * LPR + (size_t)(vs >> 12) * 512 * 4096 + (vs & 4095); ld = 4096; }
    const int c0 = u.pm * BM + wr * 64 + fr, col0 = wc * 32 + 8 * fq;
#pragma unroll
    for (int ai = 0; ai < 2; ++ai)
#pragma unroll
      for (int m = 0; m < 4; ++m) {
        ::bf16_t* rowp = base + (size_t)(c0 + ai * HALF + m * 16) * ld + col0;
#pragma unroll
        for (int bj = 0; bj < 2; ++bj) {
          const f32x4 a = acc[ai][bj][m][0], b = acc[ai][bj][m][1];
          u32x4 w; w.x = pk2(a[0], a[1]); w.y = pk2(a[2], a[3]); w.z = pk2(b[0], b[1]); w.w = pk2(b[2], b[3]);
          *(u32x4*)(rowp + bj * HALF) = w;
        }
      }
  }
};
struct EpiZs {
  static constexpr bool PERM = true, AFTER_DRAIN = false, KHOOK = false; static constexpr int KH_T = 0;
  ::bf16_t* O;
  __device__ __forceinline__ void operator()(const f32x4 (&acc)[2][2][4][2], const Unit& u, int wr, int wc, int fr, int fq, int) const {
    const int r0 = u.pm * BM + wr * 64 + fr, col0 = u.pn * BM + wc * 32 + 8 * fq;
#pragma unroll
    for (int ai = 0; ai < 2; ++ai)
#pragma unroll
      for (int m = 0; m < 4; ++m) {
        const int tok = permtok(r0 + ai * HALF + m * 16);
#pragma unroll
        for (int bj = 0; bj < 2; ++bj) {
          const int col = col0 + bj * HALF;
          const f32x4 a = acc[ai][bj][m][0], b = acc[ai][bj][m][1];
          u32x4 w; w.x = pk2(a[0], a[1]); w.y = pk2(a[2], a[3]); w.z = pk2(b[0], b[1]); w.w = pk2(b[2], b[3]);
          *(u32x4*)(O + ((size_t)(col >> 4) * NTOK + tok) * 16 + (col & 15)) = w;
        }
      }
  }
};
struct EpiWout {
  static constexpr bool PERM = false, AFTER_DRAIN = false, KHOOK = true; static constexpr int KH_T = 8;
  float* out; const float* xp; const float* xs; const float* mod;
  __device__ __forceinline__ void khook(f32x4 (&acc)[2][2][4][2], int ui, int wr, int fr, PG8_LAS unsigned char* lds) const {
    typedef float f32x2t __attribute__((ext_vector_type(2)));
    const PG8_LAS f32x2t* tab = (const PG8_LAS f32x2t*)(lds + 131072) + ui * 256;
#pragma unroll
    for (int ai = 0; ai < 2; ++ai)
#pragma unroll
      for (int m = 0; m < 4; ++m) {
        const float r = tab[ai * HALF + wr * 64 + m * 16 + fr].x;
#pragma unroll
        for (int bj = 0; bj < 2; ++bj)
#pragma unroll
          for (int n = 0; n < 2; ++n) acc[ai][bj][m][n] *= r;
      }
  }
  __device__ __forceinline__ void operator()(const f32x4 (&acc)[2][2][4][2], const Unit& u, int wr, int wc, int fr, int fq, int ui) const {
    typedef float f32x2t __attribute__((ext_vector_type(2)));
    const PG8_LAS f32x2t* tab = (const PG8_LAS f32x2t*)((PG8_LAS unsigned char*)dyn_smem + 131072) + ui * 256;
    const int col0 = u.pn * BM + wc * 32 + 4 * fq;
#pragma unroll
    for (int ai = 0; ai < 2; ++ai)
#pragma unroll
      for (int m = 0; m < 4; ++m) {
        const int rl = ai * HALF + wr * 64 + m * 16 + fr, row = u.pm * BM + rl;
        const float rs = tab[rl].y;
        const float* g1 = mod + batch_of(row) * 6144 + 2048;
        const float* xr = row < LPR ? xp + (size_t)row * 1024 : xs + (size_t)(row - LPR) * 1024;
        float* orow = out + (size_t)row * 1024;
#pragma unroll
        for (int bj = 0; bj < 2; ++bj)
#pragma unroll
          for (int n = 0; n < 2; ++n) {
            const int col = col0 + bj * HALF + n * 16;
            const f32x4 xv = *(const f32x4*)(xr + col), gv = *(const f32x4*)(g1 + col);
            *(f32x4*)(orow + col) = xv + gv * (acc[ai][bj][m][n] * rs);
          }
      }
  }
};
}

DI void phase2(const P& p) {
  {
    const pg8::Gemm g{p.wint(), p.hb(), 512, NTOK, 1024};
    pg8::StaticOrder S; S.init(512, NTOK, (int)gridDim.x, (int)blockIdx.x);
    const pg8::EpiZt E{p.zT()};
    pg8::gemm_phase<pg8::EpiZt, pg8::StaticOrder, true, true>((PG8_LAS unsigned char*)dyn_smem, otid(), g, S, E);
  }
  {
    const pg8::Gemm g{p.hb(), p.wint() + (size_t)512 * 1024, NTOK, 512, 1024};
    pg8::StaticOrder S; S.init(NTOK, 512, (int)gridDim.x, (int)(gridDim.x - 1 - blockIdx.x));
    const pg8::EpiZs E{p.zs()};
    pg8::gemm_phase<pg8::EpiZs, pg8::StaticOrder, true, true>((PG8_LAS unsigned char*)dyn_smem, otid(), g, S, E);
  }
}
DI void phase6(const P& p) {
  {
    const pg8::Gemm g{p.AF(), p.Mf(), NTOK, 512, 1024};
    pg8::StaticOrder S; S.init(NTOK, 512, (int)gridDim.x, (int)blockIdx.x);
    const pg8::EpiYf E{p.mg(), p.b_f, p.ssf()};
    pg8::gemm_phase<pg8::EpiYf, pg8::StaticOrder, true, true>((PG8_LAS unsigned char*)dyn_smem, otid(), g, S, E);
  }
  {
    const pg8::Gemm g{p.gact(), p.wglut(), NTOK, 1024, 512};
    pg8::StaticOrder S; S.init(NTOK, 1024, (int)gridDim.x, (int)(gridDim.x - 1 - blockIdx.x));
    const pg8::EpiGlu E{p.mg(), p.b_glu, p.sss()};
    pg8::gemm_phase<pg8::EpiGlu, pg8::StaticOrder, true, true>((PG8_LAS unsigned char*)dyn_smem, otid(), g, S, E);
  }
}
DI void phase7(const P& p) {
  const pg8::Gemm g{p.mg(), p.woutt(), NTOK, 1024, 1024};
  pg8::StaticOrder S; S.init(NTOK, 1024, (int)gridDim.x, (int)blockIdx.x);
  {
    typedef float f32x2t __attribute__((ext_vector_type(2)));
    PG8_LAS f32x2t* tab = (PG8_LAS f32x2t*)((PG8_LAS unsigned char*)dyn_smem + 131072);
    const int tix7 = otid();
    pg8::Unit u;
    for (int i = 0; i < 8 && S.next(i, u); ++i) {
      if (tix7 < 256) {
        const int tok = u.pm * 256 + tix7;
        float sf = 0.f, s2 = 0.f;
#pragma unroll
        for (int j = 0; j < 8; j++) sf += p.ssf()[tok * 8 + j];
#pragma unroll
        for (int j = 0; j < 16; j++) s2 += p.sss()[tok * 16 + j];
        const float rf = rsqrtf(sf * (1.f / 512.f) + EPSV), rs = rsqrtf(s2 * (1.f / 512.f) + EPSV);
        tab[i * 256 + tix7] = (f32x2t){rf / rs, rs};
      }
    }
    __syncthreads();
  }
  const pg8::EpiWout E{p.out, p.xp, p.xs, p.mod()};
  pg8::gemm_phase<pg8::EpiWout, pg8::StaticOrder, true, true>((PG8_LAS unsigned char*)dyn_smem, otid(), g, S, E);
}
DI void phase8(const P& p) {
  const pg8::Gemm g{p.hb(), p.w1t(), NTOK, 4096, 1024};
  pg8::StaticOrder S; S.init(NTOK, 4096, (int)gridDim.x, (int)blockIdx.x);
  const pg8::EpiMlpIn E{p.hid(), p.b1};
  pg8::gemm_phase<pg8::EpiMlpIn, pg8::StaticOrder, true, true>((PG8_LAS unsigned char*)dyn_smem, otid(), g, S, E);
}
DI void phase9(const P& p) {
  const pg8::Gemm g{p.hid(), p.w2t(), NTOK, 1024, 4096};
  pg8::StaticOrder S; S.init(NTOK, 1024, (int)gridDim.x, (int)blockIdx.x);
  const pg8::EpiMlpOut E{p.out, p.mod(), p.b2};
  pg8::gemm_phase<pg8::EpiMlpOut, pg8::StaticOrder, true, true>((PG8_LAS unsigned char*)dyn_smem, otid(), g, S, E);
}

__global__ void __launch_bounds__(512, 2) k_mega(P p) {
  cg::grid_group grid = cg::this_grid();
  phase0(p); grid.sync();
  rownorm_mod(p, true, p.g_mix, 0, 1024); grid.sync();
  phase2(p); grid.sync();
  phase3(p); grid.sync();
  phase4(p); grid.sync();
  phase5(p); grid.sync();
  phase6(p); grid.sync();
  phase7(p); grid.sync();
  rownorm_mod(p, false, p.g_mlp, 3072, 4096); grid.sync();
  phase8(p); grid.sync();
  phase9(p); grid.sync();
  final_norm(p);
}

extern "C" void kernel_launch(void* const* d_in, const int* in_sizes, int n_in, void* d_out, int out_size, void* d_ws, size_t ws_size,
                              hipStream_t stream) {
  P p{};
  const float** f = (const float**)&p;
  for (int i = 0; i < 29; i++) f[i] = (const float*)d_in[i];
  p.out = (float*)d_out;
  p.ws = (char*)d_ws;
  if (WS_NEED > ws_size) { fprintf(stderr, "workspace too small: need %zu have %zu\n", (size_t)WS_NEED, ws_size); return; }
  static int grid_blocks = 0;
  if (!grid_blocks) {
    int dev = 0, cus = 0, per_cu = 0;
    (void)hipGetDevice(&dev);
    (void)hipDeviceGetAttribute(&cus, hipDeviceAttributeMultiprocessorCount, dev);
    (void)hipFuncSetAttribute((const void*)k_mega, hipFuncAttributeMaxDynamicSharedMemorySize, SMEM_BYTES);
    (void)hipOccupancyMaxActiveBlocksPerMultiprocessor(&per_cu, k_mega, 512, SMEM_BYTES);
    if (per_cu < 1) per_cu = 1;
    grid_blocks = cus * per_cu;
  }
  void* args[] = {&p};
  hipError_t e = hipLaunchCooperativeKernel((void*)k_mega, dim3(grid_blocks), dim3(512), args, SMEM_BYTES, stream);
  if (e != hipSuccess) fprintf(stderr, "cooperative launch failed: %s (grid %d)\n", hipGetErrorString(e), grid_blocks);
}
```

```cpp
#include <hip/hip_runtime.h>
#include <hip/hip_cooperative_groups.h>
#include <stdint.h>
#include <stdio.h>
namespace cg = cooperative_groups;


#define DI __device__ __forceinline__
typedef unsigned short bf16_t;
typedef short bf16x8 __attribute__((ext_vector_type(8)));
typedef float f32x16 __attribute__((ext_vector_type(16)));
typedef float f32x4 __attribute__((ext_vector_type(4)));

constexpr int NTOK = 81920, LPR = 16384, LSM = 4096;
constexpr int BM = 128, BN = 128, BK = 64, LDSS = 72, TLD = 136;
constexpr int SMEM_HALF = 2 * 2 * BM * LDSS * 2;
constexpr int SMEM_BYTES = 2 * SMEM_HALF;
constexpr float EPSV = 1e-6f;

constexpr size_t al256(size_t x) { return (x + 255) & ~(size_t)255; }
constexpr size_t O_mod = 0;
constexpr size_t O_AT = O_mod + al256(17 * 6144 * 4);
constexpr size_t O_ssf = O_AT + al256(32 * 2 * 64 * 2 * 4);
constexpr size_t O_sss = O_ssf + al256((size_t)NTOK * 8 * 4);
constexpr size_t O_twp = O_sss + al256((size_t)NTOK * 16 * 4);
constexpr size_t O_tws = O_twp + al256(LPR * 8);
constexpr size_t O_wint = O_tws + al256(LSM * 8);
constexpr size_t O_wglut = O_wint + al256(1024 * 1024 * 2);
constexpr size_t O_woutt = O_wglut + al256(1024 * 512 * 2);
constexpr size_t O_w1t = O_woutt + al256(1024 * 1024 * 2);
constexpr size_t O_w2t = O_w1t + al256((size_t)4096 * 1024 * 2);
constexpr size_t O_Mf = O_w2t + al256((size_t)4096 * 1024 * 2);
constexpr size_t O_F1p = O_Mf + al256(512 * 1024 * 2);
constexpr size_t O_F1s = O_F1p + al256(256 * 128 * 2);
constexpr size_t O_F2p = O_F1s + al256(128 * 64 * 2);
constexpr size_t O_F2s = O_F2p + al256(256 * 256 * 2);
constexpr size_t O_Bs = O_F2s + al256(128 * 128 * 2);
constexpr size_t O_Tcat = O_Bs + al256((size_t)32 * 256 * 1024 * 2);
constexpr size_t O_hb = O_Tcat + al256((size_t)32 * 1024 * 1280 * 2);
constexpr size_t O_zT = O_hb + al256((size_t)NTOK * 1024 * 2);
constexpr size_t O_Ucat = O_zT + al256((size_t)NTOK * 512 * 2);
constexpr size_t O_AF = O_Ucat + al256((size_t)32 * 1280 * 1280 * 2);
constexpr size_t O_S = O_AF + al256((size_t)NTOK * 1024 * 2);
constexpr size_t O_gact = O_S + al256((size_t)1280 * 32 * 256 * 4);
constexpr size_t O_mg = O_gact + al256((size_t)NTOK * 512 * 2);
constexpr size_t O_END = O_mg + al256((size_t)NTOK * 1024 * 2);
constexpr size_t O_Tt = O_hb;
constexpr size_t O_hid = O_zT;
constexpr size_t WS_NEED = (O_hid + (size_t)NTOK * 4096 * 2 > O_END ? O_hid + (size_t)NTOK * 4096 * 2 : O_END);
struct P {
  const float *xp, *xs, *cp, *cs, *w_ada, *b_ada, *g_mix, *w_in, *w_f, *b_f, *a_re, *a_im, *log_dt, *b_re, *b_im, *c_re, *c_im,
      *ssm_d, *w_glu, *b_glu, *g_fo, *g_so, *w_out, *g_mlp, *w1, *b1, *w2, *b2, *g_final;
  float* out;
  char* ws;
  __device__ __forceinline__ float* mod() const { return (float*)(ws + O_mod); }
  __device__ __forceinline__ float* AT() const { return (float*)(ws + O_AT); }
  __device__ __forceinline__ float* ssf() const { return (float*)(ws + O_ssf); }
  __device__ __forceinline__ float* sss() const { return (float*)(ws + O_sss); }
  __device__ __forceinline__ float2* twp() const { return (float2*)(ws + O_twp); }
  __device__ __forceinline__ float2* tws() const { return (float2*)(ws + O_tws); }
  __device__ __forceinline__ bf16_t* wint() const { return (bf16_t*)(ws + O_wint); }
  __device__ __forceinline__ bf16_t* wglut() const { return (bf16_t*)(ws + O_wglut); }
  __device__ __forceinline__ bf16_t* woutt() const { return (bf16_t*)(ws + O_woutt); }
  __device__ __forceinline__ bf16_t* w1t() const { return (bf16_t*)(ws + O_w1t); }
  __device__ __forceinline__ bf16_t* w2t() const { return (bf16_t*)(ws + O_w2t); }
  __device__ __forceinline__ bf16_t* Mf() const { return (bf16_t*)(ws + O_Mf); }
  __device__ __forceinline__ bf16_t* F1p() const { return (bf16_t*)(ws + O_F1p); }
  __device__ __forceinline__ bf16_t* F1s() const { return (bf16_t*)(ws + O_F1s); }
  __device__ __forceinline__ bf16_t* F2p() const { return (bf16_t*)(ws + O_F2p); }
  __device__ __forceinline__ bf16_t* F2s() const { return (bf16_t*)(ws + O_F2s); }
  __device__ __forceinline__ bf16_t* Bs() const { return (bf16_t*)(ws + O_Bs); }
  __device__ __forceinline__ bf16_t* Tcat() const { return (bf16_t*)(ws + O_Tcat); }
  __device__ __forceinline__ bf16_t* Ucat() const { return (bf16_t*)(ws + O_Ucat); }
  __device__ __forceinline__ bf16_t* hb() const { return (bf16_t*)(ws + O_hb); }
  __device__ __forceinline__ bf16_t* zT() const { return (bf16_t*)(ws + O_zT); }
  __device__ __forceinline__ bf16_t* AF() const { return (bf16_t*)(ws + O_AF); }
  __device__ __forceinline__ float* S() const { return (float*)(ws + O_S); }
  __device__ __forceinline__ bf16_t* mg() const { return (bf16_t*)(ws + O_mg); }
  __device__ __forceinline__ bf16_t* gact() const { return (bf16_t*)(ws + O_gact); }
  __device__ __forceinline__ bf16_t* Tt() const { return (bf16_t*)(ws + O_Tt); }
  __device__ __forceinline__ bf16_t* hid() const { return (bf16_t*)(ws + O_hid); }
};

typedef float f32x2v __attribute__((ext_vector_type(2)));
typedef __bf16 bf16x2v __attribute__((ext_vector_type(2)));
DI uint32_t pk2(float lo, float hi) { const f32x2v v = {lo, hi}; const bf16x2v r = __builtin_convertvector(v, bf16x2v); return __builtin_bit_cast(uint32_t, r); }
DI bf16_t f2bf(float f) { return (bf16_t)(pk2(f, 0.f) & 0xffffu); }
extern __shared__ __attribute__((aligned(16))) unsigned char dyn_smem[];
DI int otid() { int t = (int)threadIdx.x; asm volatile("" : "+v"(t)); return t; }
DI int permtok(int v) {
  if (v < LPR) return ((v & 127) << 7) | (v >> 7);
  const int vs = v - LPR, w = vs & 4095;
  return LPR + (vs & ~4095) + ((w & 63) << 6) + (w >> 6);
}
DI int batch_of(int tok) { return tok < LPR ? 0 : 1 + ((tok - LPR) >> 12); }
DI float gelu_tanh(float x) {
  const float u = 0.7978845608028654f * (x + 0.044715f * x * x * x);
  return x / (1.f + __expf(-2.f * u));
}
DI float wave_sum(float v) {
  v += __shfl_xor(v, 32); v += __shfl_xor(v, 16); v += __shfl_xor(v, 8); v += __shfl_xor(v, 4); v += __shfl_xor(v, 2); v += __shfl_xor(v, 1);
  return v;
}

template <bool SWAP, class AF, class BF, class HK>
DI void gemm_main(bf16_t* sm, const int tid, int K, const AF& af, const BF& bf, const HK& hk, f32x16 (&acc)[2][2]) {
  const int lane = tid & 63, wid = tid >> 6, wm = wid >> 1, wn = wid & 1;
  const int kc = (tid & 7) * 8, rb = tid >> 3;
  bf16_t* As = sm;
  bf16_t* Bs = sm + 2 * BM * LDSS;
  uint4 ra[4], rv[4];
#pragma unroll
  for (int i = 0; i < 2; i++)
#pragma unroll
    for (int j = 0; j < 2; j++)
#pragma unroll
      for (int e = 0; e < 16; e++) acc[i][j][e] = 0.f;
  __syncthreads();
#pragma unroll
  for (int i = 0; i < 4; i++) { ra[i] = *(const uint4*)af(rb + 32 * i, kc); rv[i] = *(const uint4*)bf(rb + 32 * i, kc); }
#pragma unroll
  for (int i = 0; i < 4; i++) { *(uint4*)(As + (rb + 32 * i) * LDSS + kc) = ra[i]; *(uint4*)(Bs + (rb + 32 * i) * LDSS + kc) = rv[i]; }
  __syncthreads();
  const int nk = K / BK;
  for (int t = 0; t < nk; t++) {
    const int cur = t & 1;
    if (t + 1 < nk) {
      const int k = (t + 1) * BK + kc;
#pragma unroll
      for (int i = 0; i < 4; i++) { ra[i] = *(const uint4*)af(rb + 32 * i, k); rv[i] = *(const uint4*)bf(rb + 32 * i, k); }
    }
    hk(t, acc);
    const bf16_t* Ab = As + cur * BM * LDSS + (wm * 64 + (lane & 31)) * LDSS + (lane >> 5) * 8;
    const bf16_t* Bb = Bs + cur * BN * LDSS + (wn * 64 + (lane & 31)) * LDSS + (lane >> 5) * 8;
#pragma unroll
    for (int ks = 0; ks < 4; ks++) {
      const bf16x8 a0 = *(const bf16x8*)(Ab + ks * 16), a1 = *(const bf16x8*)(Ab + 32 * LDSS + ks * 16);
      const bf16x8 b0 = *(const bf16x8*)(Bb + ks * 16), b1 = *(const bf16x8*)(Bb + 32 * LDSS + ks * 16);
      if (SWAP) {
        acc[0][0] = __builtin_amdgcn_mfma_f32_32x32x16_bf16(b0, a0, acc[0][0], 0, 0, 0);
        acc[0][1] = __builtin_amdgcn_mfma_f32_32x32x16_bf16(b1, a0, acc[0][1], 0, 0, 0);
        acc[1][0] = __builtin_amdgcn_mfma_f32_32x32x16_bf16(b0, a1, acc[1][0], 0, 0, 0);
        acc[1][1] = __builtin_amdgcn_mfma_f32_32x32x16_bf16(b1, a1, acc[1][1], 0, 0, 0);
      } else {
        acc[0][0] = __builtin_amdgcn_mfma_f32_32x32x16_bf16(a0, b0, acc[0][0], 0, 0, 0);
        acc[0][1] = __builtin_amdgcn_mfma_f32_32x32x16_bf16(a0, b1, acc[0][1], 0, 0, 0);
        acc[1][0] = __builtin_amdgcn_mfma_f32_32x32x16_bf16(a1, b0, acc[1][0], 0, 0, 0);
        acc[1][1] = __builtin_amdgcn_mfma_f32_32x32x16_bf16(a1, b1, acc[1][1], 0, 0, 0);
      }
    }
    if (t + 1 < nk) {
      const int nb = cur ^ 1;
#pragma unroll
      for (int i = 0; i < 4; i++) {
        *(uint4*)(As + nb * BM * LDSS + (rb + 32 * i) * LDSS + kc) = ra[i];
        *(uint4*)(Bs + nb * BN * LDSS + (rb + 32 * i) * LDSS + kc) = rv[i];
      }
    }
    __syncthreads();
  }
}
struct NoHook { DI void operator()(int, f32x16 (&)[2][2]) const {} };

template <class EW, class DST>
DI void epi_transposed(bf16_t* sm, const int tid, f32x16 (&acc)[2][2], const EW& ew, const DST& dst) {
  const int lane = tid & 63, wid = tid >> 6, wm = wid >> 1, wn = wid & 1;
#pragma unroll
  for (int mi = 0; mi < 2; mi++)
#pragma unroll
    for (int g = 0; g < 4; g++) {
      const int ml = wm * 64 + mi * 32 + 8 * g + 4 * (lane >> 5);
      float v0[4], v1[4];
#pragma unroll
      for (int e = 0; e < 4; e++) { v0[e] = acc[mi][0][4 * g + e]; v1[e] = acc[mi][1][4 * g + e]; ew(mi, g, e, v0[e], v1[e]); }
      const int nl = wn * 64 + (lane & 31);
      uint2 w0, w1;
      w0.x = pk2(v0[0], v0[1]); w0.y = pk2(v0[2], v0[3]); w1.x = pk2(v1[0], v1[1]); w1.y = pk2(v1[2], v1[3]);
      *(uint2*)(sm + nl * TLD + ml) = w0;
      *(uint2*)(sm + (nl + 32) * TLD + ml) = w1;
    }
  __syncthreads();
  {
    const int nl = tid >> 1, r = tid & 1;
    bf16_t* d = dst(nl, r);
    const bf16_t* s = sm + nl * TLD + 64 * r;
#pragma unroll
    for (int i = 0; i < 8; i++) *(uint4*)(d + 8 * i) = *(const uint4*)(s + 8 * i);
  }
}

DI void ssm_pow(const P& p, int g, int dir, int pp, int j, float& re, float& im) {
  const int ia = (dir * 32 + g) * 64 + pp;
  const float lr = fminf(p.a_re[ia], -1e-4f), li = p.a_im[ia], dt = expf(p.log_dt[dir * 32 + g]);
  const float mag = expf(lr * dt * (float)j);
  double t = (double)li * (double)dt * (double)j * 0.15915494309189535;
  t -= rint(t);
  const float ang = (float)(t * 6.283185307179586);
  float s, c; sincosf(ang, &s, &c);
  re = mag * c; im = mag * s;
}
DI void ssm_coef(const P& p, int g, int dir, int pp, float& cr, float& ci) {
  const int ia = (dir * 32 + g) * 64 + pp;
  const float lr = fminf(p.a_re[ia], -1e-4f), li = p.a_im[ia];
  float ar, ai; ssm_pow(p, g, dir, pp, 1, ar, ai);
  const float nr = ar - 1.f, ni = ai, den = 1.f / (lr * lr + li * li);
  cr = (nr * lr + ni * li) * den; ci = (ni * lr - nr * li) * den;
}

template <class CM>
DI void transpose_job(float* tile, const int tid, bool act, int item, const float* in, int ld, int Kdim, bf16_t* out, const CM& colmap, const float* sc0, const float* sc1) {
  const int nkt = Kdim / 64, nt = item / nkt, kt = item % nkt;
  __syncthreads();
  if (act) {
    const int c = tid & 31, kr = tid >> 5, col = colmap(nt * 32 + c);
#pragma unroll
    for (int i = 0; i < 8; i++) {
      const int kl = kr + 8 * i, k = kt * 64 + kl;
      float v = in[(size_t)k * ld + col];
      if (sc0) v *= (k < 512 ? sc0[k] : sc1[k - 512]);
      tile[kl * 33 + c] = v;
    }
  }
  __syncthreads();
  if (act) {
    const int nl = tid >> 3, kc = tid & 7;
    float v[8];
#pragma unroll
    for (int j = 0; j < 8; j++) v[j] = tile[(kc * 8 + j) * 33 + nl];
    uint4 w; w.x = pk2(v[0], v[1]); w.y = pk2(v[2], v[3]); w.z = pk2(v[4], v[5]); w.w = pk2(v[6], v[7]);
    *(uint4*)(out + (size_t)(nt * 32 + nl) * Kdim + kt * 64 + kc * 8) = w;
  }
}

DI void phase0(const P& p) {
  const int tix = otid();
  unsigned char* smraw = dyn_smem + (tix >> 8) * SMEM_HALF;
  float* smf = (float*)smraw;
  const int tid = tix & 255, nb = gridDim.x * 2, bid = blockIdx.x * 2 + (tix >> 8);
  for (int base = 0; base < 96; base += nb) {
    const int item = base + bid; const bool act = item < 96;
    __syncthreads();
    if (act)
      for (int i = tid; i < 17 * 1024; i += 256) {
        const int b = i >> 10, k = i & 1023;
        const float c = b == 0 ? p.cp[k] : p.cs[(b - 1) * 1024 + k];
        smf[i] = c / (1.f + __expf(-c));
      }
    __syncthreads();
    const int col = tid & 63, kq = tid >> 6, j = item * 64 + col;
    float a[17];
#pragma unroll
    for (int b = 0; b < 17; b++) a[b] = 0.f;
    if (act)
      for (int k = kq * 256; k < kq * 256 + 256; k++) {
        const float w = p.w_ada[(size_t)k * 6144 + j];
#pragma unroll
        for (int b = 0; b < 17; b++) a[b] += smf[b * 1024 + k] * w;
      }
    __syncthreads();
#pragma unroll
    for (int b = 0; b < 17; b++) smf[(kq * 17 + b) * 64 + col] = a[b];
    __syncthreads();
    if (act)
      for (int i = tid; i < 17 * 64; i += 256) {
        const int b = i >> 6, c2 = i & 63;
        const float s = smf[(0 * 17 + b) * 64 + c2] + smf[(1 * 17 + b) * 64 + c2] + smf[(2 * 17 + b) * 64 + c2] + smf[(3 * 17 + b) * 64 + c2];
        p.mod()[b * 6144 + item * 64 + c2] = s + p.b_ada[item * 64 + c2];
      }
  }
  {
    auto ident = [](int n) { return n; };
    auto glumap = [](int n) { return ((n >> 7) & 1) * 512 + (n >> 8) * 128 + (n & 127); };
    const int n0 = 512, n1 = n0 + 256, n2 = n1 + 512, n3 = n2 + 2048, n4 = n3 + 2048;
    for (int base = 0; base < n4; base += nb) {
      const int item = base + bid; const bool act = item < n4;
      if (item < n0) transpose_job(smf, tid, act, item, p.w_in, 1024, 1024, p.wint(), ident, nullptr, nullptr);
      else if (item < n1) transpose_job(smf, tid, act, item - n0, p.w_glu, 1024, 512, p.wglut(), glumap, nullptr, nullptr);
      else if (item < n2) transpose_job(smf, tid, act, item - n1, p.w_out, 1024, 1024, p.woutt(), ident, p.g_fo, p.g_so);
      else if (item < n3) transpose_job(smf, tid, act, item - n2, p.w1, 4096, 1024, p.w1t(), ident, nullptr, nullptr);
      else transpose_job(smf, tid, act, item - n3, p.w2, 1024, 4096, p.w2t(), ident, nullptr, nullptr);
    }
  }
  {
    __syncthreads();
    float2* cs = (float2*)smraw;
    for (int i = tid; i < 512; i += 256) { float s, c; sincosf((float)i * (6.283185307179586f / 512.f), &s, &c); cs[i] = make_float2(c, s); }
    __syncthreads();
    for (int item = bid; item < 2048; item += nb) {
      const int idx = item * 256 + tid, n = idx >> 10, k = idx & 1023, h = n >> 7, e = n & 127, c = k & 511;
      const bool is_sin = k >= 512;
      const float* wf = p.w_f + (size_t)h * 128 * 128 + e;
      float a = 0.f;
      for (int d = 0; d < 128; d++) {
        const float2 t = cs[((h * 128 + d) * c) & 511];
        a += (is_sin ? t.y : t.x) * wf[d * 128];
      }
      p.Mf()[idx] = f2bf(a);
    }
  }
  {
    const int gsz = nb * 256, gt = bid * 256 + tid;
    for (int i = gt; i < 256 * 128; i += gsz) {
      const int n = i >> 7, k = i & 127, k1 = (n >> 6) * 32 + (n & 31), part = (n >> 5) & 1;
      float s, c; sincosf((float)((k1 * k) & 127) * (6.283185307179586f / 128.f), &s, &c);
      p.F1p()[i] = f2bf(part ? -s : c);
    }
    for (int i = gt; i < 128 * 64; i += gsz) {
      const int n = i >> 6, k = i & 63, k1 = (n >> 6) * 32 + (n & 31), part = (n >> 5) & 1;
      float s, c; sincosf((float)((k1 * k) & 63) * (6.283185307179586f / 64.f), &s, &c);
      p.F1s()[i] = f2bf(part ? -s : c);
    }
    for (int i = gt; i < 256 * 256; i += gsz) {
      const int n = i >> 8, k = i & 255, part = n >> 7, k2 = n & 127, l2 = k & 127, ki = k >> 7;
      float s, c; sincosf((float)((k2 * l2) & 127) * (6.283185307179586f / 128.f), &s, &c);
      p.F2p()[i] = f2bf(part == 0 ? (ki == 0 ? c : s) : (ki == 0 ? -s : c));
    }
    for (int i = gt; i < 128 * 128; i += gsz) {
      const int n = i >> 7, k = i & 127, part = n >> 6, k2 = n & 63, l2 = k & 63, ki = k >> 6;
      float s, c; sincosf((float)((k2 * l2) & 63) * (6.283185307179586f / 64.f), &s, &c);
      p.F2s()[i] = f2bf(part == 0 ? (ki == 0 ? c : s) : (ki == 0 ? -s : c));
    }
    for (int i = gt; i < LPR; i += gsz) { float s, c; sincosf((float)i * (6.283185307179586f / 16384.f), &s, &c); p.twp()[i] = make_float2(c, s); }
    for (int i = gt; i < LSM; i += gsz) { float s, c; sincosf((float)i * (6.283185307179586f / 4096.f), &s, &c); p.tws()[i] = make_float2(c, s); }
    for (int i = gt; i < 32 * 2 * 64 * 64; i += gsz) {
      const int s = i & 63, pp = (i >> 6) & 63, dir = (i >> 12) & 1, g = i >> 13;
      float pr, pi, cr, ci; ssm_pow(p, g, dir, pp, dir == 0 ? 63 - s : s, pr, pi); ssm_coef(p, g, dir, pp, cr, ci);
      const float qr = pr * cr - pi * ci, qi = pr * ci + pi * cr;
      const int ib = ((dir * 32 + g) * 64 + pp) * 16;
      float vr[16], vi[16];
#pragma unroll
      for (int h = 0; h < 16; h++) { const float br = p.b_re[ib + h], bi = p.b_im[ib + h]; vr[h] = qr * br - qi * bi; vi[h] = qr * bi + qi * br; }
      bf16_t* d0 = p.Bs() + ((size_t)(g * 256 + dir * 128 + pp)) * 1024 + s * 16;
      bf16_t* d1 = d0 + 64 * 1024;
      uint4 w;
      w.x = pk2(vr[0], vr[1]); w.y = pk2(vr[2], vr[3]); w.z = pk2(vr[4], vr[5]); w.w = pk2(vr[6], vr[7]); *(uint4*)d0 = w;
      w.x = pk2(vr[8], vr[9]); w.y = pk2(vr[10], vr[11]); w.z = pk2(vr[12], vr[13]); w.w = pk2(vr[14], vr[15]); *(uint4*)(d0 + 8) = w;
      w.x = pk2(vi[0], vi[1]); w.y = pk2(vi[2], vi[3]); w.z = pk2(vi[4], vi[5]); w.w = pk2(vi[6], vi[7]); *(uint4*)d1 = w;
      w.x = pk2(vi[8], vi[9]); w.y = pk2(vi[10], vi[11]); w.z = pk2(vi[12], vi[13]); w.w = pk2(vi[14], vi[15]); *(uint4*)(d1 + 8) = w;
    }
    for (int i = gt; i < 32 * 64 * 2 * 64; i += gsz) {
      const int pp = i & 63, dir = (i >> 6) & 1, t = (i >> 7) & 63, g = i >> 13;
      float pr, pi; ssm_pow(p, g, dir, pp, dir == 0 ? t + 1 : 64 - t, pr, pi);
#pragma unroll
      for (int h = 0; h < 16; h++) {
        const int ic = ((dir * 32 + g) * 16 + h) * 64 + pp;
        const float cr = p.c_re[ic], ci = p.c_im[ic];
        bf16_t* d = p.Tcat() + ((size_t)(g * 1024 + t * 16 + h)) * 1280 + 1024 + dir * 128 + pp;
        d[0] = f2bf(cr * pr - ci * pi);
        d[64] = f2bf(-(cr * pi + ci * pr));
      }
    }
    for (int i = gt; i < 32 * 2 * 64; i += gsz) {
      const int pp = i & 63, dir = (i >> 6) & 1, g = i >> 7;
      float pr, pi; ssm_pow(p, g, dir, pp, 64, pr, pi);
      p.AT()[i * 2] = pr; p.AT()[i * 2 + 1] = pi;
    }
  }
  {
    float2* q = (float2*)smraw;
    for (int base = 0; base < 32 * 127; base += nb) {
      const int item = base + bid; const bool act = item < 32 * 127;
      const int g = act ? item / 127 : 0, jj = act ? item % 127 : 0, lag = jj - 63;
      __syncthreads();
      if (tid < 128) {
        const int dir = tid >> 6, pp = tid & 63;
        float2 v = make_float2(0.f, 0.f);
        if ((dir == 0 && lag >= 0) || (dir == 1 && lag <= 0)) {
          float pr, pi, cr, ci; ssm_pow(p, g, dir, pp, lag < 0 ? -lag : lag, pr, pi); ssm_coef(p, g, dir, pp, cr, ci);
          v = make_float2(pr * cr - pi * ci, pr * ci + pi * cr);
        }
        q[tid] = v;
      }
      __syncthreads();
      const int hp = tid >> 4, h = tid & 15;
      float a = 0.f;
#pragma unroll
      for (int dir = 0; dir < 2; dir++) {
        if ((dir == 0 && lag < 0) || (dir == 1 && lag > 0)) continue;
        for (int pp = 0; pp < 64; pp++) {
          const int ic = ((dir * 32 + g) * 16 + hp) * 64 + pp, ib = ((dir * 32 + g) * 64 + pp) * 16 + h;
          const float cr = p.c_re[ic], ci = p.c_im[ic], br = p.b_re[ib], bi = p.b_im[ib];
          const float2 qq = q[dir * 64 + pp];
          const float er = cr * qq.x - ci * qq.y, ei = cr * qq.y + ci * qq.x;
          a += er * br - ei * bi;
        }
      }
      if (lag == 0 && hp == h) a += p.ssm_d[g * 16 + h];
      if (act) {
        const bf16_t kv = f2bf(a);
        const int t0 = lag > 0 ? lag : 0, t1 = lag > 0 ? 64 : 64 + lag;
        bf16_t* d = p.Tcat() + ((size_t)(g * 1024 + hp)) * 1280 + h;
        for (int t = t0; t < t1; t++) d[(size_t)t * 16 * 1280 + (t - lag) * 16] = kv;
      }
    }
  }
}

DI void rownorm_mod(const P& p, bool from_x, const float* g, int sh_off, int sc_off) {
  const int tix = otid(), lane = tix & 63, wv = blockIdx.x * 8 + (tix >> 6), nw = gridDim.x * 8;
  for (int tok = wv; tok < NTOK; tok += nw) {
    const float* src = from_x ? (tok < LPR ? p.xp + (size_t)tok * 1024 : p.xs + (size_t)(tok - LPR) * 1024) : p.out + (size_t)tok * 1024;
    f32x4 v[4]; float ss = 0.f;
#pragma unroll
    for (int i = 0; i < 4; i++) { v[i] = *(const f32x4*)(src + (i * 64 + lane) * 4); ss += v[i][0] * v[i][0] + v[i][1] * v[i][1] + v[i][2] * v[i][2] + v[i][3] * v[i][3]; }
    ss = wave_sum(ss);
    const float r = rsqrtf(ss * (1.f / 1024.f) + EPSV);
    const float* md = p.mod() + batch_of(tok) * 6144;
#pragma unroll
    for (int i = 0; i < 4; i++) {
      const int c = (i * 64 + lane) * 4;
      const f32x4 gg = *(const f32x4*)(g + c), sc = *(const f32x4*)(md + sc_off + c), sh = *(const f32x4*)(md + sh_off + c);
      float o[4];
#pragma unroll
      for (int e = 0; e < 4; e++) o[e] = v[i][e] * r * gg[e] * (1.f + sc[e]) + sh[e];
      uint2 w; w.x = pk2(o[0], o[1]); w.y = pk2(o[2], o[3]);
      *(uint2*)(p.hb() + (size_t)(from_x ? permtok(tok) : tok) * 1024 + c) = w;
    }
  }
}
DI void final_norm(const P& p) {
  const int tix = otid(), lane = tix & 63, wv = blockIdx.x * 8 + (tix >> 6), nw = gridDim.x * 8;
  for (int tok = wv; tok < NTOK; tok += nw) {
    float* src = p.out + (size_t)tok * 1024;
    f32x4 v[4]; float ss = 0.f;
#pragma unroll
    for (int i = 0; i < 4; i++) { v[i] = *(const f32x4*)(src + (i * 64 + lane) * 4); ss += v[i][0] * v[i][0] + v[i][1] * v[i][1] + v[i][2] * v[i][2] + v[i][3] * v[i][3]; }
    ss = wave_sum(ss);
    const float r = rsqrtf(ss * (1.f / 1024.f) + EPSV);
#pragma unroll
    for (int i = 0; i < 4; i++) {
      const int c = (i * 64 + lane) * 4;
      const f32x4 gg = *(const f32x4*)(p.g_final + c);
      f32x4 o;
#pragma unroll
      for (int e = 0; e < 4; e++) o[e] = v[i][e] * r * gg[e];
      *(f32x4*)(src + c) = o;
    }
  }
}

#define GEO const int tix = otid(), half = tix >> 8, tid = tix & 255, lane = tid & 63, wid = tid >> 6, wm = wid >> 1, wn = wid & 1, l31 = lane & 31, lh = lane >> 5; (void)tix; (void)half; (void)tid; (void)wm; (void)wn; (void)l31; (void)lh;

template <int R>
DI void fft1_tile(const P& p, bf16_t* sm, int tm, int tn) {
  GEO
  constexpr bool pr = (R == 128);
  f32x16 acc[2][2];
  const bf16_t* Abase = pr ? p.zT() + (size_t)tm * 128 * 128 : p.zT() + (size_t)512 * LPR + (size_t)tm * 128 * 64;
  const bf16_t* Bbase = pr ? p.F1p() + (size_t)tn * 128 * 128 : p.F1s();
  auto af = [&](int r, int k) { return Abase + r * R + k; };
  auto bf = [&](int r, int k) { return Bbase + r * R + k; };
  gemm_main<false>(sm, tid, R, af, bf, NoHook(), acc);
  const int k1 = (tn * 2 + wn) * 32 + l31;
  const float2* tw = pr ? p.twp() : p.tws();
  constexpr int lmask = pr ? 16383 : 4095, l2mask = R - 1;
  const float2 tb = tw[(unsigned)((k1 * ((wm * 64 + 4 * lh) & l2mask)) & lmask)], t1 = tw[(unsigned)(k1 & lmask)], t8 = tw[(unsigned)((k1 * 8) & lmask)],
               t32 = tw[(unsigned)((k1 * (32 & l2mask)) & lmask)];
  float2 wt[2][4][4];
#pragma unroll
  for (int mi = 0; mi < 2; mi++) {
    float2 w = tb;
    if (mi) w = make_float2(tb.x * t32.x - tb.y * t32.y, tb.y * t32.x + tb.x * t32.y);
#pragma unroll
    for (int g = 0; g < 4; g++) {
      float2 u = w;
#pragma unroll
      for (int e = 0; e < 4; e++) {
        wt[mi][g][e] = u;
        u = make_float2(u.x * t1.x - u.y * t1.y, u.y * t1.x + u.x * t1.y);
      }
      w = make_float2(w.x * t8.x - w.y * t8.y, w.y * t8.x + w.x * t8.y);
    }
  }
  auto ew = [&](int mi, int g, int e, float& re, float& im) {
    const float2 w = wt[mi][g][e];
    const float a = re * w.x + im * w.y, b = im * w.x - re * w.y;
    re = a; im = b;
  };
  auto dst = [&](int nl, int r) {
    const int part = (nl >> 5) & 1, kk1 = (tn * 2 + (nl >> 6)) * 32 + (nl & 31);
    if (pr) return p.Tt() + ((size_t)(tm * 128 + kk1)) * 256 + part * 128 + 64 * r;
    return p.Tt() + (size_t)65536 * 256 + ((size_t)((tm * 2 + r) * 64 + kk1)) * 128 + part * 64;
  };
  epi_transposed(sm, tid, acc, ew, dst);
}
DI void phase3(const P& p);
template <int R>
DI void fft2_tile(const P& p, bf16_t* sm, int tm, int tn) {
  GEO
  constexpr bool pr = (R == 128);
  constexpr int K = 2 * R;
  f32x16 acc[2][2];
  const int ct = tm & 3, k1 = pr ? (tm >> 2) : ((tm >> 2) & 63), b = pr ? 0 : (tm >> 8);
  const bf16_t* Abase = pr ? p.Tt() + ((size_t)(ct * 128) * 128 + k1) * 256 : p.Tt() + (size_t)65536 * 256 + ((size_t)(b * 512 + ct * 128) * 64 + k1) * 128;
  constexpr int rstride = R * K;
  const bf16_t* Bbase = pr ? p.F2p() + (size_t)tn * 128 * 256 : p.F2s();
  auto af = [&](int r, int k) { return Abase + (size_t)r * rstride + k; };
  auto bf = [&](int r, int k) { return Bbase + r * K + k; };
  gemm_main<false>(sm, tid, K, af, bf, NoHook(), acc);
  auto ew = [](int, int, int, float&, float&) {};
  auto dst = [&](int nl, int r) {
    const int n = tn * 128 + nl, part = pr ? (n >> 7) : (n >> 6), k2 = n & (R - 1);
    const int tok = (pr ? 0 : LPR + b * 4096) + k1 + R * k2;
    return p.AF() + (size_t)tok * 1024 + part * 512 + ct * 128 + 64 * r;
  };
  epi_transposed(sm, tid, acc, ew, dst);
}
DI void phase4(const P& p) {
  GEO
  bf16_t* sm = (bf16_t*)(dyn_smem + half * SMEM_HALF);
  for (int idx = blockIdx.x * 512 + tix; idx < 17 * 4096; idx += gridDim.x * 512) {
    const int seq = idx >> 12, rem = idx & 4095, g = rem >> 7, dir = (rem >> 6) & 1, pp = rem & 63;
    const int c0 = seq == 0 ? 0 : 256 + (seq - 1) * 64, nc = seq == 0 ? 256 : 64;
    const float ar = p.AT()[((g * 2 + dir) * 64 + pp) * 2], ai = p.AT()[((g * 2 + dir) * 64 + pp) * 2 + 1];
    float hr = 0.f, hi = 0.f;
    const float* Sg = p.S() + (size_t)g * 1280 * 256 + dir * 128 + pp;
    bf16_t* Hg = p.Ucat() + (size_t)g * 1280 * 1280 + 1024 + dir * 128 + pp;
    for (int i0 = 0; i0 < nc; i0 += 8) {
      float sr[8], si[8];
#pragma unroll
      for (int j = 0; j < 8; j++) {
        const int c = c0 + (dir == 0 ? i0 + j : nc - 1 - i0 - j);
        sr[j] = Sg[(size_t)c * 256]; si[j] = Sg[(size_t)c * 256 + 64];
      }
#pragma unroll
      for (int j = 0; j < 8; j++) {
        const int c = c0 + (dir == 0 ? i0 + j : nc - 1 - i0 - j);
        Hg[(size_t)c * 1280] = f2bf(hr); Hg[(size_t)c * 1280 + 64] = f2bf(hi);
        const float nr = ar * hr - ai * hi + sr[j], ni = ar * hi + ai * hr + si[j];
        hr = nr; hi = ni;
      }
    }
  }
  for (int q = blockIdx.x; q < (1024 + 4096) / 2; q += gridDim.x) {
    const int t = 2 * q + half;
    if (t < 1024) fft2_tile<128>(p, sm, t >> 1, t & 1);
    else fft2_tile<64>(p, sm, t - 1024, 0);
  }
}


namespace pg8 {
#define PG8_LAS __attribute__((address_space(3)))
typedef unsigned short bf16_t;
typedef short bf16x8 __attribute__((ext_vector_type(8)));
typedef float f32x4 __attribute__((ext_vector_type(4)));
typedef unsigned u32x4 __attribute__((ext_vector_type(4)));
constexpr int BM = 256, BK = 64, HALF = 128, HTB = HALF * BK * 2  , STAGE_BYTES = 8 * HTB, NXCD = 8, WGM = 8;

__host__ __device__ __forceinline__ int lds_byte(int r, int c) { const int st = (r >> 4) * 2 + (c >> 5), rr = r & 15, cc = c & 31, ob = rr * 64 + cc * 2; return st * 1024 + (ob ^ (((ob >> 9) & 1) << 5)); }
__host__ __device__ __forceinline__ void stage_rc(int b, int& R, int& C) { const int st = b / 1024, sb = b % 1024, swz = sb ^ (((sb >> 9) & 1) << 5); R = (st >> 1) * 16 + swz / 64; C = (st & 1) * 32 + (swz % 64) / 2; }
__host__ __device__ __forceinline__ int perm32(int rho) { const int n = rho >> 4, i = rho & 15; return 8 * (i >> 2) + 4 * n + (i & 3); }

struct Unit { int pm, pn; };
struct Gemm { const bf16_t* A; const bf16_t* Bt; int M, N, K, lda, ldb; };

struct StaticOrder {
    int nM, nN, nwg, G, c;
    __host__ __device__ void init(int M, int N, int G_, int c_) { nM = M / BM; nN = N / BM; nwg = nM * nN; G = G_; c = c_; }
    __host__ __device__ bool next(int i, Unit& u) const {
        const long L = (long)i * G + c; if (L >= nwg) return false;
        int wgid = (int)L; { const int q = nwg / NXCD, r = nwg % NXCD, xcd = wgid % NXCD, off = wgid / NXCD; wgid = (xcd < r ? xcd * (q + 1) : r * (q + 1) + (xcd - r) * q) + off; }
        const int nig = WGM * nN, gid = wgid / nig, fm = gid * WGM, gsz = (nM - fm) < WGM ? (nM - fm) : WGM;
        u.pm = fm + ((wgid % nig) % gsz); u.pn = (wgid % nig) / gsz; return true;
    }
    __device__ __forceinline__ void a_ready(const Unit&) const {}
    __device__ __forceinline__ void done(const Unit&) const {}
};

struct GroupOrder {
    int nwg, G, c, um, un;
    __host__ __device__ void init(int ngroups, int um_, int un_, int G_, int c_) { um = um_; un = un_; nwg = ngroups * um * un; G = G_; c = (c_ & 7) * (G_ >> 3) + (c_ >> 3); }
    __host__ __device__ bool next(int i, Unit& u) const {
        const int L = i * G + c; if (L >= nwg) return false;
        const int gi = L / (um * un), r = L % (um * un); u.pm = gi * um + r / un; u.pn = gi * un + r % un; return true;
    }
    __device__ __forceinline__ void a_ready(const Unit&) const {}
    __device__ __forceinline__ void done(const Unit&) const {}
};
template <class Epi, class Sched, bool ALIGN_EPI = false, bool SP2 = false>
__device__ __forceinline__ void gemm_phase(PG8_LAS unsigned char* lds, const int tix, const Gemm g, const Sched& S, const Epi& E) {
    const int tid = tix, wid = __builtin_amdgcn_readfirstlane(tid >> 6), lane = tid & 63, wr = wid >> 2, wc = wid & 3, fr = lane & 15, fq = lane >> 4;
    const int K = g.K, nt = K / BK;
    unsigned voffA[2], voffB[2];
#pragma unroll
    for (int i = 0; i < 2; ++i) { int R, C; stage_rc(tid * 16 + i * 8192, R, C); const int Rb = Epi::PERM ? ((R & ~31) + perm32(R & 31)) : R;
        voffA[i] = (unsigned)(R * g.lda + C) * 2u; voffB[i] = (unsigned)(Rb * g.ldb + C) * 2u; }
    const size_t kstep = (size_t)(BK * 2);
    const size_t hstepA = (size_t)HALF * g.lda * 2, hstepB = (size_t)HALF * g.ldb * 2;
    const size_t tstepA = 2 * hstepA, tstepB = 2 * hstepB;
    const unsigned ldsw = (unsigned)wid * 1024u;
    const int aoff = lds_byte(wr * 64 + fr, fq * 8), boff = lds_byte(wc * 32 + fr, fq * 8);
#define PG8_SA(b, h) (((b) * 2 + (h)) * HTB)
#define PG8_SB(b, h) ((4 + (b) * 2 + (h)) * HTB)
#define PG8_STAGE(bufoff, gbase, voff) do { _Pragma("unroll") for (int _i = 0; _i < 2; ++_i) \
        __builtin_amdgcn_global_load_lds((const unsigned*)((const char*)(gbase) + (voff)[_i]), (PG8_LAS unsigned*)(lds + (bufoff) + ldsw + _i * 8192), 16, 0, 0); } while (0)
#define PG8_LDA(dst, b, h) do { _Pragma("unroll") for (int m = 0; m < 4; ++m) _Pragma("unroll") for (int k = 0; k < 2; ++k) dst[m][k] = *(const PG8_LAS bf16x8*)(lds + PG8_SA(b, h) + aoff + m * 2048 + k * 1024); } while (0)
#define PG8_LDB(dst, b, h) do { _Pragma("unroll") for (int n = 0; n < 2; ++n) _Pragma("unroll") for (int k = 0; k < 2; ++k) dst[n][k] = *(const PG8_LAS bf16x8*)(lds + PG8_SB(b, h) + boff + n * 2048 + k * 1024); } while (0)
#define PG8_MMA(ai, bj, At, Bt) do { __builtin_amdgcn_s_setprio(1); _Pragma("unroll") for (int m = 0; m < 4; ++m) _Pragma("unroll") for (int n = 0; n < 2; ++n) _Pragma("unroll") for (int k = 0; k < 2; ++k) \
        acc[ai][bj][m][n] = __builtin_amdgcn_mfma_f32_16x16x32_bf16(Bt[n][k], At[m][k], acc[ai][bj][m][n], 0, 0, 0); __builtin_amdgcn_s_setprio(0); } while (0)
#define PG8_WAIT_V(n) asm volatile("s_waitcnt vmcnt(" #n ")" ::: "memory")
#define PG8_WAIT_L(n) asm volatile("s_waitcnt lgkmcnt(" #n ")" ::: "memory")
#define PG8_BAR __builtin_amdgcn_s_barrier()
#define PG8_SCHED __builtin_amdgcn_sched_barrier(0)
    Unit cur, nxt; int ui = 0;
    if (!S.next(0, cur)) return;
    f32x4 acc[2][2][4][2];
#pragma unroll
    for (int a = 0; a < 2; ++a)
#pragma unroll
        for (int b = 0; b < 2; ++b)
#pragma unroll
            for (int m = 0; m < 4; ++m)
#pragma unroll
                for (int n = 0; n < 2; ++n) acc[a][b][m][n] = (f32x4){0.f, 0.f, 0.f, 0.f};
    bf16x8 At[4][2], B0[2][2], B1[2][2];
    const char* cA = (const char*)g.A + (size_t)cur.pm * tstepA; const char* cB = (const char*)g.Bt + (size_t)cur.pn * tstepB;
    S.a_ready(cur);
    if constexpr (SP2) {
        PG8_STAGE(PG8_SB(0, 0), cB, voffB); PG8_STAGE(PG8_SB(0, 1), cB + hstepB, voffB); PG8_STAGE(PG8_SA(0, 0), cA, voffA); PG8_STAGE(PG8_SA(0, 1), cA + hstepA, voffA);
        if (wr == 1) PG8_BAR;
        PG8_WAIT_V(2); PG8_BAR;
        PG8_STAGE(PG8_SB(1, 0), cB + kstep, voffB); PG8_STAGE(PG8_SA(1, 0), cA + kstep, voffA); PG8_STAGE(PG8_SB(1, 1), cB + hstepB + kstep, voffB);
        PG8_WAIT_V(6); PG8_BAR;
    } else {
        PG8_STAGE(PG8_SB(0, 0), cB, voffB); PG8_STAGE(PG8_SA(0, 0), cA, voffA); PG8_STAGE(PG8_SB(0, 1), cB + hstepB, voffB); PG8_STAGE(PG8_SA(0, 1), cA + hstepA, voffA);
        if (wr == 1) PG8_BAR;
        PG8_WAIT_V(4); PG8_BAR;
        PG8_STAGE(PG8_SB(1, 0), cB + kstep, voffB); PG8_STAGE(PG8_SA(1, 0), cA + kstep, voffA); PG8_STAGE(PG8_SB(1, 1), cB + hstepB + kstep, voffB);
        PG8_WAIT_V(6); PG8_BAR;
    }
    for (;;) {
        const bool has_next = S.next(ui + 1, nxt);
        const char* nA = has_next ? (const char*)g.A + (size_t)nxt.pm * tstepA : cA; const char* nB = has_next ? (const char*)g.Bt + (size_t)nxt.pn * tstepB : cB;
        for (int t = 0; t < nt; t += 2) {
            if constexpr (Epi::KHOOK) { if (t == Epi::KH_T) E.khook(acc, ui, wr, fr, lds); }
            const bool last = (t == nt - 2);
            const char* a1 = cA + (size_t)(t + 1) * kstep;
            const char* a2 = last ? nA : cA + (size_t)(t + 2) * kstep; const char* b2 = last ? nB : cB + (size_t)(t + 2) * kstep;
            const char* a3 = a2 + kstep; const char* b3 = b2 + kstep;
            if (last && has_next) S.a_ready(nxt);
            if constexpr (SP2) {
            PG8_LDB(B0, 0, 0); PG8_LDB(B1, 0, 1); PG8_SCHED; PG8_LDA(At, 0, 0); PG8_STAGE(PG8_SA(1, 1), a1 + hstepA, voffA);
            PG8_WAIT_V(8); PG8_WAIT_L(0); PG8_BAR; PG8_MMA(0, 0, At, B0); PG8_MMA(0, 1, At, B1); PG8_BAR; PG8_SCHED;
            PG8_LDA(At, 0, 1); PG8_STAGE(PG8_SB(0, 0), b2, voffB); PG8_STAGE(PG8_SB(0, 1), b2 + hstepB, voffB); PG8_STAGE(PG8_SA(0, 0), a2, voffA);
            PG8_WAIT_V(8); PG8_WAIT_L(0); PG8_BAR; PG8_MMA(1, 0, At, B0); PG8_MMA(1, 1, At, B1); PG8_BAR; PG8_SCHED;
            PG8_LDB(B0, 1, 0); PG8_LDB(B1, 1, 1); PG8_SCHED; PG8_LDA(At, 1, 0); PG8_STAGE(PG8_SA(0, 1), a2 + hstepA, voffA);
            PG8_WAIT_V(8); PG8_WAIT_L(0); PG8_BAR; PG8_MMA(0, 0, At, B0); PG8_MMA(0, 1, At, B1); PG8_BAR; PG8_SCHED;
            PG8_LDA(At, 1, 1); PG8_STAGE(PG8_SB(1, 0), b3, voffB); PG8_STAGE(PG8_SB(1, 1), b3 + hstepB, voffB); PG8_STAGE(PG8_SA(1, 0), a3, voffA);
            PG8_WAIT_V(8); PG8_WAIT_L(0); PG8_BAR; PG8_MMA(1, 0, At, B0); PG8_MMA(1, 1, At, B1); PG8_BAR; PG8_SCHED;
            } else {
            PG8_LDB(B0, 0, 0); PG8_SCHED; PG8_LDA(At, 0, 0); PG8_STAGE(PG8_SA(1, 1), a1 + hstepA, voffA);
            PG8_WAIT_L(8); PG8_BAR; PG8_WAIT_L(0); PG8_MMA(0, 0, At, B0); PG8_BAR; PG8_SCHED;
            PG8_LDB(B1, 0, 1); PG8_STAGE(PG8_SB(0, 0), b2, voffB);
            PG8_BAR; PG8_WAIT_L(0); PG8_MMA(0, 1, At, B1); PG8_BAR;
            PG8_LDA(At, 0, 1); PG8_STAGE(PG8_SA(0, 0), a2, voffA);
            PG8_BAR; PG8_WAIT_L(0); PG8_MMA(1, 0, At, B0); PG8_BAR; PG8_SCHED;
            PG8_STAGE(PG8_SB(0, 1), b2 + hstepB, voffB);
            PG8_WAIT_V(6); PG8_BAR; PG8_MMA(1, 1, At, B1); PG8_BAR;
            PG8_LDB(B0, 1, 0); PG8_SCHED; PG8_LDA(At, 1, 0); PG8_STAGE(PG8_SA(0, 1), a2 + hstepA, voffA);
            PG8_WAIT_L(8); PG8_BAR; PG8_WAIT_L(0); PG8_MMA(0, 0, At, B0); PG8_BAR; PG8_SCHED;
            PG8_LDB(B1, 1, 1); PG8_STAGE(PG8_SB(1, 0), b3, voffB);
            PG8_BAR; PG8_WAIT_L(0); PG8_MMA(0, 1, At, B1); PG8_BAR;
            PG8_LDA(At, 1, 1); PG8_STAGE(PG8_SA(1, 0), a3, voffA);
            PG8_BAR; PG8_WAIT_L(0); PG8_MMA(1, 0, At, B0); PG8_BAR; PG8_SCHED;
            PG8_STAGE(PG8_SB(1, 1), b3 + hstepB, voffB);
            PG8_WAIT_V(6); PG8_BAR; PG8_MMA(1, 1, At, B1); PG8_BAR;
            }
        }
        if constexpr (ALIGN_EPI) { if (wr == 0) PG8_BAR; }
        if constexpr (!Epi::AFTER_DRAIN) { E(acc, cur, wr, wc, fr, fq, ui); S.done(cur); }
        if (!has_next) break;
#pragma unroll
        for (int a = 0; a < 2; ++a)
#pragma unroll
            for (int b = 0; b < 2; ++b)
#pragma unroll
                for (int m = 0; m < 4; ++m)
#pragma unroll
                    for (int n = 0; n < 2; ++n) acc[a][b][m][n] = (f32x4){0.f, 0.f, 0.f, 0.f};
        cur = nxt; cA = nA; cB = nB; ++ui;
        if constexpr (ALIGN_EPI) { if (wr == 1) PG8_BAR; }
    }
    PG8_WAIT_V(0);
    if constexpr (!ALIGN_EPI) { if (wr == 0) PG8_BAR; }
    PG8_BAR;
    if constexpr (Epi::AFTER_DRAIN) { E.fused(acc, cur, wr, wc, fr, fq, lds, wid, lane); S.done(cur); }
#undef PG8_SA
#undef PG8_SB
#undef PG8_STAGE
#undef PG8_LDA
#undef PG8_LDB
#undef PG8_MMA
#undef PG8_WAIT_V
#undef PG8_WAIT_L
#undef PG8_BAR
#undef PG8_SCHED
}
}

namespace pg8 {
struct EpiMlpIn {
  static constexpr bool PERM = true, AFTER_DRAIN = false, KHOOK = false; static constexpr int KH_T = 0;
  ::bf16_t* O; const float* bias;
  __device__ __forceinline__ void operator()(const f32x4 (&acc)[2][2][4][2], const Unit& u, int wr, int wc, int fr, int fq, int) const {
    const int row0 = u.pm * BM + wr * 64 + fr, col0 = u.pn * BM + wc * 32 + 8 * fq;
    f32x4 bv[2][2];
#pragma unroll
    for (int bj = 0; bj < 2; ++bj)
#pragma unroll
      for (int n = 0; n < 2; ++n) bv[bj][n] = *(const f32x4*)(bias + col0 + bj * HALF + 4 * n);
#pragma unroll
    for (int ai = 0; ai < 2; ++ai)
#pragma unroll
      for (int m = 0; m < 4; ++m) {
        ::bf16_t* rowp = O + (size_t)(row0 + ai * HALF + m * 16) * 4096 + col0;
#pragma unroll
        for (int bj = 0; bj < 2; ++bj) {
          f32x4 v0 = acc[ai][bj][m][0] + bv[bj][0], v1 = acc[ai][bj][m][1] + bv[bj][1];
#pragma unroll
          for (int e = 0; e < 4; ++e) { const float a = fmaxf(v0[e], 0.f), b = fmaxf(v1[e], 0.f); v0[e] = a * a; v1[e] = b * b; }
          u32x4 w; w.x = pk2(v0[0], v0[1]); w.y = pk2(v0[2], v0[3]); w.z = pk2(v1[0], v1[1]); w.w = pk2(v1[2], v1[3]);
          *(u32x4*)(rowp + bj * HALF) = w;
        }
      }
  }
};
struct EpiMlpOut {
  static constexpr bool PERM = false, AFTER_DRAIN = false, KHOOK = false; static constexpr int KH_T = 0;
  float* out; const float* mod; const float* bias;
  __device__ __forceinline__ void operator()(const f32x4 (&acc)[2][2][4][2], const Unit& u, int wr, int wc, int fr, int fq, int) const {
    const int col0 = u.pn * BM + wc * 32 + 4 * fq;
#pragma unroll
    for (int ai = 0; ai < 2; ++ai)
#pragma unroll
      for (int m = 0; m < 4; ++m) {
        const int row = u.pm * BM + ai * HALF + wr * 64 + m * 16 + fr;
        const float* g2 = mod + batch_of(row) * 6144 + 5120;
        float* xr = out + (size_t)row * 1024;
#pragma unroll
        for (int bj = 0; bj < 2; ++bj)
#pragma unroll
          for (int n = 0; n < 2; ++n) {
            const int col = col0 + bj * HALF + n * 16;
            const f32x4 xv = *(const f32x4*)(xr + col), gv = *(const f32x4*)(g2 + col), bb = *(const f32x4*)(bias + col);
            *(f32x4*)(xr + col) = xv + gv * (acc[ai][bj][m][n] + bb);
          }
      }
  }
};
struct EpiYf {
  static constexpr bool PERM = true, AFTER_DRAIN = false, KHOOK = false; static constexpr int KH_T = 0;
  ::bf16_t* O; const float* bias; float* ss;
  __device__ __forceinline__ void operator()(const f32x4 (&acc)[2][2][4][2], const Unit& u, int wr, int wc, int fr, int fq, int) const {
    const int row0 = u.pm * BM + wr * 64 + fr, col0 = u.pn * BM + wc * 32 + 8 * fq;
    f32x4 bv[2][2];
#pragma unroll
    for (int bj = 0; bj < 2; ++bj)
#pragma unroll
      for (int n = 0; n < 2; ++n) bv[bj][n] = *(const f32x4*)(bias + col0 + bj * HALF + 4 * n);
#pragma unroll
    for (int ai = 0; ai < 2; ++ai)
#pragma unroll
      for (int m = 0; m < 4; ++m) {
        const int row = row0 + ai * HALF + m * 16;
        const float scale = row < LPR ? 3.4526698300124393e-4f : 6.905339660024879e-4f;
        ::bf16_t* rowp = O + (size_t)row * 1024 + col0;
        float s = 0.f;
#pragma unroll
        for (int bj = 0; bj < 2; ++bj) {
          const f32x4 v0 = acc[ai][bj][m][0] * scale + bv[bj][0], v1 = acc[ai][bj][m][1] * scale + bv[bj][1];
          s += (v0[0] * v0[0] + v0[1] * v0[1]) + (v0[2] * v0[2] + v0[3] * v0[3]) + (v1[0] * v1[0] + v1[1] * v1[1]) + (v1[2] * v1[2] + v1[3] * v1[3]);
          u32x4 w; w.x = pk2(v0[0], v0[1]); w.y = pk2(v0[2], v0[3]); w.z = pk2(v1[0], v1[1]); w.w = pk2(v1[2], v1[3]);
          *(u32x4*)(rowp + bj * HALF) = w;
        }
        s += __shfl_xor(s, 16); s += __shfl_xor(s, 32);
        if (fq == 0) ss[row * 8 + u.pn * 4 + wc] = s;
      }
  }
};
struct EpiGlu {
  static constexpr bool PERM = true, AFTER_DRAIN = false, KHOOK = false; static constexpr int KH_T = 0;
  ::bf16_t* O; const float* bias; float* ss;
  __device__ __forceinline__ void operator()(const f32x4 (&acc)[2][2][4][2], const Unit& u, int wr, int wc, int fr, int fq, int) const {
    const int row0 = u.pm * BM + wr * 64 + fr, j0 = u.pn * 128 + wc * 32 + 8 * fq;
    f32x4 bv[2][2];
#pragma unroll
    for (int bj = 0; bj < 2; ++bj)
#pragma unroll
      for (int n = 0; n < 2; ++n) bv[bj][n] = *(const f32x4*)(bias + bj * 512 + j0 + 4 * n);
#pragma unroll
    for (int ai = 0; ai < 2; ++ai)
#pragma unroll
      for (int m = 0; m < 4; ++m) {
        const int row = row0 + ai * HALF + m * 16;
        float o[8], s = 0.f;
#pragma unroll
        for (int n = 0; n < 2; ++n)
#pragma unroll
          for (int e = 0; e < 4; ++e) {
            const float val = acc[ai][0][m][n][e] + bv[0][n][e], gate = acc[ai][1][m][n][e] + bv[1][n][e];
            const float y = val / (1.f + __expf(-gate));
            o[4 * n + e] = y; s += y * y;
          }
        u32x4 w; w.x = pk2(o[0], o[1]); w.y = pk2(o[2], o[3]); w.z = pk2(o[4], o[5]); w.w = pk2(o[6], o[7]);
        *(u32x4*)(O + (size_t)row * 1024 + 512 + j0) = w;
        s += __shfl_xor(s, 16); s += __shfl_xor(s, 32);
        if (fq == 0) ss[row * 16 + u.pn * 4 + wc] = s;
      }
  }
};
struct EpiZt {
  static constexpr bool PERM = true, AFTER_DRAIN = false, KHOOK = false; static constexpr int KH_T = 0;
  ::bf16_t* O;
  __device__ __forceinline__ void operator()(const f32x4 (&acc)[2][2][4][2], const Unit& u, int wr, int wc, int fr, int fq, int) const {
    const int v0 = u.pn * BM;
    ::bf16_t* base; size_t ld;
    if (v0 < LPR) { base = O + v0; ld = LPR; }
    else { const int vs = v0 - LPR; base = O + (size_t)512 * LPR + (size_t)(vs >> 12) * 512 * 4096 + (vs & 4095); ld = 4096; }
    const int c0 = u.pm * BM + wr * 64 + fr, col0 = wc * 32 + 8 * fq;
#pragma unroll
    for (int ai = 0; ai < 2; ++ai)
#pragma unroll
      for (int m = 0; m < 4; ++m) {
        ::bf16_t* rowp = base + (size_t)(c0 + ai * HALF + m * 16) * ld + col0;
#pragma unroll
        for (int bj = 0; bj < 2; ++bj) {
          const f32x4 a = acc[ai][bj][m][0], b = acc[ai][bj][m][1];
          u32x4 w; w.x = pk2(a[0], a[1]); w.y = pk2(a[2], a[3]); w.z = pk2(b[0], b[1]); w.w = pk2(b[2], b[3]);
          *(u32x4*)(rowp + bj * HALF) = w;
        }
      }
  }
};
struct EpiZs {
  static constexpr bool PERM = true, AFTER_DRAIN = false, KHOOK = false; static constexpr int KH_T = 0;
  ::bf16_t* O;
  __device__ __forceinline__ void operator()(const f32x4 (&acc)[2][2][4][2], const Unit& u, int wr, int wc, int fr, int fq, int) const {
    const int r0 = u.pm * BM + wr * 64 + fr, col0 = u.pn * BM + wc * 32 + 8 * fq;
#pragma unroll
    for (int ai = 0; ai < 2; ++ai)
#pragma unroll
      for (int m = 0; m < 4; ++m) {
        const int tok = permtok(r0 + ai * HALF + m * 16);
#pragma unroll
        for (int bj = 0; bj < 2; ++bj) {
          const int col = col0 + bj * HALF;
          const f32x4 a = acc[ai][bj][m][0], b = acc[ai][bj][m][1];
          u32x4 w; w.x = pk2(a[0], a[1]); w.y = pk2(a[2], a[3]); w.z = pk2(b[0], b[1]); w.w = pk2(b[2], b[3]);
          *(u32x4*)(O + ((size_t)(col >> 4) * 1280 + (tok >> 6)) * 1280 + (tok & 63) * 16 + (col & 15)) = w;
        }
      }
  }
};
struct EpiS {
  static constexpr bool PERM = false, AFTER_DRAIN = false, KHOOK = false; static constexpr int KH_T = 0;
  float* O;
  __device__ __forceinline__ void operator()(const f32x4 (&acc)[2][2][4][2], const Unit& u, int wr, int wc, int fr, int fq, int) const {
#pragma unroll
    for (int ai = 0; ai < 2; ++ai)
#pragma unroll
      for (int m = 0; m < 4; ++m) {
        float* rowp = O + (size_t)(u.pm * BM + ai * HALF + wr * 64 + m * 16 + fr) * 256 + wc * 32 + 4 * fq;
#pragma unroll
        for (int bj = 0; bj < 2; ++bj)
#pragma unroll
          for (int n = 0; n < 2; ++n) *(f32x4*)(rowp + bj * HALF + n * 16) = acc[ai][bj][m][n];
      }
  }
};
struct EpiGelu {
  static constexpr bool PERM = true, AFTER_DRAIN = false, KHOOK = false; static constexpr int KH_T = 0;
  ::bf16_t* O;
  __device__ __forceinline__ void operator()(const f32x4 (&acc)[2][2][4][2], const Unit& u, int wr, int wc, int fr, int fq, int) const {
    const int gi = u.pn >> 2, n0 = (u.pn & 3) * BM + wc * 32 + 8 * fq, ch0 = u.pm * BM - gi * 1280 + wr * 64 + fr;
#pragma unroll
    for (int ai = 0; ai < 2; ++ai)
#pragma unroll
      for (int m = 0; m < 4; ++m) {
        const int ch = ch0 + ai * HALF + m * 16;
#pragma unroll
        for (int bj = 0; bj < 2; ++bj) {
          const int n = n0 + bj * HALF;
          float o[8];
#pragma unroll
          for (int e = 0; e < 4; ++e) { o[e] = gelu_tanh(acc[ai][bj][m][0][e]); o[4 + e] = gelu_tanh(acc[ai][bj][m][1][e]); }
          u32x4 w; w.x = pk2(o[0], o[1]); w.y = pk2(o[2], o[3]); w.z = pk2(o[4], o[5]); w.w = pk2(o[6], o[7]);
          *(u32x4*)(O + (size_t)(ch * 64 + (n >> 4)) * 512 + gi * 16 + (n & 15)) = w;
        }
      }
  }
};
struct EpiWout {
  static constexpr bool PERM = false, AFTER_DRAIN = false, KHOOK = true; static constexpr int KH_T = 8;
  float* out; const float* xp; const float* xs; const float* mod;
  __device__ __forceinline__ void khook(f32x4 (&acc)[2][2][4][2], int ui, int wr, int fr, PG8_LAS unsigned char* lds) const {
    typedef float f32x2t __attribute__((ext_vector_type(2)));
    const PG8_LAS f32x2t* tab = (const PG8_LAS f32x2t*)(lds + 131072) + ui * 256;
#pragma unroll
    for (int ai = 0; ai < 2; ++ai)
#pragma unroll
      for (int m = 0; m < 4; ++m) {
        const float r = tab[ai * HALF + wr * 64 + m * 16 + fr].x;
#pragma unroll
        for (int bj = 0; bj < 2; ++bj)
#pragma unroll
          for (int n = 0; n < 2; ++n) acc[ai][bj][m][n] *= r;
      }
  }
  __device__ __forceinline__ void operator()(const f32x4 (&acc)[2][2][4][2], const Unit& u, int wr, int wc, int fr, int fq, int ui) const {
    typedef float f32x2t __attribute__((ext_vector_type(2)));
    const PG8_LAS f32x2t* tab = (const PG8_LAS f32x2t*)((PG8_LAS unsigned char*)dyn_smem + 131072) + ui * 256;
    const int col0 = u.pn * BM + wc * 32 + 4 * fq;
#pragma unroll
    for (int ai = 0; ai < 2; ++ai)
#pragma unroll
      for (int m = 0; m < 4; ++m) {
        const int rl = ai * HALF + wr * 64 + m * 16 + fr, row = u.pm * BM + rl;
        const float rs = tab[rl].y;
        const float* g1 = mod + batch_of(row) * 6144 + 2048;
        const float* xr = row < LPR ? xp + (size_t)row * 1024 : xs + (size_t)(row - LPR) * 1024;
        float* orow = out + (size_t)row * 1024;
#pragma unroll
        for (int bj = 0; bj < 2; ++bj)
#pragma unroll
          for (int n = 0; n < 2; ++n) {
            const int col = col0 + bj * HALF + n * 16;
            const f32x4 xv = *(const f32x4*)(xr + col), gv = *(const f32x4*)(g1 + col);
            *(f32x4*)(orow + col) = xv + gv * (acc[ai][bj][m][n] * rs);
          }
      }
  }
};
}

DI void phase2(const P& p) {
  {
    const pg8::Gemm g{p.wint(), p.hb(), 512, NTOK, 1024, 1024, 1024};
    pg8::StaticOrder S; S.init(512, NTOK, (int)gridDim.x, (int)blockIdx.x);
    const pg8::EpiZt E{p.zT()};
    pg8::gemm_phase<pg8::EpiZt, pg8::StaticOrder, true, true>((PG8_LAS unsigned char*)dyn_smem, otid(), g, S, E);
  }
  {
    const pg8::Gemm g{p.hb(), p.wint() + (size_t)512 * 1024, NTOK, 512, 1024, 1024, 1024};
    pg8::StaticOrder S; S.init(NTOK, 512, (int)gridDim.x, (int)(gridDim.x - 1 - blockIdx.x));
    const pg8::EpiZs E{p.Ucat()};
    pg8::gemm_phase<pg8::EpiZs, pg8::StaticOrder, true, true>((PG8_LAS unsigned char*)dyn_smem, otid(), g, S, E);
  }
}
DI void phase3(const P& p) {
  {
    const pg8::Gemm g{p.Ucat(), p.Bs(), 32 * 1280, 32 * 256, 1024, 1280, 1024};
    pg8::GroupOrder S; S.init(32, 5, 1, (int)gridDim.x, (int)blockIdx.x);
    const pg8::EpiS E{p.S()};
    pg8::gemm_phase<pg8::EpiS, pg8::GroupOrder, true, true>((PG8_LAS unsigned char*)dyn_smem, otid(), g, S, E);
  }
  GEO
  bf16_t* sm = (bf16_t*)(dyn_smem + half * SMEM_HALF);
  const int G = (int)gridDim.x, slot = ((int)blockIdx.x & 7) * (G >> 3) + ((int)blockIdx.x >> 3);
  const int nbusy = 160 < G ? 160 : G, nfree = G - nbusy;
  int q0, qs, qe;
  if (nfree <= 0) { q0 = slot; qs = G; qe = 2560; }
  else if (slot < nbusy) { q0 = slot; qs = nbusy; qe = nbusy * 9; }
  else { q0 = nbusy * 9 + (slot - nbusy); qs = nfree; qe = 2560; }
  for (int q = q0; q < qe; q += qs) {
    const int t = 2 * q + half;
    if (t < 1024) fft1_tile<128>(p, sm, t >> 1, t & 1);
    else fft1_tile<64>(p, sm, t - 1024, 0);
  }
}
DI void phase5(const P& p) {
  const pg8::Gemm g{p.Ucat(), p.Tcat(), 32 * 1280, 32 * 1024, 1280, 1280, 1280};
  pg8::GroupOrder S; S.init(32, 5, 4, (int)gridDim.x, (int)blockIdx.x);
  const pg8::EpiGelu E{p.gact()};
  pg8::gemm_phase<pg8::EpiGelu, pg8::GroupOrder, true, true>((PG8_LAS unsigned char*)dyn_smem, otid(), g, S, E);
}
DI void phase6(const P& p) {
  {
    const pg8::Gemm g{p.AF(), p.Mf(), NTOK, 512, 1024, 1024, 1024};
    pg8::StaticOrder S; S.init(NTOK, 512, (int)gridDim.x, (int)blockIdx.x);
    const pg8::EpiYf E{p.mg(), p.b_f, p.ssf()};
    pg8::gemm_phase<pg8::EpiYf, pg8::StaticOrder, true, true>((PG8_LAS unsigned char*)dyn_smem, otid(), g, S, E);
  }
  {
    const pg8::Gemm g{p.gact(), p.wglut(), NTOK, 1024, 512, 512, 512};
    pg8::StaticOrder S; S.init(NTOK, 1024, (int)gridDim.x, (int)(gridDim.x - 1 - blockIdx.x));
    const pg8::EpiGlu E{p.mg(), p.b_glu, p.sss()};
    pg8::gemm_phase<pg8::EpiGlu, pg8::StaticOrder, true, true>((PG8_LAS unsigned char*)dyn_smem, otid(), g, S, E);
  }
}
DI void phase7(const P& p) {
  const pg8::Gemm g{p.mg(), p.woutt(), NTOK, 1024, 1024, 1024, 1024};
  pg8::StaticOrder S; S.init(NTOK, 1024, (int)gridDim.x, (int)blockIdx.x);
  {
    typedef float f32x2t __attribute__((ext_vector_type(2)));
    PG8_LAS f32x2t* tab = (PG8_LAS f32x2t*)((PG8_LAS unsigned char*)dyn_smem + 131072);
    const int tix7 = otid();
    pg8::Unit u;
    for (int i = 0; i < 8 && S.next(i, u); ++i) {
      if (tix7 < 256) {
        const int tok = u.pm * 256 + tix7;
        float sf = 0.f, s2 = 0.f;
#pragma unroll
        for (int j = 0; j < 8; j++) sf += p.ssf()[tok * 8 + j];
#pragma unroll
        for (int j = 0; j < 16; j++) s2 += p.sss()[tok * 16 + j];
        const float rf = rsqrtf(sf * (1.f / 512.f) + EPSV), rs = rsqrtf(s2 * (1.f / 512.f) + EPSV);
        tab[i * 256 + tix7] = (f32x2t){rf / rs, rs};
      }
    }
    __syncthreads();
  }
  const pg8::EpiWout E{p.out, p.xp, p.xs, p.mod()};
  pg8::gemm_phase<pg8::EpiWout, pg8::StaticOrder, true, true>((PG8_LAS unsigned char*)dyn_smem, otid(), g, S, E);
}
DI void phase8(const P& p) {
  const pg8::Gemm g{p.hb(), p.w1t(), NTOK, 4096, 1024, 1024, 1024};
  pg8::StaticOrder S; S.init(NTOK, 4096, (int)gridDim.x, (int)blockIdx.x);
  const pg8::EpiMlpIn E{p.hid(), p.b1};
  pg8::gemm_phase<pg8::EpiMlpIn, pg8::StaticOrder, true, true>((PG8_LAS unsigned char*)dyn_smem, otid(), g, S, E);
}
DI void phase9(const P& p) {
  const pg8::Gemm g{p.hid(), p.w2t(), NTOK, 1024, 4096, 4096, 4096};
  pg8::StaticOrder S; S.init(NTOK, 1024, (int)gridDim.x, (int)blockIdx.x);
  const pg8::EpiMlpOut E{p.out, p.mod(), p.b2};
  pg8::gemm_phase<pg8::EpiMlpOut, pg8::StaticOrder, true, true>((PG8_LAS unsigned char*)dyn_smem, otid(), g, S, E);
}

__global__ void __launch_bounds__(512, 2) k_mega(P p) {
  cg::grid_group grid = cg::this_grid();
  phase0(p); grid.sync();
  rownorm_mod(p, true, p.g_mix, 0, 1024); grid.sync();
  phase2(p); grid.sync();
  phase3(p); grid.sync();
  phase4(p); grid.sync();
  phase5(p); grid.sync();
  phase6(p); grid.sync();
  phase7(p); grid.sync();
  rownorm_mod(p, false, p.g_mlp, 3072, 4096); grid.sync();
  phase8(p); grid.sync();
  phase9(p); grid.sync();
  final_norm(p);
}

extern "C" void kernel_launch(void* const* d_in, const int* in_sizes, int n_in, void* d_out, int out_size, void* d_ws, size_t ws_size,
                              hipStream_t stream) {
  P p{};
  const float** f = (const float**)&p;
  for (int i = 0; i < 29; i++) f[i] = (const float*)d_in[i];
  p.out = (float*)d_out;
  p.ws = (char*)d_ws;
  if (WS_NEED > ws_size) { fprintf(stderr, "workspace too small: need %zu have %zu\n", (size_t)WS_NEED, ws_size); return; }
  static int grid_blocks = 0;
  if (!grid_blocks) {
    int dev = 0, cus = 0, per_cu = 0;
    (void)hipGetDevice(&dev);
    (void)hipDeviceGetAttribute(&cus, hipDeviceAttributeMultiprocessorCount, dev);
    (void)hipFuncSetAttribute((const void*)k_mega, hipFuncAttributeMaxDynamicSharedMemorySize, SMEM_BYTES);
    (void)hipOccupancyMaxActiveBlocksPerMultiprocessor(&per_cu, k_mega, 512, SMEM_BYTES);
    if (per_cu < 1) per_cu = 1;
    grid_blocks = cus * per_cu;
  }
  void* args[] = {&p};
  hipError_t e = hipLaunchCooperativeKernel((void*)k_mega, dim3(grid_blocks), dim3(512), args, SMEM_BYTES, stream);
  if (e != hipSuccess) fprintf(stderr, "cooperative launch failed: %s (grid %d)\n", hipGetErrorString(e), grid_blocks);
}
```

```cpp
#include <hip/hip_runtime.h>
#include <hip/hip_cooperative_groups.h>
#include <stdint.h>
#include <stdio.h>
namespace cg = cooperative_groups;


#define DI __device__ __forceinline__
typedef unsigned short bf16_t;
typedef short bf16x8 __attribute__((ext_vector_type(8)));
typedef float f32x16 __attribute__((ext_vector_type(16)));
typedef float f32x4 __attribute__((ext_vector_type(4)));

constexpr int NTOK = 81920, LPR = 16384, LSM = 4096;
constexpr int BM = 128, BN = 128, BK = 64, LDSS = 72, TLD = 136;
constexpr int SMEM_HALF = 2 * 2 * BM * LDSS * 2;
constexpr int SMEM_BYTES = 2 * SMEM_HALF;
constexpr float EPSV = 1e-6f;

constexpr size_t al256(size_t x) { return (x + 255) & ~(size_t)255; }
constexpr size_t O_mod = 0;
constexpr size_t O_AT = O_mod + al256(17 * 6144 * 4);
constexpr size_t O_ssf = O_AT + al256(32 * 2 * 64 * 2 * 4);
constexpr size_t O_sss = O_ssf + al256((size_t)NTOK * 8 * 4);
constexpr size_t O_twp = O_sss + al256((size_t)NTOK * 16 * 4);
constexpr size_t O_tws = O_twp + al256(LPR * 8);
constexpr size_t O_wint = O_tws + al256(LSM * 8);
constexpr size_t O_wglut = O_wint + al256(1024 * 1024 * 2);
constexpr size_t O_woutt = O_wglut + al256(1024 * 512 * 2);
constexpr size_t O_w1t = O_woutt + al256(1024 * 1024 * 2);
constexpr size_t O_w2t = O_w1t + al256((size_t)4096 * 1024 * 2);
constexpr size_t O_Mf = O_w2t + al256((size_t)4096 * 1024 * 2);
constexpr size_t O_F1p = O_Mf + al256(512 * 1024 * 2);
constexpr size_t O_F1s = O_F1p + al256(256 * 128 * 2);
constexpr size_t O_F2p = O_F1s + al256(128 * 64 * 2);
constexpr size_t O_F2s = O_F2p + al256(256 * 256 * 2);
constexpr size_t O_Bs = O_F2s + al256(128 * 128 * 2);
constexpr size_t O_Tcat = O_Bs + al256((size_t)32 * 256 * 1024 * 2);
constexpr size_t O_hb = O_Tcat + al256((size_t)32 * 1024 * 1280 * 2);
constexpr size_t O_zT = O_hb + al256((size_t)NTOK * 1024 * 2);
constexpr size_t O_Ucat = O_zT + al256((size_t)NTOK * 512 * 2);
constexpr size_t O_AF = O_Ucat + al256((size_t)32 * 1280 * 1280 * 2);
constexpr size_t O_S = O_AF + al256((size_t)NTOK * 1024 * 2);
constexpr size_t O_gact = O_S + al256((size_t)1280 * 32 * 256 * 4);
constexpr size_t O_mg = O_gact + al256((size_t)NTOK * 512 * 2);
constexpr size_t O_END = O_mg + al256((size_t)NTOK * 1024 * 2);
constexpr size_t O_Tt = O_hb;
constexpr size_t O_hid = O_zT;
constexpr size_t WS_NEED = (O_hid + (size_t)NTOK * 4096 * 2 > O_END ? O_hid + (size_t)NTOK * 4096 * 2 : O_END);
struct P {
  const float *xp, *xs, *cp, *cs, *w_ada, *b_ada, *g_mix, *w_in, *w_f, *b_f, *a_re, *a_im, *log_dt, *b_re, *b_im, *c_re, *c_im,
      *ssm_d, *w_glu, *b_glu, *g_fo, *g_so, *w_out, *g_mlp, *w1, *b1, *w2, *b2, *g_final;
  float* out;
  char* ws;
  __device__ __forceinline__ float* mod() const { return (float*)(ws + O_mod); }
  __device__ __forceinline__ float* AT() const { return (float*)(ws + O_AT); }
  __device__ __forceinline__ float* ssf() const { return (float*)(ws + O_ssf); }
  __device__ __forceinline__ float* sss() const { return (float*)(ws + O_sss); }
  __device__ __forceinline__ float2* twp() const { return (float2*)(ws + O_twp); }
  __device__ __forceinline__ float2* tws() const { return (float2*)(ws + O_tws); }
  __device__ __forceinline__ bf16_t* wint() const { return (bf16_t*)(ws + O_wint); }
  __device__ __forceinline__ bf16_t* wglut() const { return (bf16_t*)(ws + O_wglut); }
  __device__ __forceinline__ bf16_t* woutt() const { return (bf16_t*)(ws + O_woutt); }
  __device__ __forceinline__ bf16_t* w1t() const { return (bf16_t*)(ws + O_w1t); }
  __device__ __forceinline__ bf16_t* w2t() const { return (bf16_t*)(ws + O_w2t); }
  __device__ __forceinline__ bf16_t* Mf() const { return (bf16_t*)(ws + O_Mf); }
  __device__ __forceinline__ bf16_t* F1p() const { return (bf16_t*)(ws + O_F1p); }
  __device__ __forceinline__ bf16_t* F1s() const { return (bf16_t*)(ws + O_F1s); }
  __device__ __forceinline__ bf16_t* F2p() const { return (bf16_t*)(ws + O_F2p); }
  __device__ __forceinline__ bf16_t* F2s() const { return (bf16_t*)(ws + O_F2s); }
  __device__ __forceinline__ bf16_t* Bs() const { return (bf16_t*)(ws + O_Bs); }
  __device__ __forceinline__ bf16_t* Tcat() const { return (bf16_t*)(ws + O_Tcat); }
  __device__ __forceinline__ bf16_t* Ucat() const { return (bf16_t*)(ws + O_Ucat); }
  __device__ __forceinline__ bf16_t* hb() const { return (bf16_t*)(ws + O_hb); }
  __device__ __forceinline__ bf16_t* zT() const { return (bf16_t*)(ws + O_zT); }
  __device__ __forceinline__ bf16_t* AF() const { return (bf16_t*)(ws + O_AF); }
  __device__ __forceinline__ float* S() const { return (float*)(ws + O_S); }
  __device__ __forceinline__ bf16_t* mg() const { return (bf16_t*)(ws + O_mg); }
  __device__ __forceinline__ bf16_t* gact() const { return (bf16_t*)(ws + O_gact); }
  __device__ __forceinline__ bf16_t* Tt() const { return (bf16_t*)(ws + O_Tt); }
  __device__ __forceinline__ bf16_t* hid() const { return (bf16_t*)(ws + O_hid); }
};

typedef float f32x2v __attribute__((ext_vector_type(2)));
typedef __bf16 bf16x2v __attribute__((ext_vector_type(2)));
DI uint32_t pk2(float lo, float hi) { const f32x2v v = {lo, hi}; const bf16x2v r = __builtin_convertvector(v, bf16x2v); return __builtin_bit_cast(uint32_t, r); }
DI bf16_t f2bf(float f) { return (bf16_t)(pk2(f, 0.f) & 0xffffu); }
extern __shared__ __attribute__((aligned(16))) unsigned char dyn_smem[];
DI int otid() { int t = (int)threadIdx.x; asm volatile("" : "+v"(t)); return t; }
DI int permtok(int v) {
  if (v < LPR) return ((v & 127) << 7) | (v >> 7);
  const int vs = v - LPR, w = vs & 4095;
  return LPR + (vs & ~4095) + ((w & 63) << 6) + (w >> 6);
}
DI int batch_of(int tok) { return tok < LPR ? 0 : 1 + ((tok - LPR) >> 12); }
DI float gelu_tanh(float x) {
  const float u = 0.7978845608028654f * (x + 0.044715f * x * x * x);
  return x / (1.f + __expf(-2.f * u));
}
DI float wave_sum(float v) {
  v += __shfl_xor(v, 32); v += __shfl_xor(v, 16); v += __shfl_xor(v, 8); v += __shfl_xor(v, 4); v += __shfl_xor(v, 2); v += __shfl_xor(v, 1);
  return v;
}

template <bool SWAP, class AF, class BF, class HK>
DI void gemm_main(bf16_t* sm, const int tid, int K, const AF& af, const BF& bf, const HK& hk, f32x16 (&acc)[2][2]) {
  const int lane = tid & 63, wid = tid >> 6, wm = wid >> 1, wn = wid & 1;
  const int kc = (tid & 7) * 8, rb = tid >> 3;
  bf16_t* As = sm;
  bf16_t* Bs = sm + 2 * BM * LDSS;
  uint4 ra[4], rv[4];
#pragma unroll
  for (int i = 0; i < 2; i++)
#pragma unroll
    for (int j = 0; j < 2; j++)
#pragma unroll
      for (int e = 0; e < 16; e++) acc[i][j][e] = 0.f;
  __syncthreads();
#pragma unroll
  for (int i = 0; i < 4; i++) { ra[i] = *(const uint4*)af(rb + 32 * i, kc); rv[i] = *(const uint4*)bf(rb + 32 * i, kc); }
#pragma unroll
  for (int i = 0; i < 4; i++) { *(uint4*)(As + (rb + 32 * i) * LDSS + kc) = ra[i]; *(uint4*)(Bs + (rb + 32 * i) * LDSS + kc) = rv[i]; }
  __syncthreads();
  const int nk = K / BK;
  for (int t = 0; t < nk; t++) {
    const int cur = t & 1;
    if (t + 1 < nk) {
      const int k = (t + 1) * BK + kc;
#pragma unroll
      for (int i = 0; i < 4; i++) { ra[i] = *(const uint4*)af(rb + 32 * i, k); rv[i] = *(const uint4*)bf(rb + 32 * i, k); }
    }
    hk(t, acc);
    const bf16_t* Ab = As + cur * BM * LDSS + (wm * 64 + (lane & 31)) * LDSS + (lane >> 5) * 8;
    const bf16_t* Bb = Bs + cur * BN * LDSS + (wn * 64 + (lane & 31)) * LDSS + (lane >> 5) * 8;
#pragma unroll
    for (int ks = 0; ks < 4; ks++) {
      const bf16x8 a0 = *(const bf16x8*)(Ab + ks * 16), a1 = *(const bf16x8*)(Ab + 32 * LDSS + ks * 16);
      const bf16x8 b0 = *(const bf16x8*)(Bb + ks * 16), b1 = *(const bf16x8*)(Bb + 32 * LDSS + ks * 16);
      if (SWAP) {
        acc[0][0] = __builtin_amdgcn_mfma_f32_32x32x16_bf16(b0, a0, acc[0][0], 0, 0, 0);
        acc[0][1] = __builtin_amdgcn_mfma_f32_32x32x16_bf16(b1, a0, acc[0][1], 0, 0, 0);
        acc[1][0] = __builtin_amdgcn_mfma_f32_32x32x16_bf16(b0, a1, acc[1][0], 0, 0, 0);
        acc[1][1] = __builtin_amdgcn_mfma_f32_32x32x16_bf16(b1, a1, acc[1][1], 0, 0, 0);
      } else {
        acc[0][0] = __builtin_amdgcn_mfma_f32_32x32x16_bf16(a0, b0, acc[0][0], 0, 0, 0);
        acc[0][1] = __builtin_amdgcn_mfma_f32_32x32x16_bf16(a0, b1, acc[0][1], 0, 0, 0);
        acc[1][0] = __builtin_amdgcn_mfma_f32_32x32x16_bf16(a1, b0, acc[1][0], 0, 0, 0);
        acc[1][1] = __builtin_amdgcn_mfma_f32_32x32x16_bf16(a1, b1, acc[1][1], 0, 0, 0);
      }
    }
    if (t + 1 < nk) {
      const int nb = cur ^ 1;
#pragma unroll
      for (int i = 0; i < 4; i++) {
        *(uint4*)(As + nb * BM * LDSS + (rb + 32 * i) * LDSS + kc) = ra[i];
        *(uint4*)(Bs + nb * BN * LDSS + (rb + 32 * i) * LDSS + kc) = rv[i];
      }
    }
    __syncthreads();
  }
}
struct NoHook { DI void operator()(int, f32x16 (&)[2][2]) const {} };

template <class EW, class DST>
DI void epi_transposed(bf16_t* sm, const int tid, f32x16 (&acc)[2][2], const EW& ew, const DST& dst) {
  const int lane = tid & 63, wid = tid >> 6, wm = wid >> 1, wn = wid & 1;
#pragma unroll
  for (int mi = 0; mi < 2; mi++)
#pragma unroll
    for (int g = 0; g < 4; g++) {
      const int ml = wm * 64 + mi * 32 + 8 * g + 4 * (lane >> 5);
      float v0[4], v1[4];
#pragma unroll
      for (int e = 0; e < 4; e++) { v0[e] = acc[mi][0][4 * g + e]; v1[e] = acc[mi][1][4 * g + e]; ew(mi, g, e, v0[e], v1[e]); }
      const int nl = wn * 64 + (lane & 31);
      uint2 w0, w1;
      w0.x = pk2(v0[0], v0[1]); w0.y = pk2(v0[2], v0[3]); w1.x = pk2(v1[0], v1[1]); w1.y = pk2(v1[2], v1[3]);
      *(uint2*)(sm + nl * TLD + ml) = w0;
      *(uint2*)(sm + (nl + 32) * TLD + ml) = w1;
    }
  __syncthreads();
  {
    const int nl = tid >> 1, r = tid & 1;
    bf16_t* d = dst(nl, r);
    const bf16_t* s = sm + nl * TLD + 64 * r;
#pragma unroll
    for (int i = 0; i < 8; i++) *(uint4*)(d + 8 * i) = *(const uint4*)(s + 8 * i);
  }
}

DI void ssm_pow(const P& p, int g, int dir, int pp, int j, float& re, float& im) {
  const int ia = (dir * 32 + g) * 64 + pp;
  const float lr = fminf(p.a_re[ia], -1e-4f), li = p.a_im[ia], dt = expf(p.log_dt[dir * 32 + g]);
  const float mag = expf(lr * dt * (float)j);
  double t = (double)li * (double)dt * (double)j * 0.15915494309189535;
  t -= rint(t);
  const float ang = (float)(t * 6.283185307179586);
  float s, c; sincosf(ang, &s, &c);
  re = mag * c; im = mag * s;
}
DI void ssm_coef(const P& p, int g, int dir, int pp, float& cr, float& ci) {
  const int ia = (dir * 32 + g) * 64 + pp;
  const float lr = fminf(p.a_re[ia], -1e-4f), li = p.a_im[ia];
  float ar, ai; ssm_pow(p, g, dir, pp, 1, ar, ai);
  const float nr = ar - 1.f, ni = ai, den = 1.f / (lr * lr + li * li);
  cr = (nr * lr + ni * li) * den; ci = (ni * lr - nr * li) * den;
}

template <class CM>
DI void transpose_job(float* tile, const int tid, bool act, int item, const float* in, int ld, int Kdim, bf16_t* out, const CM& colmap, const float* sc0, const float* sc1) {
  const int nkt = Kdim / 64, nt = item / nkt, kt = item % nkt;
  __syncthreads();
  if (act) {
    const int c = tid & 31, kr = tid >> 5, col = colmap(nt * 32 + c);
#pragma unroll
    for (int i = 0; i < 8; i++) {
      const int kl = kr + 8 * i, k = kt * 64 + kl;
      float v = in[(size_t)k * ld + col];
      if (sc0) v *= (k < 512 ? sc0[k] : sc1[k - 512]);
      tile[kl * 33 + c] = v;
    }
  }
  __syncthreads();
  if (act) {
    const int nl = tid >> 3, kc = tid & 7;
    float v[8];
#pragma unroll
    for (int j = 0; j < 8; j++) v[j] = tile[(kc * 8 + j) * 33 + nl];
    uint4 w; w.x = pk2(v[0], v[1]); w.y = pk2(v[2], v[3]); w.z = pk2(v[4], v[5]); w.w = pk2(v[6], v[7]);
    *(uint4*)(out + (size_t)(nt * 32 + nl) * Kdim + kt * 64 + kc * 8) = w;
  }
}

DI void phase0(const P& p) {
  const int tix = otid();
  unsigned char* smraw = dyn_smem + (tix >> 8) * SMEM_HALF;
  float* smf = (float*)smraw;
  const int tid = tix & 255, nb = gridDim.x * 2, bid = blockIdx.x * 2 + (tix >> 8);
  for (int base = 0; base < 96; base += nb) {
    const int item = base + bid; const bool act = item < 96;
    __syncthreads();
    if (act)
      for (int i = tid; i < 17 * 1024; i += 256) {
        const int b = i >> 10, k = i & 1023;
        const float c = b == 0 ? p.cp[k] : p.cs[(b - 1) * 1024 + k];
        smf[i] = c / (1.f + __expf(-c));
      }
    __syncthreads();
    const int col = tid & 63, kq = tid >> 6, j = item * 64 + col;
    float a[17];
#pragma unroll
    for (int b = 0; b < 17; b++) a[b] = 0.f;
    if (act)
      for (int k = kq * 256; k < kq * 256 + 256; k++) {
        const float w = p.w_ada[(size_t)k * 6144 + j];
#pragma unroll
        for (int b = 0; b < 17; b++) a[b] += smf[b * 1024 + k] * w;
      }
    __syncthreads();
#pragma unroll
    for (int b = 0; b < 17; b++) smf[(kq * 17 + b) * 64 + col] = a[b];
    __syncthreads();
    if (act)
      for (int i = tid; i < 17 * 64; i += 256) {
        const int b = i >> 6, c2 = i & 63;
        const float s = smf[(0 * 17 + b) * 64 + c2] + smf[(1 * 17 + b) * 64 + c2] + smf[(2 * 17 + b) * 64 + c2] + smf[(3 * 17 + b) * 64 + c2];
        p.mod()[b * 6144 + item * 64 + c2] = s + p.b_ada[item * 64 + c2];
      }
  }
  {
    auto ident = [](int n) { return n; };
    auto glumap = [](int n) { return ((n >> 7) & 1) * 512 + (n >> 8) * 128 + (n & 127); };
    const int n0 = 512, n1 = n0 + 256, n2 = n1 + 512, n3 = n2 + 2048, n4 = n3 + 2048;
    for (int base = 0; base < n4; base += nb) {
      const int item = base + bid; const bool act = item < n4;
      if (item < n0) transpose_job(smf, tid, act, item, p.w_in, 1024, 1024, p.wint(), ident, nullptr, nullptr);
      else if (item < n1) transpose_job(smf, tid, act, item - n0, p.w_glu, 1024, 512, p.wglut(), glumap, nullptr, nullptr);
      else if (item < n2) transpose_job(smf, tid, act, item - n1, p.w_out, 1024, 1024, p.woutt(), ident, p.g_fo, p.g_so);
      else if (item < n3) transpose_job(smf, tid, act, item - n2, p.w1, 4096, 1024, p.w1t(), ident, nullptr, nullptr);
      else transpose_job(smf, tid, act, item - n3, p.w2, 1024, 4096, p.w2t(), ident, nullptr, nullptr);
    }
  }
  {
    __syncthreads();
    float2* cs = (float2*)smraw;
    for (int i = tid; i < 512; i += 256) { float s, c; sincosf((float)i * (6.283185307179586f / 512.f), &s, &c); cs[i] = make_float2(c, s); }
    __syncthreads();
    for (int item = bid; item < 2048; item += nb) {
      const int idx = item * 256 + tid, n = idx >> 10, k = idx & 1023, h = n >> 7, e = n & 127, c = k & 511;
      const bool is_sin = k >= 512;
      const float* wf = p.w_f + (size_t)h * 128 * 128 + e;
      float a = 0.f;
      for (int d = 0; d < 128; d++) {
        const float2 t = cs[((h * 128 + d) * c) & 511];
        a += (is_sin ? t.y : t.x) * wf[d * 128];
      }
      p.Mf()[idx] = f2bf(a);
    }
  }
  {
    const int gsz = nb * 256, gt = bid * 256 + tid;
    for (int i = gt; i < 256 * 128; i += gsz) {
      const int n = i >> 7, k = i & 127, k1 = (n >> 6) * 32 + (n & 31), part = (n >> 5) & 1;
      float s, c; sincosf((float)((k1 * k) & 127) * (6.283185307179586f / 128.f), &s, &c);
      p.F1p()[i] = f2bf(part ? -s : c);
    }
    for (int i = gt; i < 128 * 64; i += gsz) {
      const int n = i >> 6, k = i & 63, k1 = (n >> 6) * 32 + (n & 31), part = (n >> 5) & 1;
      float s, c; sincosf((float)((k1 * k) & 63) * (6.283185307179586f / 64.f), &s, &c);
      p.F1s()[i] = f2bf(part ? -s : c);
    }
    for (int i = gt; i < 256 * 256; i += gsz) {
      const int n = i >> 8, k = i & 255, part = n >> 7, k2 = n & 127, l2 = k & 127, ki = k >> 7;
      float s, c; sincosf((float)((k2 * l2) & 127) * (6.283185307179586f / 128.f), &s, &c);
      p.F2p()[i] = f2bf(part == 0 ? (ki == 0 ? c : s) : (ki == 0 ? -s : c));
    }
    for (int i = gt; i < 128 * 128; i += gsz) {
      const int n = i >> 7, k = i & 127, part = n >> 6, k2 = n & 63, l2 = k & 63, ki = k >> 6;
      float s, c; sincosf((float)((k2 * l2) & 63) * (6.283185307179586f / 64.f), &s, &c);
      p.F2s()[i] = f2bf(part == 0 ? (ki == 0 ? c : s) : (ki == 0 ? -s : c));
    }
    for (int i = gt; i < LPR; i += gsz) { float s, c; sincosf((float)i * (6.283185307179586f / 16384.f), &s, &c); p.twp()[i] = make_float2(c, s); }
    for (int i = gt; i < LSM; i += gsz) { float s, c; sincosf((float)i * (6.283185307179586f / 4096.f), &s, &c); p.tws()[i] = make_float2(c, s); }
    for (int i = gt; i < 32 * 2 * 64 * 64; i += gsz) {
      const int s = i & 63, pp = (i >> 6) & 63, dir = (i >> 12) & 1, g = i >> 13;
      float pr, pi, cr, ci; ssm_pow(p, g, dir, pp, dir == 0 ? 63 - s : s, pr, pi); ssm_coef(p, g, dir, pp, cr, ci);
      const float qr = pr * cr - pi * ci, qi = pr * ci + pi * cr;
      const int ib = ((dir * 32 + g) * 64 + pp) * 16;
      float vr[16], vi[16];
#pragma unroll
      for (int h = 0; h < 16; h++) { const float br = p.b_re[ib + h], bi = p.b_im[ib + h]; vr[h] = qr * br - qi * bi; vi[h] = qr * bi + qi * br; }
      bf16_t* d0 = p.Bs() + ((size_t)(g * 256 + dir * 128 + pp)) * 1024 + s * 16;
      bf16_t* d1 = d0 + 64 * 1024;
      uint4 w;
      w.x = pk2(vr[0], vr[1]); w.y = pk2(vr[2], vr[3]); w.z = pk2(vr[4], vr[5]); w.w = pk2(vr[6], vr[7]); *(uint4*)d0 = w;
      w.x = pk2(vr[8], vr[9]); w.y = pk2(vr[10], vr[11]); w.z = pk2(vr[12], vr[13]); w.w = pk2(vr[14], vr[15]); *(uint4*)(d0 + 8) = w;
      w.x = pk2(vi[0], vi[1]); w.y = pk2(vi[2], vi[3]); w.z = pk2(vi[4], vi[5]); w.w = pk2(vi[6], vi[7]); *(uint4*)d1 = w;
      w.x = pk2(vi[8], vi[9]); w.y = pk2(vi[10], vi[11]); w.z = pk2(vi[12], vi[13]); w.w = pk2(vi[14], vi[15]); *(uint4*)(d1 + 8) = w;
    }
    for (int i = gt; i < 32 * 64 * 2 * 64; i += gsz) {
      const int pp = i & 63, dir = (i >> 6) & 1, t = (i >> 7) & 63, g = i >> 13;
      float pr, pi; ssm_pow(p, g, dir, pp, dir == 0 ? t + 1 : 64 - t, pr, pi);
#pragma unroll
      for (int h = 0; h < 16; h++) {
        const int ic = ((dir * 32 + g) * 16 + h) * 64 + pp;
        const float cr = p.c_re[ic], ci = p.c_im[ic];
        bf16_t* d = p.Tcat() + ((size_t)(g * 1024 + t * 16 + h)) * 1280 + 1024 + dir * 128 + pp;
        d[0] = f2bf(cr * pr - ci * pi);
        d[64] = f2bf(-(cr * pi + ci * pr));
      }
    }
    for (int i = gt; i < 32 * 2 * 64; i += gsz) {
      const int pp = i & 63, dir = (i >> 6) & 1, g = i >> 7;
      float pr, pi; ssm_pow(p, g, dir, pp, 64, pr, pi);
      p.AT()[i * 2] = pr; p.AT()[i * 2 + 1] = pi;
    }
  }
  {
    float2* q = (float2*)smraw;
    for (int base = 0; base < 32 * 127; base += nb) {
      const int item = base + bid; const bool act = item < 32 * 127;
      const int g = act ? item / 127 : 0, jj = act ? item % 127 : 0, lag = jj - 63;
      __syncthreads();
      if (tid < 128) {
        const int dir = tid >> 6, pp = tid & 63;
        float2 v = make_float2(0.f, 0.f);
        if ((dir == 0 && lag >= 0) || (dir == 1 && lag <= 0)) {
          float pr, pi, cr, ci; ssm_pow(p, g, dir, pp, lag < 0 ? -lag : lag, pr, pi); ssm_coef(p, g, dir, pp, cr, ci);
          v = make_float2(pr * cr - pi * ci, pr * ci + pi * cr);
        }
        q[tid] = v;
      }
      __syncthreads();
      const int hp = tid >> 4, h = tid & 15;
      float a = 0.f;
#pragma unroll
      for (int dir = 0; dir < 2; dir++) {
        if ((dir == 0 && lag < 0) || (dir == 1 && lag > 0)) continue;
        for (int pp = 0; pp < 64; pp++) {
          const int ic = ((dir * 32 + g) * 16 + hp) * 64 + pp, ib = ((dir * 32 + g) * 64 + pp) * 16 + h;
          const float cr = p.c_re[ic], ci = p.c_im[ic], br = p.b_re[ib], bi = p.b_im[ib];
          const float2 qq = q[dir * 64 + pp];
          const float er = cr * qq.x - ci * qq.y, ei = cr * qq.y + ci * qq.x;
          a += er * br - ei * bi;
        }
      }
      if (lag == 0 && hp == h) a += p.ssm_d[g * 16 + h];
      if (act) {
        const bf16_t kv = f2bf(a);
        const int t0 = lag > 0 ? lag : 0, t1 = lag > 0 ? 64 : 64 + lag;
        bf16_t* d = p.Tcat() + ((size_t)(g * 1024 + hp)) * 1280 + h;
        for (int t = t0; t < t1; t++) d[(size_t)t * 16 * 1280 + (t - lag) * 16] = kv;
      }
    }
  }
}

DI float bflo(uint32_t u) { return __uint_as_float(u << 16); }
DI float bfhi(uint32_t u) { return __uint_as_float(u & 0xffff0000u); }
template <bool FROMX>
DI void rownorm_mod(const P& p, const float* g, int sh_off, int sc_off) {
  const int tix = otid(), lane = tix & 63, wv = blockIdx.x * 8 + (tix >> 6), nw = gridDim.x * 8;
  for (int tok0 = wv; tok0 < NTOK; tok0 += 2 * nw) {
    float v[2][16]; float ss[2] = {0.f, 0.f};
#pragma unroll
    for (int rr = 0; rr < 2; rr++) {
      const int tok = tok0 + rr * nw;
      if (tok < NTOK) {
        if (FROMX) {
          const float* src = tok < LPR ? p.xp + (size_t)tok * 1024 : p.xs + (size_t)(tok - LPR) * 1024;
#pragma unroll
          for (int i = 0; i < 4; i++) { const f32x4 t = *(const f32x4*)(src + (i * 64 + lane) * 4); v[rr][4 * i] = t[0]; v[rr][4 * i + 1] = t[1]; v[rr][4 * i + 2] = t[2]; v[rr][4 * i + 3] = t[3]; }
        } else {
          const bf16_t* src = (const bf16_t*)p.out + (size_t)tok * 1024;
#pragma unroll
          for (int i = 0; i < 2; i++) { const uint4 t = *(const uint4*)(src + (i * 64 + lane) * 8);
            v[rr][8 * i] = bflo(t.x); v[rr][8 * i + 1] = bfhi(t.x); v[rr][8 * i + 2] = bflo(t.y); v[rr][8 * i + 3] = bfhi(t.y);
            v[rr][8 * i + 4] = bflo(t.z); v[rr][8 * i + 5] = bfhi(t.z); v[rr][8 * i + 6] = bflo(t.w); v[rr][8 * i + 7] = bfhi(t.w); }
        }
      } else {
#pragma unroll
        for (int e = 0; e < 16; e++) v[rr][e] = 0.f;
      }
    }
#pragma unroll
    for (int rr = 0; rr < 2; rr++) {
#pragma unroll
      for (int e = 0; e < 16; e++) ss[rr] += v[rr][e] * v[rr][e];
      ss[rr] = wave_sum(ss[rr]);
    }
#pragma unroll
    for (int rr = 0; rr < 2; rr++) {
      const int tok = tok0 + rr * nw;
      if (tok >= NTOK) continue;
      const float r = rsqrtf(ss[rr] * (1.f / 1024.f) + EPSV);
      const float* md = p.mod() + batch_of(tok) * 6144;
      bf16_t* drow = p.hb() + (size_t)(FROMX ? permtok(tok) : tok) * 1024;
      float o[16];
#pragma unroll
      for (int q = 0; q < 4; q++) {
        const int c = FROMX ? (q * 64 + lane) * 4 : ((q >> 1) * 64 + lane) * 8 + (q & 1) * 4;
        const f32x4 gg = *(const f32x4*)(g + c), sc = *(const f32x4*)(md + sc_off + c), sh = *(const f32x4*)(md + sh_off + c);
#pragma unroll
        for (int e = 0; e < 4; e++) o[4 * q + e] = v[rr][4 * q + e] * r * gg[e] * (1.f + sc[e]) + sh[e];
      }
      if (FROMX) {
#pragma unroll
        for (int q = 0; q < 4; q++) { uint2 w; w.x = pk2(o[4 * q], o[4 * q + 1]); w.y = pk2(o[4 * q + 2], o[4 * q + 3]); *(uint2*)(drow + (q * 64 + lane) * 4) = w; }
      } else {
#pragma unroll
        for (int i = 0; i < 2; i++) { uint4 w; w.x = pk2(o[8 * i], o[8 * i + 1]); w.y = pk2(o[8 * i + 2], o[8 * i + 3]); w.z = pk2(o[8 * i + 4], o[8 * i + 5]); w.w = pk2(o[8 * i + 6], o[8 * i + 7]);
          *(uint4*)(drow + (i * 64 + lane) * 8) = w; }
      }
    }
  }
}
DI void final_norm(const P& p) {
  const int tix = otid(), lane = tix & 63, wv = blockIdx.x * 8 + (tix >> 6), nw = gridDim.x * 8;
  for (int tok0 = wv; tok0 < NTOK; tok0 += 2 * nw) {
    float v[2][16]; float ss[2] = {0.f, 0.f};
#pragma unroll
    for (int rr = 0; rr < 2; rr++) {
      const int tok = tok0 + rr * nw;
      if (tok < NTOK) {
        const bf16_t* src = p.hb() + (size_t)tok * 1024;
#pragma unroll
        for (int i = 0; i < 2; i++) { const uint4 t = *(const uint4*)(src + (i * 64 + lane) * 8);
          v[rr][8 * i] = bflo(t.x); v[rr][8 * i + 1] = bfhi(t.x); v[rr][8 * i + 2] = bflo(t.y); v[rr][8 * i + 3] = bfhi(t.y);
          v[rr][8 * i + 4] = bflo(t.z); v[rr][8 * i + 5] = bfhi(t.z); v[rr][8 * i + 6] = bflo(t.w); v[rr][8 * i + 7] = bfhi(t.w); }
      } else {
#pragma unroll
        for (int e = 0; e < 16; e++) v[rr][e] = 0.f;
      }
    }
#pragma unroll
    for (int rr = 0; rr < 2; rr++) {
#pragma unroll
      for (int e = 0; e < 16; e++) ss[rr] += v[rr][e] * v[rr][e];
      ss[rr] = wave_sum(ss[rr]);
    }
#pragma unroll
    for (int rr = 0; rr < 2; rr++) {
      const int tok = tok0 + rr * nw;
      if (tok >= NTOK) continue;
      const float r = rsqrtf(ss[rr] * (1.f / 1024.f) + EPSV);
      float* drow = p.out + (size_t)tok * 1024;
#pragma unroll
      for (int q = 0; q < 4; q++) {
        const int c = ((q >> 1) * 64 + lane) * 8 + (q & 1) * 4;
        const f32x4 gg = *(const f32x4*)(p.g_final + c);
        f32x4 o;
#pragma unroll
        for (int e = 0; e < 4; e++) o[e] = v[rr][4 * q + e] * r * gg[e];
        *(f32x4*)(drow + c) = o;
      }
    }
  }
}

#define GEO const int tix = otid(), half = tix >> 8, tid = tix & 255, lane = tid & 63, wid = tid >> 6, wm = wid >> 1, wn = wid & 1, l31 = lane & 31, lh = lane >> 5; (void)tix; (void)half; (void)tid; (void)wm; (void)wn; (void)l31; (void)lh;

template <int R>
DI void fft1_tile(const P& p, bf16_t* sm, int tm, int tn) {
  GEO
  constexpr bool pr = (R == 128);
  f32x16 acc[2][2];
  const bf16_t* Abase = pr ? p.zT() + (size_t)tm * 128 * 128 : p.zT() + (size_t)512 * LPR + (size_t)tm * 128 * 64;
  const bf16_t* Bbase = pr ? p.F1p() + (size_t)tn * 128 * 128 : p.F1s();
  auto af = [&](int r, int k) { return Abase + r * R + k; };
  auto bf = [&](int r, int k) { return Bbase + r * R + k; };
  gemm_main<false>(sm, tid, R, af, bf, NoHook(), acc);
  const int k1 = (tn * 2 + wn) * 32 + l31;
  const float2* tw = pr ? p.twp() : p.tws();
  constexpr int lmask = pr ? 16383 : 4095, l2mask = R - 1;
  const float2 tb = tw[(unsigned)((k1 * ((wm * 64 + 4 * lh) & l2mask)) & lmask)], t1 = tw[(unsigned)(k1 & lmask)], t8 = tw[(unsigned)((k1 * 8) & lmask)],
               t32 = tw[(unsigned)((k1 * (32 & l2mask)) & lmask)];
  float2 wt[2][4][4];
#pragma unroll
  for (int mi = 0; mi < 2; mi++) {
    float2 w = tb;
    if (mi) w = make_float2(tb.x * t32.x - tb.y * t32.y, tb.y * t32.x + tb.x * t32.y);
#pragma unroll
    for (int g = 0; g < 4; g++) {
      float2 u = w;
#pragma unroll
      for (int e = 0; e < 4; e++) {
        wt[mi][g][e] = u;
        u = make_float2(u.x * t1.x - u.y * t1.y, u.y * t1.x + u.x * t1.y);
      }
      w = make_float2(w.x * t8.x - w.y * t8.y, w.y * t8.x + w.x * t8.y);
    }
  }
  auto ew = [&](int mi, int g, int e, float& re, float& im) {
    const float2 w = wt[mi][g][e];
    const float a = re * w.x + im * w.y, b = im * w.x - re * w.y;
    re = a; im = b;
  };
  auto dst = [&](int nl, int r) {
    const int part = (nl >> 5) & 1, kk1 = (tn * 2 + (nl >> 6)) * 32 + (nl & 31);
    if (pr) return p.Tt() + ((size_t)(tm * 128 + kk1)) * 256 + part * 128 + 64 * r;
    return p.Tt() + (size_t)65536 * 256 + ((size_t)((tm * 2 + r) * 64 + kk1)) * 128 + part * 64;
  };
  epi_transposed(sm, tid, acc, ew, dst);
}
DI void phase3(const P& p);
template <int R>
DI void fft2_tile(const P& p, bf16_t* sm, int tm, int tn) {
  GEO
  constexpr bool pr = (R == 128);
  constexpr int K = 2 * R;
  f32x16 acc[2][2];
  const int ct = tm & 3, k1 = pr ? (tm >> 2) : ((tm >> 2) & 63), b = pr ? 0 : (tm >> 8);
  const bf16_t* Abase = pr ? p.Tt() + ((size_t)(ct * 128) * 128 + k1) * 256 : p.Tt() + (size_t)65536 * 256 + ((size_t)(b * 512 + ct * 128) * 64 + k1) * 128;
  constexpr int rstride = R * K;
  const bf16_t* Bbase = pr ? p.F2p() + (size_t)tn * 128 * 256 : p.F2s();
  auto af = [&](int r, int k) { return Abase + (size_t)r * rstride + k; };
  auto bf = [&](int r, int k) { return Bbase + r * K + k; };
  gemm_main<false>(sm, tid, K, af, bf, NoHook(), acc);
  auto ew = [](int, int, int, float&, float&) {};
  auto dst = [&](int nl, int r) {
    const int n = tn * 128 + nl, part = pr ? (n >> 7) : (n >> 6), k2 = n & (R - 1);
    const int tok = (pr ? 0 : LPR + b * 4096) + k1 + R * k2;
    return p.AF() + (size_t)tok * 1024 + part * 512 + ct * 128 + 64 * r;
  };
  epi_transposed(sm, tid, acc, ew, dst);
}
DI void phase4(const P& p) {
  GEO
  bf16_t* sm = (bf16_t*)(dyn_smem + half * SMEM_HALF);
  for (int idx = blockIdx.x * 512 + tix; idx < 17 * 4096; idx += gridDim.x * 512) {
    const int seq = idx >> 12, rem = idx & 4095, g = rem >> 7, dir = (rem >> 6) & 1, pp = rem & 63;
    const int c0 = seq == 0 ? 0 : 256 + (seq - 1) * 64, nc = seq == 0 ? 256 : 64;
    const float ar = p.AT()[((g * 2 + dir) * 64 + pp) * 2], ai = p.AT()[((g * 2 + dir) * 64 + pp) * 2 + 1];
    float hr = 0.f, hi = 0.f;
    const float* Sg = p.S() + (size_t)g * 1280 * 256 + dir * 128 + pp;
    bf16_t* Hg = p.Ucat() + (size_t)g * 1280 * 1280 + 1024 + dir * 128 + pp;
    for (int i0 = 0; i0 < nc; i0 += 32) {
      float sr[32], si[32];
#pragma unroll
      for (int j = 0; j < 32; j++) {
        const int c = c0 + (dir == 0 ? i0 + j : nc - 1 - i0 - j);
        sr[j] = Sg[(size_t)c * 256]; si[j] = Sg[(size_t)c * 256 + 64];
      }
#pragma unroll
      for (int j = 0; j < 32; j++) {
        const int c = c0 + (dir == 0 ? i0 + j : nc - 1 - i0 - j);
        Hg[(size_t)c * 1280] = f2bf(hr); Hg[(size_t)c * 1280 + 64] = f2bf(hi);
        const float nr = ar * hr - ai * hi + sr[j], ni = ar * hi + ai * hr + si[j];
        hr = nr; hi = ni;
      }
    }
  }
  const int G = (int)gridDim.x, nscan = (17 * 4096 + 511) / 512, bidx = (int)blockIdx.x;
  int q0, qs, qe;
  if (G <= nscan) { q0 = bidx; qs = G; qe = 2560; }
  else if (bidx < nscan) { q0 = bidx; qs = nscan; qe = nscan * 8; }
  else { q0 = nscan * 8 + (bidx - nscan); qs = G - nscan; qe = 2560; }
  for (int q = q0; q < qe; q += qs) {
    const int t = 2 * q + half;
    if (t < 1024) fft2_tile<128>(p, sm, t >> 1, t & 1);
    else fft2_tile<64>(p, sm, t - 1024, 0);
  }
}


namespace pg8 {
#define PG8_LAS __attribute__((address_space(3)))
typedef unsigned short bf16_t;
typedef short bf16x8 __attribute__((ext_vector_type(8)));
typedef float f32x4 __attribute__((ext_vector_type(4)));
typedef unsigned u32x4 __attribute__((ext_vector_type(4)));
constexpr int BM = 256, BK = 64, HALF = 128, HTB = HALF * BK * 2  , STAGE_BYTES = 8 * HTB, NXCD = 8, WGM = 8;

__host__ __device__ __forceinline__ int lds_byte(int r, int c) { const int st = (r >> 4) * 2 + (c >> 5), rr = r & 15, cc = c & 31, ob = rr * 64 + cc * 2; return st * 1024 + (ob ^ (((ob >> 9) & 1) << 5)); }
__host__ __device__ __forceinline__ void stage_rc(int b, int& R, int& C) { const int st = b / 1024, sb = b % 1024, swz = sb ^ (((sb >> 9) & 1) << 5); R = (st >> 1) * 16 + swz / 64; C = (st & 1) * 32 + (swz % 64) / 2; }
__host__ __device__ __forceinline__ int perm32(int rho) { const int n = rho >> 4, i = rho & 15; return 8 * (i >> 2) + 4 * n + (i & 3); }

struct Unit { int pm, pn; };
struct Gemm { const bf16_t* A; const bf16_t* Bt; int M, N, K, lda, ldb; };

struct StaticOrder {
    int nM, nN, nwg, G, c;
    __host__ __device__ void init(int M, int N, int G_, int c_) { nM = M / BM; nN = N / BM; nwg = nM * nN; G = G_; c = c_; }
    __host__ __device__ bool next(int i, Unit& u) const {
        const long L = (long)i * G + c; if (L >= nwg) return false;
        int wgid = (int)L; { const int q = nwg / NXCD, r = nwg % NXCD, xcd = wgid % NXCD, off = wgid / NXCD; wgid = (xcd < r ? xcd * (q + 1) : r * (q + 1) + (xcd - r) * q) + off; }
        const int nig = WGM * nN, gid = wgid / nig, fm = gid * WGM, gsz = (nM - fm) < WGM ? (nM - fm) : WGM;
        u.pm = fm + ((wgid % nig) % gsz); u.pn = (wgid % nig) / gsz; return true;
    }
    __device__ __forceinline__ void a_ready(const Unit&) const {}
    __device__ __forceinline__ void done(const Unit&) const {}
};

struct GroupOrder {
    int nwg, G, c, um, un;
    __host__ __device__ void init(int ngroups, int um_, int un_, int G_, int c_) { um = um_; un = un_; nwg = ngroups * um * un; G = G_; c = (c_ & 7) * (G_ >> 3) + (c_ >> 3); }
    __host__ __device__ bool next(int i, Unit& u) const {
        const int L = i * G + c; if (L >= nwg) return false;
        const int gi = L / (um * un), r = L % (um * un); u.pm = gi * um + r / un; u.pn = gi * un + r % un; return true;
    }
    __device__ __forceinline__ void a_ready(const Unit&) const {}
    __device__ __forceinline__ void done(const Unit&) const {}
};
template <class Epi, class Sched, bool ALIGN_EPI = false, bool SP2 = false>
__device__ __forceinline__ void gemm_phase(PG8_LAS unsigned char* lds, const int tix, const Gemm g, const Sched& S, const Epi& E) {
    const int tid = tix, wid = __builtin_amdgcn_readfirstlane(tid >> 6), lane = tid & 63, wr = wid >> 2, wc = wid & 3, fr = lane & 15, fq = lane >> 4;
    const int K = g.K, nt = K / BK;
    unsigned voffA[2], voffB[2];
#pragma unroll
    for (int i = 0; i < 2; ++i) { int R, C; stage_rc(tid * 16 + i * 8192, R, C); const int Rb = Epi::PERM ? ((R & ~31) + perm32(R & 31)) : R;
        voffA[i] = (unsigned)(R * g.lda + C) * 2u; voffB[i] = (unsigned)(Rb * g.ldb + C) * 2u; }
    const size_t kstep = (size_t)(BK * 2);
    const size_t hstepA = (size_t)HALF * g.lda * 2, hstepB = (size_t)HALF * g.ldb * 2;
    const size_t tstepA = 2 * hstepA, tstepB = 2 * hstepB;
    const unsigned ldsw = (unsigned)wid * 1024u;
    const int aoff = lds_byte(wr * 64 + fr, fq * 8), boff = lds_byte(wc * 32 + fr, fq * 8);
#define PG8_SA(b, h) (((b) * 2 + (h)) * HTB)
#define PG8_SB(b, h) ((4 + (b) * 2 + (h)) * HTB)
#define PG8_STAGE(bufoff, gbase, voff) do { _Pragma("unroll") for (int _i = 0; _i < 2; ++_i) \
        __builtin_amdgcn_global_load_lds((const unsigned*)((const char*)(gbase) + (voff)[_i]), (PG8_LAS unsigned*)(lds + (bufoff) + ldsw + _i * 8192), 16, 0, 0); } while (0)
#define PG8_LDA(dst, b, h) do { _Pragma("unroll") for (int m = 0; m < 4; ++m) _Pragma("unroll") for (int k = 0; k < 2; ++k) dst[m][k] = *(const PG8_LAS bf16x8*)(lds + PG8_SA(b, h) + aoff + m * 2048 + k * 1024); } while (0)
#define PG8_LDB(dst, b, h) do { _Pragma("unroll") for (int n = 0; n < 2; ++n) _Pragma("unroll") for (int k = 0; k < 2; ++k) dst[n][k] = *(const PG8_LAS bf16x8*)(lds + PG8_SB(b, h) + boff + n * 2048 + k * 1024); } while (0)
#define PG8_MMA(ai, bj, At, Bt) do { __builtin_amdgcn_s_setprio(1); _Pragma("unroll") for (int m = 0; m < 4; ++m) _Pragma("unroll") for (int n = 0; n < 2; ++n) _Pragma("unroll") for (int k = 0; k < 2; ++k) \
        acc[ai][bj][m][n] = __builtin_amdgcn_mfma_f32_16x16x32_bf16(Bt[n][k], At[m][k], acc[ai][bj][m][n], 0, 0, 0); __builtin_amdgcn_s_setprio(0); } while (0)
#define PG8_WAIT_V(n) asm volatile("s_waitcnt vmcnt(" #n ")" ::: "memory")
#define PG8_WAIT_L(n) asm volatile("s_waitcnt lgkmcnt(" #n ")" ::: "memory")
#define PG8_BAR __builtin_amdgcn_s_barrier()
#define PG8_SCHED __builtin_amdgcn_sched_barrier(0)
    Unit cur, nxt; int ui = 0;
    if (!S.next(0, cur)) return;
    f32x4 acc[2][2][4][2];
#pragma unroll
    for (int a = 0; a < 2; ++a)
#pragma unroll
        for (int b = 0; b < 2; ++b)
#pragma unroll
            for (int m = 0; m < 4; ++m)
#pragma unroll
                for (int n = 0; n < 2; ++n) acc[a][b][m][n] = (f32x4){0.f, 0.f, 0.f, 0.f};
    bf16x8 At[4][2], B0[2][2], B1[2][2];
    const char* cA = (const char*)g.A + (size_t)cur.pm * tstepA; const char* cB = (const char*)g.Bt + (size_t)cur.pn * tstepB;
    S.a_ready(cur);
    if constexpr (SP2) {
        PG8_STAGE(PG8_SB(0, 0), cB, voffB); PG8_STAGE(PG8_SB(0, 1), cB + hstepB, voffB); PG8_STAGE(PG8_SA(0, 0), cA, voffA); PG8_STAGE(PG8_SA(0, 1), cA + hstepA, voffA);
        if (wr == 1) PG8_BAR;
        PG8_WAIT_V(2); PG8_BAR;
        PG8_STAGE(PG8_SB(1, 0), cB + kstep, voffB); PG8_STAGE(PG8_SA(1, 0), cA + kstep, voffA); PG8_STAGE(PG8_SB(1, 1), cB + hstepB + kstep, voffB);
        PG8_WAIT_V(6); PG8_BAR;
    } else {
        PG8_STAGE(PG8_SB(0, 0), cB, voffB); PG8_STAGE(PG8_SA(0, 0), cA, voffA); PG8_STAGE(PG8_SB(0, 1), cB + hstepB, voffB); PG8_STAGE(PG8_SA(0, 1), cA + hstepA, voffA);
        if (wr == 1) PG8_BAR;
        PG8_WAIT_V(4); PG8_BAR;
        PG8_STAGE(PG8_SB(1, 0), cB + kstep, voffB); PG8_STAGE(PG8_SA(1, 0), cA + kstep, voffA); PG8_STAGE(PG8_SB(1, 1), cB + hstepB + kstep, voffB);
        PG8_WAIT_V(6); PG8_BAR;
    }
    for (;;) {
        const bool has_next = S.next(ui + 1, nxt);
        const char* nA = has_next ? (const char*)g.A + (size_t)nxt.pm * tstepA : cA; const char* nB = has_next ? (const char*)g.Bt + (size_t)nxt.pn * tstepB : cB;
        for (int t = 0; t < nt; t += 2) {
            if constexpr (Epi::KHOOK) { if (t == Epi::KH_T) E.khook(acc, ui, wr, fr, lds); }
            const bool last = (t == nt - 2);
            const char* a1 = cA + (size_t)(t + 1) * kstep;
            const char* a2 = last ? nA : cA + (size_t)(t + 2) * kstep; const char* b2 = last ? nB : cB + (size_t)(t + 2) * kstep;
            const char* a3 = a2 + kstep; const char* b3 = b2 + kstep;
            if (last && has_next) S.a_ready(nxt);
            if constexpr (SP2) {
            PG8_LDB(B0, 0, 0); PG8_LDB(B1, 0, 1); PG8_SCHED; PG8_LDA(At, 0, 0); PG8_STAGE(PG8_SA(1, 1), a1 + hstepA, voffA);
            PG8_WAIT_V(8); PG8_WAIT_L(0); PG8_BAR; PG8_MMA(0, 0, At, B0); PG8_MMA(0, 1, At, B1); PG8_BAR; PG8_SCHED;
            PG8_LDA(At, 0, 1); PG8_STAGE(PG8_SB(0, 0), b2, voffB); PG8_STAGE(PG8_SB(0, 1), b2 + hstepB, voffB); PG8_STAGE(PG8_SA(0, 0), a2, voffA);
            PG8_WAIT_V(8); PG8_WAIT_L(0); PG8_BAR; PG8_MMA(1, 0, At, B0); PG8_MMA(1, 1, At, B1); PG8_BAR; PG8_SCHED;
            PG8_LDB(B0, 1, 0); PG8_LDB(B1, 1, 1); PG8_SCHED; PG8_LDA(At, 1, 0); PG8_STAGE(PG8_SA(0, 1), a2 + hstepA, voffA);
            PG8_WAIT_V(8); PG8_WAIT_L(0); PG8_BAR; PG8_MMA(0, 0, At, B0); PG8_MMA(0, 1, At, B1); PG8_BAR; PG8_SCHED;
            PG8_LDA(At, 1, 1); PG8_STAGE(PG8_SB(1, 0), b3, voffB); PG8_STAGE(PG8_SB(1, 1), b3 + hstepB, voffB); PG8_STAGE(PG8_SA(1, 0), a3, voffA);
            PG8_WAIT_V(8); PG8_WAIT_L(0); PG8_BAR; PG8_MMA(1, 0, At, B0); PG8_MMA(1, 1, At, B1); PG8_BAR; PG8_SCHED;
            } else {
            PG8_LDB(B0, 0, 0); PG8_SCHED; PG8_LDA(At, 0, 0); PG8_STAGE(PG8_SA(1, 1), a1 + hstepA, voffA);
            PG8_WAIT_L(8); PG8_BAR; PG8_WAIT_L(0); PG8_MMA(0, 0, At, B0); PG8_BAR; PG8_SCHED;
            PG8_LDB(B1, 0, 1); PG8_STAGE(PG8_SB(0, 0), b2, voffB);
            PG8_BAR; PG8_WAIT_L(0); PG8_MMA(0, 1, At, B1); PG8_BAR;
            PG8_LDA(At, 0, 1); PG8_STAGE(PG8_SA(0, 0), a2, voffA);
            PG8_BAR; PG8_WAIT_L(0); PG8_MMA(1, 0, At, B0); PG8_BAR; PG8_SCHED;
            PG8_STAGE(PG8_SB(0, 1), b2 + hstepB, voffB);
            PG8_WAIT_V(6); PG8_BAR; PG8_MMA(1, 1, At, B1); PG8_BAR;
            PG8_LDB(B0, 1, 0); PG8_SCHED; PG8_LDA(At, 1, 0); PG8_STAGE(PG8_SA(0, 1), a2 + hstepA, voffA);
            PG8_WAIT_L(8); PG8_BAR; PG8_WAIT_L(0); PG8_MMA(0, 0, At, B0); PG8_BAR; PG8_SCHED;
            PG8_LDB(B1, 1, 1); PG8_STAGE(PG8_SB(1, 0), b3, voffB);
            PG8_BAR; PG8_WAIT_L(0); PG8_MMA(0, 1, At, B1); PG8_BAR;
            PG8_LDA(At, 1, 1); PG8_STAGE(PG8_SA(1, 0), a3, voffA);
            PG8_BAR; PG8_WAIT_L(0); PG8_MMA(1, 0, At, B0); PG8_BAR; PG8_SCHED;
            PG8_STAGE(PG8_SB(1, 1), b3 + hstepB, voffB);
            PG8_WAIT_V(6); PG8_BAR; PG8_MMA(1, 1, At, B1); PG8_BAR;
            }
        }
        if constexpr (ALIGN_EPI) { if (wr == 0) PG8_BAR; }
        if constexpr (!Epi::AFTER_DRAIN) { E(acc, cur, wr, wc, fr, fq, ui); S.done(cur); }
        if (!has_next) break;
#pragma unroll
        for (int a = 0; a < 2; ++a)
#pragma unroll
            for (int b = 0; b < 2; ++b)
#pragma unroll
                for (int m = 0; m < 4; ++m)
#pragma unroll
                    for (int n = 0; n < 2; ++n) acc[a][b][m][n] = (f32x4){0.f, 0.f, 0.f, 0.f};
        cur = nxt; cA = nA; cB = nB; ++ui;
        if constexpr (ALIGN_EPI) { if (wr == 1) PG8_BAR; }
    }
    PG8_WAIT_V(0);
    if constexpr (!ALIGN_EPI) { if (wr == 0) PG8_BAR; }
    PG8_BAR;
    if constexpr (Epi::AFTER_DRAIN) { E.fused(acc, cur, wr, wc, fr, fq, lds, wid, lane); S.done(cur); }
#undef PG8_SA
#undef PG8_SB
#undef PG8_STAGE
#undef PG8_LDA
#undef PG8_LDB
#undef PG8_MMA
#undef PG8_WAIT_V
#undef PG8_WAIT_L
#undef PG8_BAR
#undef PG8_SCHED
}
}

namespace pg8 {
struct EpiMlpIn {
  static constexpr bool PERM = true, AFTER_DRAIN = false, KHOOK = false; static constexpr int KH_T = 0;
  ::bf16_t* O; const float* bias;
  __device__ __forceinline__ void operator()(const f32x4 (&acc)[2][2][4][2], const Unit& u, int wr, int wc, int fr, int fq, int) const {
    const int row0 = u.pm * BM + wr * 64 + fr, col0 = u.pn * BM + wc * 32 + 8 * fq;
    f32x4 bv[2][2];
#pragma unroll
    for (int bj = 0; bj < 2; ++bj)
#pragma unroll
      for (int n = 0; n < 2; ++n) bv[bj][n] = *(const f32x4*)(bias + col0 + bj * HALF + 4 * n);
#pragma unroll
    for (int ai = 0; ai < 2; ++ai)
#pragma unroll
      for (int m = 0; m < 4; ++m) {
        ::bf16_t* rowp = O + (size_t)(row0 + ai * HALF + m * 16) * 4096 + col0;
#pragma unroll
        for (int bj = 0; bj < 2; ++bj) {
          f32x4 v0 = acc[ai][bj][m][0] + bv[bj][0], v1 = acc[ai][bj][m][1] + bv[bj][1];
#pragma unroll
          for (int e = 0; e < 4; ++e) { const float a = fmaxf(v0[e], 0.f), b = fmaxf(v1[e], 0.f); v0[e] = a * a; v1[e] = b * b; }
          u32x4 w; w.x = pk2(v0[0], v0[1]); w.y = pk2(v0[2], v0[3]); w.z = pk2(v1[0], v1[1]); w.w = pk2(v1[2], v1[3]);
          *(u32x4*)(rowp + bj * HALF) = w;
        }
      }
  }
};
struct EpiMlpOut {
  static constexpr bool PERM = false, AFTER_DRAIN = false, KHOOK = false; static constexpr int KH_T = 0;
  const ::bf16_t* x1; ::bf16_t* x2; const float* mod; const float* bias;
  __device__ __forceinline__ void operator()(const f32x4 (&acc)[2][2][4][2], const Unit& u, int wr, int wc, int fr, int fq, int) const {
    const int col0 = u.pn * BM + wc * 32 + 4 * fq;
#pragma unroll
    for (int ai = 0; ai < 2; ++ai)
#pragma unroll
      for (int m = 0; m < 4; ++m) {
        const int row = u.pm * BM + ai * HALF + wr * 64 + m * 16 + fr;
        const float* g2 = mod + batch_of(row) * 6144 + 5120;
#pragma unroll
        for (int bj = 0; bj < 2; ++bj)
#pragma unroll
          for (int n = 0; n < 2; ++n) {
            const int col = col0 + bj * HALF + n * 16;
            const uint2 xr = *(const uint2*)(x1 + (size_t)row * 1024 + col);
            const f32x4 xv = {bflo(xr.x), bfhi(xr.x), bflo(xr.y), bfhi(xr.y)}, gv = *(const f32x4*)(g2 + col), bb = *(const f32x4*)(bias + col);
            const f32x4 o = xv + gv * (acc[ai][bj][m][n] + bb);
            uint2 w; w.x = pk2(o[0], o[1]); w.y = pk2(o[2], o[3]);
            *(uint2*)(x2 + (size_t)row * 1024 + col) = w;
          }
      }
  }
};
struct EpiYf {
  static constexpr bool PERM = true, AFTER_DRAIN = false, KHOOK = false; static constexpr int KH_T = 0;
  ::bf16_t* O; const float* bias; float* ss;
  __device__ __forceinline__ void operator()(const f32x4 (&acc)[2][2][4][2], const Unit& u, int wr, int wc, int fr, int fq, int) const {
    const int row0 = u.pm * BM + wr * 64 + fr, col0 = u.pn * BM + wc * 32 + 8 * fq;
    f32x4 bv[2][2];
#pragma unroll
    for (int bj = 0; bj < 2; ++bj)
#pragma unroll
      for (int n = 0; n < 2; ++n) bv[bj][n] = *(const f32x4*)(bias + col0 + bj * HALF + 4 * n);
#pragma unroll
    for (int ai = 0; ai < 2; ++ai)
#pragma unroll
      for (int m = 0; m < 4; ++m) {
        const int row = row0 + ai * HALF + m * 16;
        const float scale = row < LPR ? 3.4526698300124393e-4f : 6.905339660024879e-4f;
        ::bf16_t* rowp = O + (size_t)row * 1024 + col0;
        float s = 0.f;
#pragma unroll
        for (int bj = 0; bj < 2; ++bj) {
          const f32x4 v0 = acc[ai][bj][m][0] * scale + bv[bj][0], v1 = acc[ai][bj][m][1] * scale + bv[bj][1];
          s += (v0[0] * v0[0] + v0[1] * v0[1]) + (v0[2] * v0[2] + v0[3] * v0[3]) + (v1[0] * v1[0] + v1[1] * v1[1]) + (v1[2] * v1[2] + v1[3] * v1[3]);
          u32x4 w; w.x = pk2(v0[0], v0[1]); w.y = pk2(v0[2], v0[3]); w.z = pk2(v1[0], v1[1]); w.w = pk2(v1[2], v1[3]);
          *(u32x4*)(rowp + bj * HALF) = w;
        }
        s += __shfl_xor(s, 16); s += __shfl_xor(s, 32);
        if (fq == 0) ss[row * 8 + u.pn * 4 + wc] = s;
      }
  }
};
struct EpiGlu {
  static constexpr bool PERM = true, AFTER_DRAIN = false, KHOOK = false; static constexpr int KH_T = 0;
  ::bf16_t* O; const float* bias; float* ss;
  __device__ __forceinline__ void operator()(const f32x4 (&acc)[2][2][4][2], const Unit& u, int wr, int wc, int fr, int fq, int) const {
    const int row0 = u.pm * BM + wr * 64 + fr, j0 = u.pn * 128 + wc * 32 + 8 * fq;
    f32x4 bv[2][2];
#pragma unroll
    for (int bj = 0; bj < 2; ++bj)
#pragma unroll
      for (int n = 0; n < 2; ++n) bv[bj][n] = *(const f32x4*)(bias + bj * 512 + j0 + 4 * n);
#pragma unroll
    for (int ai = 0; ai < 2; ++ai)
#pragma unroll
      for (int m = 0; m < 4; ++m) {
        const int row = row0 + ai * HALF + m * 16;
        float o[8], s = 0.f;
#pragma unroll
        for (int n = 0; n < 2; ++n)
#pragma unroll
          for (int e = 0; e < 4; ++e) {
            const float val = acc[ai][0][m][n][e] + bv[0][n][e], gate = acc[ai][1][m][n][e] + bv[1][n][e];
            const float y = val / (1.f + __expf(-gate));
            o[4 * n + e] = y; s += y * y;
          }
        u32x4 w; w.x = pk2(o[0], o[1]); w.y = pk2(o[2], o[3]); w.z = pk2(o[4], o[5]); w.w = pk2(o[6], o[7]);
        *(u32x4*)(O + (size_t)row * 1024 + 512 + j0) = w;
        s += __shfl_xor(s, 16); s += __shfl_xor(s, 32);
        if (fq == 0) ss[row * 16 + u.pn * 4 + wc] = s;
      }
  }
};
struct EpiZt {
  static constexpr bool PERM = true, AFTER_DRAIN = false, KHOOK = false; static constexpr int KH_T = 0;
  ::bf16_t* O;
  __device__ __forceinline__ void operator()(const f32x4 (&acc)[2][2][4][2], const Unit& u, int wr, int wc, int fr, int fq, int) const {
    const int v0 = u.pn * BM;
    ::bf16_t* base; size_t ld;
    if (v0 < LPR) { base = O + v0; ld = LPR; }
    else { const int vs = v0 - LPR; base = O + (size_t)512 * LPR + (size_t)(vs >> 12) * 512 * 4096 + (vs & 4095); ld = 4096; }
    const int c0 = u.pm * BM + wr * 64 + fr, col0 = wc * 32 + 8 * fq;
#pragma unroll
    for (int ai = 0; ai < 2; ++ai)
#pragma unroll
      for (int m = 0; m < 4; ++m) {
        ::bf16_t* rowp = base + (size_t)(c0 + ai * HALF + m * 16) * ld + col0;
#pragma unroll
        for (int bj = 0; bj < 2; ++bj) {
          const f32x4 a = acc[ai][bj][m][0], b = acc[ai][bj][m][1];
          u32x4 w; w.x = pk2(a[0], a[1]); w.y = pk2(a[2], a[3]); w.z = pk2(b[0], b[1]); w.w = pk2(b[2], b[3]);
          *(u32x4*)(rowp + bj * HALF) = w;
        }
      }
  }
};
struct EpiZs {
  static constexpr bool PERM = true, AFTER_DRAIN = false, KHOOK = false; static constexpr int KH_T = 0;
  ::bf16_t* O;
  __device__ __forceinline__ void operator()(const f32x4 (&acc)[2][2][4][2], const Unit& u, int wr, int wc, int fr, int fq, int) const {
    const int r0 = u.pm * BM + wr * 64 + fr, col0 = u.pn * BM + wc * 32 + 8 * fq;
#pragma unroll
    for (int ai = 0; ai < 2; ++ai)
#pragma unroll
      for (int m = 0; m < 4; ++m) {
        const int tok = permtok(r0 + ai * HALF + m * 16);
#pragma unroll
        for (int bj = 0; bj < 2; ++bj) {
          const int col = col0 + bj * HALF;
          const f32x4 a = acc[ai][bj][m][0], b = acc[ai][bj][m][1];
          u32x4 w; w.x = pk2(a[0], a[1]); w.y = pk2(a[2], a[3]); w.z = pk2(b[0], b[1]); w.w = pk2(b[2], b[3]);
          *(u32x4*)(O + ((size_t)(col >> 4) * 1280 + (tok >> 6)) * 1280 + (tok & 63) * 16 + (col & 15)) = w;
        }
      }
  }
};
struct EpiS {
  static constexpr bool PERM = false, AFTER_DRAIN = false, KHOOK = false; static constexpr int KH_T = 0;
  float* O;
  __device__ __forceinline__ void operator()(const f32x4 (&acc)[2][2][4][2], const Unit& u, int wr, int wc, int fr, int fq, int) const {
#pragma unroll
    for (int ai = 0; ai < 2; ++ai)
#pragma unroll
      for (int m = 0; m < 4; ++m) {
        float* rowp = O + (size_t)(u.pm * BM + ai * HALF + wr * 64 + m * 16 + fr) * 256 + wc * 32 + 4 * fq;
#pragma unroll
        for (int bj = 0; bj < 2; ++bj)
#pragma unroll
          for (int n = 0; n < 2; ++n) *(f32x4*)(rowp + bj * HALF + n * 16) = acc[ai][bj][m][n];
      }
  }
};
struct EpiGelu {
  static constexpr bool PERM = true, AFTER_DRAIN = false, KHOOK = false; static constexpr int KH_T = 0;
  ::bf16_t* O;
  __device__ __forceinline__ void operator()(const f32x4 (&acc)[2][2][4][2], const Unit& u, int wr, int wc, int fr, int fq, int) const {
    const int gi = u.pn >> 2, n0 = (u.pn & 3) * BM + wc * 32 + 8 * fq, ch0 = u.pm * BM - gi * 1280 + wr * 64 + fr;
#pragma unroll
    for (int ai = 0; ai < 2; ++ai)
#pragma unroll
      for (int m = 0; m < 4; ++m) {
        const int ch = ch0 + ai * HALF + m * 16;
#pragma unroll
        for (int bj = 0; bj < 2; ++bj) {
          const int n = n0 + bj * HALF;
          float o[8];
#pragma unroll
          for (int e = 0; e < 4; ++e) { o[e] = gelu_tanh(acc[ai][bj][m][0][e]); o[4 + e] = gelu_tanh(acc[ai][bj][m][1][e]); }
          u32x4 w; w.x = pk2(o[0], o[1]); w.y = pk2(o[2], o[3]); w.z = pk2(o[4], o[5]); w.w = pk2(o[6], o[7]);
          *(u32x4*)(O + (size_t)(ch * 64 + (n >> 4)) * 512 + gi * 16 + (n & 15)) = w;
        }
      }
  }
};
struct EpiWout {
  static constexpr bool PERM = false, AFTER_DRAIN = false, KHOOK = true; static constexpr int KH_T = 8;
  float* out; const float* xp; const float* xs; const float* mod;
  __device__ __forceinline__ void khook(f32x4 (&acc)[2][2][4][2], int ui, int wr, int fr, PG8_LAS unsigned char* lds) const {
    typedef float f32x2t __attribute__((ext_vector_type(2)));
    const PG8_LAS f32x2t* tab = (const PG8_LAS f32x2t*)(lds + 131072) + ui * 256;
#pragma unroll
    for (int ai = 0; ai < 2; ++ai)
#pragma unroll
      for (int m = 0; m < 4; ++m) {
        const float r = tab[ai * HALF + wr * 64 + m * 16 + fr].x;
#pragma unroll
        for (int bj = 0; bj < 2; ++bj)
#pragma unroll
          for (int n = 0; n < 2; ++n) acc[ai][bj][m][n] *= r;
      }
  }
  __device__ __forceinline__ void operator()(const f32x4 (&acc)[2][2][4][2], const Unit& u, int wr, int wc, int fr, int fq, int ui) const {
    typedef float f32x2t __attribute__((ext_vector_type(2)));
    const PG8_LAS f32x2t* tab = (const PG8_LAS f32x2t*)((PG8_LAS unsigned char*)dyn_smem + 131072) + ui * 256;
    const int col0 = u.pn * BM + wc * 32 + 4 * fq;
#pragma unroll
    for (int ai = 0; ai < 2; ++ai)
#pragma unroll
      for (int m = 0; m < 4; ++m) {
        const int rl = ai * HALF + wr * 64 + m * 16 + fr, row = u.pm * BM + rl;
        const float rs = tab[rl].y;
        const float* g1 = mod + batch_of(row) * 6144 + 2048;
        const float* xr = row < LPR ? xp + (size_t)row * 1024 : xs + (size_t)(row - LPR) * 1024;
        ::bf16_t* orow = (::bf16_t*)out + (size_t)row * 1024;
#pragma unroll
        for (int bj = 0; bj < 2; ++bj)
#pragma unroll
          for (int n = 0; n < 2; ++n) {
            const int col = col0 + bj * HALF + n * 16;
            const f32x4 xv = *(const f32x4*)(xr + col), gv = *(const f32x4*)(g1 + col);
            const f32x4 o = xv + gv * (acc[ai][bj][m][n] * rs);
            uint2 w; w.x = pk2(o[0], o[1]); w.y = pk2(o[2], o[3]);
            *(uint2*)(orow + col) = w;
          }
      }
  }
};
}

DI void phase2(const P& p) {
  {
    const pg8::Gemm g{p.wint(), p.hb(), 512, NTOK, 1024, 1024, 1024};
    pg8::StaticOrder S; S.init(512, NTOK, (int)gridDim.x, (int)blockIdx.x);
    const pg8::EpiZt E{p.zT()};
    pg8::gemm_phase<pg8::EpiZt, pg8::StaticOrder, true, true>((PG8_LAS unsigned char*)dyn_smem, otid(), g, S, E);
  }
  {
    const pg8::Gemm g{p.hb(), p.wint() + (size_t)512 * 1024, NTOK, 512, 1024, 1024, 1024};
    pg8::StaticOrder S; S.init(NTOK, 512, (int)gridDim.x, (int)(gridDim.x - 1 - blockIdx.x));
    const pg8::EpiZs E{p.Ucat()};
    pg8::gemm_phase<pg8::EpiZs, pg8::StaticOrder, true, true>((PG8_LAS unsigned char*)dyn_smem, otid(), g, S, E);
  }
}
DI void phase3(const P& p) {
  {
    const pg8::Gemm g{p.Ucat(), p.Bs(), 32 * 1280, 32 * 256, 1024, 1280, 1024};
    pg8::GroupOrder S; S.init(32, 5, 1, (int)gridDim.x, (int)blockIdx.x);
    const pg8::EpiS E{p.S()};
    pg8::gemm_phase<pg8::EpiS, pg8::GroupOrder, true, true>((PG8_LAS unsigned char*)dyn_smem, otid(), g, S, E);
  }
  GEO
  bf16_t* sm = (bf16_t*)(dyn_smem + half * SMEM_HALF);
  const int G = (int)gridDim.x, slot = ((int)blockIdx.x & 7) * (G >> 3) + ((int)blockIdx.x >> 3);
  const int nbusy = 160 < G ? 160 : G, nfree = G - nbusy;
  int q0, qs, qe;
  if (nfree <= 0) { q0 = slot; qs = G; qe = 2560; }
  else if (slot < nbusy) { q0 = slot; qs = nbusy; qe = nbusy * 9; }
  else { q0 = nbusy * 9 + (slot - nbusy); qs = nfree; qe = 2560; }
  for (int q = q0; q < qe; q += qs) {
    const int t = 2 * q + half;
    if (t < 1024) fft1_tile<128>(p, sm, t >> 1, t & 1);
    else fft1_tile<64>(p, sm, t - 1024, 0);
  }
}
DI void phase5(const P& p) {
  const pg8::Gemm g{p.Ucat(), p.Tcat(), 32 * 1280, 32 * 1024, 1280, 1280, 1280};
  pg8::GroupOrder S; S.init(32, 5, 4, (int)gridDim.x, (int)blockIdx.x);
  const pg8::EpiGelu E{p.gact()};
  pg8::gemm_phase<pg8::EpiGelu, pg8::GroupOrder, true, true>((PG8_LAS unsigned char*)dyn_smem, otid(), g, S, E);
}
DI void phase6(const P& p) {
  {
    const pg8::Gemm g{p.AF(), p.Mf(), NTOK, 512, 1024, 1024, 1024};
    pg8::StaticOrder S; S.init(NTOK, 512, (int)gridDim.x, (int)blockIdx.x);
    const pg8::EpiYf E{p.mg(), p.b_f, p.ssf()};
    pg8::gemm_phase<pg8::EpiYf, pg8::StaticOrder, true, true>((PG8_LAS unsigned char*)dyn_smem, otid(), g, S, E);
  }
  {
    const pg8::Gemm g{p.gact(), p.wglut(), NTOK, 1024, 512, 512, 512};
    pg8::StaticOrder S; S.init(NTOK, 1024, (int)gridDim.x, (int)(gridDim.x - 1 - blockIdx.x));
    const pg8::EpiGlu E{p.mg(), p.b_glu, p.sss()};
    pg8::gemm_phase<pg8::EpiGlu, pg8::StaticOrder, true, true>((PG8_LAS unsigned char*)dyn_smem, otid(), g, S, E);
  }
}
DI void phase7(const P& p) {
  const pg8::Gemm g{p.mg(), p.woutt(), NTOK, 1024, 1024, 1024, 1024};
  pg8::StaticOrder S; S.init(NTOK, 1024, (int)gridDim.x, (int)blockIdx.x);
  {
    typedef float f32x2t __attribute__((ext_vector_type(2)));
    PG8_LAS f32x2t* tab = (PG8_LAS f32x2t*)((PG8_LAS unsigned char*)dyn_smem + 131072);
    const int tix7 = otid();
    pg8::Unit u;
    for (int i = 0; i < 8 && S.next(i, u); ++i) {
      if (tix7 < 256) {
        const int tok = u.pm * 256 + tix7;
        float sf = 0.f, s2 = 0.f;
#pragma unroll
        for (int j = 0; j < 8; j++) sf += p.ssf()[tok * 8 + j];
#pragma unroll
        for (int j = 0; j < 16; j++) s2 += p.sss()[tok * 16 + j];
        const float rf = rsqrtf(sf * (1.f / 512.f) + EPSV), rs = rsqrtf(s2 * (1.f / 512.f) + EPSV);
        tab[i * 256 + tix7] = (f32x2t){rf / rs, rs};
      }
    }
    __syncthreads();
  }
  const pg8::EpiWout E{p.out, p.xp, p.xs, p.mod()};
  pg8::gemm_phase<pg8::EpiWout, pg8::StaticOrder, true, true>((PG8_LAS unsigned char*)dyn_smem, otid(), g, S, E);
}
DI void phase8(const P& p) {
  const pg8::Gemm g{p.hb(), p.w1t(), NTOK, 4096, 1024, 1024, 1024};
  pg8::StaticOrder S; S.init(NTOK, 4096, (int)gridDim.x, (int)blockIdx.x);
  const pg8::EpiMlpIn E{p.hid(), p.b1};
  pg8::gemm_phase<pg8::EpiMlpIn, pg8::StaticOrder, true, true>((PG8_LAS unsigned char*)dyn_smem, otid(), g, S, E);
}
DI void phase9(const P& p) {
  const pg8::Gemm g{p.hid(), p.w2t(), NTOK, 1024, 4096, 4096, 4096};
  pg8::StaticOrder S; S.init(NTOK, 1024, (int)gridDim.x, (int)blockIdx.x);
  const pg8::EpiMlpOut E{(const bf16_t*)p.out, p.hb(), p.mod(), p.b2};
  pg8::gemm_phase<pg8::EpiMlpOut, pg8::StaticOrder, true, true>((PG8_LAS unsigned char*)dyn_smem, otid(), g, S, E);
}

__global__ void __launch_bounds__(512, 2) k_mega(P p) {
  cg::grid_group grid = cg::this_grid();
  phase0(p); grid.sync();
  rownorm_mod<true>(p, p.g_mix, 0, 1024); grid.sync();
  phase2(p); grid.sync();
  phase3(p); grid.sync();
  phase4(p); grid.sync();
  phase5(p); grid.sync();
  phase6(p); grid.sync();
  phase7(p); grid.sync();
  rownorm_mod<false>(p, p.g_mlp, 3072, 4096); grid.sync();
  phase8(p); grid.sync();
  phase9(p); grid.sync();
  final_norm(p);
}

extern "C" void kernel_launch(void* const* d_in, const int* in_sizes, int n_in, void* d_out, int out_size, void* d_ws, size_t ws_size,
                              hipStream_t stream) {
  P p{};
  const float** f = (const float**)&p;
  for (int i = 0; i < 29; i++) f[i] = (const float*)d_in[i];
  p.out = (float*)d_out;
  p.ws = (char*)d_ws;
  if (WS_NEED > ws_size) { fprintf(stderr, "workspace too small: need %zu have %zu\n", (size_t)WS_NEED, ws_size); return; }
  static int grid_blocks = 0;
  if (!grid_blocks) {
    int dev = 0, cus = 0, per_cu = 0;
    (void)hipGetDevice(&dev);
    (void)hipDeviceGetAttribute(&cus, hipDeviceAttributeMultiprocessorCount, dev);
    (void)hipFuncSetAttribute((const void*)k_mega, hipFuncAttributeMaxDynamicSharedMemorySize, SMEM_BYTES);
    (void)hipOccupancyMaxActiveBlocksPerMultiprocessor(&per_cu, k_mega, 512, SMEM_BYTES);
    if (per_cu < 1) per_cu = 1;
    grid_blocks = cus * per_cu;
  }
  void* args[] = {&p};
  hipError_t e = hipLaunchCooperativeKernel((void*)k_mega, dim3(grid_blocks), dim3(512), args, SMEM_BYTES, stream);
  if (e != hipSuccess) fprintf(stderr, "cooperative launch failed: %s (grid %d)\n", hipGetErrorString(e), grid_blocks);
}
```

```cpp
#include <hip/hip_runtime.h>
#include <hip/hip_cooperative_groups.h>
#include <stdint.h>
#include <stdio.h>
namespace cg = cooperative_groups;


#define DI __device__ __forceinline__
typedef unsigned short bf16_t;
typedef short bf16x8 __attribute__((ext_vector_type(8)));
typedef float f32x16 __attribute__((ext_vector_type(16)));
typedef float f32x4 __attribute__((ext_vector_type(4)));

constexpr int NTOK = 81920, LPR = 16384, LSM = 4096;
constexpr int SMEM_HALF = 73728;
constexpr int SMEM_BYTES = 2 * SMEM_HALF;
constexpr float EPSV = 1e-6f;

constexpr size_t al256(size_t x) { return (x + 255) & ~(size_t)255; }
constexpr size_t O_mod = 0;
constexpr size_t O_modp = O_mod + al256(17 * 6144 * 4);
constexpr size_t O_AT = O_modp + al256(4 * 17 * 6144 * 4);
constexpr size_t O_ssf = O_AT + al256(32 * 2 * 64 * 2 * 4);
constexpr size_t O_sss = O_ssf + al256((size_t)NTOK * 8 * 4);
constexpr size_t O_twp = O_sss + al256((size_t)NTOK * 16 * 4);
constexpr size_t O_tws = O_twp + al256(LPR * 8);
constexpr size_t O_wint = O_tws + al256(LSM * 8);
constexpr size_t O_wglut = O_wint + al256(1024 * 1024 * 2);
constexpr size_t O_woutt = O_wglut + al256(1024 * 512 * 2);
constexpr size_t O_w1t = O_woutt + al256(1024 * 1024 * 2);
constexpr size_t O_w2t = O_w1t + al256((size_t)4096 * 1024 * 2);
constexpr size_t O_Mf = O_w2t + al256((size_t)4096 * 1024 * 2);
constexpr size_t O_Fb1 = O_Mf + al256(512 * 1024 * 2);
constexpr size_t O_Fb2 = O_Fb1 + al256(1024 * 256 * 2);
constexpr size_t O_Bs = O_Fb2 + al256(512 * 256 * 2);
constexpr size_t O_Tcat = O_Bs + al256((size_t)32 * 256 * 1024 * 2);
constexpr size_t O_hb = O_Tcat + al256((size_t)32 * 1024 * 1280 * 2);
constexpr size_t O_zT = O_hb + al256((size_t)NTOK * 1024 * 2);
constexpr size_t O_Ucat = O_zT + al256((size_t)NTOK * 512 * 2);
constexpr size_t O_AF = O_Ucat + al256((size_t)32 * 1280 * 1280 * 2);
constexpr size_t O_S = O_AF + al256((size_t)NTOK * 1024 * 2);
constexpr size_t O_gact = O_S + al256((size_t)1280 * 32 * 256 * 4);
constexpr size_t O_mg = O_gact + al256((size_t)NTOK * 512 * 2);
constexpr size_t O_END = O_mg + al256((size_t)NTOK * 1024 * 2);
constexpr size_t O_Tt = O_hb;
constexpr size_t O_hid = O_zT;
constexpr size_t WS_NEED = (O_hid + (size_t)NTOK * 4096 * 2 > O_END ? O_hid + (size_t)NTOK * 4096 * 2 : O_END);
struct P {
  const float *xp, *xs, *cp, *cs, *w_ada, *b_ada, *g_mix, *w_in, *w_f, *b_f, *a_re, *a_im, *log_dt, *b_re, *b_im, *c_re, *c_im,
      *ssm_d, *w_glu, *b_glu, *g_fo, *g_so, *w_out, *g_mlp, *w1, *b1, *w2, *b2, *g_final;
  float* out;
  char* ws;
  __device__ __forceinline__ float* mod() const { return (float*)(ws + O_mod); }
  __device__ __forceinline__ float* modp() const { return (float*)(ws + O_modp); }
  __device__ __forceinline__ float* AT() const { return (float*)(ws + O_AT); }
  __device__ __forceinline__ float* ssf() const { return (float*)(ws + O_ssf); }
  __device__ __forceinline__ float* sss() const { return (float*)(ws + O_sss); }
  __device__ __forceinline__ float2* twp() const { return (float2*)(ws + O_twp); }
  __device__ __forceinline__ float2* tws() const { return (float2*)(ws + O_tws); }
  __device__ __forceinline__ bf16_t* wint() const { return (bf16_t*)(ws + O_wint); }
  __device__ __forceinline__ bf16_t* wglut() const { return (bf16_t*)(ws + O_wglut); }
  __device__ __forceinline__ bf16_t* woutt() const { return (bf16_t*)(ws + O_woutt); }
  __device__ __forceinline__ bf16_t* w1t() const { return (bf16_t*)(ws + O_w1t); }
  __device__ __forceinline__ bf16_t* w2t() const { return (bf16_t*)(ws + O_w2t); }
  __device__ __forceinline__ bf16_t* Mf() const { return (bf16_t*)(ws + O_Mf); }
  __device__ __forceinline__ bf16_t* Fb1() const { return (bf16_t*)(ws + O_Fb1); }
  __device__ __forceinline__ bf16_t* Fb2() const { return (bf16_t*)(ws + O_Fb2); }
  __device__ __forceinline__ bf16_t* Bs() const { return (bf16_t*)(ws + O_Bs); }
  __device__ __forceinline__ bf16_t* Tcat() const { return (bf16_t*)(ws + O_Tcat); }
  __device__ __forceinline__ bf16_t* Ucat() const { return (bf16_t*)(ws + O_Ucat); }
  __device__ __forceinline__ bf16_t* hb() const { return (bf16_t*)(ws + O_hb); }
  __device__ __forceinline__ bf16_t* zT() const { return (bf16_t*)(ws + O_zT); }
  __device__ __forceinline__ bf16_t* AF() const { return (bf16_t*)(ws + O_AF); }
  __device__ __forceinline__ float* S() const { return (float*)(ws + O_S); }
  __device__ __forceinline__ bf16_t* mg() const { return (bf16_t*)(ws + O_mg); }
  __device__ __forceinline__ bf16_t* gact() const { return (bf16_t*)(ws + O_gact); }
  __device__ __forceinline__ bf16_t* Tt() const { return (bf16_t*)(ws + O_Tt); }
  __device__ __forceinline__ bf16_t* hid() const { return (bf16_t*)(ws + O_hid); }
};

typedef float f32x2v __attribute__((ext_vector_type(2)));
typedef __bf16 bf16x2v __attribute__((ext_vector_type(2)));
DI uint32_t pk2(float lo, float hi) { const f32x2v v = {lo, hi}; const bf16x2v r = __builtin_convertvector(v, bf16x2v); return __builtin_bit_cast(uint32_t, r); }
DI bf16_t f2bf(float f) { return (bf16_t)(pk2(f, 0.f) & 0xffffu); }
extern __shared__ __attribute__((aligned(16))) unsigned char dyn_smem[];
DI int otid(int wv) {
  unsigned m = ~0u; asm volatile("" : "+s"(m));
  const int lane = (int)__builtin_amdgcn_mbcnt_hi(m, __builtin_amdgcn_mbcnt_lo(m, 0u));
  int t = (wv << 6) | lane; asm volatile("" : "+v"(t)); return t;
}
DI int tok2v(int tok) {
  if (tok < LPR) { const int l1 = tok >> 7, l2 = tok & 127; return ((l2 & 63) << 8) | ((l2 >> 6) << 7) | l1; }
  const int ts = tok - LPR, w = ts & 4095, l1 = w >> 6, l2 = w & 63;
  return LPR + (ts & ~4095) + (((l2 & 15) << 8) | ((l2 >> 4) << 6) | l1);
}
DI int v2tok(int v) {
  if (v < LPR) return ((v & 127) << 7) | (((v >> 7) & 1) << 6) | (v >> 8);
  const int vs = v - LPR, w = vs & 4095;
  return LPR + (vs & ~4095) + (((w & 63) << 6) | (((w >> 6) & 3) << 4) | (w >> 8));
}
DI int batch_of(int tok) { return tok < LPR ? 0 : 1 + ((tok - LPR) >> 12); }
DI float gelu_tanh(float x) {
  const float u = 0.7978845608028654f * (x + 0.044715f * x * x * x);
  return x / (1.f + __expf(-2.f * u));
}
DI float wave_sum(float v) {
  v += __shfl_xor(v, 32); v += __shfl_xor(v, 16); v += __shfl_xor(v, 8); v += __shfl_xor(v, 4); v += __shfl_xor(v, 2); v += __shfl_xor(v, 1);
  return v;
}

DI void ssm_pow(const P& p, int g, int dir, int pp, int j, float& re, float& im) {
  const int ia = (dir * 32 + g) * 64 + pp;
  const float lr = fminf(p.a_re[ia], -1e-4f), li = p.a_im[ia], dt = expf(p.log_dt[dir * 32 + g]);
  const float mag = expf(lr * dt * (float)j);
  double t = (double)li * (double)dt * (double)j * 0.15915494309189535;
  t -= rint(t);
  const float ang = (float)(t * 6.283185307179586);
  float s, c; sincosf(ang, &s, &c);
  re = mag * c; im = mag * s;
}
DI void ssm_coef(const P& p, int g, int dir, int pp, float& cr, float& ci) {
  const int ia = (dir * 32 + g) * 64 + pp;
  const float lr = fminf(p.a_re[ia], -1e-4f), li = p.a_im[ia];
  float ar, ai; ssm_pow(p, g, dir, pp, 1, ar, ai);
  const float nr = ar - 1.f, ni = ai, den = 1.f / (lr * lr + li * li);
  cr = (nr * lr + ni * li) * den; ci = (ni * lr - nr * li) * den;
}

template <class CM>
DI void transpose_job(float* tile, const int tid, bool act, int item2, const float* in, int ld, int Kdim, bf16_t* out, const CM& colmap, const float* sc0, const float* sc1) {
  const int nkt = Kdim / 64;
  __syncthreads();
  if (act) {
    float v[16];
#pragma unroll
    for (int u = 0; u < 2; u++) {
      const int item = 2 * item2 + u, nt = item / nkt, kt = item % nkt;
      const int c = tid & 31, kr = tid >> 5, col = colmap(nt * 32 + c);
#pragma unroll
      for (int i = 0; i < 8; i++) v[u * 8 + i] = in[(size_t)(kt * 64 + kr + 8 * i) * ld + col];
    }
#pragma unroll
    for (int u = 0; u < 2; u++) {
      const int item = 2 * item2 + u, kt = item % nkt;
      const int c = tid & 31, kr = tid >> 5;
#pragma unroll
      for (int i = 0; i < 8; i++) {
        const int kl = kr + 8 * i, k = kt * 64 + kl;
        float x = v[u * 8 + i];
        if (sc0) x *= (k < 512 ? sc0[k] : sc1[k - 512]);
        tile[u * 64 * 33 + kl * 33 + c] = x;
      }
    }
  }
  __syncthreads();
  if (act) {
#pragma unroll
    for (int u = 0; u < 2; u++) {
      const int item = 2 * item2 + u, nt = item / nkt, kt = item % nkt;
      const int nl = tid >> 3, kc = tid & 7;
      float x[8];
#pragma unroll
      for (int j = 0; j < 8; j++) x[j] = tile[u * 64 * 33 + (kc * 8 + j) * 33 + nl];
      uint4 w; w.x = pk2(x[0], x[1]); w.y = pk2(x[2], x[3]); w.z = pk2(x[4], x[5]); w.w = pk2(x[6], x[7]);
      *(uint4*)(out + (size_t)(nt * 32 + nl) * Kdim + kt * 64 + kc * 8) = w;
    }
  }
}

DI void phase0(const P& p, const int wv) {
  const int tix = otid(wv);
  unsigned char* smraw = dyn_smem + (tix >> 8) * SMEM_HALF;
  float* smf = (float*)smraw;
  const int tid = tix & 255, nb = gridDim.x * 2, bid = blockIdx.x * 2 + (tix >> 8);
  for (int base = 0; base < 384; base += nb) {
    const int item = base + bid; const bool act = item < 384;
    const int cg = act ? item % 96 : 0, ks = act ? item / 96 : 0;
    __syncthreads();
    if (act)
      for (int i = tid; i < 17 * 256; i += 256) {
        const int b = i >> 8, k = ks * 256 + (i & 255);
        const float c = b == 0 ? p.cp[k] : p.cs[(b - 1) * 1024 + k];
        smf[i] = c / (1.f + __expf(-c));
      }
    __syncthreads();
    const int col = tid & 63, sub = tid >> 6, j = cg * 64 + col;
    float a[17];
#pragma unroll
    for (int b = 0; b < 17; b++) a[b] = 0.f;
    if (act) {
#pragma unroll 1
      for (int bt = 0; bt < 4; bt++) {
        const int k0 = sub * 64 + bt * 16;
        float w[16];
#pragma unroll
        for (int i = 0; i < 16; i++) w[i] = p.w_ada[(size_t)(ks * 256 + k0 + i) * 6144 + j];
#pragma unroll
        for (int i = 0; i < 16; i++)
#pragma unroll
          for (int b = 0; b < 17; b++) a[b] += smf[b * 256 + k0 + i] * w[i];
      }
    }
    float* red = smf + 17 * 256;
#pragma unroll
    for (int b = 0; b < 17; b++) red[(sub * 17 + b) * 64 + col] = a[b];
    __syncthreads();
    if (act)
      for (int i = tid; i < 17 * 64; i += 256) {
        const int b = i >> 6, c2 = i & 63;
        float sum = red[(0 * 17 + b) * 64 + c2] + red[(1 * 17 + b) * 64 + c2] + red[(2 * 17 + b) * 64 + c2] + red[(3 * 17 + b) * 64 + c2];
        if (ks == 0) sum += p.b_ada[cg * 64 + c2];
        p.modp()[(size_t)(ks * 17 + b) * 6144 + cg * 64 + c2] = sum;
      }
  }
  {
    auto ident = [](int n) { return n; };
    auto glumap = [](int n) { return ((n >> 7) & 1) * 512 + (n >> 8) * 128 + (n & 127); };
    const int n0 = 256, n1 = n0 + 128, n2 = n1 + 256, n3 = n2 + 1024, n4 = n3 + 1024;
    for (int base = 0; base < n4; base += nb) {
      const int item = base + bid; const bool act = item < n4;
      if (item < n0) transpose_job(smf, tid, act, item, p.w_in, 1024, 1024, p.wint(), ident, nullptr, nullptr);
      else if (item < n1) transpose_job(smf, tid, act, item - n0, p.w_glu, 1024, 512, p.wglut(), glumap, nullptr, nullptr);
      else if (item < n2) transpose_job(smf, tid, act, item - n1, p.w_out, 1024, 1024, p.woutt(), ident, p.g_fo, p.g_so);
      else if (item < n3) transpose_job(smf, tid, act, item - n2, p.w1, 4096, 1024, p.w1t(), ident, nullptr, nullptr);
      else transpose_job(smf, tid, act, item - n3, p.w2, 1024, 4096, p.w2t(), ident, nullptr, nullptr);
    }
  }
  {
    __syncthreads();
    float2* cs = (float2*)smraw;
    for (int i = tid; i < 512; i += 256) { float s, c; sincosf((float)i * (6.283185307179586f / 512.f), &s, &c); cs[i] = make_float2(c, s); }
    __syncthreads();
    for (int item = bid; item < 128; item += nb) {
      const int idx = item * 256 + tid, k = idx & 1023, he = idx >> 10, h = he >> 3, e0 = (he & 7) * 16, c = k & 511;
      const bool is_sin = k >= 512;
      const float* wf = p.w_f + (size_t)h * 128 * 128 + e0;
      float a[16];
#pragma unroll
      for (int e = 0; e < 16; e++) a[e] = 0.f;
#pragma unroll 4
      for (int d = 0; d < 128; d++) {
        const float2 t = cs[((h * 128 + d) * c) & 511];
        const float tv = is_sin ? t.y : t.x;
        const f32x4 w0 = *(const f32x4*)(wf + d * 128), w1 = *(const f32x4*)(wf + d * 128 + 4), w2 = *(const f32x4*)(wf + d * 128 + 8), w3 = *(const f32x4*)(wf + d * 128 + 12);
#pragma unroll
        for (int e = 0; e < 4; e++) { a[e] += tv * w0[e]; a[4 + e] += tv * w1[e]; a[8 + e] += tv * w2[e]; a[12 + e] += tv * w3[e]; }
      }
#pragma unroll
      for (int e = 0; e < 16; e++) p.Mf()[(size_t)(h * 128 + e0 + e) * 1024 + k] = f2bf(a[e]);
    }
  }
  {
    const int gsz = nb * 256, gt = bid * 256 + tid;
    for (int i = gt; i < 1024 * 256; i += gsz) {
      const int nrg = i >> 8, k = i & 255, tb = nrg >> 9, nr = nrg & 511, part = (nr >> 7) & 1, idx8 = ((nr >> 8) << 7) | (nr & 127);
      const int R = tb ? 64 : 128, sh = tb ? 6 : 7, l2p = idx8 >> sh, k1 = idx8 & (R - 1), l2k = k >> sh, l1 = k & (R - 1);
      float sv, cv; sincosf((float)((k1 * l1) & (R - 1)) * (6.283185307179586f / (float)R), &sv, &cv);
      p.Fb1()[i] = f2bf(l2k == l2p ? (part ? -sv : cv) : 0.f);
    }
    for (int i = gt; i < 512 * 256; i += gsz) {
      const int nrg = i >> 8, k = i & 255, tb = nrg >> 8, nr = nrg & 255;
      float v;
      if (tb == 0) {
        const int part = nr >> 7, k2 = nr & 127, ki = k >> 7, l2 = k & 127;
        float sv, cv; sincosf((float)((k2 * l2) & 127) * (6.283185307179586f / 128.f), &sv, &cv);
        v = part == 0 ? (ki == 0 ? cv : sv) : (ki == 0 ? -sv : cv);
      } else {
        const int blk = nr >> 7, n2 = nr & 127, part = n2 >> 6, k2 = n2 & 63, kb = k >> 7, kk = k & 127, ki = kk >> 6, l2 = kk & 63;
        float sv, cv; sincosf((float)((k2 * l2) & 63) * (6.283185307179586f / 64.f), &sv, &cv);
        v = blk == kb ? (part == 0 ? (ki == 0 ? cv : sv) : (ki == 0 ? -sv : cv)) : 0.f;
      }
      p.Fb2()[i] = f2bf(v);
    }
    for (int i = gt; i < LPR; i += gsz) { float s, c; sincosf((float)i * (6.283185307179586f / 16384.f), &s, &c); p.twp()[i] = make_float2(c, s); }
    for (int i = gt; i < LSM; i += gsz) { float s, c; sincosf((float)i * (6.283185307179586f / 4096.f), &s, &c); p.tws()[i] = make_float2(c, s); }
    for (int i = gt; i < 32 * 2 * 64 * 64; i += gsz) {
      const int s = i & 63, pp = (i >> 6) & 63, dir = (i >> 12) & 1, g = i >> 13;
      float pr, pi, cr, ci; ssm_pow(p, g, dir, pp, dir == 0 ? 63 - s : s, pr, pi); ssm_coef(p, g, dir, pp, cr, ci);
      const float qr = pr * cr - pi * ci, qi = pr * ci + pi * cr;
      const int ib = ((dir * 32 + g) * 64 + pp) * 16;
      float vr[16], vi[16];
#pragma unroll
      for (int h = 0; h < 16; h++) { const float br = p.b_re[ib + h], bi = p.b_im[ib + h]; vr[h] = qr * br - qi * bi; vi[h] = qr * bi + qi * br; }
      bf16_t* d0 = p.Bs() + ((size_t)(g * 256 + dir * 128 + pp)) * 1024 + s * 16;
      bf16_t* d1 = d0 + 64 * 1024;
      uint4 w;
      w.x = pk2(vr[0], vr[1]); w.y = pk2(vr[2], vr[3]); w.z = pk2(vr[4], vr[5]); w.w = pk2(vr[6], vr[7]); *(uint4*)d0 = w;
      w.x = pk2(vr[8], vr[9]); w.y = pk2(vr[10], vr[11]); w.z = pk2(vr[12], vr[13]); w.w = pk2(vr[14], vr[15]); *(uint4*)(d0 + 8) = w;
      w.x = pk2(vi[0], vi[1]); w.y = pk2(vi[2], vi[3]); w.z = pk2(vi[4], vi[5]); w.w = pk2(vi[6], vi[7]); *(uint4*)d1 = w;
      w.x = pk2(vi[8], vi[9]); w.y = pk2(vi[10], vi[11]); w.z = pk2(vi[12], vi[13]); w.w = pk2(vi[14], vi[15]); *(uint4*)(d1 + 8) = w;
    }
    for (int i = gt; i < 32 * 64 * 2 * 64; i += gsz) {
      const int pp = i & 63, dir = (i >> 6) & 1, t = (i >> 7) & 63, g = i >> 13;
      float pr, pi; ssm_pow(p, g, dir, pp, dir == 0 ? t + 1 : 64 - t, pr, pi);
#pragma unroll
      for (int h = 0; h < 16; h++) {
        const int ic = ((dir * 32 + g) * 16 + h) * 64 + pp;
        const float cr = p.c_re[ic], ci = p.c_im[ic];
        bf16_t* d = p.Tcat() + ((size_t)(g * 1024 + t * 16 + h)) * 1280 + 1024 + dir * 128 + pp;
        d[0] = f2bf(cr * pr - ci * pi);
        d[64] = f2bf(-(cr * pi + ci * pr));
      }
    }
    for (int i = gt; i < 32 * 2 * 64; i += gsz) {
      const int pp = i & 63, dir = (i >> 6) & 1, g = i >> 7;
      float pr, pi; ssm_pow(p, g, dir, pp, 64, pr, pi);
      p.AT()[i * 2] = pr; p.AT()[i * 2 + 1] = pi;
    }
  }
  {
    float2* q = (float2*)smraw;
    for (int base = 0; base < 32 * 127; base += nb) {
      const int item = base + bid; const bool act = item < 32 * 127;
      const int g = act ? item / 127 : 0, jj = act ? item % 127 : 0, lag = jj - 63;
      __syncthreads();
      if (tid < 128) {
        const int dir = tid >> 6, pp = tid & 63;
        float2 v = make_float2(0.f, 0.f);
        if ((dir == 0 && lag >= 0) || (dir == 1 && lag <= 0)) {
          float pr, pi, cr, ci; ssm_pow(p, g, dir, pp, lag < 0 ? -lag : lag, pr, pi); ssm_coef(p, g, dir, pp, cr, ci);
          v = make_float2(pr * cr - pi * ci, pr * ci + pi * cr);
        }
        q[tid] = v;
      }
      {
        float2* Cs = q + 128; float2* Bm = q + 128 + 2048;
        for (int i = tid; i < 2048; i += 256) {
          const int dir = i >> 10, j = i & 1023, src = (dir * 32 + g) * 1024 + j;
          Cs[i] = make_float2(p.c_re[src], p.c_im[src]); Bm[i] = make_float2(p.b_re[src], p.b_im[src]);
        }
      }
      __syncthreads();
      const int hp = tid >> 4, h = tid & 15;
      float a = 0.f;
      {
        const float2* Cs = q + 128; const float2* Bm = q + 128 + 2048;
#pragma unroll
        for (int dir = 0; dir < 2; dir++) {
          if ((dir == 0 && lag < 0) || (dir == 1 && lag > 0)) continue;
#pragma unroll 8
          for (int pp = 0; pp < 64; pp++) {
            const float2 cc = Cs[dir * 1024 + hp * 64 + pp], bb = Bm[dir * 1024 + pp * 16 + h], qq = q[dir * 64 + pp];
            const float er = cc.x * qq.x - cc.y * qq.y, ei = cc.x * qq.y + cc.y * qq.x;
            a += er * bb.x - ei * bb.y;
          }
        }
      }
      if (lag == 0 && hp == h) a += p.ssm_d[g * 16 + h];
      if (act) {
        const bf16_t kv = f2bf(a);
        const int t0 = lag > 0 ? lag : 0, t1 = lag > 0 ? 64 : 64 + lag;
        bf16_t* d = p.Tcat() + ((size_t)(g * 1024 + hp)) * 1280 + h;
        for (int t = t0; t < t1; t++) d[(size_t)t * 16 * 1280 + (t - lag) * 16] = kv;
      }
    }
  }
}

constexpr int RIF = 2;
DI float bflo(uint32_t u) { return __uint_as_float(u << 16); }
DI float bfhi(uint32_t u) { return __uint_as_float(u & 0xffff0000u); }
template <bool FROMX>
DI void rownorm_mod(const P& p, const int wv, const float* g, int sh_off, int sc_off) {
  const int tix = otid(wv), lane = tix & 63, wrow = blockIdx.x * 8 + (tix >> 6), nw = gridDim.x * 8;
  if (FROMX) {
    for (int i = blockIdx.x * 512 + tix; i < 17 * 6144; i += gridDim.x * 512)
      p.mod()[i] = (p.modp()[i] + p.modp()[17 * 6144 + i]) + (p.modp()[2 * 17 * 6144 + i] + p.modp()[3 * 17 * 6144 + i]);
  }
  for (int tok0 = wrow; tok0 < NTOK; tok0 += RIF * nw) {
    float v[RIF][16]; float ss[RIF];
#pragma unroll
    for (int rr = 0; rr < RIF; rr++) {
      const int tok = tok0 + rr * nw;
      if (tok < NTOK) {
        if (FROMX) {
          const float* src = tok < LPR ? p.xp + (size_t)tok * 1024 : p.xs + (size_t)(tok - LPR) * 1024;
#pragma unroll
          for (int i = 0; i < 4; i++) { const f32x4 t = *(const f32x4*)(src + (i * 64 + lane) * 4); v[rr][4 * i] = t[0]; v[rr][4 * i + 1] = t[1]; v[rr][4 * i + 2] = t[2]; v[rr][4 * i + 3] = t[3]; }
        } else {
          const bf16_t* src = (const bf16_t*)p.out + (size_t)tok * 1024;
#pragma unroll
          for (int i = 0; i < 2; i++) { const uint4 t = *(const uint4*)(src + (i * 64 + lane) * 8);
            v[rr][8 * i] = bflo(t.x); v[rr][8 * i + 1] = bfhi(t.x); v[rr][8 * i + 2] = bflo(t.y); v[rr][8 * i + 3] = bfhi(t.y);
            v[rr][8 * i + 4] = bflo(t.z); v[rr][8 * i + 5] = bfhi(t.z); v[rr][8 * i + 6] = bflo(t.w); v[rr][8 * i + 7] = bfhi(t.w); }
        }
      } else {
#pragma unroll
        for (int e = 0; e < 16; e++) v[rr][e] = 0.f;
      }
    }
#pragma unroll
    for (int rr = 0; rr < RIF; rr++) {
      ss[rr] = 0.f;
#pragma unroll
      for (int e = 0; e < 16; e++) ss[rr] += v[rr][e] * v[rr][e];
      ss[rr] = wave_sum(ss[rr]);
    }
#pragma unroll
    for (int rr = 0; rr < RIF; rr++) {
      const int tok = tok0 + rr * nw;
      if (tok >= NTOK) continue;
      const float r = rsqrtf(ss[rr] * (1.f / 1024.f) + EPSV);
      const float* md = (FROMX ? p.modp() : p.mod()) + batch_of(tok) * 6144;
      bf16_t* drow = p.hb() + (size_t)(FROMX ? tok2v(tok) : tok) * 1024;
      float o[16];
#pragma unroll
      for (int q = 0; q < 4; q++) {
        const int c = FROMX ? (q * 64 + lane) * 4 : ((q >> 1) * 64 + lane) * 8 + (q & 1) * 4;
        const f32x4 gg = *(const f32x4*)(g + c);
        f32x4 sc = *(const f32x4*)(md + sc_off + c), sh = *(const f32x4*)(md + sh_off + c);
        if (FROMX) {
#pragma unroll
          for (int ks = 1; ks < 4; ks++) { sc += *(const f32x4*)(md + ks * 17 * 6144 + sc_off + c); sh += *(const f32x4*)(md + ks * 17 * 6144 + sh_off + c); }
        }
#pragma unroll
        for (int e = 0; e < 4; e++) o[4 * q + e] = v[rr][4 * q + e] * r * gg[e] * (1.f + sc[e]) + sh[e];
      }
      if (FROMX) {
#pragma unroll
        for (int q = 0; q < 4; q++) { uint2 w; w.x = pk2(o[4 * q], o[4 * q + 1]); w.y = pk2(o[4 * q + 2], o[4 * q + 3]); *(uint2*)(drow + (q * 64 + lane) * 4) = w; }
      } else {
#pragma unroll
        for (int i = 0; i < 2; i++) { uint4 w; w.x = pk2(o[8 * i], o[8 * i + 1]); w.y = pk2(o[8 * i + 2], o[8 * i + 3]); w.z = pk2(o[8 * i + 4], o[8 * i + 5]); w.w = pk2(o[8 * i + 6], o[8 * i + 7]);
          *(uint4*)(drow + (i * 64 + lane) * 8) = w; }
      }
    }
  }
}
DI void final_norm(const P& p, const int wv) {
  const int tix = otid(wv), lane = tix & 63, wrow = blockIdx.x * 8 + (tix >> 6), nw = gridDim.x * 8;
  for (int tok0 = wrow; tok0 < NTOK; tok0 += RIF * nw) {
    float v[RIF][16]; float ss[RIF];
#pragma unroll
    for (int rr = 0; rr < RIF; rr++) {
      const int tok = tok0 + rr * nw;
      if (tok < NTOK) {
        const bf16_t* src = p.hb() + (size_t)tok * 1024;
#pragma unroll
        for (int i = 0; i < 2; i++) { const uint4 t = *(const uint4*)(src + (i * 64 + lane) * 8);
          v[rr][8 * i] = bflo(t.x); v[rr][8 * i + 1] = bfhi(t.x); v[rr][8 * i + 2] = bflo(t.y); v[rr][8 * i + 3] = bfhi(t.y);
          v[rr][8 * i + 4] = bflo(t.z); v[rr][8 * i + 5] = bfhi(t.z); v[rr][8 * i + 6] = bflo(t.w); v[rr][8 * i + 7] = bfhi(t.w); }
      } else {
#pragma unroll
        for (int e = 0; e < 16; e++) v[rr][e] = 0.f;
      }
    }
#pragma unroll
    for (int rr = 0; rr < RIF; rr++) {
      ss[rr] = 0.f;
#pragma unroll
      for (int e = 0; e < 16; e++) ss[rr] += v[rr][e] * v[rr][e];
      ss[rr] = wave_sum(ss[rr]);
    }
#pragma unroll
    for (int rr = 0; rr < RIF; rr++) {
      const int tok = tok0 + rr * nw;
      if (tok >= NTOK) continue;
      const float r = rsqrtf(ss[rr] * (1.f / 1024.f) + EPSV);
      float* drow = p.out + (size_t)tok * 1024;
#pragma unroll
      for (int q = 0; q < 4; q++) {
        const int c = ((q >> 1) * 64 + lane) * 8 + (q & 1) * 4;
        const f32x4 gg = *(const f32x4*)(p.g_final + c);
        f32x4 o;
#pragma unroll
        for (int e = 0; e < 4; e++) o[e] = v[rr][4 * q + e] * r * gg[e];
        *(f32x4*)(drow + c) = o;
      }
    }
  }
}

namespace pg8 {
#define PG8_LAS __attribute__((address_space(3)))
typedef unsigned short bf16_t;
typedef short bf16x8 __attribute__((ext_vector_type(8)));
typedef float f32x4 __attribute__((ext_vector_type(4)));
typedef unsigned u32x4 __attribute__((ext_vector_type(4)));
constexpr int BM = 256, BK = 64, HALF = 128, HTB = HALF * BK * 2  , STAGE_BYTES = 8 * HTB, NXCD = 8, WGM = 8;

__host__ __device__ __forceinline__ int lds_byte(int r, int c) { const int st = (r >> 4) * 2 + (c >> 5), rr = r & 15, cc = c & 31, ob = rr * 64 + cc * 2; return st * 1024 + (ob ^ (((ob >> 9) & 1) << 5)); }
__host__ __device__ __forceinline__ void stage_rc(int b, int& R, int& C) { const int st = b / 1024, sb = b % 1024, swz = sb ^ (((sb >> 9) & 1) << 5); R = (st >> 1) * 16 + swz / 64; C = (st & 1) * 32 + (swz % 64) / 2; }
__host__ __device__ __forceinline__ int perm32(int rho) { const int n = rho >> 4, i = rho & 15; return 8 * (i >> 2) + 4 * n + (i & 3); }

struct Unit { int pm, pn; };
struct Gemm { const bf16_t* A; const bf16_t* Bt; int M, N, K, lda, ldb; };

struct StaticOrder {
    int nM, nN, nwg, G, c;
    __host__ __device__ void init(int M, int N, int G_, int c_) { nM = M / BM; nN = N / BM; nwg = nM * nN; G = G_; c = c_; }
    __host__ __device__ bool next(int i, Unit& u) const {
        const long L = (long)i * G + c; if (L >= nwg) return false;
        int wgid = (int)L; { const int q = nwg / NXCD, r = nwg % NXCD, xcd = wgid % NXCD, off = wgid / NXCD; wgid = (xcd < r ? xcd * (q + 1) : r * (q + 1) + (xcd - r) * q) + off; }
        const int nig = WGM * nN, gid = wgid / nig, fm = gid * WGM, gsz = (nM - fm) < WGM ? (nM - fm) : WGM;
        u.pm = fm + ((wgid % nig) % gsz); u.pn = (wgid % nig) / gsz; return true;
    }
    __device__ __forceinline__ void a_ready(const Unit&) const {}
    __device__ __forceinline__ void done(const Unit&) const {}
};

struct GroupOrder {
    int nwg, G, c, um, un;
    __host__ __device__ void init(int ngroups, int um_, int un_, int G_, int c_) { um = um_; un = un_; nwg = ngroups * um * un; G = G_; c = (c_ & 7) * (G_ >> 3) + (c_ >> 3); }
    __host__ __device__ bool next(int i, Unit& u) const {
        const int L = i * G + c; if (L >= nwg) return false;
        const int gi = L / (um * un), r = L % (um * un); u.pm = gi * um + r / un; u.pn = gi * un + r % un; return true;
    }
    __device__ __forceinline__ void a_ready(const Unit&) const {}
    __device__ __forceinline__ void done(const Unit&) const {}
};
struct Fft1Order {
    int q0, qs, qe;
    __host__ __device__ void init(int G, int bidx) {
        const int slot = (bidx & 7) * (G >> 3) + (bidx >> 3), nbusy = 160 < G ? 160 : G, nfree = G - nbusy;
        if (nfree <= 0) { q0 = slot; qs = G; qe = 1280; }
        else if (slot < nbusy) { q0 = slot; qs = nbusy; qe = 560; }
        else { q0 = 560 + (slot - nbusy); qs = nfree; qe = 1280; }
    }
    __host__ __device__ bool next(int i, Unit& u) const { const int L = q0 + i * qs; if (L >= qe) return false; u.pn = L >> 1; u.pm = (L & 1) + (u.pn >= 128 ? 2 : 0); return true; }
    __device__ __forceinline__ void a_ready(const Unit&) const {}
    __device__ __forceinline__ void done(const Unit&) const {}
};
struct Fft2Order {
    int G, c;
    __host__ __device__ void init(int G_, int c_) { G = G_; c = c_; }
    __host__ __device__ bool next(int i, Unit& u) const { const int L = i * G + c; if (L >= 1280) return false; u.pn = L; u.pm = L < 256 ? 0 : 1; return true; }
    __device__ __forceinline__ void a_ready(const Unit&) const {}
    __device__ __forceinline__ void done(const Unit&) const {}
};
template <class Epi, class Sched, bool ALIGN_EPI = false, bool SP2 = false>
__device__ __forceinline__ void gemm_phase(PG8_LAS unsigned char* lds, const int tix, const Gemm g, const Sched& S, const Epi& E) {
    const int tid = tix, wid = __builtin_amdgcn_readfirstlane(tid >> 6), lane = tid & 63, wr = wid >> 2, wc = wid & 3, fr = lane & 15, fq = lane >> 4;
    const int K = g.K, nt = K / BK;
    unsigned voffA[2], voffB[2];
#pragma unroll
    for (int i = 0; i < 2; ++i) { int R, C; stage_rc(tid * 16 + i * 8192, R, C); const int Rb = Epi::PERM ? ((R & ~31) + perm32(R & 31)) : R;
        voffA[i] = (unsigned)(R * g.lda + C) * 2u; voffB[i] = (unsigned)(Rb * g.ldb + C) * 2u; }
    const size_t kstep = (size_t)(BK * 2);
    const size_t hstepA = (size_t)HALF * g.lda * 2, hstepB = (size_t)HALF * g.ldb * 2;
    const size_t tstepA = 2 * hstepA, tstepB = 2 * hstepB;
    const unsigned ldsw = (unsigned)wid * 1024u;
    const int aoff = lds_byte(wr * 64 + fr, fq * 8), boff = lds_byte(wc * 32 + fr, fq * 8);
#define PG8_SA(b, h) (((b) * 2 + (h)) * HTB)
#define PG8_SB(b, h) ((4 + (b) * 2 + (h)) * HTB)
#define PG8_STAGE(bufoff, gbase, voff) do { _Pragma("unroll") for (int _i = 0; _i < 2; ++_i) \
        __builtin_amdgcn_global_load_lds((const unsigned*)((const char*)(gbase) + (voff)[_i]), (PG8_LAS unsigned*)(lds + (bufoff) + ldsw + _i * 8192), 16, 0, 0); } while (0)
#define PG8_LDA(dst, b, h) do { _Pragma("unroll") for (int m = 0; m < 4; ++m) _Pragma("unroll") for (int k = 0; k < 2; ++k) dst[m][k] = *(const PG8_LAS bf16x8*)(lds + PG8_SA(b, h) + aoff + m * 2048 + k * 1024); } while (0)
#define PG8_LDB(dst, b, h) do { _Pragma("unroll") for (int n = 0; n < 2; ++n) _Pragma("unroll") for (int k = 0; k < 2; ++k) dst[n][k] = *(const PG8_LAS bf16x8*)(lds + PG8_SB(b, h) + boff + n * 2048 + k * 1024); } while (0)
#define PG8_MMA(ai, bj, At, Bt) do { __builtin_amdgcn_s_setprio(1); _Pragma("unroll") for (int m = 0; m < 4; ++m) _Pragma("unroll") for (int n = 0; n < 2; ++n) _Pragma("unroll") for (int k = 0; k < 2; ++k) \
        acc[ai][bj][m][n] = __builtin_amdgcn_mfma_f32_16x16x32_bf16(Bt[n][k], At[m][k], acc[ai][bj][m][n], 0, 0, 0); __builtin_amdgcn_s_setprio(0); } while (0)
#define PG8_WAIT_V(n) asm volatile("s_waitcnt vmcnt(" #n ")" ::: "memory")
#define PG8_WAIT_L(n) asm volatile("s_waitcnt lgkmcnt(" #n ")" ::: "memory")
#define PG8_BAR __builtin_amdgcn_s_barrier()
#define PG8_SCHED __builtin_amdgcn_sched_barrier(0)
    Unit cur, nxt; int ui = 0;
    if (!S.next(0, cur)) return;
    f32x4 acc[2][2][4][2];
#pragma unroll
    for (int a = 0; a < 2; ++a)
#pragma unroll
        for (int b = 0; b < 2; ++b)
#pragma unroll
            for (int m = 0; m < 4; ++m)
#pragma unroll
                for (int n = 0; n < 2; ++n) acc[a][b][m][n] = (f32x4){0.f, 0.f, 0.f, 0.f};
    bf16x8 At[4][2], B0[2][2], B1[2][2];
    const char* cA = (const char*)g.A + (size_t)cur.pm * tstepA; const char* cB = (const char*)g.Bt + (size_t)cur.pn * tstepB;
    S.a_ready(cur);
    if constexpr (SP2) {
        PG8_STAGE(PG8_SB(0, 0), cB, voffB); PG8_STAGE(PG8_SB(0, 1), cB + hstepB, voffB); PG8_STAGE(PG8_SA(0, 0), cA, voffA); PG8_STAGE(PG8_SA(0, 1), cA + hstepA, voffA);
        if (wr == 1) PG8_BAR;
        PG8_WAIT_V(2); PG8_BAR;
        PG8_STAGE(PG8_SB(1, 0), cB + kstep, voffB); PG8_STAGE(PG8_SA(1, 0), cA + kstep, voffA); PG8_STAGE(PG8_SB(1, 1), cB + hstepB + kstep, voffB);
        PG8_WAIT_V(6); PG8_BAR;
    } else {
        PG8_STAGE(PG8_SB(0, 0), cB, voffB); PG8_STAGE(PG8_SA(0, 0), cA, voffA); PG8_STAGE(PG8_SB(0, 1), cB + hstepB, voffB); PG8_STAGE(PG8_SA(0, 1), cA + hstepA, voffA);
        if (wr == 1) PG8_BAR;
        PG8_WAIT_V(4); PG8_BAR;
        PG8_STAGE(PG8_SB(1, 0), cB + kstep, voffB); PG8_STAGE(PG8_SA(1, 0), cA + kstep, voffA); PG8_STAGE(PG8_SB(1, 1), cB + hstepB + kstep, voffB);
        PG8_WAIT_V(6); PG8_BAR;
    }
    for (;;) {
        const bool has_next = S.next(ui + 1, nxt);
        const char* nA = has_next ? (const char*)g.A + (size_t)nxt.pm * tstepA : cA; const char* nB = has_next ? (const char*)g.Bt + (size_t)nxt.pn * tstepB : cB;
        for (int t = 0; t < nt; t += 2) {
            if constexpr (Epi::KHOOK) { if (t == Epi::KH_T) E.khook(acc, ui, wr, fr, lds); }
            const bool last = (t == nt - 2);
            const char* a1 = cA + (size_t)(t + 1) * kstep;
            const char* a2 = last ? nA : cA + (size_t)(t + 2) * kstep; const char* b2 = last ? nB : cB + (size_t)(t + 2) * kstep;
            const char* a3 = a2 + kstep; const char* b3 = b2 + kstep;
            if (last && has_next) S.a_ready(nxt);
            if constexpr (SP2) {
            PG8_LDB(B0, 0, 0); PG8_LDB(B1, 0, 1); PG8_SCHED; PG8_LDA(At, 0, 0); PG8_STAGE(PG8_SA(1, 1), a1 + hstepA, voffA);
            PG8_WAIT_V(8); PG8_WAIT_L(0); PG8_BAR; PG8_MMA(0, 0, At, B0); PG8_MMA(0, 1, At, B1); PG8_BAR; PG8_SCHED;
            PG8_LDA(At, 0, 1); PG8_STAGE(PG8_SB(0, 0), b2, voffB); PG8_STAGE(PG8_SB(0, 1), b2 + hstepB, voffB); PG8_STAGE(PG8_SA(0, 0), a2, voffA);
            PG8_WAIT_V(8); PG8_WAIT_L(0); PG8_BAR; PG8_MMA(1, 0, At, B0); PG8_MMA(1, 1, At, B1); PG8_BAR; PG8_SCHED;
            PG8_LDB(B0, 1, 0); PG8_LDB(B1, 1, 1); PG8_SCHED; PG8_LDA(At, 1, 0); PG8_STAGE(PG8_SA(0, 1), a2 + hstepA, voffA);
            PG8_WAIT_V(8); PG8_WAIT_L(0); PG8_BAR; PG8_MMA(0, 0, At, B0); PG8_MMA(0, 1, At, B1); PG8_BAR; PG8_SCHED;
            PG8_LDA(At, 1, 1); PG8_STAGE(PG8_SB(1, 0), b3, voffB); PG8_STAGE(PG8_SB(1, 1), b3 + hstepB, voffB); PG8_STAGE(PG8_SA(1, 0), a3, voffA);
            PG8_WAIT_V(8); PG8_WAIT_L(0); PG8_BAR; PG8_MMA(1, 0, At, B0); PG8_MMA(1, 1, At, B1); PG8_BAR; PG8_SCHED;
            } else {
            PG8_LDB(B0, 0, 0); PG8_SCHED; PG8_LDA(At, 0, 0); PG8_STAGE(PG8_SA(1, 1), a1 + hstepA, voffA);
            PG8_WAIT_L(8); PG8_BAR; PG8_WAIT_L(0); PG8_MMA(0, 0, At, B0); PG8_BAR; PG8_SCHED;
            PG8_LDB(B1, 0, 1); PG8_STAGE(PG8_SB(0, 0), b2, voffB);
            PG8_BAR; PG8_WAIT_L(0); PG8_MMA(0, 1, At, B1); PG8_BAR;
            PG8_LDA(At, 0, 1); PG8_STAGE(PG8_SA(0, 0), a2, voffA);
            PG8_BAR; PG8_WAIT_L(0); PG8_MMA(1, 0, At, B0); PG8_BAR; PG8_SCHED;
            PG8_STAGE(PG8_SB(0, 1), b2 + hstepB, voffB);
            PG8_WAIT_V(6); PG8_BAR; PG8_MMA(1, 1, At, B1); PG8_BAR;
            PG8_LDB(B0, 1, 0); PG8_SCHED; PG8_LDA(At, 1, 0); PG8_STAGE(PG8_SA(0, 1), a2 + hstepA, voffA);
            PG8_WAIT_L(8); PG8_BAR; PG8_WAIT_L(0); PG8_MMA(0, 0, At, B0); PG8_BAR; PG8_SCHED;
            PG8_LDB(B1, 1, 1); PG8_STAGE(PG8_SB(1, 0), b3, voffB);
            PG8_BAR; PG8_WAIT_L(0); PG8_MMA(0, 1, At, B1); PG8_BAR;
            PG8_LDA(At, 1, 1); PG8_STAGE(PG8_SA(1, 0), a3, voffA);
            PG8_BAR; PG8_WAIT_L(0); PG8_MMA(1, 0, At, B0); PG8_BAR; PG8_SCHED;
            PG8_STAGE(PG8_SB(1, 1), b3 + hstepB, voffB);
            PG8_WAIT_V(6); PG8_BAR; PG8_MMA(1, 1, At, B1); PG8_BAR;
            }
        }
        if constexpr (ALIGN_EPI) { if (wr == 0) PG8_BAR; }
        if constexpr (!Epi::AFTER_DRAIN) { E(acc, cur, wr, wc, fr, fq, ui); S.done(cur); }
        if (!has_next) break;
#pragma unroll
        for (int a = 0; a < 2; ++a)
#pragma unroll
            for (int b = 0; b < 2; ++b)
#pragma unroll
                for (int m = 0; m < 4; ++m)
#pragma unroll
                    for (int n = 0; n < 2; ++n) acc[a][b][m][n] = (f32x4){0.f, 0.f, 0.f, 0.f};
        cur = nxt; cA = nA; cB = nB; ++ui;
        if constexpr (ALIGN_EPI) { if (wr == 1) PG8_BAR; }
    }
    PG8_WAIT_V(0);
    if constexpr (!ALIGN_EPI) { if (wr == 0) PG8_BAR; }
    PG8_BAR;
    if constexpr (Epi::AFTER_DRAIN) { E.fused(acc, cur, wr, wc, fr, fq, lds, wid, lane); S.done(cur); }
#undef PG8_SA
#undef PG8_SB
#undef PG8_STAGE
#undef PG8_LDA
#undef PG8_LDB
#undef PG8_MMA
#undef PG8_WAIT_V
#undef PG8_WAIT_L
#undef PG8_BAR
#undef PG8_SCHED
}
}

namespace pg8 {
struct EpiMlpIn {
  static constexpr bool PERM = true, AFTER_DRAIN = false, KHOOK = false; static constexpr int KH_T = 0;
  ::bf16_t* O; const float* bias;
  __device__ __forceinline__ void operator()(const f32x4 (&acc)[2][2][4][2], const Unit& u, int wr, int wc, int fr, int fq, int) const {
    const int row0 = u.pm * BM + wr * 64 + fr, col0 = u.pn * BM + wc * 32 + 8 * fq;
    f32x4 bv[2][2];
#pragma unroll
    for (int bj = 0; bj < 2; ++bj)
#pragma unroll
      for (int n = 0; n < 2; ++n) bv[bj][n] = *(const f32x4*)(bias + col0 + bj * HALF + 4 * n);
#pragma unroll
    for (int ai = 0; ai < 2; ++ai)
#pragma unroll
      for (int m = 0; m < 4; ++m) {
        ::bf16_t* rowp = O + (size_t)(row0 + ai * HALF + m * 16) * 4096 + col0;
#pragma unroll
        for (int bj = 0; bj < 2; ++bj) {
          f32x4 v0 = acc[ai][bj][m][0] + bv[bj][0], v1 = acc[ai][bj][m][1] + bv[bj][1];
#pragma unroll
          for (int e = 0; e < 4; ++e) { const float a = fmaxf(v0[e], 0.f), b = fmaxf(v1[e], 0.f); v0[e] = a * a; v1[e] = b * b; }
          u32x4 w; w.x = pk2(v0[0], v0[1]); w.y = pk2(v0[2], v0[3]); w.z = pk2(v1[0], v1[1]); w.w = pk2(v1[2], v1[3]);
          *(u32x4*)(rowp + bj * HALF) = w;
        }
      }
  }
};
struct EpiMlpOut {
  static constexpr bool PERM = false, AFTER_DRAIN = false, KHOOK = false; static constexpr int KH_T = 0;
  const ::bf16_t* x1; ::bf16_t* x2; const float* mod; const float* bias;
  __device__ __forceinline__ void operator()(const f32x4 (&acc)[2][2][4][2], const Unit& u, int wr, int wc, int fr, int fq, int) const {
    const int col0 = u.pn * BM + wc * 32 + 4 * fq;
#pragma unroll
    for (int ai = 0; ai < 2; ++ai)
#pragma unroll
      for (int m = 0; m < 4; ++m) {
        const int row = u.pm * BM + ai * HALF + wr * 64 + m * 16 + fr;
        const float* g2 = mod + batch_of(row) * 6144 + 5120;
#pragma unroll
        for (int bj = 0; bj < 2; ++bj)
#pragma unroll
          for (int n = 0; n < 2; ++n) {
            const int col = col0 + bj * HALF + n * 16;
            const uint2 xr = *(const uint2*)(x1 + (size_t)row * 1024 + col);
            const f32x4 xv = {bflo(xr.x), bfhi(xr.x), bflo(xr.y), bfhi(xr.y)}, gv = *(const f32x4*)(g2 + col), bb = *(const f32x4*)(bias + col);
            const f32x4 o = xv + gv * (acc[ai][bj][m][n] + bb);
            uint2 w; w.x = pk2(o[0], o[1]); w.y = pk2(o[2], o[3]);
            *(uint2*)(x2 + (size_t)row * 1024 + col) = w;
          }
      }
  }
};
struct EpiYf {
  static constexpr bool PERM = true, AFTER_DRAIN = false, KHOOK = false; static constexpr int KH_T = 0;
  ::bf16_t* O; const float* bias; float* ss;
  __device__ __forceinline__ void operator()(const f32x4 (&acc)[2][2][4][2], const Unit& u, int wr, int wc, int fr, int fq, int) const {
    const int row0 = u.pm * BM + wr * 64 + fr, col0 = u.pn * BM + wc * 32 + 8 * fq;
    f32x4 bv[2][2];
#pragma unroll
    for (int bj = 0; bj < 2; ++bj)
#pragma unroll
      for (int n = 0; n < 2; ++n) bv[bj][n] = *(const f32x4*)(bias + col0 + bj * HALF + 4 * n);
#pragma unroll
    for (int ai = 0; ai < 2; ++ai)
#pragma unroll
      for (int m = 0; m < 4; ++m) {
        const int row = row0 + ai * HALF + m * 16;
        const float scale = row < LPR ? 3.4526698300124393e-4f : 6.905339660024879e-4f;
        ::bf16_t* rowp = O + (size_t)row * 1024 + col0;
        float s = 0.f;
#pragma unroll
        for (int bj = 0; bj < 2; ++bj) {
          const f32x4 v0 = acc[ai][bj][m][0] * scale + bv[bj][0], v1 = acc[ai][bj][m][1] * scale + bv[bj][1];
          s += (v0[0] * v0[0] + v0[1] * v0[1]) + (v0[2] * v0[2] + v0[3] * v0[3]) + (v1[0] * v1[0] + v1[1] * v1[1]) + (v1[2] * v1[2] + v1[3] * v1[3]);
          u32x4 w; w.x = pk2(v0[0], v0[1]); w.y = pk2(v0[2], v0[3]); w.z = pk2(v1[0], v1[1]); w.w = pk2(v1[2], v1[3]);
          *(u32x4*)(rowp + bj * HALF) = w;
        }
        s += __shfl_xor(s, 16); s += __shfl_xor(s, 32);
        if (fq == 0) ss[row * 8 + u.pn * 4 + wc] = s;
      }
  }
};
struct EpiGlu {
  static constexpr bool PERM = true, AFTER_DRAIN = false, KHOOK = false; static constexpr int KH_T = 0;
  ::bf16_t* O; const float* bias; float* ss;
  __device__ __forceinline__ void operator()(const f32x4 (&acc)[2][2][4][2], const Unit& u, int wr, int wc, int fr, int fq, int) const {
    const int row0 = u.pm * BM + wr * 64 + fr, j0 = u.pn * 128 + wc * 32 + 8 * fq;
    f32x4 bv[2][2];
#pragma unroll
    for (int bj = 0; bj < 2; ++bj)
#pragma unroll
      for (int n = 0; n < 2; ++n) bv[bj][n] = *(const f32x4*)(bias + bj * 512 + j0 + 4 * n);
#pragma unroll
    for (int ai = 0; ai < 2; ++ai)
#pragma unroll
      for (int m = 0; m < 4; ++m) {
        const int row = row0 + ai * HALF + m * 16;
        float o[8], s = 0.f;
#pragma unroll
        for (int n = 0; n < 2; ++n)
#pragma unroll
          for (int e = 0; e < 4; ++e) {
            const float val = acc[ai][0][m][n][e] + bv[0][n][e], gate = acc[ai][1][m][n][e] + bv[1][n][e];
            const float y = val / (1.f + __expf(-gate));
            o[4 * n + e] = y; s += y * y;
          }
        u32x4 w; w.x = pk2(o[0], o[1]); w.y = pk2(o[2], o[3]); w.z = pk2(o[4], o[5]); w.w = pk2(o[6], o[7]);
        *(u32x4*)(O + (size_t)row * 1024 + 512 + j0) = w;
        s += __shfl_xor(s, 16); s += __shfl_xor(s, 32);
        if (fq == 0) ss[row * 16 + u.pn * 4 + wc] = s;
      }
  }
};
struct EpiZt {
  static constexpr bool PERM = true, AFTER_DRAIN = false, KHOOK = false; static constexpr int KH_T = 0;
  ::bf16_t* O;
  __device__ __forceinline__ void operator()(const f32x4 (&acc)[2][2][4][2], const Unit& u, int wr, int wc, int fr, int fq, int) const {
    const int v0 = u.pn * BM;
    ::bf16_t* base; size_t ld;
    if (v0 < LPR) { base = O + v0; ld = LPR; }
    else { const int vs = v0 - LPR; base = O + (size_t)512 * LPR + (size_t)(vs >> 12) * 512 * 4096 + (vs & 4095); ld = 4096; }
    const int c0 = u.pm * BM + wr * 64 + fr, col0 = wc * 32 + 8 * fq;
#pragma unroll
    for (int ai = 0; ai < 2; ++ai)
#pragma unroll
      for (int m = 0; m < 4; ++m) {
        ::bf16_t* rowp = base + (size_t)(c0 + ai * HALF + m * 16) * ld + col0;
#pragma unroll
        for (int bj = 0; bj < 2; ++bj) {
          const f32x4 a = acc[ai][bj][m][0], b = acc[ai][bj][m][1];
          u32x4 w; w.x = pk2(a[0], a[1]); w.y = pk2(a[2], a[3]); w.z = pk2(b[0], b[1]); w.w = pk2(b[2], b[3]);
          *(u32x4*)(rowp + bj * HALF) = w;
        }
      }
  }
};
struct EpiZs {
  static constexpr bool PERM = true, AFTER_DRAIN = false, KHOOK = false; static constexpr int KH_T = 0;
  ::bf16_t* O;
  __device__ __forceinline__ void operator()(const f32x4 (&acc)[2][2][4][2], const Unit& u, int wr, int wc, int fr, int fq, int) const {
    const int r0 = u.pm * BM + wr * 64 + fr, col0 = u.pn * BM + wc * 32 + 8 * fq;
#pragma unroll
    for (int ai = 0; ai < 2; ++ai)
#pragma unroll
      for (int m = 0; m < 4; ++m) {
        const int tok = v2tok(r0 + ai * HALF + m * 16);
#pragma unroll
        for (int bj = 0; bj < 2; ++bj) {
          const int col = col0 + bj * HALF;
          const f32x4 a = acc[ai][bj][m][0], b = acc[ai][bj][m][1];
          u32x4 w; w.x = pk2(a[0], a[1]); w.y = pk2(a[2], a[3]); w.z = pk2(b[0], b[1]); w.w = pk2(b[2], b[3]);
          *(u32x4*)(O + ((size_t)(col >> 4) * 1280 + (tok >> 6)) * 1280 + (tok & 63) * 16 + (col & 15)) = w;
        }
      }
  }
};
struct EpiS {
  static constexpr bool PERM = false, AFTER_DRAIN = false, KHOOK = false; static constexpr int KH_T = 0;
  float* O;
  __device__ __forceinline__ void operator()(const f32x4 (&acc)[2][2][4][2], const Unit& u, int wr, int wc, int fr, int fq, int) const {
#pragma unroll
    for (int ai = 0; ai < 2; ++ai)
#pragma unroll
      for (int m = 0; m < 4; ++m) {
        float* rowp = O + (size_t)(u.pm * BM + ai * HALF + wr * 64 + m * 16 + fr) * 256 + wc * 32 + 4 * fq;
#pragma unroll
        for (int bj = 0; bj < 2; ++bj)
#pragma unroll
          for (int n = 0; n < 2; ++n) *(f32x4*)(rowp + bj * HALF + n * 16) = acc[ai][bj][m][n];
      }
  }
};
struct EpiGelu {
  static constexpr bool PERM = true, AFTER_DRAIN = false, KHOOK = false; static constexpr int KH_T = 0;
  ::bf16_t* O;
  __device__ __forceinline__ void operator()(const f32x4 (&acc)[2][2][4][2], const Unit& u, int wr, int wc, int fr, int fq, int) const {
    const int gi = u.pn >> 2, n0 = (u.pn & 3) * BM + wc * 32 + 8 * fq, ch0 = u.pm * BM - gi * 1280 + wr * 64 + fr;
#pragma unroll
    for (int ai = 0; ai < 2; ++ai)
#pragma unroll
      for (int m = 0; m < 4; ++m) {
        const int ch = ch0 + ai * HALF + m * 16;
#pragma unroll
        for (int bj = 0; bj < 2; ++bj) {
          const int n = n0 + bj * HALF;
          float o[8];
#pragma unroll
          for (int e = 0; e < 4; ++e) { o[e] = gelu_tanh(acc[ai][bj][m][0][e]); o[4 + e] = gelu_tanh(acc[ai][bj][m][1][e]); }
          u32x4 w; w.x = pk2(o[0], o[1]); w.y = pk2(o[2], o[3]); w.z = pk2(o[4], o[5]); w.w = pk2(o[6], o[7]);
          *(u32x4*)(O + (size_t)(ch * 64 + (n >> 4)) * 512 + gi * 16 + (n & 15)) = w;
        }
      }
  }
};
struct EpiFft1 {
  static constexpr bool PERM = true, AFTER_DRAIN = false, KHOOK = false; static constexpr int KH_T = 0;
  ::bf16_t* Tt; const float2* twp; const float2* tws;
  __device__ __forceinline__ void operator()(const f32x4 (&acc)[2][2][4][2], const Unit& u, int wr, int wc, int fr, int fq, int) const {
    const bool pr = u.pn < 128;
    const int r0b = u.pn * BM + wc * 32 + 8 * fq;
    const float2* tw = pr ? twp : tws;
    const int mask = pr ? 16383 : 4095;
#pragma unroll
    for (int m = 0; m < 4; ++m) {
      const int idx = ((u.pm & 1) << 7) | (wr * 64 + m * 16 + fr);
      const int k1 = pr ? (idx & 127) : (idx & 63), l2loc = pr ? (idx >> 7) : (idx >> 6);
      const int l20 = pr ? (l2loc * 64 + (r0b & 63)) : (l2loc * 16 + (r0b & 15));
      const float2 st = tw[(unsigned)(k1 & mask)];
      const float2 w0 = tw[(unsigned)((k1 * l20) & mask)];
#pragma unroll
      for (int bj = 0; bj < 2; ++bj) {
        const int r0 = r0b + bj * HALF;
        size_t off; int pstride;
        if (pr) { off = ((size_t)(k1 * 512 + (r0 >> 6))) * 256 + l20; pstride = 128; }
        else { const int bc = (r0 - 32768) >> 4; off = (size_t)65536 * 256 + ((size_t)(((bc >> 9) * 32 + (k1 >> 1)) * 512 + (bc & 511))) * 256 + (k1 & 1) * 128 + l20; pstride = 64; }
        float ore[8], oim[8];
        float2 wv = w0;
#pragma unroll
        for (int e = 0; e < 8; ++e) {
          const float re = acc[0][bj][m][e >> 2][e & 3], im = acc[1][bj][m][e >> 2][e & 3];
          ore[e] = re * wv.x + im * wv.y; oim[e] = im * wv.x - re * wv.y;
          wv = make_float2(wv.x * st.x - wv.y * st.y, wv.y * st.x + wv.x * st.y);
        }
        u32x4 w; w.x = pk2(ore[0], ore[1]); w.y = pk2(ore[2], ore[3]); w.z = pk2(ore[4], ore[5]); w.w = pk2(ore[6], ore[7]);
        *(u32x4*)(Tt + off) = w;
        w.x = pk2(oim[0], oim[1]); w.y = pk2(oim[2], oim[3]); w.z = pk2(oim[4], oim[5]); w.w = pk2(oim[6], oim[7]);
        *(u32x4*)(Tt + off + pstride) = w;
      }
    }
  }
};
struct EpiFft2 {
  static constexpr bool PERM = true, AFTER_DRAIN = false, KHOOK = false; static constexpr int KH_T = 0;
  ::bf16_t* AF;
  __device__ __forceinline__ void operator()(const f32x4 (&acc)[2][2][4][2], const Unit& u, int wr, int wc, int fr, int fq, int) const {
    const bool pr = u.pn < 256;
    const int pnl = pr ? u.pn : u.pn - 256, c0 = (pnl & 1) * 256 + wc * 32 + 8 * fq;
#pragma unroll
    for (int ai = 0; ai < 2; ++ai)
#pragma unroll
      for (int m = 0; m < 4; ++m) {
        int part, tok;
        if (pr) { part = ai; tok = (pnl >> 1) + 128 * (wr * 64 + m * 16 + fr); }
        else { const int bk = pnl >> 1; part = wr; tok = LPR + (bk >> 5) * 4096 + (bk & 31) * 2 + ai + 64 * (m * 16 + fr); }
        ::bf16_t* rowp = AF + (size_t)tok * 1024 + part * 512 + c0;
#pragma unroll
        for (int bj = 0; bj < 2; ++bj) {
          const f32x4 a = acc[ai][bj][m][0], b = acc[ai][bj][m][1];
          u32x4 w; w.x = pk2(a[0], a[1]); w.y = pk2(a[2], a[3]); w.z = pk2(b[0], b[1]); w.w = pk2(b[2], b[3]);
          *(u32x4*)(rowp + bj * HALF) = w;
        }
      }
  }
};
struct EpiWout {
  static constexpr bool PERM = false, AFTER_DRAIN = false, KHOOK = true; static constexpr int KH_T = 8;
  float* out; const float* xp; const float* xs; const float* mod;
  __device__ __forceinline__ void khook(f32x4 (&acc)[2][2][4][2], int ui, int wr, int fr, PG8_LAS unsigned char* lds) const {
    typedef float f32x2t __attribute__((ext_vector_type(2)));
    const PG8_LAS f32x2t* tab = (const PG8_LAS f32x2t*)(lds + 131072) + ui * 256;
#pragma unroll
    for (int ai = 0; ai < 2; ++ai)
#pragma unroll
      for (int m = 0; m < 4; ++m) {
        const float r = tab[ai * HALF + wr * 64 + m * 16 + fr].x;
#pragma unroll
        for (int bj = 0; bj < 2; ++bj)
#pragma unroll
          for (int n = 0; n < 2; ++n) acc[ai][bj][m][n] *= r;
      }
  }
  __device__ __forceinline__ void operator()(const f32x4 (&acc)[2][2][4][2], const Unit& u, int wr, int wc, int fr, int fq, int ui) const {
    typedef float f32x2t __attribute__((ext_vector_type(2)));
    const PG8_LAS f32x2t* tab = (const PG8_LAS f32x2t*)((PG8_LAS unsigned char*)dyn_smem + 131072) + ui * 256;
    const int col0 = u.pn * BM + wc * 32 + 4 * fq;
#pragma unroll
    for (int ai = 0; ai < 2; ++ai)
#pragma unroll
      for (int m = 0; m < 4; ++m) {
        const int rl = ai * HALF + wr * 64 + m * 16 + fr, row = u.pm * BM + rl;
        const float rs = tab[rl].y;
        const float* g1 = mod + batch_of(row) * 6144 + 2048;
        const float* xr = row < LPR ? xp + (size_t)row * 1024 : xs + (size_t)(row - LPR) * 1024;
        ::bf16_t* orow = (::bf16_t*)out + (size_t)row * 1024;
#pragma unroll
        for (int bj = 0; bj < 2; ++bj)
#pragma unroll
          for (int n = 0; n < 2; ++n) {
            const int col = col0 + bj * HALF + n * 16;
            const f32x4 xv = *(const f32x4*)(xr + col), gv = *(const f32x4*)(g1 + col);
            const f32x4 o = xv + gv * (acc[ai][bj][m][n] * rs);
            uint2 w; w.x = pk2(o[0], o[1]); w.y = pk2(o[2], o[3]);
            *(uint2*)(orow + col) = w;
          }
      }
  }
};
}

DI void phase2(const P& p, const int wv) {
  {
    const pg8::Gemm g{p.wint(), p.hb(), 512, NTOK, 1024, 1024, 1024};
    pg8::StaticOrder S; S.init(512, NTOK, (int)gridDim.x, (int)blockIdx.x);
    const pg8::EpiZt E{p.zT()};
    pg8::gemm_phase<pg8::EpiZt, pg8::StaticOrder, true, true>((PG8_LAS unsigned char*)dyn_smem, otid(wv), g, S, E);
  }
  {
    const pg8::Gemm g{p.hb(), p.wint() + (size_t)512 * 1024, NTOK, 512, 1024, 1024, 1024};
    pg8::StaticOrder S; S.init(NTOK, 512, (int)gridDim.x, (int)(gridDim.x - 1 - blockIdx.x));
    const pg8::EpiZs E{p.Ucat()};
    pg8::gemm_phase<pg8::EpiZs, pg8::StaticOrder, true, true>((PG8_LAS unsigned char*)dyn_smem, otid(wv), g, S, E);
  }
}
DI void phase3(const P& p, const int wv) {
  {
    const pg8::Gemm g{p.Ucat(), p.Bs(), 32 * 1280, 32 * 256, 1024, 1280, 1024};
    pg8::GroupOrder S; S.init(32, 5, 1, (int)gridDim.x, (int)blockIdx.x);
    const pg8::EpiS E{p.S()};
    pg8::gemm_phase<pg8::EpiS, pg8::GroupOrder, true, true>((PG8_LAS unsigned char*)dyn_smem, otid(wv), g, S, E);
  }
  {
    const pg8::Gemm g{p.Fb1(), p.zT(), 1024, 163840, 256, 256, 256};
    pg8::Fft1Order S; S.init((int)gridDim.x, (int)blockIdx.x);
    const pg8::EpiFft1 E{p.Tt(), p.twp(), p.tws()};
    pg8::gemm_phase<pg8::EpiFft1, pg8::Fft1Order, true, true>((PG8_LAS unsigned char*)dyn_smem, otid(wv), g, S, E);
  }
}
DI void phase4(const P& p, const int wv) {
  {
    const int tix = otid(wv), pp = tix & 63, G = (int)gridDim.x;
    for (int task = (int)blockIdx.x + G * wv; task < 17 * 64; task += G * 8) {
      const int seq = task >> 6, g = (task >> 1) & 31, dir = task & 1;
      const int c0 = seq == 0 ? 0 : 256 + (seq - 1) * 64, nc = seq == 0 ? 256 : 64;
      const float ar = p.AT()[((g * 2 + dir) * 64 + pp) * 2], ai = p.AT()[((g * 2 + dir) * 64 + pp) * 2 + 1];
      float hr = 0.f, hi = 0.f;
      const float* Sg = p.S() + (size_t)g * 1280 * 256 + dir * 128 + pp;
      bf16_t* Hg = p.Ucat() + (size_t)g * 1280 * 1280 + 1024 + dir * 128 + pp;
      for (int i0 = 0; i0 < nc; i0 += 32) {
        float sr[32], si[32];
#pragma unroll
        for (int j = 0; j < 32; j++) {
          const int c = c0 + (dir == 0 ? i0 + j : nc - 1 - i0 - j);
          sr[j] = Sg[(size_t)c * 256]; si[j] = Sg[(size_t)c * 256 + 64];
        }
#pragma unroll
        for (int j = 0; j < 32; j++) {
          const int c = c0 + (dir == 0 ? i0 + j : nc - 1 - i0 - j);
          Hg[(size_t)c * 1280] = f2bf(hr); Hg[(size_t)c * 1280 + 64] = f2bf(hi);
          const float nr = ar * hr - ai * hi + sr[j], ni = ar * hi + ai * hr + si[j];
          hr = nr; hi = ni;
        }
      }
    }
  }
  {
    const pg8::Gemm g{p.Fb2(), p.Tt(), 512, 327680, 256, 256, 256};
    pg8::Fft2Order S; S.init((int)gridDim.x, (int)blockIdx.x);
    const pg8::EpiFft2 E{p.AF()};
    pg8::gemm_phase<pg8::EpiFft2, pg8::Fft2Order, true, true>((PG8_LAS unsigned char*)dyn_smem, otid(wv), g, S, E);
  }
}
DI void phase5(const P& p, const int wv) {
  const pg8::Gemm g{p.Ucat(), p.Tcat(), 32 * 1280, 32 * 1024, 1280, 1280, 1280};
  pg8::GroupOrder S; S.init(32, 5, 4, (int)gridDim.x, (int)blockIdx.x);
  const pg8::EpiGelu E{p.gact()};
  pg8::gemm_phase<pg8::EpiGelu, pg8::GroupOrder, true, true>((PG8_LAS unsigned char*)dyn_smem, otid(wv), g, S, E);
}
DI void phase6(const P& p, const int wv) {
  {
    const pg8::Gemm g{p.AF(), p.Mf(), NTOK, 512, 1024, 1024, 1024};
    pg8::StaticOrder S; S.init(NTOK, 512, (int)gridDim.x, (int)blockIdx.x);
    const pg8::EpiYf E{p.mg(), p.b_f, p.ssf()};
    pg8::gemm_phase<pg8::EpiYf, pg8::StaticOrder, true, true>((PG8_LAS unsigned char*)dyn_smem, otid(wv), g, S, E);
  }
  {
    const pg8::Gemm g{p.gact(), p.wglut(), NTOK, 1024, 512, 512, 512};
    pg8::StaticOrder S; S.init(NTOK, 1024, (int)gridDim.x, (int)(gridDim.x - 1 - blockIdx.x));
    const pg8::EpiGlu E{p.mg(), p.b_glu, p.sss()};
    pg8::gemm_phase<pg8::EpiGlu, pg8::StaticOrder, true, true>((PG8_LAS unsigned char*)dyn_smem, otid(wv), g, S, E);
  }
}
DI void phase7(const P& p, const int wv) {
  const pg8::Gemm g{p.mg(), p.woutt(), NTOK, 1024, 1024, 1024, 1024};
  pg8::StaticOrder S; S.init(NTOK, 1024, (int)gridDim.x, (int)blockIdx.x);
  {
    typedef float f32x2t __attribute__((ext_vector_type(2)));
    PG8_LAS f32x2t* tab = (PG8_LAS f32x2t*)((PG8_LAS unsigned char*)dyn_smem + 131072);
    const int tix7 = otid(wv);
    pg8::Unit u;
    for (int i = 0; i < 8 && S.next(i, u); ++i) {
      if (tix7 < 256) {
        const int tok = u.pm * 256 + tix7;
        float sf = 0.f, s2 = 0.f;
#pragma unroll
        for (int j = 0; j < 8; j++) sf += p.ssf()[tok * 8 + j];
#pragma unroll
        for (int j = 0; j < 16; j++) s2 += p.sss()[tok * 16 + j];
        const float rf = rsqrtf(sf * (1.f / 512.f) + EPSV), rs = rsqrtf(s2 * (1.f / 512.f) + EPSV);
        tab[i * 256 + tix7] = (f32x2t){rf / rs, rs};
      }
    }
    __syncthreads();
  }
  const pg8::EpiWout E{p.out, p.xp, p.xs, p.mod()};
  pg8::gemm_phase<pg8::EpiWout, pg8::StaticOrder, true, true>((PG8_LAS unsigned char*)dyn_smem, otid(wv), g, S, E);
}
DI void phase8(const P& p, const int wv) {
  const pg8::Gemm g{p.hb(), p.w1t(), NTOK, 4096, 1024, 1024, 1024};
  pg8::StaticOrder S; S.init(NTOK, 4096, (int)gridDim.x, (int)blockIdx.x);
  const pg8::EpiMlpIn E{p.hid(), p.b1};
  pg8::gemm_phase<pg8::EpiMlpIn, pg8::StaticOrder, true, true>((PG8_LAS unsigned char*)dyn_smem, otid(wv), g, S, E);
}
DI void phase9(const P& p, const int wv) {
  const pg8::Gemm g{p.hid(), p.w2t(), NTOK, 1024, 4096, 4096, 4096};
  pg8::StaticOrder S; S.init(NTOK, 1024, (int)gridDim.x, (int)blockIdx.x);
  const pg8::EpiMlpOut E{(const bf16_t*)p.out, p.hb(), p.mod(), p.b2};
  pg8::gemm_phase<pg8::EpiMlpOut, pg8::StaticOrder, true, true>((PG8_LAS unsigned char*)dyn_smem, otid(wv), g, S, E);
}

__global__ void __launch_bounds__(512, 2) k_mega(P p) {
  cg::grid_group grid = cg::this_grid();
  const int wv = __builtin_amdgcn_readfirstlane((int)threadIdx.x >> 6);
  phase0(p, wv); grid.sync();
  rownorm_mod<true>(p, wv, p.g_mix, 0, 1024); grid.sync();
  phase2(p, wv); grid.sync();
  phase3(p, wv); grid.sync();
  phase4(p, wv); grid.sync();
  phase5(p, wv); grid.sync();
  phase6(p, wv); grid.sync();
  phase7(p, wv); grid.sync();
  rownorm_mod<false>(p, wv, p.g_mlp, 3072, 4096); grid.sync();
  phase8(p, wv); grid.sync();
  phase9(p, wv); grid.sync();
  final_norm(p, wv);
}

extern "C" void kernel_launch(void* const* d_in, const int* in_sizes, int n_in, void* d_out, int out_size, void* d_ws, size_t ws_size,
                              hipStream_t stream) {
  P p{};
  const float** f = (const float**)&p;
  for (int i = 0; i < 29; i++) f[i] = (const float*)d_in[i];
  p.out = (float*)d_out;
  p.ws = (char*)d_ws;
  if (WS_NEED > ws_size) { fprintf(stderr, "workspace too small: need %zu have %zu\n", (size_t)WS_NEED, ws_size); return; }
  static int grid_blocks = 0;
  if (!grid_blocks) {
    int dev = 0, cus = 0, per_cu = 0;
    (void)hipGetDevice(&dev);
    (void)hipDeviceGetAttribute(&cus, hipDeviceAttributeMultiprocessorCount, dev);
    (void)hipFuncSetAttribute((const void*)k_mega, hipFuncAttributeMaxDynamicSharedMemorySize, SMEM_BYTES);
    (void)hipOccupancyMaxActiveBlocksPerMultiprocessor(&per_cu, k_mega, 512, SMEM_BYTES);
    if (per_cu < 1) per_cu = 1;
    grid_blocks = cus * per_cu;
  }
  void* args[] = {&p};
  hipError_t e = hipLaunchCooperativeKernel((void*)k_mega, dim3(grid_blocks), dim3(512), args, SMEM_BYTES, stream);
  if (e != hipSuccess) fprintf(stderr, "cooperative launch failed: %s (grid %d)\n", hipGetErrorString(e), grid_blocks);
}
```

```cpp
#include <hip/hip_runtime.h>
#include <hip/hip_cooperative_groups.h>
#include <stdint.h>
#include <stdio.h>
namespace cg = cooperative_groups;


#define DI __device__ __forceinline__
typedef unsigned short bf16_t;
typedef short bf16x8 __attribute__((ext_vector_type(8)));
typedef float f32x16 __attribute__((ext_vector_type(16)));
typedef float f32x4 __attribute__((ext_vector_type(4)));

constexpr int NTOK = 81920, LPR = 16384, LSM = 4096;
constexpr int SMEM_HALF = 73728;
constexpr int SMEM_BYTES = 2 * SMEM_HALF;
constexpr float EPSV = 1e-6f;

constexpr size_t al256(size_t x) { return (x + 255) & ~(size_t)255; }
constexpr size_t O_mod = 0;
constexpr size_t O_modp = O_mod + al256(17 * 6144 * 4);
constexpr size_t O_AT = O_modp + al256(4 * 17 * 6144 * 4);
constexpr size_t O_ssf = O_AT + al256(32 * 2 * 64 * 2 * 4);
constexpr size_t O_sss = O_ssf + al256((size_t)NTOK * 8 * 4);
constexpr size_t O_twp = O_sss + al256((size_t)NTOK * 16 * 4);
constexpr size_t O_tws = O_twp + al256(LPR * 8);
constexpr size_t O_wint = O_tws + al256(LSM * 8);
constexpr size_t O_wglut = O_wint + al256(1024 * 1024 * 2);
constexpr size_t O_woutt = O_wglut + al256(1024 * 512 * 2);
constexpr size_t O_w1t = O_woutt + al256(1024 * 1024 * 2);
constexpr size_t O_w2t = O_w1t + al256((size_t)4096 * 1024 * 2);
constexpr size_t O_Mf = O_w2t + al256((size_t)4096 * 1024 * 2);
constexpr size_t O_Fb1 = O_Mf + al256(512 * 1024 * 2);
constexpr size_t O_Fb2 = O_Fb1 + al256(1024 * 256 * 2);
constexpr size_t O_Bs = O_Fb2 + al256(512 * 256 * 2);
constexpr size_t O_Tcat = O_Bs + al256((size_t)32 * 256 * 1024 * 2);
constexpr size_t O_hb = O_Tcat + al256((size_t)32 * 1024 * 1280 * 2);
constexpr size_t O_zT = O_hb + al256((size_t)NTOK * 1024 * 2);
constexpr size_t O_Ucat = O_zT + al256((size_t)NTOK * 512 * 2);
constexpr size_t O_AF = O_Ucat + al256((size_t)32 * 1280 * 1280 * 2);
constexpr size_t O_S = O_AF + al256((size_t)NTOK * 1024 * 2);
constexpr size_t O_gact = O_S + al256((size_t)1280 * 32 * 256 * 4);
constexpr size_t O_mg = O_gact + al256((size_t)NTOK * 512 * 2);
constexpr size_t O_END = O_mg + al256((size_t)NTOK * 1024 * 2);
constexpr size_t O_Tt = O_hb;
constexpr size_t O_hid = O_zT;
constexpr size_t WS_NEED = (O_hid + (size_t)NTOK * 4096 * 2 > O_END ? O_hid + (size_t)NTOK * 4096 * 2 : O_END);
struct P {
  const float *xp, *xs, *cp, *cs, *w_ada, *b_ada, *g_mix, *w_in, *w_f, *b_f, *a_re, *a_im, *log_dt, *b_re, *b_im, *c_re, *c_im,
      *ssm_d, *w_glu, *b_glu, *g_fo, *g_so, *w_out, *g_mlp, *w1, *b1, *w2, *b2, *g_final;
  float* out;
  char* ws;
  __device__ __forceinline__ float* mod() const { return (float*)(ws + O_mod); }
  __device__ __forceinline__ float* modp() const { return (float*)(ws + O_modp); }
  __device__ __forceinline__ float* AT() const { return (float*)(ws + O_AT); }
  __device__ __forceinline__ float* ssf() const { return (float*)(ws + O_ssf); }
  __device__ __forceinline__ float* sss() const { return (float*)(ws + O_sss); }
  __device__ __forceinline__ float2* twp() const { return (float2*)(ws + O_twp); }
  __device__ __forceinline__ float2* tws() const { return (float2*)(ws + O_tws); }
  __device__ __forceinline__ bf16_t* wint() const { return (bf16_t*)(ws + O_wint); }
  __device__ __forceinline__ bf16_t* wglut() const { return (bf16_t*)(ws + O_wglut); }
  __device__ __forceinline__ bf16_t* woutt() const { return (bf16_t*)(ws + O_woutt); }
  __device__ __forceinline__ bf16_t* w1t() const { return (bf16_t*)(ws + O_w1t); }
  __device__ __forceinline__ bf16_t* w2t() const { return (bf16_t*)(ws + O_w2t); }
  __device__ __forceinline__ bf16_t* Mf() const { return (bf16_t*)(ws + O_Mf); }
  __device__ __forceinline__ bf16_t* Fb1() const { return (bf16_t*)(ws + O_Fb1); }
  __device__ __forceinline__ bf16_t* Fb2() const { return (bf16_t*)(ws + O_Fb2); }
  __device__ __forceinline__ bf16_t* Bs() const { return (bf16_t*)(ws + O_Bs); }
  __device__ __forceinline__ bf16_t* Tcat() const { return (bf16_t*)(ws + O_Tcat); }
  __device__ __forceinline__ bf16_t* Ucat() const { return (bf16_t*)(ws + O_Ucat); }
  __device__ __forceinline__ bf16_t* hb() const { return (bf16_t*)(ws + O_hb); }
  __device__ __forceinline__ bf16_t* zT() const { return (bf16_t*)(ws + O_zT); }
  __device__ __forceinline__ bf16_t* AF() const { return (bf16_t*)(ws + O_AF); }
  __device__ __forceinline__ float* S() const { return (float*)(ws + O_S); }
  __device__ __forceinline__ bf16_t* mg() const { return (bf16_t*)(ws + O_mg); }
  __device__ __forceinline__ bf16_t* gact() const { return (bf16_t*)(ws + O_gact); }
  __device__ __forceinline__ bf16_t* Tt() const { return (bf16_t*)(ws + O_Tt); }
  __device__ __forceinline__ bf16_t* hid() const { return (bf16_t*)(ws + O_hid); }
};

typedef float f32x2v __attribute__((ext_vector_type(2)));
typedef __bf16 bf16x2v __attribute__((ext_vector_type(2)));
DI uint32_t pk2(float lo, float hi) { const f32x2v v = {lo, hi}; const bf16x2v r = __builtin_convertvector(v, bf16x2v); return __builtin_bit_cast(uint32_t, r); }
DI bf16_t f2bf(float f) { return (bf16_t)(pk2(f, 0.f) & 0xffffu); }
extern __shared__ __attribute__((aligned(16))) unsigned char dyn_smem[];
DI int otid(int wv) {
  unsigned m = ~0u; asm volatile("" : "+s"(m));
  const int lane = (int)__builtin_amdgcn_mbcnt_hi(m, __builtin_amdgcn_mbcnt_lo(m, 0u));
  int t = (wv << 6) | lane; asm volatile("" : "+v"(t)); return t;
}
DI int tok2v(int tok) {
  if (tok < LPR) { const int l1 = tok >> 7, l2 = tok & 127; return ((l2 & 63) << 8) | ((l2 >> 6) << 7) | l1; }
  const int ts = tok - LPR, w = ts & 4095, l1 = w >> 6, l2 = w & 63;
  return LPR + (ts & ~4095) + (((l2 & 15) << 8) | ((l2 >> 4) << 6) | l1);
}
DI int v2tok(int v) {
  if (v < LPR) return ((v & 127) << 7) | (((v >> 7) & 1) << 6) | (v >> 8);
  const int vs = v - LPR, w = vs & 4095;
  return LPR + (vs & ~4095) + (((w & 63) << 6) | (((w >> 6) & 3) << 4) | (w >> 8));
}
DI int batch_of(int tok) { return tok < LPR ? 0 : 1 + ((tok - LPR) >> 12); }
DI float gelu_tanh(float x) {
  const float u = 0.7978845608028654f * (x + 0.044715f * x * x * x);
  return x / (1.f + __expf(-2.f * u));
}
DI float wave_sum(float v) {
  v += __shfl_xor(v, 32); v += __shfl_xor(v, 16); v += __shfl_xor(v, 8); v += __shfl_xor(v, 4); v += __shfl_xor(v, 2); v += __shfl_xor(v, 1);
  return v;
}

DI void ssm_pow(const P& p, int g, int dir, int pp, int j, float& re, float& im) {
  const int ia = (dir * 32 + g) * 64 + pp;
  const float lr = fminf(p.a_re[ia], -1e-4f), li = p.a_im[ia], dt = expf(p.log_dt[dir * 32 + g]);
  const float mag = expf(lr * dt * (float)j);
  double t = (double)li * (double)dt * (double)j * 0.15915494309189535;
  t -= rint(t);
  const float ang = (float)(t * 6.283185307179586);
  float s, c; sincosf(ang, &s, &c);
  re = mag * c; im = mag * s;
}
DI void ssm_coef(const P& p, int g, int dir, int pp, float& cr, float& ci) {
  const int ia = (dir * 32 + g) * 64 + pp;
  const float lr = fminf(p.a_re[ia], -1e-4f), li = p.a_im[ia];
  float ar, ai; ssm_pow(p, g, dir, pp, 1, ar, ai);
  const float nr = ar - 1.f, ni = ai, den = 1.f / (lr * lr + li * li);
  cr = (nr * lr + ni * li) * den; ci = (ni * lr - nr * li) * den;
}

template <class CM>
DI void transpose_job(float* tile, const int tid, bool act, int item2, const float* in, int ld, int Kdim, bf16_t* out, const CM& colmap, const float* sc0, const float* sc1) {
  const int nkt = Kdim / 64;
  __syncthreads();
  if (act) {
    float v[16];
#pragma unroll
    for (int u = 0; u < 2; u++) {
      const int item = 2 * item2 + u, nt = item / nkt, kt = item % nkt;
      const int c = tid & 31, kr = tid >> 5, col = colmap(nt * 32 + c);
#pragma unroll
      for (int i = 0; i < 8; i++) v[u * 8 + i] = in[(size_t)(kt * 64 + kr + 8 * i) * ld + col];
    }
#pragma unroll
    for (int u = 0; u < 2; u++) {
      const int item = 2 * item2 + u, kt = item % nkt;
      const int c = tid & 31, kr = tid >> 5;
#pragma unroll
      for (int i = 0; i < 8; i++) {
        const int kl = kr + 8 * i, k = kt * 64 + kl;
        float x = v[u * 8 + i];
        if (sc0) x *= (k < 512 ? sc0[k] : sc1[k - 512]);
        tile[u * 64 * 33 + kl * 33 + c] = x;
      }
    }
  }
  __syncthreads();
  if (act) {
#pragma unroll
    for (int u = 0; u < 2; u++) {
      const int item = 2 * item2 + u, nt = item / nkt, kt = item % nkt;
      const int nl = tid >> 3, kc = tid & 7;
      float x[8];
#pragma unroll
      for (int j = 0; j < 8; j++) x[j] = tile[u * 64 * 33 + (kc * 8 + j) * 33 + nl];
      uint4 w; w.x = pk2(x[0], x[1]); w.y = pk2(x[2], x[3]); w.z = pk2(x[4], x[5]); w.w = pk2(x[6], x[7]);
      *(uint4*)(out + (size_t)(nt * 32 + nl) * Kdim + kt * 64 + kc * 8) = w;
    }
  }
}

DI void phase0(const P& p, const int wv) {
  const int tix = otid(wv);
  unsigned char* smraw = dyn_smem + (tix >> 8) * SMEM_HALF;
  float* smf = (float*)smraw;
  const int tid = tix & 255, nb = gridDim.x * 2, bid = blockIdx.x * 2 + (tix >> 8);
  for (int base = 0; base < 384; base += nb) {
    const int item = base + bid; const bool act = item < 384;
    const int cg = act ? item % 96 : 0, ks = act ? item / 96 : 0;
    __syncthreads();
    if (act)
      for (int i = tid; i < 17 * 256; i += 256) {
        const int b = i >> 8, k = ks * 256 + (i & 255);
        const float c = b == 0 ? p.cp[k] : p.cs[(b - 1) * 1024 + k];
        smf[i] = c / (1.f + __expf(-c));
      }
    __syncthreads();
    const int col = tid & 63, sub = tid >> 6, j = cg * 64 + col;
    float a[17];
#pragma unroll
    for (int b = 0; b < 17; b++) a[b] = 0.f;
    if (act) {
#pragma unroll 1
      for (int bt = 0; bt < 4; bt++) {
        const int k0 = sub * 64 + bt * 16;
        float w[16];
#pragma unroll
        for (int i = 0; i < 16; i++) w[i] = p.w_ada[(size_t)(ks * 256 + k0 + i) * 6144 + j];
#pragma unroll
        for (int i = 0; i < 16; i++)
#pragma unroll
          for (int b = 0; b < 17; b++) a[b] += smf[b * 256 + k0 + i] * w[i];
      }
    }
    float* red = smf + 17 * 256;
#pragma unroll
    for (int b = 0; b < 17; b++) red[(sub * 17 + b) * 64 + col] = a[b];
    __syncthreads();
    if (act)
      for (int i = tid; i < 17 * 64; i += 256) {
        const int b = i >> 6, c2 = i & 63;
        float sum = red[(0 * 17 + b) * 64 + c2] + red[(1 * 17 + b) * 64 + c2] + red[(2 * 17 + b) * 64 + c2] + red[(3 * 17 + b) * 64 + c2];
        if (ks == 0) sum += p.b_ada[cg * 64 + c2];
        atomicAdd(p.mod() + b * 6144 + cg * 64 + c2, sum);
      }
  }
  {
    auto ident = [](int n) { return n; };
    auto glumap = [](int n) { return ((n >> 7) & 1) * 512 + (n >> 8) * 128 + (n & 127); };
    const int n0 = 256, n1 = n0 + 128, n2 = n1 + 256, n3 = n2 + 1024, n4 = n3 + 1024;
    for (int base = 0; base < n4; base += nb) {
      const int item = base + bid; const bool act = item < n4;
      if (item < n0) transpose_job(smf, tid, act, item, p.w_in, 1024, 1024, p.wint(), ident, nullptr, nullptr);
      else if (item < n1) transpose_job(smf, tid, act, item - n0, p.w_glu, 1024, 512, p.wglut(), glumap, nullptr, nullptr);
      else if (item < n2) transpose_job(smf, tid, act, item - n1, p.w_out, 1024, 1024, p.woutt(), ident, p.g_fo, p.g_so);
      else if (item < n3) transpose_job(smf, tid, act, item - n2, p.w1, 4096, 1024, p.w1t(), ident, nullptr, nullptr);
      else transpose_job(smf, tid, act, item - n3, p.w2, 1024, 4096, p.w2t(), ident, nullptr, nullptr);
    }
  }
  {
    __syncthreads();
    float2* cs = (float2*)smraw;
    for (int i = tid; i < 512; i += 256) { float s, c; sincosf((float)i * (6.283185307179586f / 512.f), &s, &c); cs[i] = make_float2(c, s); }
    __syncthreads();
    for (int item = bid; item < 128; item += nb) {
      const int idx = item * 256 + tid, k = idx & 1023, he = idx >> 10, h = he >> 3, e0 = (he & 7) * 16, c = k & 511;
      const bool is_sin = k >= 512;
      const float* wf = p.w_f + (size_t)h * 128 * 128 + e0;
      float a[16];
#pragma unroll
      for (int e = 0; e < 16; e++) a[e] = 0.f;
#pragma unroll 4
      for (int d = 0; d < 128; d++) {
        const float2 t = cs[((h * 128 + d) * c) & 511];
        const float tv = is_sin ? t.y : t.x;
        const f32x4 w0 = *(const f32x4*)(wf + d * 128), w1 = *(const f32x4*)(wf + d * 128 + 4), w2 = *(const f32x4*)(wf + d * 128 + 8), w3 = *(const f32x4*)(wf + d * 128 + 12);
#pragma unroll
        for (int e = 0; e < 4; e++) { a[e] += tv * w0[e]; a[4 + e] += tv * w1[e]; a[8 + e] += tv * w2[e]; a[12 + e] += tv * w3[e]; }
      }
#pragma unroll
      for (int e = 0; e < 16; e++) p.Mf()[(size_t)(h * 128 + e0 + e) * 1024 + k] = f2bf(a[e]);
    }
  }
  {
    const int gsz = nb * 256, gt = bid * 256 + tid;
    for (int i = gt; i < 1024 * 256; i += gsz) {
      const int nrg = i >> 8, k = i & 255, tb = nrg >> 9, nr = nrg & 511, part = (nr >> 7) & 1, idx8 = ((nr >> 8) << 7) | (nr & 127);
      const int R = tb ? 64 : 128, sh = tb ? 6 : 7, l2p = idx8 >> sh, k1 = idx8 & (R - 1), l2k = k >> sh, l1 = k & (R - 1);
      float sv, cv; sincosf((float)((k1 * l1) & (R - 1)) * (6.283185307179586f / (float)R), &sv, &cv);
      p.Fb1()[i] = f2bf(l2k == l2p ? (part ? -sv : cv) : 0.f);
    }
    for (int i = gt; i < 512 * 256; i += gsz) {
      const int nrg = i >> 8, k = i & 255, tb = nrg >> 8, nr = nrg & 255;
      float v;
      if (tb == 0) {
        const int part = nr >> 7, k2 = nr & 127, ki = k >> 7, l2 = k & 127;
        float sv, cv; sincosf((float)((k2 * l2) & 127) * (6.283185307179586f / 128.f), &sv, &cv);
        v = part == 0 ? (ki == 0 ? cv : sv) : (ki == 0 ? -sv : cv);
      } else {
        const int blk = nr >> 7, n2 = nr & 127, part = n2 >> 6, k2 = n2 & 63, kb = k >> 7, kk = k & 127, ki = kk >> 6, l2 = kk & 63;
        float sv, cv; sincosf((float)((k2 * l2) & 63) * (6.283185307179586f / 64.f), &sv, &cv);
        v = blk == kb ? (part == 0 ? (ki == 0 ? cv : sv) : (ki == 0 ? -sv : cv)) : 0.f;
      }
      p.Fb2()[i] = f2bf(v);
    }
    for (int i = gt; i < LPR; i += gsz) { float s, c; sincosf((float)i * (6.283185307179586f / 16384.f), &s, &c); p.twp()[i] = make_float2(c, s); }
    for (int i = gt; i < LSM; i += gsz) { float s, c; sincosf((float)i * (6.283185307179586f / 4096.f), &s, &c); p.tws()[i] = make_float2(c, s); }
    for (int i = gt; i < 32 * 2 * 64 * 64; i += gsz) {
      const int s = i & 63, pp = (i >> 6) & 63, dir = (i >> 12) & 1, g = i >> 13;
      float pr, pi, cr, ci; ssm_pow(p, g, dir, pp, dir == 0 ? 63 - s : s, pr, pi); ssm_coef(p, g, dir, pp, cr, ci);
      const float qr = pr * cr - pi * ci, qi = pr * ci + pi * cr;
      const int ib = ((dir * 32 + g) * 64 + pp) * 16;
      float vr[16], vi[16];
#pragma unroll
      for (int h = 0; h < 16; h++) { const float br = p.b_re[ib + h], bi = p.b_im[ib + h]; vr[h] = qr * br - qi * bi; vi[h] = qr * bi + qi * br; }
      bf16_t* d0 = p.Bs() + ((size_t)(g * 256 + dir * 128 + pp)) * 1024 + s * 16;
      bf16_t* d1 = d0 + 64 * 1024;
      uint4 w;
      w.x = pk2(vr[0], vr[1]); w.y = pk2(vr[2], vr[3]); w.z = pk2(vr[4], vr[5]); w.w = pk2(vr[6], vr[7]); *(uint4*)d0 = w;
      w.x = pk2(vr[8], vr[9]); w.y = pk2(vr[10], vr[11]); w.z = pk2(vr[12], vr[13]); w.w = pk2(vr[14], vr[15]); *(uint4*)(d0 + 8) = w;
      w.x = pk2(vi[0], vi[1]); w.y = pk2(vi[2], vi[3]); w.z = pk2(vi[4], vi[5]); w.w = pk2(vi[6], vi[7]); *(uint4*)d1 = w;
      w.x = pk2(vi[8], vi[9]); w.y = pk2(vi[10], vi[11]); w.z = pk2(vi[12], vi[13]); w.w = pk2(vi[14], vi[15]); *(uint4*)(d1 + 8) = w;
    }
    for (int i = gt; i < 32 * 64 * 2 * 64; i += gsz) {
      const int pp = i & 63, dir = (i >> 6) & 1, t = (i >> 7) & 63, g = i >> 13;
      float pr, pi; ssm_pow(p, g, dir, pp, dir == 0 ? t + 1 : 64 - t, pr, pi);
#pragma unroll
      for (int h = 0; h < 16; h++) {
        const int ic = ((dir * 32 + g) * 16 + h) * 64 + pp;
        const float cr = p.c_re[ic], ci = p.c_im[ic];
        bf16_t* d = p.Tcat() + ((size_t)(g * 1024 + t * 16 + h)) * 1280 + 1024 + dir * 128 + pp;
        d[0] = f2bf(cr * pr - ci * pi);
        d[64] = f2bf(-(cr * pi + ci * pr));
      }
    }
    for (int i = gt; i < 32 * 2 * 64; i += gsz) {
      const int pp = i & 63, dir = (i >> 6) & 1, g = i >> 7;
      float pr, pi; ssm_pow(p, g, dir, pp, 64, pr, pi);
      p.AT()[i * 2] = pr; p.AT()[i * 2 + 1] = pi;
    }
  }
  {
    float2* q = (float2*)smraw;
    float2* q1 = q + 512;
    float2* Cs = q + 576;
    float2* Bm = Cs + 2048;
    float2* E = Bm + 2048;
    for (int base = 0; base < 512; base += nb) {
      const int item = base + bid; const bool act = item < 512;
      const int g = act ? item >> 4 : 0, ch = act ? item & 15 : 0;
      __syncthreads();
      for (int e = tid; e < 512; e += 256) {
        const int j = e >> 6, pp = e & 63, jj = ch * 8 + j, lag = jj - 63;
        float2 v = make_float2(0.f, 0.f);
        if (jj < 127) {
          const int dir = lag >= 0 ? 0 : 1;
          float pr, pi, cr, ci; ssm_pow(p, g, dir, pp, lag < 0 ? -lag : lag, pr, pi); ssm_coef(p, g, dir, pp, cr, ci);
          v = make_float2(pr * cr - pi * ci, pr * ci + pi * cr);
        }
        q[e] = v;
      }
      if (tid < 64) { float cr, ci; ssm_coef(p, g, 1, tid, cr, ci); q1[tid] = make_float2(cr, ci); }
      for (int i = tid; i < 2048; i += 256) {
        const int dir = i >> 10, j = i & 1023, src = (dir * 32 + g) * 1024 + j;
        Cs[i] = make_float2(p.c_re[src], p.c_im[src]); Bm[i] = make_float2(p.b_re[src], p.b_im[src]);
      }
      const int hp = tid >> 4, h = tid & 15;
      float a0 = 0.f;
#pragma unroll 1
      for (int ps = 0; ps < 9; ps++) {
        const int j = ps < 8 ? ps : 7, jj = ch * 8 + j, lag = jj - 63;
        const bool valid = ps < 8 ? (jj < 127) : (jj == 63);
        const int dir = ps < 8 ? (lag >= 0 ? 0 : 1) : 1;
        const float2* qs = ps < 8 ? q + j * 64 : q1;
        __syncthreads();
        for (int i = tid; i < 1024; i += 256) {
          const float2 cc = Cs[dir * 1024 + i], qq = qs[i & 63];
          E[i] = make_float2(cc.x * qq.x - cc.y * qq.y, cc.x * qq.y + cc.y * qq.x);
        }
        __syncthreads();
        float a = 0.f;
        if (valid) {
#pragma unroll 8
          for (int pp = 0; pp < 64; pp++) { const float2 ee = E[hp * 64 + pp], bb = Bm[dir * 1024 + pp * 16 + h]; a += ee.x * bb.x - ee.y * bb.y; }
        }
        bool st = valid && act;
        if (ps < 8 && lag == 0) { a0 = a; st = false; }
        if (ps == 8) { a += a0; if (hp == h) a += p.ssm_d[g * 16 + h]; }
        if (st) {
          const bf16_t kv = f2bf(a);
          const int t0 = lag > 0 ? lag : 0, t1 = lag > 0 ? 64 : 64 + lag;
          bf16_t* d = p.Tcat() + ((size_t)(g * 1024 + hp)) * 1280 + h;
          for (int t = t0; t < t1; t++) d[(size_t)t * 16 * 1280 + (t - lag) * 16] = kv;
        }
      }
    }
  }
}

constexpr int RIF = 2;
DI float bflo(uint32_t u) { return __uint_as_float(u << 16); }
DI float bfhi(uint32_t u) { return __uint_as_float(u & 0xffff0000u); }
template <bool FROMX>
DI void rownorm_mod(const P& p, const int wv, const float* g, int sh_off, int sc_off) {
  const int tix = otid(wv), lane = tix & 63, wrow = blockIdx.x * 8 + (tix >> 6), nw = gridDim.x * 8;
  for (int tok0 = wrow; tok0 < NTOK; tok0 += RIF * nw) {
    float v[RIF][16]; float ss[RIF];
#pragma unroll
    for (int rr = 0; rr < RIF; rr++) {
      const int tok = tok0 + rr * nw;
      if (tok < NTOK) {
        if (FROMX) {
          const float* src = tok < LPR ? p.xp + (size_t)tok * 1024 : p.xs + (size_t)(tok - LPR) * 1024;
#pragma unroll
          for (int i = 0; i < 4; i++) { const f32x4 t = *(const f32x4*)(src + (i * 64 + lane) * 4); v[rr][4 * i] = t[0]; v[rr][4 * i + 1] = t[1]; v[rr][4 * i + 2] = t[2]; v[rr][4 * i + 3] = t[3]; }
        } else {
          const bf16_t* src = (const bf16_t*)p.out + (size_t)tok * 1024;
#pragma unroll
          for (int i = 0; i < 2; i++) { const uint4 t = *(const uint4*)(src + (i * 64 + lane) * 8);
            v[rr][8 * i] = bflo(t.x); v[rr][8 * i + 1] = bfhi(t.x); v[rr][8 * i + 2] = bflo(t.y); v[rr][8 * i + 3] = bfhi(t.y);
            v[rr][8 * i + 4] = bflo(t.z); v[rr][8 * i + 5] = bfhi(t.z); v[rr][8 * i + 6] = bflo(t.w); v[rr][8 * i + 7] = bfhi(t.w); }
        }
      } else {
#pragma unroll
        for (int e = 0; e < 16; e++) v[rr][e] = 0.f;
      }
    }
#pragma unroll
    for (int rr = 0; rr < RIF; rr++) {
      ss[rr] = 0.f;
#pragma unroll
      for (int e = 0; e < 16; e++) ss[rr] += v[rr][e] * v[rr][e];
      ss[rr] = wave_sum(ss[rr]);
    }
#pragma unroll
    for (int rr = 0; rr < RIF; rr++) {
      const int tok = tok0 + rr * nw;
      if (tok >= NTOK) continue;
      const float r = rsqrtf(ss[rr] * (1.f / 1024.f) + EPSV);
      const float* md = p.mod() + batch_of(tok) * 6144;
      bf16_t* drow = p.hb() + (size_t)(FROMX ? tok2v(tok) : tok) * 1024;
      float o[16];
#pragma unroll
      for (int q = 0; q < 4; q++) {
        const int c = FROMX ? (q * 64 + lane) * 4 : ((q >> 1) * 64 + lane) * 8 + (q & 1) * 4;
        const f32x4 gg = *(const f32x4*)(g + c);
        f32x4 sc = *(const f32x4*)(md + sc_off + c), sh = *(const f32x4*)(md + sh_off + c);
#pragma unroll
        for (int e = 0; e < 4; e++) o[4 * q + e] = v[rr][4 * q + e] * r * gg[e] * (1.f + sc[e]) + sh[e];
      }
      if (FROMX) {
#pragma unroll
        for (int q = 0; q < 4; q++) { uint2 w; w.x = pk2(o[4 * q], o[4 * q + 1]); w.y = pk2(o[4 * q + 2], o[4 * q + 3]); *(uint2*)(drow + (q * 64 + lane) * 4) = w; }
      } else {
#pragma unroll
        for (int i = 0; i < 2; i++) { uint4 w; w.x = pk2(o[8 * i], o[8 * i + 1]); w.y = pk2(o[8 * i + 2], o[8 * i + 3]); w.z = pk2(o[8 * i + 4], o[8 * i + 5]); w.w = pk2(o[8 * i + 6], o[8 * i + 7]);
          *(uint4*)(drow + (i * 64 + lane) * 8) = w; }
      }
    }
  }
}
DI void final_norm(const P& p, const int wv) {
  const int tix = otid(wv), lane = tix & 63, wrow = blockIdx.x * 8 + (tix >> 6), nw = gridDim.x * 8;
  for (int tok0 = wrow; tok0 < NTOK; tok0 += RIF * nw) {
    float v[RIF][16]; float ss[RIF];
#pragma unroll
    for (int rr = 0; rr < RIF; rr++) {
      const int tok = tok0 + rr * nw;
      if (tok < NTOK) {
        const bf16_t* src = p.hb() + (size_t)tok * 1024;
#pragma unroll
        for (int i = 0; i < 2; i++) { const uint4 t = *(const uint4*)(src + (i * 64 + lane) * 8);
          v[rr][8 * i] = bflo(t.x); v[rr][8 * i + 1] = bfhi(t.x); v[rr][8 * i + 2] = bflo(t.y); v[rr][8 * i + 3] = bfhi(t.y);
          v[rr][8 * i + 4] = bflo(t.z); v[rr][8 * i + 5] = bfhi(t.z); v[rr][8 * i + 6] = bflo(t.w); v[rr][8 * i + 7] = bfhi(t.w); }
      } else {
#pragma unroll
        for (int e = 0; e < 16; e++) v[rr][e] = 0.f;
      }
    }
#pragma unroll
    for (int rr = 0; rr < RIF; rr++) {
      ss[rr] = 0.f;
#pragma unroll
      for (int e = 0; e < 16; e++) ss[rr] += v[rr][e] * v[rr][e];
      ss[rr] = wave_sum(ss[rr]);
    }
#pragma unroll
    for (int rr = 0; rr < RIF; rr++) {
      const int tok = tok0 + rr * nw;
      if (tok >= NTOK) continue;
      const float r = rsqrtf(ss[rr] * (1.f / 1024.f) + EPSV);
      float* drow = p.out + (size_t)tok * 1024;
#pragma unroll
      for (int q = 0; q < 4; q++) {
        const int c = ((q >> 1) * 64 + lane) * 8 + (q & 1) * 4;
        const f32x4 gg = *(const f32x4*)(p.g_final + c);
        f32x4 o;
#pragma unroll
        for (int e = 0; e < 4; e++) o[e] = v[rr][4 * q + e] * r * gg[e];
        *(f32x4*)(drow + c) = o;
      }
    }
  }
}

namespace pg8 {
#define PG8_LAS __attribute__((address_space(3)))
typedef unsigned short bf16_t;
typedef short bf16x8 __attribute__((ext_vector_type(8)));
typedef float f32x4 __attribute__((ext_vector_type(4)));
typedef unsigned u32x4 __attribute__((ext_vector_type(4)));
constexpr int BM = 256, BK = 64, HALF = 128, HTB = HALF * BK * 2  , STAGE_BYTES = 8 * HTB, NXCD = 8, WGM = 8;

__host__ __device__ __forceinline__ int lds_byte(int r, int c) { const int st = (r >> 4) * 2 + (c >> 5), rr = r & 15, cc = c & 31, ob = rr * 64 + cc * 2; return st * 1024 + (ob ^ (((ob >> 9) & 1) << 5)); }
__host__ __device__ __forceinline__ void stage_rc(int b, int& R, int& C) { const int st = b / 1024, sb = b % 1024, swz = sb ^ (((sb >> 9) & 1) << 5); R = (st >> 1) * 16 + swz / 64; C = (st & 1) * 32 + (swz % 64) / 2; }
__host__ __device__ __forceinline__ int perm32(int rho) { const int n = rho >> 4, i = rho & 15; return 8 * (i >> 2) + 4 * n + (i & 3); }

struct Unit { int pm, pn; };
struct Gemm { const bf16_t* A; const bf16_t* Bt; int M, N, K, lda, ldb; };

struct StaticOrder {
    int nM, nN, nwg, G, c;
    __host__ __device__ void init(int M, int N, int G_, int c_) { nM = M / BM; nN = N / BM; nwg = nM * nN; G = G_; c = c_; }
    __host__ __device__ bool next(int i, Unit& u) const {
        const long L = (long)i * G + c; if (L >= nwg) return false;
        int wgid = (int)L; { const int q = nwg / NXCD, r = nwg % NXCD, xcd = wgid % NXCD, off = wgid / NXCD; wgid = (xcd < r ? xcd * (q + 1) : r * (q + 1) + (xcd - r) * q) + off; }
        const int nig = WGM * nN, gid = wgid / nig, fm = gid * WGM, gsz = (nM - fm) < WGM ? (nM - fm) : WGM;
        u.pm = fm + ((wgid % nig) % gsz); u.pn = (wgid % nig) / gsz; return true;
    }
    __device__ __forceinline__ void a_ready(const Unit&) const {}
    __device__ __forceinline__ void done(const Unit&) const {}
};

struct GroupOrder {
    int nwg, G, c, um, un;
    __host__ __device__ void init(int ngroups, int um_, int un_, int G_, int c_) { um = um_; un = un_; nwg = ngroups * um * un; G = G_; c = (c_ & 7) * (G_ >> 3) + (c_ >> 3); }
    __host__ __device__ bool next(int i, Unit& u) const {
        const int L = i * G + c; if (L >= nwg) return false;
        const int gi = L / (um * un), r = L % (um * un); u.pm = gi * um + r / un; u.pn = gi * un + r % un; return true;
    }
    __device__ __forceinline__ void a_ready(const Unit&) const {}
    __device__ __forceinline__ void done(const Unit&) const {}
};
struct Fft1Order {
    int q0, qs, qe;
    __host__ __device__ void init(int G, int bidx) {
        const int slot = (bidx & 7) * (G >> 3) + (bidx >> 3), nbusy = 160 < G ? 160 : G, nfree = G - nbusy;
        if (nfree <= 0) { q0 = slot; qs = G; qe = 1280; }
        else if (slot < nbusy) { q0 = slot; qs = nbusy; qe = 560; }
        else { q0 = 560 + (slot - nbusy); qs = nfree; qe = 1280; }
    }
    __host__ __device__ bool next(int i, Unit& u) const { const int L = q0 + i * qs; if (L >= qe) return false; u.pn = L >> 1; u.pm = (L & 1) + (u.pn >= 128 ? 2 : 0); return true; }
    __device__ __forceinline__ void a_ready(const Unit&) const {}
    __device__ __forceinline__ void done(const Unit&) const {}
};
struct Fft2Order {
    int G, c;
    __host__ __device__ void init(int G_, int c_) { G = G_; c = c_; }
    __host__ __device__ bool next(int i, Unit& u) const { const int L = i * G + c; if (L >= 1280) return false; u.pn = L; u.pm = L < 256 ? 0 : 1; return true; }
    __device__ __forceinline__ void a_ready(const Unit&) const {}
    __device__ __forceinline__ void done(const Unit&) const {}
};
struct YfOrder {
    int G, c;
    __host__ __device__ void init(int G_, int bidx) { G = G_; const int slot = (bidx & 7) * (G_ >> 3) + (bidx >> 3); c = (slot + (G_ >> 1)) % G_; }
    __host__ __device__ bool next(int i, Unit& u) const { const int L = i * G + c; if (L >= 640) return false; u.pm = L >> 1; u.pn = L & 1; return true; }
    __device__ __forceinline__ void a_ready(const Unit&) const {}
    __device__ __forceinline__ void done(const Unit&) const {}
};
template <class Epi, class Sched, bool ALIGN_EPI = false, bool SP2 = false>
__device__ __forceinline__ void gemm_phase(PG8_LAS unsigned char* lds, const int tix, const Gemm g, const Sched& S, const Epi& E) {
    const int tid = tix, wid = __builtin_amdgcn_readfirstlane(tid >> 6), lane = tid & 63, wr = wid >> 2, wc = wid & 3, fr = lane & 15, fq = lane >> 4;
    const int K = g.K, nt = K / BK;
    unsigned voffA[2], voffB[2];
#pragma unroll
    for (int i = 0; i < 2; ++i) { int R, C; stage_rc(tid * 16 + i * 8192, R, C); const int Rb = Epi::PERM ? ((R & ~31) + perm32(R & 31)) : R;
        voffA[i] = (unsigned)(R * g.lda + C) * 2u; voffB[i] = (unsigned)(Rb * g.ldb + C) * 2u; }
    const size_t kstep = (size_t)(BK * 2);
    const size_t hstepA = (size_t)HALF * g.lda * 2, hstepB = (size_t)HALF * g.ldb * 2;
    const size_t tstepA = 2 * hstepA, tstepB = 2 * hstepB;
    const unsigned ldsw = (unsigned)wid * 1024u;
    const int aoff = lds_byte(wr * 64 + fr, fq * 8), boff = lds_byte(wc * 32 + fr, fq * 8);
#define PG8_SA(b, h) (((b) * 2 + (h)) * HTB)
#define PG8_SB(b, h) ((4 + (b) * 2 + (h)) * HTB)
#define PG8_STAGE(bufoff, gbase, voff) do { _Pragma("unroll") for (int _i = 0; _i < 2; ++_i) \
        __builtin_amdgcn_global_load_lds((const unsigned*)((const char*)(gbase) + (voff)[_i]), (PG8_LAS unsigned*)(lds + (bufoff) + ldsw + _i * 8192), 16, 0, 0); } while (0)
#define PG8_LDA(dst, b, h) do { _Pragma("unroll") for (int m = 0; m < 4; ++m) _Pragma("unroll") for (int k = 0; k < 2; ++k) dst[m][k] = *(const PG8_LAS bf16x8*)(lds + PG8_SA(b, h) + aoff + m * 2048 + k * 1024); } while (0)
#define PG8_LDB(dst, b, h) do { _Pragma("unroll") for (int n = 0; n < 2; ++n) _Pragma("unroll") for (int k = 0; k < 2; ++k) dst[n][k] = *(const PG8_LAS bf16x8*)(lds + PG8_SB(b, h) + boff + n * 2048 + k * 1024); } while (0)
#define PG8_MMA(ai, bj, At, Bt) do { __builtin_amdgcn_s_setprio(1); _Pragma("unroll") for (int m = 0; m < 4; ++m) _Pragma("unroll") for (int n = 0; n < 2; ++n) _Pragma("unroll") for (int k = 0; k < 2; ++k) \
        acc[ai][bj][m][n] = __builtin_amdgcn_mfma_f32_16x16x32_bf16(Bt[n][k], At[m][k], acc[ai][bj][m][n], 0, 0, 0); __builtin_amdgcn_s_setprio(0); } while (0)
#define PG8_WAIT_V(n) asm volatile("s_waitcnt vmcnt(" #n ")" ::: "memory")
#define PG8_WAIT_L(n) asm volatile("s_waitcnt lgkmcnt(" #n ")" ::: "memory")
#define PG8_BAR __builtin_amdgcn_s_barrier()
#define PG8_SCHED __builtin_amdgcn_sched_barrier(0)
    Unit cur, nxt; int ui = 0;
    if (!S.next(0, cur)) return;
    f32x4 acc[2][2][4][2];
#pragma unroll
    for (int a = 0; a < 2; ++a)
#pragma unroll
        for (int b = 0; b < 2; ++b)
#pragma unroll
            for (int m = 0; m < 4; ++m)
#pragma unroll
                for (int n = 0; n < 2; ++n) acc[a][b][m][n] = (f32x4){0.f, 0.f, 0.f, 0.f};
    bf16x8 At[4][2], B0[2][2], B1[2][2];
    const char* cA = (const char*)g.A + (size_t)cur.pm * tstepA; const char* cB = (const char*)g.Bt + (size_t)cur.pn * tstepB;
    S.a_ready(cur);
    if constexpr (SP2) {
        PG8_STAGE(PG8_SB(0, 0), cB, voffB); PG8_STAGE(PG8_SB(0, 1), cB + hstepB, voffB); PG8_STAGE(PG8_SA(0, 0), cA, voffA); PG8_STAGE(PG8_SA(0, 1), cA + hstepA, voffA);
        if (wr == 1) PG8_BAR;
        PG8_WAIT_V(2); PG8_BAR;
        PG8_STAGE(PG8_SB(1, 0), cB + kstep, voffB); PG8_STAGE(PG8_SA(1, 0), cA + kstep, voffA); PG8_STAGE(PG8_SB(1, 1), cB + hstepB + kstep, voffB);
        PG8_WAIT_V(6); PG8_BAR;
    } else {
        PG8_STAGE(PG8_SB(0, 0), cB, voffB); PG8_STAGE(PG8_SA(0, 0), cA, voffA); PG8_STAGE(PG8_SB(0, 1), cB + hstepB, voffB); PG8_STAGE(PG8_SA(0, 1), cA + hstepA, voffA);
        if (wr == 1) PG8_BAR;
        PG8_WAIT_V(4); PG8_BAR;
        PG8_STAGE(PG8_SB(1, 0), cB + kstep, voffB); PG8_STAGE(PG8_SA(1, 0), cA + kstep, voffA); PG8_STAGE(PG8_SB(1, 1), cB + hstepB + kstep, voffB);
        PG8_WAIT_V(6); PG8_BAR;
    }
    for (;;) {
        const bool has_next = S.next(ui + 1, nxt);
        const char* nA = has_next ? (const char*)g.A + (size_t)nxt.pm * tstepA : cA; const char* nB = has_next ? (const char*)g.Bt + (size_t)nxt.pn * tstepB : cB;
        for (int t = 0; t < nt; t += 2) {
            if constexpr (Epi::KHOOK) { if (t == Epi::KH_T) E.khook(acc, ui, wr, fr, lds); }
            const bool last = (t == nt - 2);
            const char* a1 = cA + (size_t)(t + 1) * kstep;
            const char* a2 = last ? nA : cA + (size_t)(t + 2) * kstep; const char* b2 = last ? nB : cB + (size_t)(t + 2) * kstep;
            const char* a3 = a2 + kstep; const char* b3 = b2 + kstep;
            if (last && has_next) S.a_ready(nxt);
            if constexpr (SP2) {
            PG8_LDB(B0, 0, 0); PG8_LDB(B1, 0, 1); PG8_SCHED; PG8_LDA(At, 0, 0); PG8_STAGE(PG8_SA(1, 1), a1 + hstepA, voffA);
            PG8_WAIT_V(8); PG8_WAIT_L(0); PG8_BAR; PG8_MMA(0, 0, At, B0); PG8_MMA(0, 1, At, B1); PG8_BAR; PG8_SCHED;
            PG8_LDA(At, 0, 1); PG8_STAGE(PG8_SB(0, 0), b2, voffB); PG8_STAGE(PG8_SB(0, 1), b2 + hstepB, voffB); PG8_STAGE(PG8_SA(0, 0), a2, voffA);
            PG8_WAIT_V(8); PG8_WAIT_L(0); PG8_BAR; PG8_MMA(1, 0, At, B0); PG8_MMA(1, 1, At, B1); PG8_BAR; PG8_SCHED;
            PG8_LDB(B0, 1, 0); PG8_LDB(B1, 1, 1); PG8_SCHED; PG8_LDA(At, 1, 0); PG8_STAGE(PG8_SA(0, 1), a2 + hstepA, voffA);
            PG8_WAIT_V(8); PG8_WAIT_L(0); PG8_BAR; PG8_MMA(0, 0, At, B0); PG8_MMA(0, 1, At, B1); PG8_BAR; PG8_SCHED;
            PG8_LDA(At, 1, 1); PG8_STAGE(PG8_SB(1, 0), b3, voffB); PG8_STAGE(PG8_SB(1, 1), b3 + hstepB, voffB); PG8_STAGE(PG8_SA(1, 0), a3, voffA);
            PG8_WAIT_V(8); PG8_WAIT_L(0); PG8_BAR; PG8_MMA(1, 0, At, B0); PG8_MMA(1, 1, At, B1); PG8_BAR; PG8_SCHED;
            } else {
            PG8_LDB(B0, 0, 0); PG8_SCHED; PG8_LDA(At, 0, 0); PG8_STAGE(PG8_SA(1, 1), a1 + hstepA, voffA);
            PG8_WAIT_L(8); PG8_BAR; PG8_WAIT_L(0); PG8_MMA(0, 0, At, B0); PG8_BAR; PG8_SCHED;
            PG8_LDB(B1, 0, 1); PG8_STAGE(PG8_SB(0, 0), b2, voffB);
            PG8_BAR; PG8_WAIT_L(0); PG8_MMA(0, 1, At, B1); PG8_BAR;
            PG8_LDA(At, 0, 1); PG8_STAGE(PG8_SA(0, 0), a2, voffA);
            PG8_BAR; PG8_WAIT_L(0); PG8_MMA(1, 0, At, B0); PG8_BAR; PG8_SCHED;
            PG8_STAGE(PG8_SB(0, 1), b2 + hstepB, voffB);
            PG8_WAIT_V(6); PG8_BAR; PG8_MMA(1, 1, At, B1); PG8_BAR;
            PG8_LDB(B0, 1, 0); PG8_SCHED; PG8_LDA(At, 1, 0); PG8_STAGE(PG8_SA(0, 1), a2 + hstepA, voffA);
            PG8_WAIT_L(8); PG8_BAR; PG8_WAIT_L(0); PG8_MMA(0, 0, At, B0); PG8_BAR; PG8_SCHED;
            PG8_LDB(B1, 1, 1); PG8_STAGE(PG8_SB(1, 0), b3, voffB);
            PG8_BAR; PG8_WAIT_L(0); PG8_MMA(0, 1, At, B1); PG8_BAR;
            PG8_LDA(At, 1, 1); PG8_STAGE(PG8_SA(1, 0), a3, voffA);
            PG8_BAR; PG8_WAIT_L(0); PG8_MMA(1, 0, At, B0); PG8_BAR; PG8_SCHED;
            PG8_STAGE(PG8_SB(1, 1), b3 + hstepB, voffB);
            PG8_WAIT_V(6); PG8_BAR; PG8_MMA(1, 1, At, B1); PG8_BAR;
            }
        }
        if constexpr (ALIGN_EPI) { if (wr == 0) PG8_BAR; }
        if constexpr (!Epi::AFTER_DRAIN) { E(acc, cur, wr, wc, fr, fq, ui); S.done(cur); }
        if (!has_next) break;
#pragma unroll
        for (int a = 0; a < 2; ++a)
#pragma unroll
            for (int b = 0; b < 2; ++b)
#pragma unroll
                for (int m = 0; m < 4; ++m)
#pragma unroll
                    for (int n = 0; n < 2; ++n) acc[a][b][m][n] = (f32x4){0.f, 0.f, 0.f, 0.f};
        cur = nxt; cA = nA; cB = nB; ++ui;
        if constexpr (ALIGN_EPI) { if (wr == 1) PG8_BAR; }
    }
    PG8_WAIT_V(0);
    if constexpr (!ALIGN_EPI) { if (wr == 0) PG8_BAR; }
    PG8_BAR;
    if constexpr (Epi::AFTER_DRAIN) { E.fused(acc, cur, wr, wc, fr, fq, lds, wid, lane); S.done(cur); }
#undef PG8_SA
#undef PG8_SB
#undef PG8_STAGE
#undef PG8_LDA
#undef PG8_LDB
#undef PG8_MMA
#undef PG8_WAIT_V
#undef PG8_WAIT_L
#undef PG8_BAR
#undef PG8_SCHED
}
}

namespace pg8 {
struct EpiMlpIn {
  static constexpr bool PERM = true, AFTER_DRAIN = false, KHOOK = false; static constexpr int KH_T = 0;
  ::bf16_t* O; const float* bias;
  __device__ __forceinline__ void operator()(const f32x4 (&acc)[2][2][4][2], const Unit& u, int wr, int wc, int fr, int fq, int) const {
    const int row0 = u.pm * BM + wr * 64 + fr, col0 = u.pn * BM + wc * 32 + 8 * fq;
    f32x4 bv[2][2];
#pragma unroll
    for (int bj = 0; bj < 2; ++bj)
#pragma unroll
      for (int n = 0; n < 2; ++n) bv[bj][n] = *(const f32x4*)(bias + col0 + bj * HALF + 4 * n);
#pragma unroll
    for (int ai = 0; ai < 2; ++ai)
#pragma unroll
      for (int m = 0; m < 4; ++m) {
        ::bf16_t* rowp = O + (size_t)(row0 + ai * HALF + m * 16) * 4096 + col0;
#pragma unroll
        for (int bj = 0; bj < 2; ++bj) {
          f32x4 v0 = acc[ai][bj][m][0] + bv[bj][0], v1 = acc[ai][bj][m][1] + bv[bj][1];
#pragma unroll
          for (int e = 0; e < 4; ++e) { const float a = fmaxf(v0[e], 0.f), b = fmaxf(v1[e], 0.f); v0[e] = a * a; v1[e] = b * b; }
          u32x4 w; w.x = pk2(v0[0], v0[1]); w.y = pk2(v0[2], v0[3]); w.z = pk2(v1[0], v1[1]); w.w = pk2(v1[2], v1[3]);
          *(u32x4*)(rowp + bj * HALF) = w;
        }
      }
  }
};
struct EpiMlpOut {
  static constexpr bool PERM = false, AFTER_DRAIN = false, KHOOK = false; static constexpr int KH_T = 0;
  const ::bf16_t* x1; ::bf16_t* x2; const float* mod; const float* bias;
  __device__ __forceinline__ void operator()(const f32x4 (&acc)[2][2][4][2], const Unit& u, int wr, int wc, int fr, int fq, int) const {
    const int col0 = u.pn * BM + wc * 32 + 4 * fq;
    f32x4 bb[2][2];
#pragma unroll
    for (int bj = 0; bj < 2; ++bj)
#pragma unroll
      for (int n = 0; n < 2; ++n) bb[bj][n] = *(const f32x4*)(bias + col0 + bj * HALF + n * 16);
#pragma unroll
    for (int ai = 0; ai < 2; ++ai)
#pragma unroll
      for (int mp = 0; mp < 2; ++mp) {
        uint2 xr[2][2][2]; f32x4 gv[2][2][2];
#pragma unroll
        for (int mm = 0; mm < 2; ++mm) {
          const int row = u.pm * BM + ai * HALF + wr * 64 + (mp * 2 + mm) * 16 + fr;
          const float* g2 = mod + batch_of(row) * 6144 + 5120;
#pragma unroll
          for (int bj = 0; bj < 2; ++bj)
#pragma unroll
            for (int n = 0; n < 2; ++n) { const int col = col0 + bj * HALF + n * 16; xr[mm][bj][n] = *(const uint2*)(x1 + (size_t)row * 1024 + col); gv[mm][bj][n] = *(const f32x4*)(g2 + col); }
        }
        asm volatile("" ::: "memory");
#pragma unroll
        for (int mm = 0; mm < 2; ++mm) {
          const int m = mp * 2 + mm, row = u.pm * BM + ai * HALF + wr * 64 + m * 16 + fr;
#pragma unroll
          for (int bj = 0; bj < 2; ++bj)
#pragma unroll
            for (int n = 0; n < 2; ++n) {
              const int col = col0 + bj * HALF + n * 16;
              const uint2 xx = xr[mm][bj][n];
              const f32x4 xv = {bflo(xx.x), bfhi(xx.x), bflo(xx.y), bfhi(xx.y)};
              const f32x4 o = xv + gv[mm][bj][n] * (acc[ai][bj][m][n] + bb[bj][n]);
              uint2 w; w.x = pk2(o[0], o[1]); w.y = pk2(o[2], o[3]);
              *(uint2*)(x2 + (size_t)row * 1024 + col) = w;
            }
        }
      }
  }
};
struct EpiYf {
  static constexpr bool PERM = true, AFTER_DRAIN = false, KHOOK = false; static constexpr int KH_T = 0;
  ::bf16_t* O; const float* bias; float* ss;
  __device__ __forceinline__ void operator()(const f32x4 (&acc)[2][2][4][2], const Unit& u, int wr, int wc, int fr, int fq, int) const {
    const int row0 = u.pm * BM + wr * 64 + fr, col0 = u.pn * BM + wc * 32 + 8 * fq;
    f32x4 bv[2][2];
#pragma unroll
    for (int bj = 0; bj < 2; ++bj)
#pragma unroll
      for (int n = 0; n < 2; ++n) bv[bj][n] = *(const f32x4*)(bias + col0 + bj * HALF + 4 * n);
#pragma unroll
    for (int ai = 0; ai < 2; ++ai)
#pragma unroll
      for (int m = 0; m < 4; ++m) {
        const int row = row0 + ai * HALF + m * 16;
        const float scale = row < LPR ? 3.4526698300124393e-4f : 6.905339660024879e-4f;
        ::bf16_t* rowp = O + (size_t)row * 1024 + col0;
        float s = 0.f;
#pragma unroll
        for (int bj = 0; bj < 2; ++bj) {
          const f32x4 v0 = acc[ai][bj][m][0] * scale + bv[bj][0], v1 = acc[ai][bj][m][1] * scale + bv[bj][1];
          s += (v0[0] * v0[0] + v0[1] * v0[1]) + (v0[2] * v0[2] + v0[3] * v0[3]) + (v1[0] * v1[0] + v1[1] * v1[1]) + (v1[2] * v1[2] + v1[3] * v1[3]);
          u32x4 w; w.x = pk2(v0[0], v0[1]); w.y = pk2(v0[2], v0[3]); w.z = pk2(v1[0], v1[1]); w.w = pk2(v1[2], v1[3]);
          *(u32x4*)(rowp + bj * HALF) = w;
        }
        s += __shfl_xor(s, 16); s += __shfl_xor(s, 32);
        if (fq == 0) ss[row * 8 + u.pn * 4 + wc] = s;
      }
  }
};
struct EpiGlu {
  static constexpr bool PERM = true, AFTER_DRAIN = false, KHOOK = false; static constexpr int KH_T = 0;
  ::bf16_t* O; const float* bias; float* ss;
  __device__ __forceinline__ void operator()(const f32x4 (&acc)[2][2][4][2], const Unit& u, int wr, int wc, int fr, int fq, int) const {
    const int row0 = u.pm * BM + wr * 64 + fr, j0 = u.pn * 128 + wc * 32 + 8 * fq;
    f32x4 bv[2][2];
#pragma unroll
    for (int bj = 0; bj < 2; ++bj)
#pragma unroll
      for (int n = 0; n < 2; ++n) bv[bj][n] = *(const f32x4*)(bias + bj * 512 + j0 + 4 * n);
#pragma unroll
    for (int ai = 0; ai < 2; ++ai)
#pragma unroll
      for (int m = 0; m < 4; ++m) {
        const int row = row0 + ai * HALF + m * 16;
        float o[8], s = 0.f;
#pragma unroll
        for (int n = 0; n < 2; ++n)
#pragma unroll
          for (int e = 0; e < 4; ++e) {
            const float val = acc[ai][0][m][n][e] + bv[0][n][e], gate = acc[ai][1][m][n][e] + bv[1][n][e];
            const float y = val / (1.f + __expf(-gate));
            o[4 * n + e] = y; s += y * y;
          }
        u32x4 w; w.x = pk2(o[0], o[1]); w.y = pk2(o[2], o[3]); w.z = pk2(o[4], o[5]); w.w = pk2(o[6], o[7]);
        *(u32x4*)(O + (size_t)row * 1024 + 512 + j0) = w;
        s += __shfl_xor(s, 16); s += __shfl_xor(s, 32);
        if (fq == 0) ss[row * 16 + u.pn * 4 + wc] = s;
      }
  }
};
struct EpiZt {
  static constexpr bool PERM = true, AFTER_DRAIN = false, KHOOK = false; static constexpr int KH_T = 0;
  ::bf16_t* O;
  __device__ __forceinline__ void operator()(const f32x4 (&acc)[2][2][4][2], const Unit& u, int wr, int wc, int fr, int fq, int) const {
    const int v0 = u.pn * BM;
    ::bf16_t* base; size_t ld;
    if (v0 < LPR) { base = O + v0; ld = LPR; }
    else { const int vs = v0 - LPR; base = O + (size_t)512 * LPR + (size_t)(vs >> 12) * 512 * 4096 + (vs & 4095); ld = 4096; }
    const int c0 = u.pm * BM + wr * 64 + fr, col0 = wc * 32 + 8 * fq;
#pragma unroll
    for (int ai = 0; ai < 2; ++ai)
#pragma unroll
      for (int m = 0; m < 4; ++m) {
        ::bf16_t* rowp = base + (size_t)(c0 + ai * HALF + m * 16) * ld + col0;
#pragma unroll
        for (int bj = 0; bj < 2; ++bj) {
          const f32x4 a = acc[ai][bj][m][0], b = acc[ai][bj][m][1];
          u32x4 w; w.x = pk2(a[0], a[1]); w.y = pk2(a[2], a[3]); w.z = pk2(b[0], b[1]); w.w = pk2(b[2], b[3]);
          *(u32x4*)(rowp + bj * HALF) = w;
        }
      }
  }
};
struct EpiZs {
  static constexpr bool PERM = true, AFTER_DRAIN = false, KHOOK = false; static constexpr int KH_T = 0;
  ::bf16_t* O;
  __device__ __forceinline__ void operator()(const f32x4 (&acc)[2][2][4][2], const Unit& u, int wr, int wc, int fr, int fq, int) const {
    const int r0 = u.pm * BM + wr * 64 + fr, col0 = u.pn * BM + wc * 32 + 8 * fq;
#pragma unroll
    for (int ai = 0; ai < 2; ++ai)
#pragma unroll
      for (int m = 0; m < 4; ++m) {
        const int tok = v2tok(r0 + ai * HALF + m * 16);
#pragma unroll
        for (int bj = 0; bj < 2; ++bj) {
          const int col = col0 + bj * HALF;
          const f32x4 a = acc[ai][bj][m][0], b = acc[ai][bj][m][1];
          u32x4 w; w.x = pk2(a[0], a[1]); w.y = pk2(a[2], a[3]); w.z = pk2(b[0], b[1]); w.w = pk2(b[2], b[3]);
          *(u32x4*)(O + ((size_t)(col >> 4) * 1280 + (tok >> 6)) * 1280 + (tok & 63) * 16 + (col & 15)) = w;
        }
      }
  }
};
struct EpiS {
  static constexpr bool PERM = false, AFTER_DRAIN = false, KHOOK = false; static constexpr int KH_T = 0;
  float* O;
  __device__ __forceinline__ void operator()(const f32x4 (&acc)[2][2][4][2], const Unit& u, int wr, int wc, int fr, int fq, int) const {
#pragma unroll
    for (int ai = 0; ai < 2; ++ai)
#pragma unroll
      for (int m = 0; m < 4; ++m) {
        float* rowp = O + (size_t)(u.pm * BM + ai * HALF + wr * 64 + m * 16 + fr) * 256 + wc * 32 + 4 * fq;
#pragma unroll
        for (int bj = 0; bj < 2; ++bj)
#pragma unroll
          for (int n = 0; n < 2; ++n) *(f32x4*)(rowp + bj * HALF + n * 16) = acc[ai][bj][m][n];
      }
  }
};
struct EpiGelu {
  static constexpr bool PERM = true, AFTER_DRAIN = false, KHOOK = false; static constexpr int KH_T = 0;
  ::bf16_t* O;
  __device__ __forceinline__ void operator()(const f32x4 (&acc)[2][2][4][2], const Unit& u, int wr, int wc, int fr, int fq, int) const {
    const int gi = u.pn >> 2, n0 = (u.pn & 3) * BM + wc * 32 + 8 * fq, ch0 = u.pm * BM - gi * 1280 + wr * 64 + fr;
#pragma unroll
    for (int ai = 0; ai < 2; ++ai)
#pragma unroll
      for (int m = 0; m < 4; ++m) {
        const int ch = ch0 + ai * HALF + m * 16;
#pragma unroll
        for (int bj = 0; bj < 2; ++bj) {
          const int n = n0 + bj * HALF;
          float o[8];
#pragma unroll
          for (int e = 0; e < 4; ++e) { o[e] = gelu_tanh(acc[ai][bj][m][0][e]); o[4 + e] = gelu_tanh(acc[ai][bj][m][1][e]); }
          u32x4 w; w.x = pk2(o[0], o[1]); w.y = pk2(o[2], o[3]); w.z = pk2(o[4], o[5]); w.w = pk2(o[6], o[7]);
          *(u32x4*)(O + (size_t)(ch * 64 + (n >> 4)) * 512 + gi * 16 + (n & 15)) = w;
        }
      }
  }
};
struct EpiFft1 {
  static constexpr bool PERM = true, AFTER_DRAIN = false, KHOOK = false; static constexpr int KH_T = 0;
  ::bf16_t* Tt; const float2* twp; const float2* tws;
  __device__ __forceinline__ void operator()(const f32x4 (&acc)[2][2][4][2], const Unit& u, int wr, int wc, int fr, int fq, int) const {
    const bool pr = u.pn < 128;
    const int r0b = u.pn * BM + wc * 32 + 8 * fq;
    const float2* tw = pr ? twp : tws;
    const int mask = pr ? 16383 : 4095;
    float2 stv[4], w0v[4];
#pragma unroll
    for (int m = 0; m < 4; ++m) {
      const int idx = ((u.pm & 1) << 7) | (wr * 64 + m * 16 + fr);
      const int k1 = pr ? (idx & 127) : (idx & 63), l2loc = pr ? (idx >> 7) : (idx >> 6);
      const int l20 = pr ? (l2loc * 64 + (r0b & 63)) : (l2loc * 16 + (r0b & 15));
      stv[m] = tw[(unsigned)(k1 & mask)]; w0v[m] = tw[(unsigned)((k1 * l20) & mask)];
    }
    asm volatile("" ::: "memory");
#pragma unroll
    for (int m = 0; m < 4; ++m) {
      const int idx = ((u.pm & 1) << 7) | (wr * 64 + m * 16 + fr);
      const int k1 = pr ? (idx & 127) : (idx & 63), l2loc = pr ? (idx >> 7) : (idx >> 6);
      const int l20 = pr ? (l2loc * 64 + (r0b & 63)) : (l2loc * 16 + (r0b & 15));
      const float2 st = stv[m], w0 = w0v[m];
#pragma unroll
      for (int bj = 0; bj < 2; ++bj) {
        const int r0 = r0b + bj * HALF;
        size_t off; int pstride;
        if (pr) { off = ((size_t)(k1 * 512 + (r0 >> 6))) * 256 + l20; pstride = 128; }
        else { const int bc = (r0 - 32768) >> 4; off = (size_t)65536 * 256 + ((size_t)(((bc >> 9) * 32 + (k1 >> 1)) * 512 + (bc & 511))) * 256 + (k1 & 1) * 128 + l20; pstride = 64; }
        float ore[8], oim[8];
        float2 wv = w0;
#pragma unroll
        for (int e = 0; e < 8; ++e) {
          const float re = acc[0][bj][m][e >> 2][e & 3], im = acc[1][bj][m][e >> 2][e & 3];
          ore[e] = re * wv.x + im * wv.y; oim[e] = im * wv.x - re * wv.y;
          wv = make_float2(wv.x * st.x - wv.y * st.y, wv.y * st.x + wv.x * st.y);
        }
        u32x4 w; w.x = pk2(ore[0], ore[1]); w.y = pk2(ore[2], ore[3]); w.z = pk2(ore[4], ore[5]); w.w = pk2(ore[6], ore[7]);
        *(u32x4*)(Tt + off) = w;
        w.x = pk2(oim[0], oim[1]); w.y = pk2(oim[2], oim[3]); w.z = pk2(oim[4], oim[5]); w.w = pk2(oim[6], oim[7]);
        *(u32x4*)(Tt + off + pstride) = w;
      }
    }
  }
};
struct EpiFft2 {
  static constexpr bool PERM = true, AFTER_DRAIN = false, KHOOK = false; static constexpr int KH_T = 0;
  ::bf16_t* AF;
  __device__ __forceinline__ void operator()(const f32x4 (&acc)[2][2][4][2], const Unit& u, int wr, int wc, int fr, int fq, int) const {
    const bool pr = u.pn < 256;
    const int pnl = pr ? u.pn : u.pn - 256, c0 = (pnl & 1) * 256 + wc * 32 + 8 * fq;
#pragma unroll
    for (int ai = 0; ai < 2; ++ai)
#pragma unroll
      for (int m = 0; m < 4; ++m) {
        int part, tok;
        if (pr) { part = ai; tok = (pnl >> 1) + 128 * (wr * 64 + m * 16 + fr); }
        else { const int bk = pnl >> 1; part = wr; tok = LPR + (bk >> 5) * 4096 + (bk & 31) * 2 + ai + 64 * (m * 16 + fr); }
        ::bf16_t* rowp = AF + (size_t)tok * 1024 + part * 512 + c0;
#pragma unroll
        for (int bj = 0; bj < 2; ++bj) {
          const f32x4 a = acc[ai][bj][m][0], b = acc[ai][bj][m][1];
          u32x4 w; w.x = pk2(a[0], a[1]); w.y = pk2(a[2], a[3]); w.z = pk2(b[0], b[1]); w.w = pk2(b[2], b[3]);
          *(u32x4*)(rowp + bj * HALF) = w;
        }
      }
  }
};
struct EpiWout {
  static constexpr bool PERM = false, AFTER_DRAIN = false, KHOOK = true; static constexpr int KH_T = 8;
  float* out; const float* xp; const float* xs; const float* mod;
  __device__ __forceinline__ void khook(f32x4 (&acc)[2][2][4][2], int ui, int wr, int fr, PG8_LAS unsigned char* lds) const {
    typedef float f32x2t __attribute__((ext_vector_type(2)));
    const PG8_LAS f32x2t* tab = (const PG8_LAS f32x2t*)(lds + 131072) + ui * 256;
#pragma unroll
    for (int ai = 0; ai < 2; ++ai)
#pragma unroll
      for (int m = 0; m < 4; ++m) {
        const float r = tab[ai * HALF + wr * 64 + m * 16 + fr].x;
#pragma unroll
        for (int bj = 0; bj < 2; ++bj)
#pragma unroll
          for (int n = 0; n < 2; ++n) acc[ai][bj][m][n] *= r;
      }
  }
  __device__ __forceinline__ void operator()(const f32x4 (&acc)[2][2][4][2], const Unit& u, int wr, int wc, int fr, int fq, int ui) const {
    typedef float f32x2t __attribute__((ext_vector_type(2)));
    const PG8_LAS f32x2t* tab = (const PG8_LAS f32x2t*)((PG8_LAS unsigned char*)dyn_smem + 131072) + ui * 256;
    const int col0 = u.pn * BM + wc * 32 + 4 * fq;
#pragma unroll
    for (int ai = 0; ai < 2; ++ai)
#pragma unroll
      for (int mp = 0; mp < 2; ++mp) {
        f32x4 xv[2][2][2], gv[2][2][2]; float rs[2];
#pragma unroll
        for (int mm = 0; mm < 2; ++mm) {
          const int m = mp * 2 + mm, rl = ai * HALF + wr * 64 + m * 16 + fr, row = u.pm * BM + rl;
          rs[mm] = tab[rl].y;
          const float* g1 = mod + batch_of(row) * 6144 + 2048;
          const float* xr = row < LPR ? xp + (size_t)row * 1024 : xs + (size_t)(row - LPR) * 1024;
#pragma unroll
          for (int bj = 0; bj < 2; ++bj)
#pragma unroll
            for (int n = 0; n < 2; ++n) { const int col = col0 + bj * HALF + n * 16; xv[mm][bj][n] = *(const f32x4*)(xr + col); gv[mm][bj][n] = *(const f32x4*)(g1 + col); }
        }
        asm volatile("" ::: "memory");
#pragma unroll
        for (int mm = 0; mm < 2; ++mm) {
          const int m = mp * 2 + mm, row = u.pm * BM + ai * HALF + wr * 64 + m * 16 + fr;
          ::bf16_t* orow = (::bf16_t*)out + (size_t)row * 1024;
#pragma unroll
          for (int bj = 0; bj < 2; ++bj)
#pragma unroll
            for (int n = 0; n < 2; ++n) {
              const int col = col0 + bj * HALF + n * 16;
              const f32x4 o = xv[mm][bj][n] + gv[mm][bj][n] * (acc[ai][bj][m][n] * rs[mm]);
              uint2 w; w.x = pk2(o[0], o[1]); w.y = pk2(o[2], o[3]);
              *(uint2*)(orow + col) = w;
            }
        }
      }
  }
};
}

DI void phase2(const P& p, const int wv) {
  {
    const pg8::Gemm g{p.wint(), p.hb(), 512, NTOK, 1024, 1024, 1024};
    pg8::StaticOrder S; S.init(512, NTOK, (int)gridDim.x, (int)blockIdx.x);
    const pg8::EpiZt E{p.zT()};
    pg8::gemm_phase<pg8::EpiZt, pg8::StaticOrder, true, true>((PG8_LAS unsigned char*)dyn_smem, otid(wv), g, S, E);
  }
  {
    const pg8::Gemm g{p.hb(), p.wint() + (size_t)512 * 1024, NTOK, 512, 1024, 1024, 1024};
    pg8::StaticOrder S; S.init(NTOK, 512, (int)gridDim.x, (int)(gridDim.x - 1 - blockIdx.x));
    const pg8::EpiZs E{p.Ucat()};
    pg8::gemm_phase<pg8::EpiZs, pg8::StaticOrder, true, true>((PG8_LAS unsigned char*)dyn_smem, otid(wv), g, S, E);
  }
}
DI void phase3(const P& p, const int wv) {
  {
    const pg8::Gemm g{p.Ucat(), p.Bs(), 32 * 1280, 32 * 256, 1024, 1280, 1024};
    pg8::GroupOrder S; S.init(32, 5, 1, (int)gridDim.x, (int)blockIdx.x);
    const pg8::EpiS E{p.S()};
    pg8::gemm_phase<pg8::EpiS, pg8::GroupOrder, true, true>((PG8_LAS unsigned char*)dyn_smem, otid(wv), g, S, E);
  }
  {
    const pg8::Gemm g{p.Fb1(), p.zT(), 1024, 163840, 256, 256, 256};
    pg8::Fft1Order S; S.init((int)gridDim.x, (int)blockIdx.x);
    const pg8::EpiFft1 E{p.Tt(), p.twp(), p.tws()};
    pg8::gemm_phase<pg8::EpiFft1, pg8::Fft1Order, true, true>((PG8_LAS unsigned char*)dyn_smem, otid(wv), g, S, E);
  }
}
DI void phase4(const P& p, const int wv) {
  {
    const int tix = otid(wv), pp = tix & 63, G = (int)gridDim.x;
    for (int task = (int)blockIdx.x + G * wv; task < 17 * 64; task += G * 8) {
      const int seq = task >> 6, g = (task >> 1) & 31, dir = task & 1;
      const int c0 = seq == 0 ? 0 : 256 + (seq - 1) * 64, nc = seq == 0 ? 256 : 64;
      const float ar = p.AT()[((g * 2 + dir) * 64 + pp) * 2], ai = p.AT()[((g * 2 + dir) * 64 + pp) * 2 + 1];
      float hr = 0.f, hi = 0.f;
      const float* Sg = p.S() + (size_t)g * 1280 * 256 + dir * 128 + pp;
      bf16_t* Hg = p.Ucat() + (size_t)g * 1280 * 1280 + 1024 + dir * 128 + pp;
      for (int i0 = 0; i0 < nc; i0 += 32) {
        float sr[32], si[32];
#pragma unroll
        for (int j = 0; j < 32; j++) {
          const int c = c0 + (dir == 0 ? i0 + j : nc - 1 - i0 - j);
          sr[j] = Sg[(size_t)c * 256]; si[j] = Sg[(size_t)c * 256 + 64];
        }
#pragma unroll
        for (int j = 0; j < 32; j++) {
          const int c = c0 + (dir == 0 ? i0 + j : nc - 1 - i0 - j);
          Hg[(size_t)c * 1280] = f2bf(hr); Hg[(size_t)c * 1280 + 64] = f2bf(hi);
          const float nr = ar * hr - ai * hi + sr[j], ni = ar * hi + ai * hr + si[j];
          hr = nr; hi = ni;
        }
      }
    }
  }
  {
    const pg8::Gemm g{p.Fb2(), p.Tt(), 512, 327680, 256, 256, 256};
    pg8::Fft2Order S; S.init((int)gridDim.x, (int)blockIdx.x);
    const pg8::EpiFft2 E{p.AF()};
    pg8::gemm_phase<pg8::EpiFft2, pg8::Fft2Order, true, true>((PG8_LAS unsigned char*)dyn_smem, otid(wv), g, S, E);
  }
}
DI void phase5(const P& p, const int wv) {
  const pg8::Gemm g{p.Ucat(), p.Tcat(), 32 * 1280, 32 * 1024, 1280, 1280, 1280};
  pg8::GroupOrder S; S.init(32, 5, 4, (int)gridDim.x, (int)blockIdx.x);
  const pg8::EpiGelu E{p.gact()};
  pg8::gemm_phase<pg8::EpiGelu, pg8::GroupOrder, true, true>((PG8_LAS unsigned char*)dyn_smem, otid(wv), g, S, E);
  {
    const pg8::Gemm g{p.AF(), p.Mf(), NTOK, 512, 1024, 1024, 1024};
    pg8::YfOrder S; S.init((int)gridDim.x, (int)blockIdx.x);
    const pg8::EpiYf E{p.mg(), p.b_f, p.ssf()};
    pg8::gemm_phase<pg8::EpiYf, pg8::YfOrder, true, true>((PG8_LAS unsigned char*)dyn_smem, otid(wv), g, S, E);
  }
}
DI void phase6(const P& p, const int wv) {
  {
    const pg8::Gemm g{p.gact(), p.wglut(), NTOK, 1024, 512, 512, 512};
    pg8::StaticOrder S; S.init(NTOK, 1024, (int)gridDim.x, (int)blockIdx.x);
    const pg8::EpiGlu E{p.mg(), p.b_glu, p.sss()};
    pg8::gemm_phase<pg8::EpiGlu, pg8::StaticOrder, true, true>((PG8_LAS unsigned char*)dyn_smem, otid(wv), g, S, E);
  }
}
DI void phase7(const P& p, const int wv) {
  const pg8::Gemm g{p.mg(), p.woutt(), NTOK, 1024, 1024, 1024, 1024};
  pg8::StaticOrder S; S.init(NTOK, 1024, (int)gridDim.x, (int)blockIdx.x);
  {
    typedef float f32x2t __attribute__((ext_vector_type(2)));
    PG8_LAS f32x2t* tab = (PG8_LAS f32x2t*)((PG8_LAS unsigned char*)dyn_smem + 131072);
    const int tix7 = otid(wv);
    pg8::Unit u;
    for (int i = 0; i < 8 && S.next(i, u); ++i) {
      if (tix7 < 256) {
        const int tok = u.pm * 256 + tix7;
        float sf = 0.f, s2 = 0.f;
#pragma unroll
        for (int j = 0; j < 8; j++) sf += p.ssf()[tok * 8 + j];
#pragma unroll
        for (int j = 0; j < 16; j++) s2 += p.sss()[tok * 16 + j];
        const float rf = rsqrtf(sf * (1.f / 512.f) + EPSV), rs = rsqrtf(s2 * (1.f / 512.f) + EPSV);
        tab[i * 256 + tix7] = (f32x2t){rf / rs, rs};
      }
    }
    __syncthreads();
  }
  const pg8::EpiWout E{p.out, p.xp, p.xs, p.mod()};
  pg8::gemm_phase<pg8::EpiWout, pg8::StaticOrder, true, true>((PG8_LAS unsigned char*)dyn_smem, otid(wv), g, S, E);
}
DI void phase8(const P& p, const int wv) {
  const pg8::Gemm g{p.hb(), p.w1t(), NTOK, 4096, 1024, 1024, 1024};
  pg8::StaticOrder S; S.init(NTOK, 4096, (int)gridDim.x, (int)blockIdx.x);
  const pg8::EpiMlpIn E{p.hid(), p.b1};
  pg8::gemm_phase<pg8::EpiMlpIn, pg8::StaticOrder, true, true>((PG8_LAS unsigned char*)dyn_smem, otid(wv), g, S, E);
}
DI void phase9(const P& p, const int wv) {
  const pg8::Gemm g{p.hid(), p.w2t(), NTOK, 1024, 4096, 4096, 4096};
  pg8::StaticOrder S; S.init(NTOK, 1024, (int)gridDim.x, (int)blockIdx.x);
  const pg8::EpiMlpOut E{(const bf16_t*)p.out, p.hb(), p.mod(), p.b2};
  pg8::gemm_phase<pg8::EpiMlpOut, pg8::StaticOrder, true, true>((PG8_LAS unsigned char*)dyn_smem, otid(wv), g, S, E);
}

__global__ void __launch_bounds__(512, 2) k_mega(P p) {
  cg::grid_group grid = cg::this_grid();
  const int wv = __builtin_amdgcn_readfirstlane((int)threadIdx.x >> 6);
  phase0(p, wv); grid.sync();
  rownorm_mod<true>(p, wv, p.g_mix, 0, 1024); grid.sync();
  phase2(p, wv); grid.sync();
  phase3(p, wv); grid.sync();
  phase4(p, wv); grid.sync();
  phase5(p, wv); grid.sync();
  phase6(p, wv); grid.sync();
  phase7(p, wv); grid.sync();
  rownorm_mod<false>(p, wv, p.g_mlp, 3072, 4096); grid.sync();
  phase8(p, wv); grid.sync();
  phase9(p, wv); grid.sync();
  final_norm(p, wv);
}

extern "C" void kernel_launch(void* const* d_in, const int* in_sizes, int n_in, void* d_out, int out_size, void* d_ws, size_t ws_size,
                              hipStream_t stream) {
  P p{};
  const float** f = (const float**)&p;
  for (int i = 0; i < 29; i++) f[i] = (const float*)d_in[i];
  p.out = (float*)d_out;
  p.ws = (char*)d_ws;
  if (WS_NEED > ws_size) { fprintf(stderr, "workspace too small: need %zu have %zu\n", (size_t)WS_NEED, ws_size); return; }
  static int grid_blocks = 0;
  if (!grid_blocks) {
    int dev = 0, cus = 0, per_cu = 0;
    (void)hipGetDevice(&dev);
    (void)hipDeviceGetAttribute(&cus, hipDeviceAttributeMultiprocessorCount, dev);
    (void)hipFuncSetAttribute((const void*)k_mega, hipFuncAttributeMaxDynamicSharedMemorySize, SMEM_BYTES);
    (void)hipOccupancyMaxActiveBlocksPerMultiprocessor(&per_cu, k_mega, 512, SMEM_BYTES);
    if (per_cu < 1) per_cu = 1;
    grid_blocks = cus * per_cu;
  }
  (void)hipMemsetAsync((char*)d_ws + O_mod, 0, 17 * 6144 * 4, stream);
  void* args[] = {&p};
  hipError_t e = hipLaunchCooperativeKernel((void*)k_mega, dim3(grid_blocks), dim3(512), args, SMEM_BYTES, stream);
  if (e != hipSuccess) fprintf(stderr, "cooperative launch failed: %s (grid %d)\n", hipGetErrorString(e), grid_blocks);
}
```

```cpp
#include <hip/hip_runtime.h>
#include <hip/hip_cooperative_groups.h>
#include <stdint.h>
#include <stdio.h>
namespace cg = cooperative_groups;


#define DI __device__ __forceinline__
typedef unsigned short bf16_t;
typedef short bf16x8 __attribute__((ext_vector_type(8)));
typedef float f32x16 __attribute__((ext_vector_type(16)));
typedef float f32x4 __attribute__((ext_vector_type(4)));

constexpr int NTOK = 81920, LPR = 16384, LSM = 4096;
constexpr int SMEM_HALF = 73728;
constexpr int SMEM_BYTES = 2 * SMEM_HALF;
constexpr float EPSV = 1e-6f;

constexpr size_t al256(size_t x) { return (x + 255) & ~(size_t)255; }
constexpr size_t O_mod = 0;
constexpr size_t O_bar = O_mod + al256(17 * 6144 * 4);
constexpr size_t O_AT = O_bar + al256(3456 * 4);
constexpr size_t O_ssf = O_AT + al256(32 * 2 * 64 * 2 * 4);
constexpr size_t O_sss = O_ssf + al256((size_t)NTOK * 8 * 4);
constexpr size_t O_twp = O_sss + al256((size_t)NTOK * 16 * 4);
constexpr size_t O_tws = O_twp + al256(LPR * 8);
constexpr size_t O_wint = O_tws + al256(LSM * 8);
constexpr size_t O_wglut = O_wint + al256(1024 * 1024 * 2);
constexpr size_t O_woutt = O_wglut + al256(1024 * 512 * 2);
constexpr size_t O_w1t = O_woutt + al256(1024 * 1024 * 2);
constexpr size_t O_w2t = O_w1t + al256((size_t)4096 * 1024 * 2);
constexpr size_t O_Mf = O_w2t + al256((size_t)4096 * 1024 * 2);
constexpr size_t O_Fb1 = O_Mf + al256(512 * 1024 * 2);
constexpr size_t O_Fb2 = O_Fb1 + al256(1024 * 256 * 2);
constexpr size_t O_Bs = O_Fb2 + al256(512 * 256 * 2);
constexpr size_t O_Tcat = O_Bs + al256((size_t)32 * 256 * 1024 * 2);
constexpr size_t O_hb = O_Tcat + al256((size_t)32 * 1024 * 1280 * 2);
constexpr size_t O_zT = O_hb + al256((size_t)NTOK * 1024 * 2);
constexpr size_t O_Ucat = O_zT + al256((size_t)NTOK * 512 * 2);
constexpr size_t O_AF = O_Ucat + al256((size_t)32 * 1280 * 1280 * 2);
constexpr size_t O_S = O_AF + al256((size_t)NTOK * 1024 * 2);
constexpr size_t O_gact = O_S + al256((size_t)1280 * 32 * 256 * 4);
constexpr size_t O_mg = O_gact + al256((size_t)NTOK * 512 * 2);
constexpr size_t O_END = O_mg + al256((size_t)NTOK * 1024 * 2);
constexpr size_t O_Tt = O_hb;
constexpr size_t O_hid = O_zT;
constexpr size_t WS_NEED = (O_hid + (size_t)NTOK * 4096 * 2 > O_END ? O_hid + (size_t)NTOK * 4096 * 2 : O_END);
struct P {
  const float *xp, *xs, *cp, *cs, *w_ada, *b_ada, *g_mix, *w_in, *w_f, *b_f, *a_re, *a_im, *log_dt, *b_re, *b_im, *c_re, *c_im,
      *ssm_d, *w_glu, *b_glu, *g_fo, *g_so, *w_out, *g_mlp, *w1, *b1, *w2, *b2, *g_final;
  float* out;
  char* ws;
  __device__ __forceinline__ float* mod() const { return (float*)(ws + O_mod); }
  __device__ __forceinline__ float* AT() const { return (float*)(ws + O_AT); }
  __device__ __forceinline__ float* ssf() const { return (float*)(ws + O_ssf); }
  __device__ __forceinline__ float* sss() const { return (float*)(ws + O_sss); }
  __device__ __forceinline__ float2* twp() const { return (float2*)(ws + O_twp); }
  __device__ __forceinline__ float2* tws() const { return (float2*)(ws + O_tws); }
  __device__ __forceinline__ bf16_t* wint() const { return (bf16_t*)(ws + O_wint); }
  __device__ __forceinline__ bf16_t* wglut() const { return (bf16_t*)(ws + O_wglut); }
  __device__ __forceinline__ bf16_t* woutt() const { return (bf16_t*)(ws + O_woutt); }
  __device__ __forceinline__ bf16_t* w1t() const { return (bf16_t*)(ws + O_w1t); }
  __device__ __forceinline__ bf16_t* w2t() const { return (bf16_t*)(ws + O_w2t); }
  __device__ __forceinline__ bf16_t* Mf() const { return (bf16_t*)(ws + O_Mf); }
  __device__ __forceinline__ bf16_t* Fb1() const { return (bf16_t*)(ws + O_Fb1); }
  __device__ __forceinline__ bf16_t* Fb2() const { return (bf16_t*)(ws + O_Fb2); }
  __device__ __forceinline__ bf16_t* Bs() const { return (bf16_t*)(ws + O_Bs); }
  __device__ __forceinline__ bf16_t* Tcat() const { return (bf16_t*)(ws + O_Tcat); }
  __device__ __forceinline__ bf16_t* Ucat() const { return (bf16_t*)(ws + O_Ucat); }
  __device__ __forceinline__ bf16_t* hb() const { return (bf16_t*)(ws + O_hb); }
  __device__ __forceinline__ bf16_t* zT() const { return (bf16_t*)(ws + O_zT); }
  __device__ __forceinline__ bf16_t* AF() const { return (bf16_t*)(ws + O_AF); }
  __device__ __forceinline__ float* S() const { return (float*)(ws + O_S); }
  __device__ __forceinline__ bf16_t* mg() const { return (bf16_t*)(ws + O_mg); }
  __device__ __forceinline__ bf16_t* gact() const { return (bf16_t*)(ws + O_gact); }
  __device__ __forceinline__ bf16_t* Tt() const { return (bf16_t*)(ws + O_Tt); }
  __device__ __forceinline__ bf16_t* hid() const { return (bf16_t*)(ws + O_hid); }
};

typedef float f32x2v __attribute__((ext_vector_type(2)));
typedef __bf16 bf16x2v __attribute__((ext_vector_type(2)));
DI uint32_t pk2(float lo, float hi) { const f32x2v v = {lo, hi}; const bf16x2v r = __builtin_convertvector(v, bf16x2v); return __builtin_bit_cast(uint32_t, r); }
DI bf16_t f2bf(float f) { return (bf16_t)(pk2(f, 0.f) & 0xffffu); }
extern __shared__ __attribute__((aligned(16))) unsigned char dyn_smem[];
DI int otid(int wv) {
  unsigned m = ~0u; asm volatile("" : "+s"(m));
  const int lane = (int)__builtin_amdgcn_mbcnt_hi(m, __builtin_amdgcn_mbcnt_lo(m, 0u));
  int t = (wv << 6) | lane; asm volatile("" : "+v"(t)); return t;
}
#define XB_TMO      128
#define XB_XCNT(j)  (256  + 64 * (j))
#define XB_XSUB(j)  (1280 + 64 * (j))
#define XB_XGEN(j)  (2304 + 64 * (j))
#define XB_TOP      3328
#define XB_TOPGEN   3392
#define XCD_BAR_WORDS 3456
#define XB_SPIN_CAP (1u << 18)
#define XB_LAS __attribute__((address_space(3)))
constexpr int XB_LDS_OFF = 147440;
DI unsigned xb_ld(unsigned* p) { return __hip_atomic_load(p, __ATOMIC_RELAXED, __HIP_MEMORY_SCOPE_AGENT); }
DI unsigned xb_add(unsigned* p, unsigned v) { return __hip_atomic_fetch_add(p, v, __ATOMIC_RELAXED, __HIP_MEMORY_SCOPE_AGENT); }
DI unsigned xb_xcc_id() { return (unsigned)__builtin_amdgcn_s_getreg((3 << 11) | 20) & 0xFu; }
#define XB_SPIN(cond, bar) do { unsigned _sp = 0; while (cond) { __builtin_amdgcn_s_sleep(1); \
    if ((++_sp & 255u) == 0u) { if (xb_ld(&(bar)[XB_TMO])) break; if (_sp > XB_SPIN_CAP) { atomicAdd(&(bar)[XB_TMO], 1u); break; } } } } while (0)
DI void xcd_barrier_complete(unsigned* bar, unsigned x, unsigned& nloc, unsigned& nx) {
  const unsigned G = gridDim.x * gridDim.y * gridDim.z;
  unsigned sum, cnt, mine, sp = 0u;
  for (;;) {
    sum = 0u; cnt = 0u; mine = 0u;
#pragma unroll
    for (unsigned j = 0; j < 16; ++j) { const unsigned c = xb_ld(&bar[XB_XCNT(j)]); sum += c; cnt += (c > 0u) ? 1u : 0u; mine = (j == x) ? c : mine; }
    if (sum == G) break;
    __builtin_amdgcn_s_sleep(1);
    if ((++sp & 255u) == 0u) { if (xb_ld(&bar[XB_TMO])) break; if (sp > XB_SPIN_CAP) { atomicAdd(&bar[XB_TMO], 1u); break; } }
  }
  nloc = mine > 0u ? mine : 1u; nx = cnt > 0u ? cnt : 1u;
}
DI void xcd_barrier(unsigned* bar, const int tix) {
  asm volatile("s_waitcnt vmcnt(0)" ::: "memory");
  __syncthreads();
  if (tix == 0) {
    volatile XB_LAS unsigned* st = (volatile XB_LAS unsigned*)((XB_LAS unsigned char*)dyn_smem + XB_LDS_OFF);
    const unsigned x = xb_xcc_id();
    __builtin_amdgcn_s_waitcnt(0);
    unsigned nloc = st[0], nx = st[1];
    if (nloc == 0u) { xcd_barrier_complete(bar, x, nloc, nx); st[0] = nloc; st[1] = nx; }
    const unsigned old = xb_add(&bar[XB_XSUB(x)], 1u);
    const unsigned gen = old / nloc;
    if (old + 1u == (gen + 1u) * nloc) {
      __builtin_amdgcn_fence(__ATOMIC_RELEASE, "agent");
      asm volatile("s_waitcnt vmcnt(0)" ::: "memory");
      const unsigned og = xb_add(&bar[XB_TOP], 1u);
      const unsigned tg = og / nx;
      if (og + 1u == (tg + 1u) * nx) xb_add(&bar[XB_TOPGEN], 1u);
      else XB_SPIN(xb_ld(&bar[XB_TOPGEN]) == tg, bar);
      __builtin_amdgcn_fence(__ATOMIC_ACQUIRE, "agent");
      xb_add(&bar[XB_XGEN(x)], 1u);
      asm volatile("s_waitcnt vmcnt(0)" ::: "memory");
    } else {
      XB_SPIN(xb_ld(&bar[XB_XGEN(x)]) == gen, bar);
      __builtin_amdgcn_fence(__ATOMIC_ACQUIRE, "agent");
      asm volatile("s_waitcnt vmcnt(0)" ::: "memory");
    }
  }
  __syncthreads();
}

DI int tok2v(int tok) {
  if (tok < LPR) { const int l1 = tok >> 7, l2 = tok & 127; return ((l2 & 63) << 8) | ((l2 >> 6) << 7) | l1; }
  const int ts = tok - LPR, w = ts & 4095, l1 = w >> 6, l2 = w & 63;
  return LPR + (ts & ~4095) + (((l2 & 15) << 8) | ((l2 >> 4) << 6) | l1);
}
DI int v2tok(int v) {
  if (v < LPR) return ((v & 127) << 7) | (((v >> 7) & 1) << 6) | (v >> 8);
  const int vs = v - LPR, w = vs & 4095;
  return LPR + (vs & ~4095) + (((w & 63) << 6) | (((w >> 6) & 3) << 4) | (w >> 8));
}
DI int batch_of(int tok) { return tok < LPR ? 0 : 1 + ((tok - LPR) >> 12); }
DI float gelu_tanh(float x) {
  const float u = 0.7978845608028654f * (x + 0.044715f * x * x * x);
  return x / (1.f + __expf(-2.f * u));
}
DI float wave_sum(float v) {
  v += __shfl_xor(v, 32); v += __shfl_xor(v, 16); v += __shfl_xor(v, 8); v += __shfl_xor(v, 4); v += __shfl_xor(v, 2); v += __shfl_xor(v, 1);
  return v;
}

DI void ssm_pow(const P& p, int g, int dir, int pp, int j, float& re, float& im) {
  const int ia = (dir * 32 + g) * 64 + pp;
  const float lr = fminf(p.a_re[ia], -1e-4f), li = p.a_im[ia], dt = expf(p.log_dt[dir * 32 + g]);
  const float mag = expf(lr * dt * (float)j);
  double t = (double)li * (double)dt * (double)j * 0.15915494309189535;
  t -= rint(t);
  const float ang = (float)(t * 6.283185307179586);
  float s, c; sincosf(ang, &s, &c);
  re = mag * c; im = mag * s;
}
DI void ssm_coef(const P& p, int g, int dir, int pp, float& cr, float& ci) {
  const int ia = (dir * 32 + g) * 64 + pp;
  const float lr = fminf(p.a_re[ia], -1e-4f), li = p.a_im[ia];
  float ar, ai; ssm_pow(p, g, dir, pp, 1, ar, ai);
  const float nr = ar - 1.f, ni = ai, den = 1.f / (lr * lr + li * li);
  cr = (nr * lr + ni * li) * den; ci = (ni * lr - nr * li) * den;
}

template <class CM>
DI void transpose_job(float* tile, const int tid, bool act, int item2, const float* in, int ld, int Kdim, bf16_t* out, const CM& colmap, const float* sc0, const float* sc1) {
  const int nkt = Kdim / 64;
  __syncthreads();
  if (act) {
    float v[16];
#pragma unroll
    for (int u = 0; u < 2; u++) {
      const int item = 2 * item2 + u, nt = item / nkt, kt = item % nkt;
      const int c = tid & 31, kr = tid >> 5, col = colmap(nt * 32 + c);
#pragma unroll
      for (int i = 0; i < 8; i++) v[u * 8 + i] = in[(size_t)(kt * 64 + kr + 8 * i) * ld + col];
    }
#pragma unroll
    for (int u = 0; u < 2; u++) {
      const int item = 2 * item2 + u, kt = item % nkt;
      const int c = tid & 31, kr = tid >> 5;
#pragma unroll
      for (int i = 0; i < 8; i++) {
        const int kl = kr + 8 * i, k = kt * 64 + kl;
        float x = v[u * 8 + i];
        if (sc0) x *= (k < 512 ? sc0[k] : sc1[k - 512]);
        tile[u * 64 * 33 + kl * 33 + c] = x;
      }
    }
  }
  __syncthreads();
  if (act) {
#pragma unroll
    for (int u = 0; u < 2; u++) {
      const int item = 2 * item2 + u, nt = item / nkt, kt = item % nkt;
      const int nl = tid >> 3, kc = tid & 7;
      float x[8];
#pragma unroll
      for (int j = 0; j < 8; j++) x[j] = tile[u * 64 * 33 + (kc * 8 + j) * 33 + nl];
      uint4 w; w.x = pk2(x[0], x[1]); w.y = pk2(x[2], x[3]); w.z = pk2(x[4], x[5]); w.w = pk2(x[6], x[7]);
      *(uint4*)(out + (size_t)(nt * 32 + nl) * Kdim + kt * 64 + kc * 8) = w;
    }
  }
}

DI void phase0(const P& p, const int wv) {
  const int tix = otid(wv);
  unsigned char* smraw = dyn_smem + (tix >> 8) * SMEM_HALF;
  float* smf = (float*)smraw;
  const int tid = tix & 255, nb = gridDim.x * 2, bid = blockIdx.x * 2 + (tix >> 8);
  for (int base = 0; base < 384; base += nb) {
    const int item = base + bid; const bool act = item < 384;
    const int cg = act ? item % 96 : 0, ks = act ? item / 96 : 0;
    __syncthreads();
    if (act)
      for (int i = tid; i < 17 * 256; i += 256) {
        const int b = i >> 8, k = ks * 256 + (i & 255);
        const float c = b == 0 ? p.cp[k] : p.cs[(b - 1) * 1024 + k];
        smf[i] = c / (1.f + __expf(-c));
      }
    __syncthreads();
    const int col = tid & 63, sub = tid >> 6, j = cg * 64 + col;
    float a[17];
#pragma unroll
    for (int b = 0; b < 17; b++) a[b] = 0.f;
    if (act) {
#pragma unroll 1
      for (int bt = 0; bt < 4; bt++) {
        const int k0 = sub * 64 + bt * 16;
        float w[16];
#pragma unroll
        for (int i = 0; i < 16; i++) w[i] = p.w_ada[(size_t)(ks * 256 + k0 + i) * 6144 + j];
#pragma unroll
        for (int i = 0; i < 16; i++)
#pragma unroll
          for (int b = 0; b < 17; b++) a[b] += smf[b * 256 + k0 + i] * w[i];
      }
    }
    float* red = smf + 17 * 256;
#pragma unroll
    for (int b = 0; b < 17; b++) red[(sub * 17 + b) * 64 + col] = a[b];
    __syncthreads();
    if (act)
      for (int i = tid; i < 17 * 64; i += 256) {
        const int b = i >> 6, c2 = i & 63;
        float sum = red[(0 * 17 + b) * 64 + c2] + red[(1 * 17 + b) * 64 + c2] + red[(2 * 17 + b) * 64 + c2] + red[(3 * 17 + b) * 64 + c2];
        if (ks == 0) sum += p.b_ada[cg * 64 + c2];
        atomicAdd(p.mod() + b * 6144 + cg * 64 + c2, sum);
      }
  }
  {
    auto ident = [](int n) { return n; };
    auto glumap = [](int n) { return ((n >> 7) & 1) * 512 + (n >> 8) * 128 + (n & 127); };
    const int n0 = 256, n1 = n0 + 128, n2 = n1 + 256, n3 = n2 + 1024, n4 = n3 + 1024;
    for (int base = 0; base < n4; base += nb) {
      const int item = base + bid; const bool act = item < n4;
      if (item < n0) transpose_job(smf, tid, act, item, p.w_in, 1024, 1024, p.wint(), ident, nullptr, nullptr);
      else if (item < n1) transpose_job(smf, tid, act, item - n0, p.w_glu, 1024, 512, p.wglut(), glumap, nullptr, nullptr);
      else if (item < n2) transpose_job(smf, tid, act, item - n1, p.w_out, 1024, 1024, p.woutt(), ident, p.g_fo, p.g_so);
      else if (item < n3) transpose_job(smf, tid, act, item - n2, p.w1, 4096, 1024, p.w1t(), ident, nullptr, nullptr);
      else transpose_job(smf, tid, act, item - n3, p.w2, 1024, 4096, p.w2t(), ident, nullptr, nullptr);
    }
  }
  {
    __syncthreads();
    float2* cs = (float2*)smraw;
    for (int i = tid; i < 512; i += 256) { float s, c; sincosf((float)i * (6.283185307179586f / 512.f), &s, &c); cs[i] = make_float2(c, s); }
    __syncthreads();
    for (int item = bid; item < 128; item += nb) {
      const int idx = item * 256 + tid, k = idx & 1023, he = idx >> 10, h = he >> 3, e0 = (he & 7) * 16, c = k & 511;
      const bool is_sin = k >= 512;
      const float* wf = p.w_f + (size_t)h * 128 * 128 + e0;
      float a[16];
#pragma unroll
      for (int e = 0; e < 16; e++) a[e] = 0.f;
#pragma unroll 4
      for (int d = 0; d < 128; d++) {
        const float2 t = cs[((h * 128 + d) * c) & 511];
        const float tv = is_sin ? t.y : t.x;
        const f32x4 w0 = *(const f32x4*)(wf + d * 128), w1 = *(const f32x4*)(wf + d * 128 + 4), w2 = *(const f32x4*)(wf + d * 128 + 8), w3 = *(const f32x4*)(wf + d * 128 + 12);
#pragma unroll
        for (int e = 0; e < 4; e++) { a[e] += tv * w0[e]; a[4 + e] += tv * w1[e]; a[8 + e] += tv * w2[e]; a[12 + e] += tv * w3[e]; }
      }
#pragma unroll
      for (int e = 0; e < 16; e++) p.Mf()[(size_t)(h * 128 + e0 + e) * 1024 + k] = f2bf(a[e]);
    }
  }
  {
    const int gsz = nb * 256, gt = bid * 256 + tid;
    for (int i = gt; i < 1024 * 256; i += gsz) {
      const int nrg = i >> 8, k = i & 255, tb = nrg >> 9, nr = nrg & 511, part = (nr >> 7) & 1, idx8 = ((nr >> 8) << 7) | (nr & 127);
      const int R = tb ? 64 : 128, sh = tb ? 6 : 7, l2p = idx8 >> sh, k1 = idx8 & (R - 1), l2k = k >> sh, l1 = k & (R - 1);
      float sv, cv; sincosf((float)((k1 * l1) & (R - 1)) * (6.283185307179586f / (float)R), &sv, &cv);
      p.Fb1()[i] = f2bf(l2k == l2p ? (part ? -sv : cv) : 0.f);
    }
    for (int i = gt; i < 512 * 256; i += gsz) {
      const int nrg = i >> 8, k = i & 255, tb = nrg >> 8, nr = nrg & 255;
      float v;
      if (tb == 0) {
        const int part = nr >> 7, k2 = nr & 127, ki = k >> 7, l2 = k & 127;
        float sv, cv; sincosf((float)((k2 * l2) & 127) * (6.283185307179586f / 128.f), &sv, &cv);
        v = part == 0 ? (ki == 0 ? cv : sv) : (ki == 0 ? -sv : cv);
      } else {
        const int blk = nr >> 7, n2 = nr & 127, part = n2 >> 6, k2 = n2 & 63, kb = k >> 7, kk = k & 127, ki = kk >> 6, l2 = kk & 63;
        float sv, cv; sincosf((float)((k2 * l2) & 63) * (6.283185307179586f / 64.f), &sv, &cv);
        v = blk == kb ? (part == 0 ? (ki == 0 ? cv : sv) : (ki == 0 ? -sv : cv)) : 0.f;
      }
      p.Fb2()[i] = f2bf(v);
    }
    for (int i = gt; i < LPR; i += gsz) { float s, c; sincosf((float)i * (6.283185307179586f / 16384.f), &s, &c); p.twp()[i] = make_float2(c, s); }
    for (int i = gt; i < LSM; i += gsz) { float s, c; sincosf((float)i * (6.283185307179586f / 4096.f), &s, &c); p.tws()[i] = make_float2(c, s); }
    for (int i = gt; i < 32 * 2 * 64 * 64; i += gsz) {
      const int s = i & 63, pp = (i >> 6) & 63, dir = (i >> 12) & 1, g = i >> 13;
      float pr, pi, cr, ci; ssm_pow(p, g, dir, pp, dir == 0 ? 63 - s : s, pr, pi); ssm_coef(p, g, dir, pp, cr, ci);
      const float qr = pr * cr - pi * ci, qi = pr * ci + pi * cr;
      const int ib = ((dir * 32 + g) * 64 + pp) * 16;
      float vr[16], vi[16];
#pragma unroll
      for (int h = 0; h < 16; h++) { const float br = p.b_re[ib + h], bi = p.b_im[ib + h]; vr[h] = qr * br - qi * bi; vi[h] = qr * bi + qi * br; }
      bf16_t* d0 = p.Bs() + ((size_t)(g * 256 + dir * 128 + pp)) * 1024 + s * 16;
      bf16_t* d1 = d0 + 64 * 1024;
      uint4 w;
      w.x = pk2(vr[0], vr[1]); w.y = pk2(vr[2], vr[3]); w.z = pk2(vr[4], vr[5]); w.w = pk2(vr[6], vr[7]); *(uint4*)d0 = w;
      w.x = pk2(vr[8], vr[9]); w.y = pk2(vr[10], vr[11]); w.z = pk2(vr[12], vr[13]); w.w = pk2(vr[14], vr[15]); *(uint4*)(d0 + 8) = w;
      w.x = pk2(vi[0], vi[1]); w.y = pk2(vi[2], vi[3]); w.z = pk2(vi[4], vi[5]); w.w = pk2(vi[6], vi[7]); *(uint4*)d1 = w;
      w.x = pk2(vi[8], vi[9]); w.y = pk2(vi[10], vi[11]); w.z = pk2(vi[12], vi[13]); w.w = pk2(vi[14], vi[15]); *(uint4*)(d1 + 8) = w;
    }
    for (int i = gt; i < 32 * 64 * 2 * 64; i += gsz) {
      const int pp = i & 63, dir = (i >> 6) & 1, t = (i >> 7) & 63, g = i >> 13;
      float pr, pi; ssm_pow(p, g, dir, pp, dir == 0 ? t + 1 : 64 - t, pr, pi);
#pragma unroll
      for (int h = 0; h < 16; h++) {
        const int ic = ((dir * 32 + g) * 16 + h) * 64 + pp;
        const float cr = p.c_re[ic], ci = p.c_im[ic];
        bf16_t* d = p.Tcat() + ((size_t)(g * 1024 + t * 16 + h)) * 1280 + 1024 + dir * 128 + pp;
        d[0] = f2bf(cr * pr - ci * pi);
        d[64] = f2bf(-(cr * pi + ci * pr));
      }
    }
    for (int i = gt; i < 32 * 2 * 64; i += gsz) {
      const int pp = i & 63, dir = (i >> 6) & 1, g = i >> 7;
      float pr, pi; ssm_pow(p, g, dir, pp, 64, pr, pi);
      p.AT()[i * 2] = pr; p.AT()[i * 2 + 1] = pi;
    }
  }
  {
    float2* q = (float2*)smraw;
    float2* q1 = q + 512;
    float2* Cs = q + 576;
    float2* Bm = Cs + 2048;
    float2* E = Bm + 2048;
    for (int base = 0; base < 512; base += nb) {
      const int item = base + bid; const bool act = item < 512;
      const int g = act ? item >> 4 : 0, ch = act ? item & 15 : 0;
      __syncthreads();
      for (int e = tid; e < 512; e += 256) {
        const int j = e >> 6, pp = e & 63, jj = ch * 8 + j, lag = jj - 63;
        float2 v = make_float2(0.f, 0.f);
        if (jj < 127) {
          const int dir = lag >= 0 ? 0 : 1;
          float pr, pi, cr, ci; ssm_pow(p, g, dir, pp, lag < 0 ? -lag : lag, pr, pi); ssm_coef(p, g, dir, pp, cr, ci);
          v = make_float2(pr * cr - pi * ci, pr * ci + pi * cr);
        }
        q[e] = v;
      }
      if (tid < 64) { float cr, ci; ssm_coef(p, g, 1, tid, cr, ci); q1[tid] = make_float2(cr, ci); }
      for (int i = tid; i < 2048; i += 256) {
        const int dir = i >> 10, j = i & 1023, src = (dir * 32 + g) * 1024 + j;
        Cs[i] = make_float2(p.c_re[src], p.c_im[src]); Bm[i] = make_float2(p.b_re[src], p.b_im[src]);
      }
      const int hp = tid >> 4, h = tid & 15;
      float a0 = 0.f;
#pragma unroll 1
      for (int ps = 0; ps < 9; ps++) {
        const int j = ps < 8 ? ps : 7, jj = ch * 8 + j, lag = jj - 63;
        const bool valid = ps < 8 ? (jj < 127) : (jj == 63);
        const int dir = ps < 8 ? (lag >= 0 ? 0 : 1) : 1;
        const float2* qs = ps < 8 ? q + j * 64 : q1;
        __syncthreads();
        for (int i = tid; i < 1024; i += 256) {
          const float2 cc = Cs[dir * 1024 + i], qq = qs[i & 63];
          E[i] = make_float2(cc.x * qq.x - cc.y * qq.y, cc.x * qq.y + cc.y * qq.x);
        }
        __syncthreads();
        float a = 0.f;
        if (valid) {
#pragma unroll 8
          for (int pp = 0; pp < 64; pp++) { const float2 ee = E[hp * 64 + pp], bb = Bm[dir * 1024 + pp * 16 + h]; a += ee.x * bb.x - ee.y * bb.y; }
        }
        bool st = valid && act;
        if (ps < 8 && lag == 0) { a0 = a; st = false; }
        if (ps == 8) { a += a0; if (hp == h) a += p.ssm_d[g * 16 + h]; }
        if (st) {
          const bf16_t kv = f2bf(a);
          const int t0 = lag > 0 ? lag : 0, t1 = lag > 0 ? 64 : 64 + lag;
          bf16_t* d = p.Tcat() + ((size_t)(g * 1024 + hp)) * 1280 + h;
          for (int t = t0; t < t1; t++) d[(size_t)t * 16 * 1280 + (t - lag) * 16] = kv;
        }
      }
    }
  }
}

constexpr int RIF = 2;
DI float bflo(uint32_t u) { return __uint_as_float(u << 16); }
DI float bfhi(uint32_t u) { return __uint_as_float(u & 0xffff0000u); }
template <bool FROMX>
DI void rownorm_mod(const P& p, const int wv, const float* g, int sh_off, int sc_off) {
  const int tix = otid(wv), lane = tix & 63, wrow = blockIdx.x * 8 + (tix >> 6), nw = gridDim.x * 8;
  for (int tok0 = wrow; tok0 < NTOK; tok0 += RIF * nw) {
    float v[RIF][16]; float ss[RIF];
#pragma unroll
    for (int rr = 0; rr < RIF; rr++) {
      const int tok = tok0 + rr * nw;
      if (tok < NTOK) {
        if (FROMX) {
          const float* src = tok < LPR ? p.xp + (size_t)tok * 1024 : p.xs + (size_t)(tok - LPR) * 1024;
#pragma unroll
          for (int i = 0; i < 4; i++) { const f32x4 t = *(const f32x4*)(src + (i * 64 + lane) * 4); v[rr][4 * i] = t[0]; v[rr][4 * i + 1] = t[1]; v[rr][4 * i + 2] = t[2]; v[rr][4 * i + 3] = t[3]; }
        } else {
          const bf16_t* src = (const bf16_t*)p.out + (size_t)tok * 1024;
#pragma unroll
          for (int i = 0; i < 2; i++) { const uint4 t = *(const uint4*)(src + (i * 64 + lane) * 8);
            v[rr][8 * i] = bflo(t.x); v[rr][8 * i + 1] = bfhi(t.x); v[rr][8 * i + 2] = bflo(t.y); v[rr][8 * i + 3] = bfhi(t.y);
            v[rr][8 * i + 4] = bflo(t.z); v[rr][8 * i + 5] = bfhi(t.z); v[rr][8 * i + 6] = bflo(t.w); v[rr][8 * i + 7] = bfhi(t.w); }
        }
      } else {
#pragma unroll
        for (int e = 0; e < 16; e++) v[rr][e] = 0.f;
      }
    }
#pragma unroll
    for (int rr = 0; rr < RIF; rr++) {
      ss[rr] = 0.f;
#pragma unroll
      for (int e = 0; e < 16; e++) ss[rr] += v[rr][e] * v[rr][e];
      ss[rr] = wave_sum(ss[rr]);
    }
#pragma unroll
    for (int rr = 0; rr < RIF; rr++) {
      const int tok = tok0 + rr * nw;
      if (tok >= NTOK) continue;
      const float r = rsqrtf(ss[rr] * (1.f / 1024.f) + EPSV);
      const float* md = p.mod() + batch_of(tok) * 6144;
      bf16_t* drow = p.hb() + (size_t)(FROMX ? tok2v(tok) : tok) * 1024;
      float o[16];
#pragma unroll
      for (int q = 0; q < 4; q++) {
        const int c = FROMX ? (q * 64 + lane) * 4 : ((q >> 1) * 64 + lane) * 8 + (q & 1) * 4;
        const f32x4 gg = *(const f32x4*)(g + c);
        f32x4 sc = *(const f32x4*)(md + sc_off + c), sh = *(const f32x4*)(md + sh_off + c);
#pragma unroll
        for (int e = 0; e < 4; e++) o[4 * q + e] = v[rr][4 * q + e] * r * gg[e] * (1.f + sc[e]) + sh[e];
      }
      if (FROMX) {
#pragma unroll
        for (int q = 0; q < 4; q++) { uint2 w; w.x = pk2(o[4 * q], o[4 * q + 1]); w.y = pk2(o[4 * q + 2], o[4 * q + 3]); *(uint2*)(drow + (q * 64 + lane) * 4) = w; }
      } else {
#pragma unroll
        for (int i = 0; i < 2; i++) { uint4 w; w.x = pk2(o[8 * i], o[8 * i + 1]); w.y = pk2(o[8 * i + 2], o[8 * i + 3]); w.z = pk2(o[8 * i + 4], o[8 * i + 5]); w.w = pk2(o[8 * i + 6], o[8 * i + 7]);
          *(uint4*)(drow + (i * 64 + lane) * 8) = w; }
      }
    }
  }
}
DI void final_norm(const P& p, const int wv) {
  const int tix = otid(wv), lane = tix & 63, wrow = blockIdx.x * 8 + (tix >> 6), nw = gridDim.x * 8;
  for (int tok0 = wrow; tok0 < NTOK; tok0 += RIF * nw) {
    float v[RIF][16]; float ss[RIF];
#pragma unroll
    for (int rr = 0; rr < RIF; rr++) {
      const int tok = tok0 + rr * nw;
      if (tok < NTOK) {
        const bf16_t* src = p.hb() + (size_t)tok * 1024;
#pragma unroll
        for (int i = 0; i < 2; i++) { const uint4 t = *(const uint4*)(src + (i * 64 + lane) * 8);
          v[rr][8 * i] = bflo(t.x); v[rr][8 * i + 1] = bfhi(t.x); v[rr][8 * i + 2] = bflo(t.y); v[rr][8 * i + 3] = bfhi(t.y);
          v[rr][8 * i + 4] = bflo(t.z); v[rr][8 * i + 5] = bfhi(t.z); v[rr][8 * i + 6] = bflo(t.w); v[rr][8 * i + 7] = bfhi(t.w); }
      } else {
#pragma unroll
        for (int e = 0; e < 16; e++) v[rr][e] = 0.f;
      }
    }
#pragma unroll
    for (int rr = 0; rr < RIF; rr++) {
      ss[rr] = 0.f;
#pragma unroll
      for (int e = 0; e < 16; e++) ss[rr] += v[rr][e] * v[rr][e];
      ss[rr] = wave_sum(ss[rr]);
    }
#pragma unroll
    for (int rr = 0; rr < RIF; rr++) {
      const int tok = tok0 + rr * nw;
      if (tok >= NTOK) continue;
      const float r = rsqrtf(ss[rr] * (1.f / 1024.f) + EPSV);
      float* drow = p.out + (size_t)tok * 1024;
#pragma unroll
      for (int q = 0; q < 4; q++) {
        const int c = ((q >> 1) * 64 + lane) * 8 + (q & 1) * 4;
        const f32x4 gg = *(const f32x4*)(p.g_final + c);
        f32x4 o;
#pragma unroll
        for (int e = 0; e < 4; e++) o[e] = v[rr][4 * q + e] * r * gg[e];
        *(f32x4*)(drow + c) = o;
      }
    }
  }
}

namespace pg8 {
#define PG8_LAS __attribute__((address_space(3)))
typedef unsigned short bf16_t;
typedef short bf16x8 __attribute__((ext_vector_type(8)));
typedef float f32x4 __attribute__((ext_vector_type(4)));
typedef unsigned u32x4 __attribute__((ext_vector_type(4)));
constexpr int BM = 256, BK = 64, HALF = 128, HTB = HALF * BK * 2  , STAGE_BYTES = 8 * HTB, NXCD = 8, WGM = 8;

__host__ __device__ __forceinline__ int lds_byte(int r, int c) { const int st = (r >> 4) * 2 + (c >> 5), rr = r & 15, cc = c & 31, ob = rr * 64 + cc * 2; return st * 1024 + (ob ^ (((ob >> 9) & 1) << 5)); }
__host__ __device__ __forceinline__ void stage_rc(int b, int& R, int& C) { const int st = b / 1024, sb = b % 1024, swz = sb ^ (((sb >> 9) & 1) << 5); R = (st >> 1) * 16 + swz / 64; C = (st & 1) * 32 + (swz % 64) / 2; }
__host__ __device__ __forceinline__ int perm32(int rho) { const int n = rho >> 4, i = rho & 15; return 8 * (i >> 2) + 4 * n + (i & 3); }

struct Unit { int pm, pn; };
struct Gemm { const bf16_t* A; const bf16_t* Bt; int M, N, K, lda, ldb; };

struct StaticOrder {
    int nM, nN, nwg, G, c;
    __host__ __device__ void init(int M, int N, int G_, int c_) { nM = M / BM; nN = N / BM; nwg = nM * nN; G = G_; c = c_; }
    __host__ __device__ bool next(int i, Unit& u) const {
        const long L = (long)i * G + c; if (L >= nwg) return false;
        int wgid = (int)L; { const int q = nwg / NXCD, r = nwg % NXCD, xcd = wgid % NXCD, off = wgid / NXCD; wgid = (xcd < r ? xcd * (q + 1) : r * (q + 1) + (xcd - r) * q) + off; }
        const int nig = WGM * nN, gid = wgid / nig, fm = gid * WGM, gsz = (nM - fm) < WGM ? (nM - fm) : WGM;
        u.pm = fm + ((wgid % nig) % gsz); u.pn = (wgid % nig) / gsz; return true;
    }
    __device__ __forceinline__ void a_ready(const Unit&) const {}
    __device__ __forceinline__ void done(const Unit&) const {}
};

struct GroupOrder {
    int nwg, G, c, um, un;
    __host__ __device__ void init(int ngroups, int um_, int un_, int G_, int c_) { um = um_; un = un_; nwg = ngroups * um * un; G = G_; c = (c_ & 7) * (G_ >> 3) + (c_ >> 3); }
    __host__ __device__ bool next(int i, Unit& u) const {
        const int L = i * G + c; if (L >= nwg) return false;
        const int gi = L / (um * un), r = L % (um * un); u.pm = gi * um + r / un; u.pn = gi * un + r % un; return true;
    }
    __device__ __forceinline__ void a_ready(const Unit&) const {}
    __device__ __forceinline__ void done(const Unit&) const {}
};
struct Fft1Order {
    int q0, qs, qe;
    __host__ __device__ void init(int G, int bidx) {
        const int slot = (bidx & 7) * (G >> 3) + (bidx >> 3), nbusy = 160 < G ? 160 : G, nfree = G - nbusy;
        if (nfree <= 0) { q0 = slot; qs = G; qe = 1280; }
        else if (slot < nbusy) { q0 = slot; qs = nbusy; qe = 560; }
        else { q0 = 560 + (slot - nbusy); qs = nfree; qe = 1280; }
    }
    __host__ __device__ bool next(int i, Unit& u) const { const int L = q0 + i * qs; if (L >= qe) return false; u.pn = L >> 1; u.pm = (L & 1) + (u.pn >= 128 ? 2 : 0); return true; }
    __device__ __forceinline__ void a_ready(const Unit&) const {}
    __device__ __forceinline__ void done(const Unit&) const {}
};
struct Fft2Order {
    int G, c;
    __host__ __device__ void init(int G_, int c_) { G = G_; c = c_; }
    __host__ __device__ bool next(int i, Unit& u) const { const int L = i * G + c; if (L >= 1280) return false; u.pn = L; u.pm = L < 256 ? 0 : 1; return true; }
    __device__ __forceinline__ void a_ready(const Unit&) const {}
    __device__ __forceinline__ void done(const Unit&) const {}
};
struct YfOrder {
    int G, c;
    __host__ __device__ void init(int G_, int bidx) { G = G_; const int slot = (bidx & 7) * (G_ >> 3) + (bidx >> 3); c = (slot + (G_ >> 1)) % G_; }
    __host__ __device__ bool next(int i, Unit& u) const { const int L = i * G + c; if (L >= 640) return false; u.pm = L >> 1; u.pn = L & 1; return true; }
    __device__ __forceinline__ void a_ready(const Unit&) const {}
    __device__ __forceinline__ void done(const Unit&) const {}
};
template <class Epi, class Sched, bool ALIGN_EPI = false, bool SP2 = false>
__device__ __forceinline__ void gemm_phase(PG8_LAS unsigned char* lds, const int tix, const Gemm g, const Sched& S, const Epi& E) {
    const int tid = tix, wid = __builtin_amdgcn_readfirstlane(tid >> 6), lane = tid & 63, wr = wid >> 2, wc = wid & 3, fr = lane & 15, fq = lane >> 4;
    const int K = g.K, nt = K / BK;
    unsigned voffA[2], voffB[2];
#pragma unroll
    for (int i = 0; i < 2; ++i) { int R, C; stage_rc(tid * 16 + i * 8192, R, C); const int Rb = Epi::PERM ? ((R & ~31) + perm32(R & 31)) : R;
        voffA[i] = (unsigned)(R * g.lda + C) * 2u; voffB[i] = (unsigned)(Rb * g.ldb + C) * 2u; }
    const size_t kstep = (size_t)(BK * 2);
    const size_t hstepA = (size_t)HALF * g.lda * 2, hstepB = (size_t)HALF * g.ldb * 2;
    const size_t tstepA = 2 * hstepA, tstepB = 2 * hstepB;
    const unsigned ldsw = (unsigned)wid * 1024u;
    const int aoff = lds_byte(wr * 64 + fr, fq * 8), boff = lds_byte(wc * 32 + fr, fq * 8);
#define PG8_SA(b, h) (((b) * 2 + (h)) * HTB)
#define PG8_SB(b, h) ((4 + (b) * 2 + (h)) * HTB)
#define PG8_STAGE(bufoff, gbase, voff) do { _Pragma("unroll") for (int _i = 0; _i < 2; ++_i) \
        __builtin_amdgcn_global_load_lds((const unsigned*)((const char*)(gbase) + (voff)[_i]), (PG8_LAS unsigned*)(lds + (bufoff) + ldsw + _i * 8192), 16, 0, 0); } while (0)
#define PG8_LDA(dst, b, h) do { _Pragma("unroll") for (int m = 0; m < 4; ++m) _Pragma("unroll") for (int k = 0; k < 2; ++k) dst[m][k] = *(const PG8_LAS bf16x8*)(lds + PG8_SA(b, h) + aoff + m * 2048 + k * 1024); } while (0)
#define PG8_LDB(dst, b, h) do { _Pragma("unroll") for (int n = 0; n < 2; ++n) _Pragma("unroll") for (int k = 0; k < 2; ++k) dst[n][k] = *(const PG8_LAS bf16x8*)(lds + PG8_SB(b, h) + boff + n * 2048 + k * 1024); } while (0)
#define PG8_MMA(ai, bj, At, Bt) do { __builtin_amdgcn_s_setprio(1); _Pragma("unroll") for (int m = 0; m < 4; ++m) _Pragma("unroll") for (int n = 0; n < 2; ++n) _Pragma("unroll") for (int k = 0; k < 2; ++k) \
        acc[ai][bj][m][n] = __builtin_amdgcn_mfma_f32_16x16x32_bf16(Bt[n][k], At[m][k], acc[ai][bj][m][n], 0, 0, 0); __builtin_amdgcn_s_setprio(0); } while (0)
#define PG8_WAIT_V(n) asm volatile("s_waitcnt vmcnt(" #n ")" ::: "memory")
#define PG8_WAIT_L(n) asm volatile("s_waitcnt lgkmcnt(" #n ")" ::: "memory")
#define PG8_BAR __builtin_amdgcn_s_barrier()
#define PG8_SCHED __builtin_amdgcn_sched_barrier(0)
    Unit cur, nxt; int ui = 0;
    if (!S.next(0, cur)) return;
    f32x4 acc[2][2][4][2];
#pragma unroll
    for (int a = 0; a < 2; ++a)
#pragma unroll
        for (int b = 0; b < 2; ++b)
#pragma unroll
            for (int m = 0; m < 4; ++m)
#pragma unroll
                for (int n = 0; n < 2; ++n) acc[a][b][m][n] = (f32x4){0.f, 0.f, 0.f, 0.f};
    bf16x8 At[4][2], B0[2][2], B1[2][2];
    const char* cA = (const char*)g.A + (size_t)cur.pm * tstepA; const char* cB = (const char*)g.Bt + (size_t)cur.pn * tstepB;
    S.a_ready(cur);
    if constexpr (SP2) {
        PG8_STAGE(PG8_SB(0, 0), cB, voffB); PG8_STAGE(PG8_SB(0, 1), cB + hstepB, voffB); PG8_STAGE(PG8_SA(0, 0), cA, voffA); PG8_STAGE(PG8_SA(0, 1), cA + hstepA, voffA);
        if (wr == 1) PG8_BAR;
        PG8_WAIT_V(2); PG8_BAR;
        PG8_STAGE(PG8_SB(1, 0), cB + kstep, voffB); PG8_STAGE(PG8_SA(1, 0), cA + kstep, voffA); PG8_STAGE(PG8_SB(1, 1), cB + hstepB + kstep, voffB);
        PG8_WAIT_V(6); PG8_BAR;
    } else {
        PG8_STAGE(PG8_SB(0, 0), cB, voffB); PG8_STAGE(PG8_SA(0, 0), cA, voffA); PG8_STAGE(PG8_SB(0, 1), cB + hstepB, voffB); PG8_STAGE(PG8_SA(0, 1), cA + hstepA, voffA);
        if (wr == 1) PG8_BAR;
        PG8_WAIT_V(4); PG8_BAR;
        PG8_STAGE(PG8_SB(1, 0), cB + kstep, voffB); PG8_STAGE(PG8_SA(1, 0), cA + kstep, voffA); PG8_STAGE(PG8_SB(1, 1), cB + hstepB + kstep, voffB);
        PG8_WAIT_V(6); PG8_BAR;
    }
    for (;;) {
        const bool has_next = S.next(ui + 1, nxt);
        const char* nA = has_next ? (const char*)g.A + (size_t)nxt.pm * tstepA : cA; const char* nB = has_next ? (const char*)g.Bt + (size_t)nxt.pn * tstepB : cB;
        for (int t = 0; t < nt; t += 2) {
            if constexpr (Epi::KHOOK) { if (t == Epi::KH_T) E.khook(acc, ui, wr, fr, lds); }
            const bool last = (t == nt - 2);
            const char* a1 = cA + (size_t)(t + 1) * kstep;
            const char* a2 = last ? nA : cA + (size_t)(t + 2) * kstep; const char* b2 = last ? nB : cB + (size_t)(t + 2) * kstep;
            const char* a3 = a2 + kstep; const char* b3 = b2 + kstep;
            if (last && has_next) S.a_ready(nxt);
            if constexpr (SP2) {
            PG8_LDB(B0, 0, 0); PG8_LDB(B1, 0, 1); PG8_SCHED; PG8_LDA(At, 0, 0); PG8_STAGE(PG8_SA(1, 1), a1 + hstepA, voffA);
            PG8_WAIT_V(8); PG8_WAIT_L(0); PG8_BAR; PG8_MMA(0, 0, At, B0); PG8_MMA(0, 1, At, B1); PG8_BAR; PG8_SCHED;
            PG8_LDA(At, 0, 1); PG8_STAGE(PG8_SB(0, 0), b2, voffB); PG8_STAGE(PG8_SB(0, 1), b2 + hstepB, voffB); PG8_STAGE(PG8_SA(0, 0), a2, voffA);
            PG8_WAIT_V(8); PG8_WAIT_L(0); PG8_BAR; PG8_MMA(1, 0, At, B0); PG8_MMA(1, 1, At, B1); PG8_BAR; PG8_SCHED;
            PG8_LDB(B0, 1, 0); PG8_LDB(B1, 1, 1); PG8_SCHED; PG8_LDA(At, 1, 0); PG8_STAGE(PG8_SA(0, 1), a2 + hstepA, voffA);
            PG8_WAIT_V(8); PG8_WAIT_L(0); PG8_BAR; PG8_MMA(0, 0, At, B0); PG8_MMA(0, 1, At, B1); PG8_BAR; PG8_SCHED;
            PG8_LDA(At, 1, 1); PG8_STAGE(PG8_SB(1, 0), b3, voffB); PG8_STAGE(PG8_SB(1, 1), b3 + hstepB, voffB); PG8_STAGE(PG8_SA(1, 0), a3, voffA);
            PG8_WAIT_V(8); PG8_WAIT_L(0); PG8_BAR; PG8_MMA(1, 0, At, B0); PG8_MMA(1, 1, At, B1); PG8_BAR; PG8_SCHED;
            } else {
            PG8_LDB(B0, 0, 0); PG8_SCHED; PG8_LDA(At, 0, 0); PG8_STAGE(PG8_SA(1, 1), a1 + hstepA, voffA);
            PG8_WAIT_L(8); PG8_BAR; PG8_WAIT_L(0); PG8_MMA(0, 0, At, B0); PG8_BAR; PG8_SCHED;
            PG8_LDB(B1, 0, 1); PG8_STAGE(PG8_SB(0, 0), b2, voffB);
            PG8_BAR; PG8_WAIT_L(0); PG8_MMA(0, 1, At, B1); PG8_BAR;
            PG8_LDA(At, 0, 1); PG8_STAGE(PG8_SA(0, 0), a2, voffA);
            PG8_BAR; PG8_WAIT_L(0); PG8_MMA(1, 0, At, B0); PG8_BAR; PG8_SCHED;
            PG8_STAGE(PG8_SB(0, 1), b2 + hstepB, voffB);
            PG8_WAIT_V(6); PG8_BAR; PG8_MMA(1, 1, At, B1); PG8_BAR;
            PG8_LDB(B0, 1, 0); PG8_SCHED; PG8_LDA(At, 1, 0); PG8_STAGE(PG8_SA(0, 1), a2 + hstepA, voffA);
            PG8_WAIT_L(8); PG8_BAR; PG8_WAIT_L(0); PG8_MMA(0, 0, At, B0); PG8_BAR; PG8_SCHED;
            PG8_LDB(B1, 1, 1); PG8_STAGE(PG8_SB(1, 0), b3, voffB);
            PG8_BAR; PG8_WAIT_L(0); PG8_MMA(0, 1, At, B1); PG8_BAR;
            PG8_LDA(At, 1, 1); PG8_STAGE(PG8_SA(1, 0), a3, voffA);
            PG8_BAR; PG8_WAIT_L(0); PG8_MMA(1, 0, At, B0); PG8_BAR; PG8_SCHED;
            PG8_STAGE(PG8_SB(1, 1), b3 + hstepB, voffB);
            PG8_WAIT_V(6); PG8_BAR; PG8_MMA(1, 1, At, B1); PG8_BAR;
            }
        }
        if constexpr (ALIGN_EPI) { if (wr == 0) PG8_BAR; }
        if constexpr (!Epi::AFTER_DRAIN) { E(acc, cur, wr, wc, fr, fq, ui); S.done(cur); }
        if (!has_next) break;
#pragma unroll
        for (int a = 0; a < 2; ++a)
#pragma unroll
            for (int b = 0; b < 2; ++b)
#pragma unroll
                for (int m = 0; m < 4; ++m)
#pragma unroll
                    for (int n = 0; n < 2; ++n) acc[a][b][m][n] = (f32x4){0.f, 0.f, 0.f, 0.f};
        cur = nxt; cA = nA; cB = nB; ++ui;
        if constexpr (ALIGN_EPI) { if (wr == 1) PG8_BAR; }
    }
    PG8_WAIT_V(0);
    if constexpr (!ALIGN_EPI) { if (wr == 0) PG8_BAR; }
    PG8_BAR;
    if constexpr (Epi::AFTER_DRAIN) { E.fused(acc, cur, wr, wc, fr, fq, lds, wid, lane); S.done(cur); }
#undef PG8_SA
#undef PG8_SB
#undef PG8_STAGE
#undef PG8_LDA
#undef PG8_LDB
#undef PG8_MMA
#undef PG8_WAIT_V
#undef PG8_WAIT_L
#undef PG8_BAR
#undef PG8_SCHED
}
}

namespace pg8 {
struct EpiMlpIn {
  static constexpr bool PERM = true, AFTER_DRAIN = false, KHOOK = false; static constexpr int KH_T = 0;
  ::bf16_t* O; const float* bias;
  __device__ __forceinline__ void operator()(const f32x4 (&acc)[2][2][4][2], const Unit& u, int wr, int wc, int fr, int fq, int) const {
    const int row0 = u.pm * BM + wr * 64 + fr, col0 = u.pn * BM + wc * 32 + 8 * fq;
    f32x4 bv[2][2];
#pragma unroll
    for (int bj = 0; bj < 2; ++bj)
#pragma unroll
      for (int n = 0; n < 2; ++n) bv[bj][n] = *(const f32x4*)(bias + col0 + bj * HALF + 4 * n);
#pragma unroll
    for (int ai = 0; ai < 2; ++ai)
#pragma unroll
      for (int m = 0; m < 4; ++m) {
        ::bf16_t* rowp = O + (size_t)(row0 + ai * HALF + m * 16) * 4096 + col0;
#pragma unroll
        for (int bj = 0; bj < 2; ++bj) {
          f32x4 v0 = acc[ai][bj][m][0] + bv[bj][0], v1 = acc[ai][bj][m][1] + bv[bj][1];
#pragma unroll
          for (int e = 0; e < 4; ++e) { const float a = fmaxf(v0[e], 0.f), b = fmaxf(v1[e], 0.f); v0[e] = a * a; v1[e] = b * b; }
          u32x4 w; w.x = pk2(v0[0], v0[1]); w.y = pk2(v0[2], v0[3]); w.z = pk2(v1[0], v1[1]); w.w = pk2(v1[2], v1[3]);
          *(u32x4*)(rowp + bj * HALF) = w;
        }
      }
  }
};
struct EpiMlpOut {
  static constexpr bool PERM = false, AFTER_DRAIN = false, KHOOK = false; static constexpr int KH_T = 0;
  const ::bf16_t* x1; ::bf16_t* x2; const float* mod; const float* bias;
  __device__ __forceinline__ void operator()(const f32x4 (&acc)[2][2][4][2], const Unit& u, int wr, int wc, int fr, int fq, int) const {
    const int col0 = u.pn * BM + wc * 32 + 4 * fq;
    f32x4 bb[2][2];
#pragma unroll
    for (int bj = 0; bj < 2; ++bj)
#pragma unroll
      for (int n = 0; n < 2; ++n) bb[bj][n] = *(const f32x4*)(bias + col0 + bj * HALF + n * 16);
#pragma unroll
    for (int ai = 0; ai < 2; ++ai)
#pragma unroll
      for (int mp = 0; mp < 2; ++mp) {
        uint2 xr[2][2][2]; f32x4 gv[2][2][2];
#pragma unroll
        for (int mm = 0; mm < 2; ++mm) {
          const int row = u.pm * BM + ai * HALF + wr * 64 + (mp * 2 + mm) * 16 + fr;
          const float* g2 = mod + batch_of(row) * 6144 + 5120;
#pragma unroll
          for (int bj = 0; bj < 2; ++bj)
#pragma unroll
            for (int n = 0; n < 2; ++n) { const int col = col0 + bj * HALF + n * 16; xr[mm][bj][n] = *(const uint2*)(x1 + (size_t)row * 1024 + col); gv[mm][bj][n] = *(const f32x4*)(g2 + col); }
        }
        asm volatile("" ::: "memory");
#pragma unroll
        for (int mm = 0; mm < 2; ++mm) {
          const int m = mp * 2 + mm, row = u.pm * BM + ai * HALF + wr * 64 + m * 16 + fr;
#pragma unroll
          for (int bj = 0; bj < 2; ++bj)
#pragma unroll
            for (int n = 0; n < 2; ++n) {
              const int col = col0 + bj * HALF + n * 16;
              const uint2 xx = xr[mm][bj][n];
              const f32x4 xv = {bflo(xx.x), bfhi(xx.x), bflo(xx.y), bfhi(xx.y)};
              const f32x4 o = xv + gv[mm][bj][n] * (acc[ai][bj][m][n] + bb[bj][n]);
              uint2 w; w.x = pk2(o[0], o[1]); w.y = pk2(o[2], o[3]);
              *(uint2*)(x2 + (size_t)row * 1024 + col) = w;
            }
        }
      }
  }
};
struct EpiYf {
  static constexpr bool PERM = true, AFTER_DRAIN = false, KHOOK = false; static constexpr int KH_T = 0;
  ::bf16_t* O; const float* bias; float* ss;
  __device__ __forceinline__ void operator()(const f32x4 (&acc)[2][2][4][2], const Unit& u, int wr, int wc, int fr, int fq, int) const {
    const int row0 = u.pm * BM + wr * 64 + fr, col0 = u.pn * BM + wc * 32 + 8 * fq;
    f32x4 bv[2][2];
#pragma unroll
    for (int bj = 0; bj < 2; ++bj)
#pragma unroll
      for (int n = 0; n < 2; ++n) bv[bj][n] = *(const f32x4*)(bias + col0 + bj * HALF + 4 * n);
#pragma unroll
    for (int ai = 0; ai < 2; ++ai)
#pragma unroll
      for (int m = 0; m < 4; ++m) {
        const int row = row0 + ai * HALF + m * 16;
        const float scale = row < LPR ? 3.4526698300124393e-4f : 6.905339660024879e-4f;
        ::bf16_t* rowp = O + (size_t)row * 1024 + col0;
        float s = 0.f;
#pragma unroll
        for (int bj = 0; bj < 2; ++bj) {
          const f32x4 v0 = acc[ai][bj][m][0] * scale + bv[bj][0], v1 = acc[ai][bj][m][1] * scale + bv[bj][1];
          s += (v0[0] * v0[0] + v0[1] * v0[1]) + (v0[2] * v0[2] + v0[3] * v0[3]) + (v1[0] * v1[0] + v1[1] * v1[1]) + (v1[2] * v1[2] + v1[3] * v1[3]);
          u32x4 w; w.x = pk2(v0[0], v0[1]); w.y = pk2(v0[2], v0[3]); w.z = pk2(v1[0], v1[1]); w.w = pk2(v1[2], v1[3]);
          *(u32x4*)(rowp + bj * HALF) = w;
        }
        s += __shfl_xor(s, 16); s += __shfl_xor(s, 32);
        if (fq == 0) ss[row * 8 + u.pn * 4 + wc] = s;
      }
  }
};
struct EpiGlu {
  static constexpr bool PERM = true, AFTER_DRAIN = false, KHOOK = false; static constexpr int KH_T = 0;
  ::bf16_t* O; const float* bias; float* ss;
  __device__ __forceinline__ void operator()(const f32x4 (&acc)[2][2][4][2], const Unit& u, int wr, int wc, int fr, int fq, int) const {
    const int row0 = u.pm * BM + wr * 64 + fr, j0 = u.pn * 128 + wc * 32 + 8 * fq;
    f32x4 bv[2][2];
#pragma unroll
    for (int bj = 0; bj < 2; ++bj)
#pragma unroll
      for (int n = 0; n < 2; ++n) bv[bj][n] = *(const f32x4*)(bias + bj * 512 + j0 + 4 * n);
#pragma unroll
    for (int ai = 0; ai < 2; ++ai)
#pragma unroll
      for (int m = 0; m < 4; ++m) {
        const int row = row0 + ai * HALF + m * 16;
        float o[8], s = 0.f;
#pragma unroll
        for (int n = 0; n < 2; ++n)
#pragma unroll
          for (int e = 0; e < 4; ++e) {
            const float val = acc[ai][0][m][n][e] + bv[0][n][e], gate = acc[ai][1][m][n][e] + bv[1][n][e];
            const float y = val / (1.f + __expf(-gate));
            o[4 * n + e] = y; s += y * y;
          }
        u32x4 w; w.x = pk2(o[0], o[1]); w.y = pk2(o[2], o[3]); w.z = pk2(o[4], o[5]); w.w = pk2(o[6], o[7]);
        *(u32x4*)(O + (size_t)row * 1024 + 512 + j0) = w;
        s += __shfl_xor(s, 16); s += __shfl_xor(s, 32);
        if (fq == 0) ss[row * 16 + u.pn * 4 + wc] = s;
      }
  }
};
struct EpiZt {
  static constexpr bool PERM = true, AFTER_DRAIN = false, KHOOK = false; static constexpr int KH_T = 0;
  ::bf16_t* O;
  __device__ __forceinline__ void operator()(const f32x4 (&acc)[2][2][4][2], const Unit& u, int wr, int wc, int fr, int fq, int) const {
    const int v0 = u.pn * BM;
    ::bf16_t* base; size_t ld;
    if (v0 < LPR) { base = O + v0; ld = LPR; }
    else { const int vs = v0 - LPR; base = O + (size_t)512 * LPR + (size_t)(vs >> 12) * 512 * 4096 + (vs & 4095); ld = 4096; }
    const int c0 = u.pm * BM + wr * 64 + fr, col0 = wc * 32 + 8 * fq;
#pragma unroll
    for (int ai = 0; ai < 2; ++ai)
#pragma unroll
      for (int m = 0; m < 4; ++m) {
        ::bf16_t* rowp = base + (size_t)(c0 + ai * HALF + m * 16) * ld + col0;
#pragma unroll
        for (int bj = 0; bj < 2; ++bj) {
          const f32x4 a = acc[ai][bj][m][0], b = acc[ai][bj][m][1];
          u32x4 w; w.x = pk2(a[0], a[1]); w.y = pk2(a[2], a[3]); w.z = pk2(b[0], b[1]); w.w = pk2(b[2], b[3]);
          *(u32x4*)(rowp + bj * HALF) = w;
        }
      }
  }
};
struct EpiZs {
  static constexpr bool PERM = true, AFTER_DRAIN = false, KHOOK = false; static constexpr int KH_T = 0;
  ::bf16_t* O;
  __device__ __forceinline__ void operator()(const f32x4 (&acc)[2][2][4][2], const Unit& u, int wr, int wc, int fr, int fq, int) const {
    const int r0 = u.pm * BM + wr * 64 + fr, col0 = u.pn * BM + wc * 32 + 8 * fq;
#pragma unroll
    for (int ai = 0; ai < 2; ++ai)
#pragma unroll
      for (int m = 0; m < 4; ++m) {
        const int tok = v2tok(r0 + ai * HALF + m * 16);
#pragma unroll
        for (int bj = 0; bj < 2; ++bj) {
          const int col = col0 + bj * HALF;
          const f32x4 a = acc[ai][bj][m][0], b = acc[ai][bj][m][1];
          u32x4 w; w.x = pk2(a[0], a[1]); w.y = pk2(a[2], a[3]); w.z = pk2(b[0], b[1]); w.w = pk2(b[2], b[3]);
          *(u32x4*)(O + ((size_t)(col >> 4) * 1280 + (tok >> 6)) * 1280 + (tok & 63) * 16 + (col & 15)) = w;
        }
      }
  }
};
struct EpiS {
  static constexpr bool PERM = false, AFTER_DRAIN = false, KHOOK = false; static constexpr int KH_T = 0;
  float* O;
  __device__ __forceinline__ void operator()(const f32x4 (&acc)[2][2][4][2], const Unit& u, int wr, int wc, int fr, int fq, int) const {
#pragma unroll
    for (int ai = 0; ai < 2; ++ai)
#pragma unroll
      for (int m = 0; m < 4; ++m) {
        float* rowp = O + (size_t)(u.pm * BM + ai * HALF + wr * 64 + m * 16 + fr) * 256 + wc * 32 + 4 * fq;
#pragma unroll
        for (int bj = 0; bj < 2; ++bj)
#pragma unroll
          for (int n = 0; n < 2; ++n) *(f32x4*)(rowp + bj * HALF + n * 16) = acc[ai][bj][m][n];
      }
  }
};
struct EpiGelu {
  static constexpr bool PERM = true, AFTER_DRAIN = false, KHOOK = false; static constexpr int KH_T = 0;
  ::bf16_t* O;
  __device__ __forceinline__ void operator()(const f32x4 (&acc)[2][2][4][2], const Unit& u, int wr, int wc, int fr, int fq, int) const {
    const int gi = u.pn >> 2, n0 = (u.pn & 3) * BM + wc * 32 + 8 * fq, ch0 = u.pm * BM - gi * 1280 + wr * 64 + fr;
#pragma unroll
    for (int ai = 0; ai < 2; ++ai)
#pragma unroll
      for (int m = 0; m < 4; ++m) {
        const int ch = ch0 + ai * HALF + m * 16;
#pragma unroll
        for (int bj = 0; bj < 2; ++bj) {
          const int n = n0 + bj * HALF;
          float o[8];
#pragma unroll
          for (int e = 0; e < 4; ++e) { o[e] = gelu_tanh(acc[ai][bj][m][0][e]); o[4 + e] = gelu_tanh(acc[ai][bj][m][1][e]); }
          u32x4 w; w.x = pk2(o[0], o[1]); w.y = pk2(o[2], o[3]); w.z = pk2(o[4], o[5]); w.w = pk2(o[6], o[7]);
          *(u32x4*)(O + (size_t)(ch * 64 + (n >> 4)) * 512 + gi * 16 + (n & 15)) = w;
        }
      }
  }
};
struct EpiFft1 {
  static constexpr bool PERM = true, AFTER_DRAIN = false, KHOOK = false; static constexpr int KH_T = 0;
  ::bf16_t* Tt; const float2* twp; const float2* tws;
  __device__ __forceinline__ void operator()(const f32x4 (&acc)[2][2][4][2], const Unit& u, int wr, int wc, int fr, int fq, int) const {
    const bool pr = u.pn < 128;
    const int r0b = u.pn * BM + wc * 32 + 8 * fq;
    const float2* tw = pr ? twp : tws;
    const int mask = pr ? 16383 : 4095;
    float2 stv[4], w0v[4];
#pragma unroll
    for (int m = 0; m < 4; ++m) {
      const int idx = ((u.pm & 1) << 7) | (wr * 64 + m * 16 + fr);
      const int k1 = pr ? (idx & 127) : (idx & 63), l2loc = pr ? (idx >> 7) : (idx >> 6);
      const int l20 = pr ? (l2loc * 64 + (r0b & 63)) : (l2loc * 16 + (r0b & 15));
      stv[m] = tw[(unsigned)(k1 & mask)]; w0v[m] = tw[(unsigned)((k1 * l20) & mask)];
    }
    asm volatile("" ::: "memory");
#pragma unroll
    for (int m = 0; m < 4; ++m) {
      const int idx = ((u.pm & 1) << 7) | (wr * 64 + m * 16 + fr);
      const int k1 = pr ? (idx & 127) : (idx & 63), l2loc = pr ? (idx >> 7) : (idx >> 6);
      const int l20 = pr ? (l2loc * 64 + (r0b & 63)) : (l2loc * 16 + (r0b & 15));
      const float2 st = stv[m], w0 = w0v[m];
#pragma unroll
      for (int bj = 0; bj < 2; ++bj) {
        const int r0 = r0b + bj * HALF;
        size_t off; int pstride;
        if (pr) { off = ((size_t)(k1 * 512 + (r0 >> 6))) * 256 + l20; pstride = 128; }
        else { const int bc = (r0 - 32768) >> 4; off = (size_t)65536 * 256 + ((size_t)(((bc >> 9) * 32 + (k1 >> 1)) * 512 + (bc & 511))) * 256 + (k1 & 1) * 128 + l20; pstride = 64; }
        float ore[8], oim[8];
        float2 wv = w0;
#pragma unroll
        for (int e = 0; e < 8; ++e) {
          const float re = acc[0][bj][m][e >> 2][e & 3], im = acc[1][bj][m][e >> 2][e & 3];
          ore[e] = re * wv.x + im * wv.y; oim[e] = im * wv.x - re * wv.y;
          wv = make_float2(wv.x * st.x - wv.y * st.y, wv.y * st.x + wv.x * st.y);
        }
        u32x4 w; w.x = pk2(ore[0], ore[1]); w.y = pk2(ore[2], ore[3]); w.z = pk2(ore[4], ore[5]); w.w = pk2(ore[6], ore[7]);
        *(u32x4*)(Tt + off) = w;
        w.x = pk2(oim[0], oim[1]); w.y = pk2(oim[2], oim[3]); w.z = pk2(oim[4], oim[5]); w.w = pk2(oim[6], oim[7]);
        *(u32x4*)(Tt + off + pstride) = w;
      }
    }
  }
};
struct EpiFft2 {
  static constexpr bool PERM = true, AFTER_DRAIN = false, KHOOK = false; static constexpr int KH_T = 0;
  ::bf16_t* AF;
  __device__ __forceinline__ void operator()(const f32x4 (&acc)[2][2][4][2], const Unit& u, int wr, int wc, int fr, int fq, int) const {
    const bool pr = u.pn < 256;
    const int pnl = pr ? u.pn : u.pn - 256, c0 = (pnl & 1) * 256 + wc * 32 + 8 * fq;
#pragma unroll
    for (int ai = 0; ai < 2; ++ai)
#pragma unroll
      for (int m = 0; m < 4; ++m) {
        int part, tok;
        if (pr) { part = ai; tok = (pnl >> 1) + 128 * (wr * 64 + m * 16 + fr); }
        else { const int bk = pnl >> 1; part = wr; tok = LPR + (bk >> 5) * 4096 + (bk & 31) * 2 + ai + 64 * (m * 16 + fr); }
        ::bf16_t* rowp = AF + (size_t)tok * 1024 + part * 512 + c0;
#pragma unroll
        for (int bj = 0; bj < 2; ++bj) {
          const f32x4 a = acc[ai][bj][m][0], b = acc[ai][bj][m][1];
          u32x4 w; w.x = pk2(a[0], a[1]); w.y = pk2(a[2], a[3]); w.z = pk2(b[0], b[1]); w.w = pk2(b[2], b[3]);
          *(u32x4*)(rowp + bj * HALF) = w;
        }
      }
  }
};
struct EpiWout {
  static constexpr bool PERM = false, AFTER_DRAIN = false, KHOOK = true; static constexpr int KH_T = 8;
  float* out; const float* xp; const float* xs; const float* mod;
  __device__ __forceinline__ void khook(f32x4 (&acc)[2][2][4][2], int ui, int wr, int fr, PG8_LAS unsigned char* lds) const {
    typedef float f32x2t __attribute__((ext_vector_type(2)));
    const PG8_LAS f32x2t* tab = (const PG8_LAS f32x2t*)(lds + 131072) + ui * 256;
#pragma unroll
    for (int ai = 0; ai < 2; ++ai)
#pragma unroll
      for (int m = 0; m < 4; ++m) {
        const float r = tab[ai * HALF + wr * 64 + m * 16 + fr].x;
#pragma unroll
        for (int bj = 0; bj < 2; ++bj)
#pragma unroll
          for (int n = 0; n < 2; ++n) acc[ai][bj][m][n] *= r;
      }
  }
  __device__ __forceinline__ void operator()(const f32x4 (&acc)[2][2][4][2], const Unit& u, int wr, int wc, int fr, int fq, int ui) const {
    typedef float f32x2t __attribute__((ext_vector_type(2)));
    const PG8_LAS f32x2t* tab = (const PG8_LAS f32x2t*)((PG8_LAS unsigned char*)dyn_smem + 131072) + ui * 256;
    const int col0 = u.pn * BM + wc * 32 + 4 * fq;
#pragma unroll
    for (int ai = 0; ai < 2; ++ai)
#pragma unroll
      for (int mp = 0; mp < 2; ++mp) {
        f32x4 xv[2][2][2], gv[2][2][2]; float rs[2];
#pragma unroll
        for (int mm = 0; mm < 2; ++mm) {
          const int m = mp * 2 + mm, rl = ai * HALF + wr * 64 + m * 16 + fr, row = u.pm * BM + rl;
          rs[mm] = tab[rl].y;
          const float* g1 = mod + batch_of(row) * 6144 + 2048;
          const float* xr = row < LPR ? xp + (size_t)row * 1024 : xs + (size_t)(row - LPR) * 1024;
#pragma unroll
          for (int bj = 0; bj < 2; ++bj)
#pragma unroll
            for (int n = 0; n < 2; ++n) { const int col = col0 + bj * HALF + n * 16; xv[mm][bj][n] = *(const f32x4*)(xr + col); gv[mm][bj][n] = *(const f32x4*)(g1 + col); }
        }
        asm volatile("" ::: "memory");
#pragma unroll
        for (int mm = 0; mm < 2; ++mm) {
          const int m = mp * 2 + mm, row = u.pm * BM + ai * HALF + wr * 64 + m * 16 + fr;
          ::bf16_t* orow = (::bf16_t*)out + (size_t)row * 1024;
#pragma unroll
          for (int bj = 0; bj < 2; ++bj)
#pragma unroll
            for (int n = 0; n < 2; ++n) {
              const int col = col0 + bj * HALF + n * 16;
              const f32x4 o = xv[mm][bj][n] + gv[mm][bj][n] * (acc[ai][bj][m][n] * rs[mm]);
              uint2 w; w.x = pk2(o[0], o[1]); w.y = pk2(o[2], o[3]);
              *(uint2*)(orow + col) = w;
            }
        }
      }
  }
};
}

DI void phase2(const P& p, const int wv) {
  {
    const pg8::Gemm g{p.wint(), p.hb(), 512, NTOK, 1024, 1024, 1024};
    pg8::StaticOrder S; S.init(512, NTOK, (int)gridDim.x, (int)blockIdx.x);
    const pg8::EpiZt E{p.zT()};
    pg8::gemm_phase<pg8::EpiZt, pg8::StaticOrder, true, true>((PG8_LAS unsigned char*)dyn_smem, otid(wv), g, S, E);
  }
  {
    const pg8::Gemm g{p.hb(), p.wint() + (size_t)512 * 1024, NTOK, 512, 1024, 1024, 1024};
    pg8::StaticOrder S; S.init(NTOK, 512, (int)gridDim.x, (int)(gridDim.x - 1 - blockIdx.x));
    const pg8::EpiZs E{p.Ucat()};
    pg8::gemm_phase<pg8::EpiZs, pg8::StaticOrder, true, true>((PG8_LAS unsigned char*)dyn_smem, otid(wv), g, S, E);
  }
}
DI void phase3(const P& p, const int wv) {
  {
    const pg8::Gemm g{p.Ucat(), p.Bs(), 32 * 1280, 32 * 256, 1024, 1280, 1024};
    pg8::GroupOrder S; S.init(32, 5, 1, (int)gridDim.x, (int)blockIdx.x);
    const pg8::EpiS E{p.S()};
    pg8::gemm_phase<pg8::EpiS, pg8::GroupOrder, true, true>((PG8_LAS unsigned char*)dyn_smem, otid(wv), g, S, E);
  }
  {
    const pg8::Gemm g{p.Fb1(), p.zT(), 1024, 163840, 256, 256, 256};
    pg8::Fft1Order S; S.init((int)gridDim.x, (int)blockIdx.x);
    const pg8::EpiFft1 E{p.Tt(), p.twp(), p.tws()};
    pg8::gemm_phase<pg8::EpiFft1, pg8::Fft1Order, true, true>((PG8_LAS unsigned char*)dyn_smem, otid(wv), g, S, E);
  }
}
DI void phase4(const P& p, const int wv) {
  {
    const int tix = otid(wv), pp = tix & 63, G = (int)gridDim.x;
    for (int task = (int)blockIdx.x + G * wv; task < 17 * 64; task += G * 8) {
      const int seq = task >> 6, g = (task >> 1) & 31, dir = task & 1;
      const int c0 = seq == 0 ? 0 : 256 + (seq - 1) * 64, nc = seq == 0 ? 256 : 64;
      const float ar = p.AT()[((g * 2 + dir) * 64 + pp) * 2], ai = p.AT()[((g * 2 + dir) * 64 + pp) * 2 + 1];
      float hr = 0.f, hi = 0.f;
      const float* Sg = p.S() + (size_t)g * 1280 * 256 + dir * 128 + pp;
      bf16_t* Hg = p.Ucat() + (size_t)g * 1280 * 1280 + 1024 + dir * 128 + pp;
      for (int i0 = 0; i0 < nc; i0 += 32) {
        float sr[32], si[32];
#pragma unroll
        for (int j = 0; j < 32; j++) {
          const int c = c0 + (dir == 0 ? i0 + j : nc - 1 - i0 - j);
          sr[j] = Sg[(size_t)c * 256]; si[j] = Sg[(size_t)c * 256 + 64];
        }
#pragma unroll
        for (int j = 0; j < 32; j++) {
          const int c = c0 + (dir == 0 ? i0 + j : nc - 1 - i0 - j);
          Hg[(size_t)c * 1280] = f2bf(hr); Hg[(size_t)c * 1280 + 64] = f2bf(hi);
          const float nr = ar * hr - ai * hi + sr[j], ni = ar * hi + ai * hr + si[j];
          hr = nr; hi = ni;
        }
      }
    }
  }
  {
    const pg8::Gemm g{p.Fb2(), p.Tt(), 512, 327680, 256, 256, 256};
    pg8::Fft2Order S; S.init((int)gridDim.x, (int)blockIdx.x);
    const pg8::EpiFft2 E{p.AF()};
    pg8::gemm_phase<pg8::EpiFft2, pg8::Fft2Order, true, true>((PG8_LAS unsigned char*)dyn_smem, otid(wv), g, S, E);
  }
}
DI void phase5(const P& p, const int wv) {
  const pg8::Gemm g{p.Ucat(), p.Tcat(), 32 * 1280, 32 * 1024, 1280, 1280, 1280};
  pg8::GroupOrder S; S.init(32, 5, 4, (int)gridDim.x, (int)blockIdx.x);
  const pg8::EpiGelu E{p.gact()};
  pg8::gemm_phase<pg8::EpiGelu, pg8::GroupOrder, true, true>((PG8_LAS unsigned char*)dyn_smem, otid(wv), g, S, E);
  {
    const pg8::Gemm g{p.AF(), p.Mf(), NTOK, 512, 1024, 1024, 1024};
    pg8::YfOrder S; S.init((int)gridDim.x, (int)blockIdx.x);
    const pg8::EpiYf E{p.mg(), p.b_f, p.ssf()};
    pg8::gemm_phase<pg8::EpiYf, pg8::YfOrder, true, true>((PG8_LAS unsigned char*)dyn_smem, otid(wv), g, S, E);
  }
}
DI void phase6(const P& p, const int wv) {
  {
    const pg8::Gemm g{p.gact(), p.wglut(), NTOK, 1024, 512, 512, 512};
    pg8::StaticOrder S; S.init(NTOK, 1024, (int)gridDim.x, (int)blockIdx.x);
    const pg8::EpiGlu E{p.mg(), p.b_glu, p.sss()};
    pg8::gemm_phase<pg8::EpiGlu, pg8::StaticOrder, true, true>((PG8_LAS unsigned char*)dyn_smem, otid(wv), g, S, E);
  }
}
DI void phase7(const P& p, const int wv) {
  const pg8::Gemm g{p.mg(), p.woutt(), NTOK, 1024, 1024, 1024, 1024};
  pg8::StaticOrder S; S.init(NTOK, 1024, (int)gridDim.x, (int)blockIdx.x);
  {
    typedef float f32x2t __attribute__((ext_vector_type(2)));
    PG8_LAS f32x2t* tab = (PG8_LAS f32x2t*)((PG8_LAS unsigned char*)dyn_smem + 131072);
    const int tix7 = otid(wv);
    pg8::Unit u;
    for (int i = 0; i < 8 && S.next(i, u); ++i) {
      if (tix7 < 256) {
        const int tok = u.pm * 256 + tix7;
        float sf = 0.f, s2 = 0.f;
#pragma unroll
        for (int j = 0; j < 8; j++) sf += p.ssf()[tok * 8 + j];
#pragma unroll
        for (int j = 0; j < 16; j++) s2 += p.sss()[tok * 16 + j];
        const float rf = rsqrtf(sf * (1.f / 512.f) + EPSV), rs = rsqrtf(s2 * (1.f / 512.f) + EPSV);
        tab[i * 256 + tix7] = (f32x2t){rf / rs, rs};
      }
    }
    __syncthreads();
  }
  const pg8::EpiWout E{p.out, p.xp, p.xs, p.mod()};
  pg8::gemm_phase<pg8::EpiWout, pg8::StaticOrder, true, true>((PG8_LAS unsigned char*)dyn_smem, otid(wv), g, S, E);
}
DI void phase8(const P& p, const int wv) {
  const pg8::Gemm g{p.hb(), p.w1t(), NTOK, 4096, 1024, 1024, 1024};
  pg8::StaticOrder S; S.init(NTOK, 4096, (int)gridDim.x, (int)blockIdx.x);
  const pg8::EpiMlpIn E{p.hid(), p.b1};
  pg8::gemm_phase<pg8::EpiMlpIn, pg8::StaticOrder, true, true>((PG8_LAS unsigned char*)dyn_smem, otid(wv), g, S, E);
}
DI void phase9(const P& p, const int wv) {
  const pg8::Gemm g{p.hid(), p.w2t(), NTOK, 1024, 4096, 4096, 4096};
  pg8::StaticOrder S; S.init(NTOK, 1024, (int)gridDim.x, (int)blockIdx.x);
  const pg8::EpiMlpOut E{(const bf16_t*)p.out, p.hb(), p.mod(), p.b2};
  pg8::gemm_phase<pg8::EpiMlpOut, pg8::StaticOrder, true, true>((PG8_LAS unsigned char*)dyn_smem, otid(wv), g, S, E);
}

__global__ void __launch_bounds__(512, 2) k_mega(P p) {
  cg::grid_group grid = cg::this_grid();
  const int wv = __builtin_amdgcn_readfirstlane((int)threadIdx.x >> 6);
  {
    const int t0 = otid(wv);
    volatile XB_LAS unsigned* st = (volatile XB_LAS unsigned*)((XB_LAS unsigned char*)dyn_smem + XB_LDS_OFF);
    if (t0 == 0) { st[0] = 0u; st[1] = 0u; }
    __syncthreads();
    if (t0 == 0) (void)xb_add((unsigned*)(p.ws + O_bar) + XB_XCNT(xb_xcc_id()), 1u);
  }
#define GSYNC() xcd_barrier((unsigned*)(p.ws + O_bar), otid(wv))
  phase0(p, wv); grid.sync();
  rownorm_mod<true>(p, wv, p.g_mix, 0, 1024); GSYNC();
  phase2(p, wv); GSYNC();
  phase3(p, wv); GSYNC();
  phase4(p, wv); GSYNC();
  phase5(p, wv); GSYNC();
  phase6(p, wv); GSYNC();
  phase7(p, wv); GSYNC();
  rownorm_mod<false>(p, wv, p.g_mlp, 3072, 4096); GSYNC();
  phase8(p, wv); GSYNC();
  phase9(p, wv); GSYNC();
  final_norm(p, wv);
}

extern "C" void kernel_launch(void* const* d_in, const int* in_sizes, int n_in, void* d_out, int out_size, void* d_ws, size_t ws_size,
                              hipStream_t stream) {
  P p{};
  const float** f = (const float**)&p;
  for (int i = 0; i < 29; i++) f[i] = (const float*)d_in[i];
  p.out = (float*)d_out;
  p.ws = (char*)d_ws;
  if (WS_NEED > ws_size) { fprintf(stderr, "workspace too small: need %zu have %zu\n", (size_t)WS_NEED, ws_size); return; }
  static int grid_blocks = 0;
  if (!grid_blocks) {
    int dev = 0, cus = 0, per_cu = 0;
    (void)hipGetDevice(&dev);
    (void)hipDeviceGetAttribute(&cus, hipDeviceAttributeMultiprocessorCount, dev);
    (void)hipFuncSetAttribute((const void*)k_mega, hipFuncAttributeMaxDynamicSharedMemorySize, SMEM_BYTES);
    (void)hipOccupancyMaxActiveBlocksPerMultiprocessor(&per_cu, k_mega, 512, SMEM_BYTES);
    if (per_cu < 1) per_cu = 1;
    grid_blocks = cus * per_cu;
  }
  (void)hipMemsetAsync((char*)d_ws + O_mod, 0, O_AT - O_mod, stream);
  void* args[] = {&p};
  hipError_t e = hipLaunchCooperativeKernel((void*)k_mega, dim3(grid_blocks), dim3(512), args, SMEM_BYTES, stream);
  if (e != hipSuccess) fprintf(stderr, "cooperative launch failed: %s (grid %d)\n", hipGetErrorString(e), grid_blocks);
}
```

```cpp
#include <hip/hip_runtime.h>
#include <hip/hip_cooperative_groups.h>
#include <stdint.h>
#include <stdio.h>
namespace cg = cooperative_groups;


#define DI __device__ __forceinline__
typedef unsigned short bf16_t;
typedef short bf16x8 __attribute__((ext_vector_type(8)));
typedef float f32x16 __attribute__((ext_vector_type(16)));
typedef float f32x4 __attribute__((ext_vector_type(4)));

constexpr int NTOK = 81920, LPR = 16384, LSM = 4096;
constexpr int SMEM_HALF = 73728;
constexpr int SMEM_BYTES = 2 * SMEM_HALF;
constexpr float EPSV = 1e-6f;

constexpr size_t al256(size_t x) { return (x + 255) & ~(size_t)255; }
constexpr size_t O_mod = 0;
constexpr size_t O_bar = O_mod + al256(17 * 6144 * 4);
constexpr size_t O_ss1 = O_bar + al256(3456 * 4);
constexpr size_t O_sb2 = O_ss1 + al256((size_t)NTOK * 4);
constexpr size_t O_AT = O_sb2 + al256(17 * 4096 * 4);
constexpr size_t O_ssf = O_AT + al256(32 * 2 * 64 * 2 * 4);
constexpr size_t O_sss = O_ssf + al256((size_t)NTOK * 8 * 4);
constexpr size_t O_twp = O_sss + al256((size_t)NTOK * 16 * 4);
constexpr size_t O_tws = O_twp + al256(LPR * 8);
constexpr size_t O_wint = O_tws + al256(LSM * 8);
constexpr size_t O_wglut = O_wint + al256(1024 * 1024 * 2);
constexpr size_t O_woutt = O_wglut + al256(1024 * 512 * 2);
constexpr size_t O_w1t = O_woutt + al256(1024 * 1024 * 2);
constexpr size_t O_w2t = O_w1t + al256((size_t)4096 * 1024 * 2);
constexpr size_t O_Mf = O_w2t + al256((size_t)4096 * 1024 * 2);
constexpr size_t O_Fb1 = O_Mf + al256(512 * 1024 * 2);
constexpr size_t O_Fb2 = O_Fb1 + al256(1024 * 256 * 2);
constexpr size_t O_Bs = O_Fb2 + al256(512 * 256 * 2);
constexpr size_t O_Tcat = O_Bs + al256((size_t)32 * 256 * 1024 * 2);
constexpr size_t O_hb = O_Tcat + al256((size_t)32 * 1024 * 1280 * 2);
constexpr size_t O_zT = O_hb + al256((size_t)NTOK * 1024 * 2);
constexpr size_t O_Ucat = O_zT + al256((size_t)NTOK * 512 * 2);
constexpr size_t O_AF = O_Ucat + al256((size_t)32 * 1280 * 1280 * 2);
constexpr size_t O_S = O_AF + al256((size_t)NTOK * 1024 * 2);
constexpr size_t O_gact = O_S + al256((size_t)1280 * 32 * 256 * 4);
constexpr size_t O_mg = O_gact + al256((size_t)NTOK * 512 * 2);
constexpr size_t O_END = O_mg + al256((size_t)NTOK * 1024 * 2);
constexpr size_t O_Tt = O_hb;
constexpr size_t O_hid = O_zT;
constexpr size_t WS_NEED = (O_hid + (size_t)NTOK * 4096 * 2 > O_END ? O_hid + (size_t)NTOK * 4096 * 2 : O_END);
struct P {
  const float *xp, *xs, *cp, *cs, *w_ada, *b_ada, *g_mix, *w_in, *w_f, *b_f, *a_re, *a_im, *log_dt, *b_re, *b_im, *c_re, *c_im,
      *ssm_d, *w_glu, *b_glu, *g_fo, *g_so, *w_out, *g_mlp, *w1, *b1, *w2, *b2, *g_final;
  float* out;
  char* ws;
  __device__ __forceinline__ float* mod() const { return (float*)(ws + O_mod); }
  __device__ __forceinline__ float* ss1() const { return (float*)(ws + O_ss1); }
  __device__ __forceinline__ float* sb2() const { return (float*)(ws + O_sb2); }
  __device__ __forceinline__ float* AT() const { return (float*)(ws + O_AT); }
  __device__ __forceinline__ float* ssf() const { return (float*)(ws + O_ssf); }
  __device__ __forceinline__ float* sss() const { return (float*)(ws + O_sss); }
  __device__ __forceinline__ float2* twp() const { return (float2*)(ws + O_twp); }
  __device__ __forceinline__ float2* tws() const { return (float2*)(ws + O_tws); }
  __device__ __forceinline__ bf16_t* wint() const { return (bf16_t*)(ws + O_wint); }
  __device__ __forceinline__ bf16_t* wglut() const { return (bf16_t*)(ws + O_wglut); }
  __device__ __forceinline__ bf16_t* woutt() const { return (bf16_t*)(ws + O_woutt); }
  __device__ __forceinline__ bf16_t* w1t() const { return (bf16_t*)(ws + O_w1t); }
  __device__ __forceinline__ bf16_t* w2t() const { return (bf16_t*)(ws + O_w2t); }
  __device__ __forceinline__ bf16_t* Mf() const { return (bf16_t*)(ws + O_Mf); }
  __device__ __forceinline__ bf16_t* Fb1() const { return (bf16_t*)(ws + O_Fb1); }
  __device__ __forceinline__ bf16_t* Fb2() const { return (bf16_t*)(ws + O_Fb2); }
  __device__ __forceinline__ bf16_t* Bs() const { return (bf16_t*)(ws + O_Bs); }
  __device__ __forceinline__ bf16_t* Tcat() const { return (bf16_t*)(ws + O_Tcat); }
  __device__ __forceinline__ bf16_t* Ucat() const { return (bf16_t*)(ws + O_Ucat); }
  __device__ __forceinline__ bf16_t* hb() const { return (bf16_t*)(ws + O_hb); }
  __device__ __forceinline__ bf16_t* zT() const { return (bf16_t*)(ws + O_zT); }
  __device__ __forceinline__ bf16_t* AF() const { return (bf16_t*)(ws + O_AF); }
  __device__ __forceinline__ float* S() const { return (float*)(ws + O_S); }
  __device__ __forceinline__ bf16_t* mg() const { return (bf16_t*)(ws + O_mg); }
  __device__ __forceinline__ bf16_t* gact() const { return (bf16_t*)(ws + O_gact); }
  __device__ __forceinline__ bf16_t* Tt() const { return (bf16_t*)(ws + O_Tt); }
  __device__ __forceinline__ bf16_t* hid() const { return (bf16_t*)(ws + O_hid); }
};

typedef float f32x2v __attribute__((ext_vector_type(2)));
typedef __bf16 bf16x2v __attribute__((ext_vector_type(2)));
DI uint32_t pk2(float lo, float hi) { const f32x2v v = {lo, hi}; const bf16x2v r = __builtin_convertvector(v, bf16x2v); return __builtin_bit_cast(uint32_t, r); }
DI bf16_t f2bf(float f) { return (bf16_t)(pk2(f, 0.f) & 0xffffu); }
extern __shared__ __attribute__((aligned(16))) unsigned char dyn_smem[];
DI int otid(int wv) {
  unsigned m = ~0u; asm volatile("" : "+s"(m));
  const int lane = (int)__builtin_amdgcn_mbcnt_hi(m, __builtin_amdgcn_mbcnt_lo(m, 0u));
  int t = (wv << 6) | lane; asm volatile("" : "+v"(t)); return t;
}
#define XB_TMO      128
#define XB_XCNT(j)  (256  + 64 * (j))
#define XB_XSUB(j)  (1280 + 64 * (j))
#define XB_XGEN(j)  (2304 + 64 * (j))
#define XB_TOP      3328
#define XB_TOPGEN   3392
#define XCD_BAR_WORDS 3456
#define XB_SPIN_CAP (1u << 18)
#define XB_LAS __attribute__((address_space(3)))
constexpr int XB_LDS_OFF = 147440;
DI unsigned xb_ld(unsigned* p) { return __hip_atomic_load(p, __ATOMIC_RELAXED, __HIP_MEMORY_SCOPE_AGENT); }
DI unsigned xb_add(unsigned* p, unsigned v) { return __hip_atomic_fetch_add(p, v, __ATOMIC_RELAXED, __HIP_MEMORY_SCOPE_AGENT); }
DI unsigned xb_xcc_id() { return (unsigned)__builtin_amdgcn_s_getreg((3 << 11) | 20) & 0xFu; }
#define XB_SPIN(cond, bar) do { unsigned _sp = 0; while (cond) { __builtin_amdgcn_s_sleep(1); \
    if ((++_sp & 255u) == 0u) { if (xb_ld(&(bar)[XB_TMO])) break; if (_sp > XB_SPIN_CAP) { atomicAdd(&(bar)[XB_TMO], 1u); break; } } } } while (0)
DI void xcd_barrier_complete(unsigned* bar, unsigned x, unsigned& nloc, unsigned& nx) {
  const unsigned G = gridDim.x * gridDim.y * gridDim.z;
  unsigned sum, cnt, mine, sp = 0u;
  for (;;) {
    sum = 0u; cnt = 0u; mine = 0u;
#pragma unroll
    for (unsigned j = 0; j < 16; ++j) { const unsigned c = xb_ld(&bar[XB_XCNT(j)]); sum += c; cnt += (c > 0u) ? 1u : 0u; mine = (j == x) ? c : mine; }
    if (sum == G) break;
    __builtin_amdgcn_s_sleep(1);
    if ((++sp & 255u) == 0u) { if (xb_ld(&bar[XB_TMO])) break; if (sp > XB_SPIN_CAP) { atomicAdd(&bar[XB_TMO], 1u); break; } }
  }
  nloc = mine > 0u ? mine : 1u; nx = cnt > 0u ? cnt : 1u;
}
DI void xcd_barrier(unsigned* bar, const int tix) {
  asm volatile("s_waitcnt vmcnt(0)" ::: "memory");
  __syncthreads();
  if (tix == 0) {
    volatile XB_LAS unsigned* st = (volatile XB_LAS unsigned*)((XB_LAS unsigned char*)dyn_smem + XB_LDS_OFF);
    const unsigned x = xb_xcc_id();
    __builtin_amdgcn_s_waitcnt(0);
    unsigned nloc = st[0], nx = st[1];
    if (nloc == 0u) { xcd_barrier_complete(bar, x, nloc, nx); st[0] = nloc; st[1] = nx; }
    const unsigned old = xb_add(&bar[XB_XSUB(x)], 1u);
    const unsigned gen = old / nloc;
    if (old + 1u == (gen + 1u) * nloc) {
      __builtin_amdgcn_fence(__ATOMIC_RELEASE, "agent");
      asm volatile("s_waitcnt vmcnt(0)" ::: "memory");
      const unsigned og = xb_add(&bar[XB_TOP], 1u);
      const unsigned tg = og / nx;
      if (og + 1u == (tg + 1u) * nx) xb_add(&bar[XB_TOPGEN], 1u);
      else XB_SPIN(xb_ld(&bar[XB_TOPGEN]) == tg, bar);
      __builtin_amdgcn_fence(__ATOMIC_ACQUIRE, "agent");
      xb_add(&bar[XB_XGEN(x)], 1u);
      asm volatile("s_waitcnt vmcnt(0)" ::: "memory");
    } else {
      XB_SPIN(xb_ld(&bar[XB_XGEN(x)]) == gen, bar);
      __builtin_amdgcn_fence(__ATOMIC_ACQUIRE, "agent");
      asm volatile("s_waitcnt vmcnt(0)" ::: "memory");
    }
  }
  __syncthreads();
}

DI int tok2v(int tok) {
  if (tok < LPR) { const int l1 = tok >> 7, l2 = tok & 127; return ((l2 & 63) << 8) | ((l2 >> 6) << 7) | l1; }
  const int ts = tok - LPR, w = ts & 4095, l1 = w >> 6, l2 = w & 63;
  return LPR + (ts & ~4095) + (((l2 & 15) << 8) | ((l2 >> 4) << 6) | l1);
}
DI int v2tok(int v) {
  if (v < LPR) return ((v & 127) << 7) | (((v >> 7) & 1) << 6) | (v >> 8);
  const int vs = v - LPR, w = vs & 4095;
  return LPR + (vs & ~4095) + (((w & 63) << 6) | (((w >> 6) & 3) << 4) | (w >> 8));
}
DI int batch_of(int tok) { return tok < LPR ? 0 : 1 + ((tok - LPR) >> 12); }
DI float gelu_tanh(float x) {
  const float u = 0.7978845608028654f * (x + 0.044715f * x * x * x);
  return x / (1.f + __expf(-2.f * u));
}
DI float wave_sum(float v) {
  v += __shfl_xor(v, 32); v += __shfl_xor(v, 16); v += __shfl_xor(v, 8); v += __shfl_xor(v, 4); v += __shfl_xor(v, 2); v += __shfl_xor(v, 1);
  return v;
}

DI void ssm_pow(const P& p, int g, int dir, int pp, int j, float& re, float& im) {
  const int ia = (dir * 32 + g) * 64 + pp;
  const float lr = fminf(p.a_re[ia], -1e-4f), li = p.a_im[ia], dt = expf(p.log_dt[dir * 32 + g]);
  const float mag = expf(lr * dt * (float)j);
  double t = (double)li * (double)dt * (double)j * 0.15915494309189535;
  t -= rint(t);
  const float ang = (float)(t * 6.283185307179586);
  float s, c; sincosf(ang, &s, &c);
  re = mag * c; im = mag * s;
}
DI void ssm_coef(const P& p, int g, int dir, int pp, float& cr, float& ci) {
  const int ia = (dir * 32 + g) * 64 + pp;
  const float lr = fminf(p.a_re[ia], -1e-4f), li = p.a_im[ia];
  float ar, ai; ssm_pow(p, g, dir, pp, 1, ar, ai);
  const float nr = ar - 1.f, ni = ai, den = 1.f / (lr * lr + li * li);
  cr = (nr * lr + ni * li) * den; ci = (ni * lr - nr * li) * den;
}

template <class CM>
DI void transpose_job(float* tile, const int tid, bool act, int item2, const float* in, int ld, int Kdim, bf16_t* out, const CM& colmap, const float* sc0, const float* sc1) {
  const int nkt = Kdim / 64;
  __syncthreads();
  if (act) {
    float v[16];
#pragma unroll
    for (int u = 0; u < 2; u++) {
      const int item = 2 * item2 + u, nt = item / nkt, kt = item % nkt;
      const int c = tid & 31, kr = tid >> 5, col = colmap(nt * 32 + c);
#pragma unroll
      for (int i = 0; i < 8; i++) v[u * 8 + i] = in[(size_t)(kt * 64 + kr + 8 * i) * ld + col];
    }
#pragma unroll
    for (int u = 0; u < 2; u++) {
      const int item = 2 * item2 + u, kt = item % nkt;
      const int c = tid & 31, kr = tid >> 5;
#pragma unroll
      for (int i = 0; i < 8; i++) {
        const int kl = kr + 8 * i, k = kt * 64 + kl;
        float x = v[u * 8 + i];
        if (sc0) x *= (k < 512 ? sc0[k] : sc1[k - 512]);
        tile[u * 64 * 33 + kl * 33 + c] = x;
      }
    }
  }
  __syncthreads();
  if (act) {
#pragma unroll
    for (int u = 0; u < 2; u++) {
      const int item = 2 * item2 + u, nt = item / nkt, kt = item % nkt;
      const int nl = tid >> 3, kc = tid & 7;
      float x[8];
#pragma unroll
      for (int j = 0; j < 8; j++) x[j] = tile[u * 64 * 33 + (kc * 8 + j) * 33 + nl];
      uint4 w; w.x = pk2(x[0], x[1]); w.y = pk2(x[2], x[3]); w.z = pk2(x[4], x[5]); w.w = pk2(x[6], x[7]);
      *(uint4*)(out + (size_t)(nt * 32 + nl) * Kdim + kt * 64 + kc * 8) = w;
    }
  }
}

DI void phase0(const P& p, const int wv) {
  const int tix = otid(wv);
  unsigned char* smraw = dyn_smem + (tix >> 8) * SMEM_HALF;
  float* smf = (float*)smraw;
  const int tid = tix & 255, nb = gridDim.x * 2, bid = blockIdx.x * 2 + (tix >> 8);
  for (int base = 0; base < 384; base += nb) {
    const int item = base + bid; const bool act = item < 384;
    const int cg = act ? item % 96 : 0, ks = act ? item / 96 : 0;
    __syncthreads();
    if (act)
      for (int i = tid; i < 17 * 256; i += 256) {
        const int b = i >> 8, k = ks * 256 + (i & 255);
        const float c = b == 0 ? p.cp[k] : p.cs[(b - 1) * 1024 + k];
        smf[i] = c / (1.f + __expf(-c));
      }
    __syncthreads();
    const int col = tid & 63, sub = tid >> 6, j = cg * 64 + col;
    float a[17];
#pragma unroll
    for (int b = 0; b < 17; b++) a[b] = 0.f;
    if (act) {
#pragma unroll 1
      for (int bt = 0; bt < 4; bt++) {
        const int k0 = sub * 64 + bt * 16;
        float w[16];
#pragma unroll
        for (int i = 0; i < 16; i++) w[i] = p.w_ada[(size_t)(ks * 256 + k0 + i) * 6144 + j];
#pragma unroll
        for (int i = 0; i < 16; i++)
#pragma unroll
          for (int b = 0; b < 17; b++) a[b] += smf[b * 256 + k0 + i] * w[i];
      }
    }
    float* red = smf + 17 * 256;
#pragma unroll
    for (int b = 0; b < 17; b++) red[(sub * 17 + b) * 64 + col] = a[b];
    __syncthreads();
    if (act)
      for (int i = tid; i < 17 * 64; i += 256) {
        const int b = i >> 6, c2 = i & 63;
        float sum = red[(0 * 17 + b) * 64 + c2] + red[(1 * 17 + b) * 64 + c2] + red[(2 * 17 + b) * 64 + c2] + red[(3 * 17 + b) * 64 + c2];
        if (ks == 0) sum += p.b_ada[cg * 64 + c2];
        atomicAdd(p.mod() + b * 6144 + cg * 64 + c2, sum);
      }
  }
  {
    auto ident = [](int n) { return n; };
    auto glumap = [](int n) { return ((n >> 7) & 1) * 512 + (n >> 8) * 128 + (n & 127); };
    const int n0 = 256, n1 = n0 + 128, n2 = n1 + 256, n3 = n2 + 1024, n4 = n3 + 1024;
    for (int base = 0; base < n4; base += nb) {
      const int item = base + bid; const bool act = item < n4;
      if (item < n0) transpose_job(smf, tid, act, item, p.w_in, 1024, 1024, p.wint(), ident, nullptr, nullptr);
      else if (item < n1) transpose_job(smf, tid, act, item - n0, p.w_glu, 1024, 512, p.wglut(), glumap, nullptr, nullptr);
      else if (item < n2) transpose_job(smf, tid, act, item - n1, p.w_out, 1024, 1024, p.woutt(), ident, p.g_fo, p.g_so);
      else if (item < n3) transpose_job(smf, tid, act, item - n2, p.w1, 4096, 1024, p.w1t(), ident, nullptr, nullptr);
      else transpose_job(smf, tid, act, item - n3, p.w2, 1024, 4096, p.w2t(), ident, nullptr, nullptr);
    }
  }
  {
    __syncthreads();
    float2* cs = (float2*)smraw;
    for (int i = tid; i < 512; i += 256) { float s, c; sincosf((float)i * (6.283185307179586f / 512.f), &s, &c); cs[i] = make_float2(c, s); }
    __syncthreads();
    for (int item = bid; item < 128; item += nb) {
      const int idx = item * 256 + tid, k = idx & 1023, he = idx >> 10, h = he >> 3, e0 = (he & 7) * 16, c = k & 511;
      const bool is_sin = k >= 512;
      const float* wf = p.w_f + (size_t)h * 128 * 128 + e0;
      float a[16];
#pragma unroll
      for (int e = 0; e < 16; e++) a[e] = 0.f;
#pragma unroll 4
      for (int d = 0; d < 128; d++) {
        const float2 t = cs[((h * 128 + d) * c) & 511];
        const float tv = is_sin ? t.y : t.x;
        const f32x4 w0 = *(const f32x4*)(wf + d * 128), w1 = *(const f32x4*)(wf + d * 128 + 4), w2 = *(const f32x4*)(wf + d * 128 + 8), w3 = *(const f32x4*)(wf + d * 128 + 12);
#pragma unroll
        for (int e = 0; e < 4; e++) { a[e] += tv * w0[e]; a[4 + e] += tv * w1[e]; a[8 + e] += tv * w2[e]; a[12 + e] += tv * w3[e]; }
      }
#pragma unroll
      for (int e = 0; e < 16; e++) p.Mf()[(size_t)(h * 128 + e0 + e) * 1024 + k] = f2bf(a[e]);
    }
  }
  {
    const int gsz = nb * 256, gt = bid * 256 + tid;
    for (int i = gt; i < 1024 * 256; i += gsz) {
      const int nrg = i >> 8, k = i & 255, tb = nrg >> 9, nr = nrg & 511, part = (nr >> 7) & 1, idx8 = ((nr >> 8) << 7) | (nr & 127);
      const int R = tb ? 64 : 128, sh = tb ? 6 : 7, l2p = idx8 >> sh, k1 = idx8 & (R - 1), l2k = k >> sh, l1 = k & (R - 1);
      float sv, cv; sincosf((float)((k1 * l1) & (R - 1)) * (6.283185307179586f / (float)R), &sv, &cv);
      p.Fb1()[i] = f2bf(l2k == l2p ? (part ? -sv : cv) : 0.f);
    }
    for (int i = gt; i < 512 * 256; i += gsz) {
      const int nrg = i >> 8, k = i & 255, tb = nrg >> 8, nr = nrg & 255;
      float v;
      if (tb == 0) {
        const int part = nr >> 7, k2 = nr & 127, ki = k >> 7, l2 = k & 127;
        float sv, cv; sincosf((float)((k2 * l2) & 127) * (6.283185307179586f / 128.f), &sv, &cv);
        v = part == 0 ? (ki == 0 ? cv : sv) : (ki == 0 ? -sv : cv);
      } else {
        const int blk = nr >> 7, n2 = nr & 127, part = n2 >> 6, k2 = n2 & 63, kb = k >> 7, kk = k & 127, ki = kk >> 6, l2 = kk & 63;
        float sv, cv; sincosf((float)((k2 * l2) & 63) * (6.283185307179586f / 64.f), &sv, &cv);
        v = blk == kb ? (part == 0 ? (ki == 0 ? cv : sv) : (ki == 0 ? -sv : cv)) : 0.f;
      }
      p.Fb2()[i] = f2bf(v);
    }
    for (int i = gt; i < LPR; i += gsz) { float s, c; sincosf((float)i * (6.283185307179586f / 16384.f), &s, &c); p.twp()[i] = make_float2(c, s); }
    for (int i = gt; i < LSM; i += gsz) { float s, c; sincosf((float)i * (6.283185307179586f / 4096.f), &s, &c); p.tws()[i] = make_float2(c, s); }
    for (int i = gt; i < 32 * 2 * 64 * 64; i += gsz) {
      const int s = i & 63, pp = (i >> 6) & 63, dir = (i >> 12) & 1, g = i >> 13;
      float pr, pi, cr, ci; ssm_pow(p, g, dir, pp, dir == 0 ? 63 - s : s, pr, pi); ssm_coef(p, g, dir, pp, cr, ci);
      const float qr = pr * cr - pi * ci, qi = pr * ci + pi * cr;
      const int ib = ((dir * 32 + g) * 64 + pp) * 16;
      float vr[16], vi[16];
#pragma unroll
      for (int h = 0; h < 16; h++) { const float br = p.b_re[ib + h], bi = p.b_im[ib + h]; vr[h] = qr * br - qi * bi; vi[h] = qr * bi + qi * br; }
      bf16_t* d0 = p.Bs() + ((size_t)(g * 256 + dir * 128 + pp)) * 1024 + s * 16;
      bf16_t* d1 = d0 + 64 * 1024;
      uint4 w;
      w.x = pk2(vr[0], vr[1]); w.y = pk2(vr[2], vr[3]); w.z = pk2(vr[4], vr[5]); w.w = pk2(vr[6], vr[7]); *(uint4*)d0 = w;
      w.x = pk2(vr[8], vr[9]); w.y = pk2(vr[10], vr[11]); w.z = pk2(vr[12], vr[13]); w.w = pk2(vr[14], vr[15]); *(uint4*)(d0 + 8) = w;
      w.x = pk2(vi[0], vi[1]); w.y = pk2(vi[2], vi[3]); w.z = pk2(vi[4], vi[5]); w.w = pk2(vi[6], vi[7]); *(uint4*)d1 = w;
      w.x = pk2(vi[8], vi[9]); w.y = pk2(vi[10], vi[11]); w.z = pk2(vi[12], vi[13]); w.w = pk2(vi[14], vi[15]); *(uint4*)(d1 + 8) = w;
    }
    for (int i = gt; i < 32 * 64 * 2 * 64; i += gsz) {
      const int pp = i & 63, dir = (i >> 6) & 1, t = (i >> 7) & 63, g = i >> 13;
      float pr, pi; ssm_pow(p, g, dir, pp, dir == 0 ? t + 1 : 64 - t, pr, pi);
#pragma unroll
      for (int h = 0; h < 16; h++) {
        const int ic = ((dir * 32 + g) * 16 + h) * 64 + pp;
        const float cr = p.c_re[ic], ci = p.c_im[ic];
        bf16_t* d = p.Tcat() + ((size_t)(g * 1024 + t * 16 + h)) * 1280 + 1024 + dir * 128 + pp;
        d[0] = f2bf(cr * pr - ci * pi);
        d[64] = f2bf(-(cr * pi + ci * pr));
      }
    }
    for (int i = gt; i < 32 * 2 * 64; i += gsz) {
      const int pp = i & 63, dir = (i >> 6) & 1, g = i >> 7;
      float pr, pi; ssm_pow(p, g, dir, pp, 64, pr, pi);
      p.AT()[i * 2] = pr; p.AT()[i * 2 + 1] = pi;
    }
  }
  {
    float2* q = (float2*)smraw;
    float2* q1 = q + 512;
    float2* Cs = q + 576;
    float2* Bm = Cs + 2048;
    float2* E = Bm + 2048;
    for (int base = 0; base < 512; base += nb) {
      const int item = base + bid; const bool act = item < 512;
      const int g = act ? item >> 4 : 0, ch = act ? item & 15 : 0;
      __syncthreads();
      for (int e = tid; e < 512; e += 256) {
        const int j = e >> 6, pp = e & 63, jj = ch * 8 + j, lag = jj - 63;
        float2 v = make_float2(0.f, 0.f);
        if (jj < 127) {
          const int dir = lag >= 0 ? 0 : 1;
          float pr, pi, cr, ci; ssm_pow(p, g, dir, pp, lag < 0 ? -lag : lag, pr, pi); ssm_coef(p, g, dir, pp, cr, ci);
          v = make_float2(pr * cr - pi * ci, pr * ci + pi * cr);
        }
        q[e] = v;
      }
      if (tid < 64) { float cr, ci; ssm_coef(p, g, 1, tid, cr, ci); q1[tid] = make_float2(cr, ci); }
      for (int i = tid; i < 2048; i += 256) {
        const int dir = i >> 10, j = i & 1023, src = (dir * 32 + g) * 1024 + j;
        Cs[i] = make_float2(p.c_re[src], p.c_im[src]); Bm[i] = make_float2(p.b_re[src], p.b_im[src]);
      }
      const int hp = tid >> 4, h = tid & 15;
      float a0 = 0.f;
#pragma unroll 1
      for (int ps = 0; ps < 9; ps++) {
        const int j = ps < 8 ? ps : 7, jj = ch * 8 + j, lag = jj - 63;
        const bool valid = ps < 8 ? (jj < 127) : (jj == 63);
        const int dir = ps < 8 ? (lag >= 0 ? 0 : 1) : 1;
        const float2* qs = ps < 8 ? q + j * 64 : q1;
        __syncthreads();
        for (int i = tid; i < 1024; i += 256) {
          const float2 cc = Cs[dir * 1024 + i], qq = qs[i & 63];
          E[i] = make_float2(cc.x * qq.x - cc.y * qq.y, cc.x * qq.y + cc.y * qq.x);
        }
        __syncthreads();
        float a = 0.f;
        if (valid) {
#pragma unroll 8
          for (int pp = 0; pp < 64; pp++) { const float2 ee = E[hp * 64 + pp], bb = Bm[dir * 1024 + pp * 16 + h]; a += ee.x * bb.x - ee.y * bb.y; }
        }
        bool st = valid && act;
        if (ps < 8 && lag == 0) { a0 = a; st = false; }
        if (ps == 8) { a += a0; if (hp == h) a += p.ssm_d[g * 16 + h]; }
        if (st) {
          const bf16_t kv = f2bf(a);
          const int t0 = lag > 0 ? lag : 0, t1 = lag > 0 ? 64 : 64 + lag;
          bf16_t* d = p.Tcat() + ((size_t)(g * 1024 + hp)) * 1280 + h;
          for (int t = t0; t < t1; t++) d[(size_t)t * 16 * 1280 + (t - lag) * 16] = kv;
        }
      }
    }
  }
}

constexpr int RIF = 2;
DI float bflo(uint32_t u) { return __uint_as_float(u << 16); }
DI float bfhi(uint32_t u) { return __uint_as_float(u & 0xffff0000u); }
template <bool FROMX>
DI void rownorm_mod(const P& p, const int wv, const float* g, int sh_off, int sc_off) {
  const int tix = otid(wv), lane = tix & 63, wrow = blockIdx.x * 8 + (tix >> 6), nw = gridDim.x * 8;
  if (FROMX) {
    for (int i = blockIdx.x * 512 + tix; i < 4096 * 32; i += gridDim.x * 512) {
      const int col = i & 4095, ks = i >> 12;
      float a[17];
#pragma unroll
      for (int b = 0; b < 17; b++) a[b] = 0.f;
#pragma unroll 8
      for (int k = ks * 32; k < ks * 32 + 32; k++) {
        const float w = p.w1[(size_t)k * 4096 + col];
#pragma unroll
        for (int b = 0; b < 17; b++) a[b] += p.mod()[b * 6144 + 3072 + k] * w;
      }
      const float b1v = ks == 0 ? p.b1[col] : 0.f;
#pragma unroll
      for (int b = 0; b < 17; b++) atomicAdd(p.sb2() + b * 4096 + col, a[b] + b1v);
    }
  }
  for (int tok0 = wrow; tok0 < NTOK; tok0 += RIF * nw) {
    float v[RIF][16]; float ss[RIF];
#pragma unroll
    for (int rr = 0; rr < RIF; rr++) {
      const int tok = tok0 + rr * nw;
      if (tok < NTOK) {
        if (FROMX) {
          const float* src = tok < LPR ? p.xp + (size_t)tok * 1024 : p.xs + (size_t)(tok - LPR) * 1024;
#pragma unroll
          for (int i = 0; i < 4; i++) { const f32x4 t = *(const f32x4*)(src + (i * 64 + lane) * 4); v[rr][4 * i] = t[0]; v[rr][4 * i + 1] = t[1]; v[rr][4 * i + 2] = t[2]; v[rr][4 * i + 3] = t[3]; }
        } else {
          const bf16_t* src = (const bf16_t*)p.out + (size_t)tok * 1024;
#pragma unroll
          for (int i = 0; i < 2; i++) { const uint4 t = *(const uint4*)(src + (i * 64 + lane) * 8);
            v[rr][8 * i] = bflo(t.x); v[rr][8 * i + 1] = bfhi(t.x); v[rr][8 * i + 2] = bflo(t.y); v[rr][8 * i + 3] = bfhi(t.y);
            v[rr][8 * i + 4] = bflo(t.z); v[rr][8 * i + 5] = bfhi(t.z); v[rr][8 * i + 6] = bflo(t.w); v[rr][8 * i + 7] = bfhi(t.w); }
        }
      } else {
#pragma unroll
        for (int e = 0; e < 16; e++) v[rr][e] = 0.f;
      }
    }
#pragma unroll
    for (int rr = 0; rr < RIF; rr++) {
      ss[rr] = 0.f;
#pragma unroll
      for (int e = 0; e < 16; e++) ss[rr] += v[rr][e] * v[rr][e];
      ss[rr] = wave_sum(ss[rr]);
    }
#pragma unroll
    for (int rr = 0; rr < RIF; rr++) {
      const int tok = tok0 + rr * nw;
      if (tok >= NTOK) continue;
      const float r = rsqrtf(ss[rr] * (1.f / 1024.f) + EPSV);
      const float* md = p.mod() + batch_of(tok) * 6144;
      bf16_t* drow = p.hb() + (size_t)(FROMX ? tok2v(tok) : tok) * 1024;
      float o[16];
#pragma unroll
      for (int q = 0; q < 4; q++) {
        const int c = FROMX ? (q * 64 + lane) * 4 : ((q >> 1) * 64 + lane) * 8 + (q & 1) * 4;
        const f32x4 gg = *(const f32x4*)(g + c);
        f32x4 sc = *(const f32x4*)(md + sc_off + c), sh = *(const f32x4*)(md + sh_off + c);
#pragma unroll
        for (int e = 0; e < 4; e++) o[4 * q + e] = v[rr][4 * q + e] * r * gg[e] * (1.f + sc[e]) + sh[e];
      }
      if (FROMX) {
#pragma unroll
        for (int q = 0; q < 4; q++) { uint2 w; w.x = pk2(o[4 * q], o[4 * q + 1]); w.y = pk2(o[4 * q + 2], o[4 * q + 3]); *(uint2*)(drow + (q * 64 + lane) * 4) = w; }
      } else {
#pragma unroll
        for (int i = 0; i < 2; i++) { uint4 w; w.x = pk2(o[8 * i], o[8 * i + 1]); w.y = pk2(o[8 * i + 2], o[8 * i + 3]); w.z = pk2(o[8 * i + 4], o[8 * i + 5]); w.w = pk2(o[8 * i + 6], o[8 * i + 7]);
          *(uint4*)(drow + (i * 64 + lane) * 8) = w; }
      }
    }
  }
}
DI void final_norm(const P& p, const int wv) {
  const int tix = otid(wv), lane = tix & 63, wrow = blockIdx.x * 8 + (tix >> 6), nw = gridDim.x * 8;
  for (int tok0 = wrow; tok0 < NTOK; tok0 += RIF * nw) {
    float v[RIF][16]; float ss[RIF];
#pragma unroll
    for (int rr = 0; rr < RIF; rr++) {
      const int tok = tok0 + rr * nw;
      if (tok < NTOK) {
        const bf16_t* src = p.hb() + (size_t)tok * 1024;
#pragma unroll
        for (int i = 0; i < 2; i++) { const uint4 t = *(const uint4*)(src + (i * 64 + lane) * 8);
          v[rr][8 * i] = bflo(t.x); v[rr][8 * i + 1] = bfhi(t.x); v[rr][8 * i + 2] = bflo(t.y); v[rr][8 * i + 3] = bfhi(t.y);
          v[rr][8 * i + 4] = bflo(t.z); v[rr][8 * i + 5] = bfhi(t.z); v[rr][8 * i + 6] = bflo(t.w); v[rr][8 * i + 7] = bfhi(t.w); }
      } else {
#pragma unroll
        for (int e = 0; e < 16; e++) v[rr][e] = 0.f;
      }
    }
#pragma unroll
    for (int rr = 0; rr < RIF; rr++) {
      ss[rr] = 0.f;
#pragma unroll
      for (int e = 0; e < 16; e++) ss[rr] += v[rr][e] * v[rr][e];
      ss[rr] = wave_sum(ss[rr]);
    }
#pragma unroll
    for (int rr = 0; rr < RIF; rr++) {
      const int tok = tok0 + rr * nw;
      if (tok >= NTOK) continue;
      const float r = rsqrtf(ss[rr] * (1.f / 1024.f) + EPSV);
      float* drow = p.out + (size_t)tok * 1024;
#pragma unroll
      for (int q = 0; q < 4; q++) {
        const int c = ((q >> 1) * 64 + lane) * 8 + (q & 1) * 4;
        const f32x4 gg = *(const f32x4*)(p.g_final + c);
        f32x4 o;
#pragma unroll
        for (int e = 0; e < 4; e++) o[e] = v[rr][4 * q + e] * r * gg[e];
        *(f32x4*)(drow + c) = o;
      }
    }
  }
}

namespace pg8 {
#define PG8_LAS __attribute__((address_space(3)))
typedef unsigned short bf16_t;
typedef short bf16x8 __attribute__((ext_vector_type(8)));
typedef float f32x4 __attribute__((ext_vector_type(4)));
typedef unsigned u32x4 __attribute__((ext_vector_type(4)));
constexpr int BM = 256, BK = 64, HALF = 128, HTB = HALF * BK * 2  , STAGE_BYTES = 8 * HTB, NXCD = 8, WGM = 8;

__host__ __device__ __forceinline__ int lds_byte(int r, int c) { const int st = (r >> 4) * 2 + (c >> 5), rr = r & 15, cc = c & 31, ob = rr * 64 + cc * 2; return st * 1024 + (ob ^ (((ob >> 9) & 1) << 5)); }
__host__ __device__ __forceinline__ void stage_rc(int b, int& R, int& C) { const int st = b / 1024, sb = b % 1024, swz = sb ^ (((sb >> 9) & 1) << 5); R = (st >> 1) * 16 + swz / 64; C = (st & 1) * 32 + (swz % 64) / 2; }
__host__ __device__ __forceinline__ int perm32(int rho) { const int n = rho >> 4, i = rho & 15; return 8 * (i >> 2) + 4 * n + (i & 3); }

struct Unit { int pm, pn; };
struct Gemm { const bf16_t* A; const bf16_t* Bt; int M, N, K, lda, ldb; };

struct StaticOrder {
    int nM, nN, nwg, G, c;
    __host__ __device__ void init(int M, int N, int G_, int c_) { nM = M / BM; nN = N / BM; nwg = nM * nN; G = G_; c = c_; }
    __host__ __device__ bool next(int i, Unit& u) const {
        const long L = (long)i * G + c; if (L >= nwg) return false;
        int wgid = (int)L; { const int q = nwg / NXCD, r = nwg % NXCD, xcd = wgid % NXCD, off = wgid / NXCD; wgid = (xcd < r ? xcd * (q + 1) : r * (q + 1) + (xcd - r) * q) + off; }
        const int nig = WGM * nN, gid = wgid / nig, fm = gid * WGM, gsz = (nM - fm) < WGM ? (nM - fm) : WGM;
        u.pm = fm + ((wgid % nig) % gsz); u.pn = (wgid % nig) / gsz; return true;
    }
    __device__ __forceinline__ void a_ready(const Unit&) const {}
    __device__ __forceinline__ void done(const Unit&) const {}
};

struct GroupOrder {
    int nwg, G, c, um, un;
    __host__ __device__ void init(int ngroups, int um_, int un_, int G_, int c_) { um = um_; un = un_; nwg = ngroups * um * un; G = G_; c = (c_ & 7) * (G_ >> 3) + (c_ >> 3); }
    __host__ __device__ bool next(int i, Unit& u) const {
        const int L = i * G + c; if (L >= nwg) return false;
        const int gi = L / (um * un), r = L % (um * un); u.pm = gi * um + r / un; u.pn = gi * un + r % un; return true;
    }
    __device__ __forceinline__ void a_ready(const Unit&) const {}
    __device__ __forceinline__ void done(const Unit&) const {}
};
struct Fft1Order {
    int q0, qs, qe;
    __host__ __device__ void init(int G, int bidx) {
        const int slot = (bidx & 7) * (G >> 3) + (bidx >> 3), nbusy = 160 < G ? 160 : G, nfree = G - nbusy;
        if (nfree <= 0) { q0 = slot; qs = G; qe = 1280; }
        else if (slot < nbusy) { q0 = slot; qs = nbusy; qe = 560; }
        else { q0 = 560 + (slot - nbusy); qs = nfree; qe = 1280; }
    }
    __host__ __device__ bool next(int i, Unit& u) const { const int L = q0 + i * qs; if (L >= qe) return false; u.pn = L >> 1; u.pm = (L & 1) + (u.pn >= 128 ? 2 : 0); return true; }
    __device__ __forceinline__ void a_ready(const Unit&) const {}
    __device__ __forceinline__ void done(const Unit&) const {}
};
struct Fft2Order {
    int G, c;
    __host__ __device__ void init(int G_, int c_) { G = G_; c = c_; }
    __host__ __device__ bool next(int i, Unit& u) const { const int L = i * G + c; if (L >= 1280) return false; u.pn = L; u.pm = L < 256 ? 0 : 1; return true; }
    __device__ __forceinline__ void a_ready(const Unit&) const {}
    __device__ __forceinline__ void done(const Unit&) const {}
};
struct YfOrder {
    int G, c;
    __host__ __device__ void init(int G_, int bidx) { G = G_; const int slot = (bidx & 7) * (G_ >> 3) + (bidx >> 3); c = (slot + (G_ >> 1)) % G_; }
    __host__ __device__ bool next(int i, Unit& u) const { const int L = i * G + c; if (L >= 640) return false; u.pm = L >> 1; u.pn = L & 1; return true; }
    __device__ __forceinline__ void a_ready(const Unit&) const {}
    __device__ __forceinline__ void done(const Unit&) const {}
};
template <class Epi, class Sched, bool ALIGN_EPI = false, bool SP2 = false>
__device__ __forceinline__ void gemm_phase(PG8_LAS unsigned char* lds, const int tix, const Gemm g, const Sched& S, const Epi& E) {
    const int tid = tix, wid = __builtin_amdgcn_readfirstlane(tid >> 6), lane = tid & 63, wr = wid >> 2, wc = wid & 3, fr = lane & 15, fq = lane >> 4;
    const int K = g.K, nt = K / BK;
    unsigned voffA[2], voffB[2];
#pragma unroll
    for (int i = 0; i < 2; ++i) { int R, C; stage_rc(tid * 16 + i * 8192, R, C); const int Rb = Epi::PERM ? ((R & ~31) + perm32(R & 31)) : R;
        voffA[i] = (unsigned)(R * g.lda + C) * 2u; voffB[i] = (unsigned)(Rb * g.ldb + C) * 2u; }
    const size_t kstep = (size_t)(BK * 2);
    const size_t hstepA = (size_t)HALF * g.lda * 2, hstepB = (size_t)HALF * g.ldb * 2;
    const size_t tstepA = 2 * hstepA, tstepB = 2 * hstepB;
    const unsigned ldsw = (unsigned)wid * 1024u;
    const int aoff = lds_byte(wr * 64 + fr, fq * 8), boff = lds_byte(wc * 32 + fr, fq * 8);
#define PG8_SA(b, h) (((b) * 2 + (h)) * HTB)
#define PG8_SB(b, h) ((4 + (b) * 2 + (h)) * HTB)
#define PG8_STAGE(bufoff, gbase, voff) do { _Pragma("unroll") for (int _i = 0; _i < 2; ++_i) \
        __builtin_amdgcn_global_load_lds((const unsigned*)((const char*)(gbase) + (voff)[_i]), (PG8_LAS unsigned*)(lds + (bufoff) + ldsw + _i * 8192), 16, 0, 0); } while (0)
#define PG8_LDA(dst, b, h) do { _Pragma("unroll") for (int m = 0; m < 4; ++m) _Pragma("unroll") for (int k = 0; k < 2; ++k) dst[m][k] = *(const PG8_LAS bf16x8*)(lds + PG8_SA(b, h) + aoff + m * 2048 + k * 1024); } while (0)
#define PG8_LDB(dst, b, h) do { _Pragma("unroll") for (int n = 0; n < 2; ++n) _Pragma("unroll") for (int k = 0; k < 2; ++k) dst[n][k] = *(const PG8_LAS bf16x8*)(lds + PG8_SB(b, h) + boff + n * 2048 + k * 1024); } while (0)
#define PG8_MMA(ai, bj, At, Bt) do { __builtin_amdgcn_s_setprio(1); _Pragma("unroll") for (int m = 0; m < 4; ++m) _Pragma("unroll") for (int n = 0; n < 2; ++n) _Pragma("unroll") for (int k = 0; k < 2; ++k) \
        acc[ai][bj][m][n] = __builtin_amdgcn_mfma_f32_16x16x32_bf16(Bt[n][k], At[m][k], acc[ai][bj][m][n], 0, 0, 0); __builtin_amdgcn_s_setprio(0); } while (0)
#define PG8_WAIT_V(n) asm volatile("s_waitcnt vmcnt(" #n ")" ::: "memory")
#define PG8_WAIT_L(n) asm volatile("s_waitcnt lgkmcnt(" #n ")" ::: "memory")
#define PG8_BAR __builtin_amdgcn_s_barrier()
#define PG8_SCHED __builtin_amdgcn_sched_barrier(0)
    Unit cur, nxt; int ui = 0;
    if (!S.next(0, cur)) return;
    f32x4 acc[2][2][4][2];
#pragma unroll
    for (int a = 0; a < 2; ++a)
#pragma unroll
        for (int b = 0; b < 2; ++b)
#pragma unroll
            for (int m = 0; m < 4; ++m)
#pragma unroll
                for (int n = 0; n < 2; ++n) acc[a][b][m][n] = (f32x4){0.f, 0.f, 0.f, 0.f};
    bf16x8 At[4][2], B0[2][2], B1[2][2];
    const char* cA = (const char*)g.A + (size_t)cur.pm * tstepA; const char* cB = (const char*)g.Bt + (size_t)cur.pn * tstepB;
    S.a_ready(cur);
    if constexpr (SP2) {
        PG8_STAGE(PG8_SB(0, 0), cB, voffB); PG8_STAGE(PG8_SB(0, 1), cB + hstepB, voffB); PG8_STAGE(PG8_SA(0, 0), cA, voffA); PG8_STAGE(PG8_SA(0, 1), cA + hstepA, voffA);
        if (wr == 1) PG8_BAR;
        PG8_WAIT_V(2); PG8_BAR;
        PG8_STAGE(PG8_SB(1, 0), cB + kstep, voffB); PG8_STAGE(PG8_SA(1, 0), cA + kstep, voffA); PG8_STAGE(PG8_SB(1, 1), cB + hstepB + kstep, voffB);
        PG8_WAIT_V(6); PG8_BAR;
    } else {
        PG8_STAGE(PG8_SB(0, 0), cB, voffB); PG8_STAGE(PG8_SA(0, 0), cA, voffA); PG8_STAGE(PG8_SB(0, 1), cB + hstepB, voffB); PG8_STAGE(PG8_SA(0, 1), cA + hstepA, voffA);
        if (wr == 1) PG8_BAR;
        PG8_WAIT_V(4); PG8_BAR;
        PG8_STAGE(PG8_SB(1, 0), cB + kstep, voffB); PG8_STAGE(PG8_SA(1, 0), cA + kstep, voffA); PG8_STAGE(PG8_SB(1, 1), cB + hstepB + kstep, voffB);
        PG8_WAIT_V(6); PG8_BAR;
    }
    for (;;) {
        const bool has_next = S.next(ui + 1, nxt);
        const char* nA = has_next ? (const char*)g.A + (size_t)nxt.pm * tstepA : cA; const char* nB = has_next ? (const char*)g.Bt + (size_t)nxt.pn * tstepB : cB;
        for (int t = 0; t < nt; t += 2) {
            if constexpr (Epi::KHOOK) { if (t == Epi::KH_T) E.khook(acc, ui, wr, fr, lds); }
            const bool last = (t == nt - 2);
            const char* a1 = cA + (size_t)(t + 1) * kstep;
            const char* a2 = last ? nA : cA + (size_t)(t + 2) * kstep; const char* b2 = last ? nB : cB + (size_t)(t + 2) * kstep;
            const char* a3 = a2 + kstep; const char* b3 = b2 + kstep;
            if (last && has_next) S.a_ready(nxt);
            if constexpr (SP2) {
            PG8_LDB(B0, 0, 0); PG8_LDB(B1, 0, 1); PG8_SCHED; PG8_LDA(At, 0, 0); PG8_STAGE(PG8_SA(1, 1), a1 + hstepA, voffA);
            PG8_WAIT_V(8); PG8_WAIT_L(0); PG8_BAR; PG8_MMA(0, 0, At, B0); PG8_MMA(0, 1, At, B1); PG8_BAR; PG8_SCHED;
            PG8_LDA(At, 0, 1); PG8_STAGE(PG8_SB(0, 0), b2, voffB); PG8_STAGE(PG8_SB(0, 1), b2 + hstepB, voffB); PG8_STAGE(PG8_SA(0, 0), a2, voffA);
            PG8_WAIT_V(8); PG8_WAIT_L(0); PG8_BAR; PG8_MMA(1, 0, At, B0); PG8_MMA(1, 1, At, B1); PG8_BAR; PG8_SCHED;
            PG8_LDB(B0, 1, 0); PG8_LDB(B1, 1, 1); PG8_SCHED; PG8_LDA(At, 1, 0); PG8_STAGE(PG8_SA(0, 1), a2 + hstepA, voffA);
            PG8_WAIT_V(8); PG8_WAIT_L(0); PG8_BAR; PG8_MMA(0, 0, At, B0); PG8_MMA(0, 1, At, B1); PG8_BAR; PG8_SCHED;
            PG8_LDA(At, 1, 1); PG8_STAGE(PG8_SB(1, 0), b3, voffB); PG8_STAGE(PG8_SB(1, 1), b3 + hstepB, voffB); PG8_STAGE(PG8_SA(1, 0), a3, voffA);
            PG8_WAIT_V(8); PG8_WAIT_L(0); PG8_BAR; PG8_MMA(1, 0, At, B0); PG8_MMA(1, 1, At, B1); PG8_BAR; PG8_SCHED;
            } else {
            PG8_LDB(B0, 0, 0); PG8_SCHED; PG8_LDA(At, 0, 0); PG8_STAGE(PG8_SA(1, 1), a1 + hstepA, voffA);
            PG8_WAIT_L(8); PG8_BAR; PG8_WAIT_L(0); PG8_MMA(0, 0, At, B0); PG8_BAR; PG8_SCHED;
            PG8_LDB(B1, 0, 1); PG8_STAGE(PG8_SB(0, 0), b2, voffB);
            PG8_BAR; PG8_WAIT_L(0); PG8_MMA(0, 1, At, B1); PG8_BAR;
            PG8_LDA(At, 0, 1); PG8_STAGE(PG8_SA(0, 0), a2, voffA);
            PG8_BAR; PG8_WAIT_L(0); PG8_MMA(1, 0, At, B0); PG8_BAR; PG8_SCHED;
            PG8_STAGE(PG8_SB(0, 1), b2 + hstepB, voffB);
            PG8_WAIT_V(6); PG8_BAR; PG8_MMA(1, 1, At, B1); PG8_BAR;
            PG8_LDB(B0, 1, 0); PG8_SCHED; PG8_LDA(At, 1, 0); PG8_STAGE(PG8_SA(0, 1), a2 + hstepA, voffA);
            PG8_WAIT_L(8); PG8_BAR; PG8_WAIT_L(0); PG8_MMA(0, 0, At, B0); PG8_BAR; PG8_SCHED;
            PG8_LDB(B1, 1, 1); PG8_STAGE(PG8_SB(1, 0), b3, voffB);
            PG8_BAR; PG8_WAIT_L(0); PG8_MMA(0, 1, At, B1); PG8_BAR;
            PG8_LDA(At, 1, 1); PG8_STAGE(PG8_SA(1, 0), a3, voffA);
            PG8_BAR; PG8_WAIT_L(0); PG8_MMA(1, 0, At, B0); PG8_BAR; PG8_SCHED;
            PG8_STAGE(PG8_SB(1, 1), b3 + hstepB, voffB);
            PG8_WAIT_V(6); PG8_BAR; PG8_MMA(1, 1, At, B1); PG8_BAR;
            }
        }
        if constexpr (ALIGN_EPI) { if (wr == 0) PG8_BAR; }
        if constexpr (!Epi::AFTER_DRAIN) { E(acc, cur, wr, wc, fr, fq, ui); S.done(cur); }
        if (!has_next) break;
#pragma unroll
        for (int a = 0; a < 2; ++a)
#pragma unroll
            for (int b = 0; b < 2; ++b)
#pragma unroll
                for (int m = 0; m < 4; ++m)
#pragma unroll
                    for (int n = 0; n < 2; ++n) acc[a][b][m][n] = (f32x4){0.f, 0.f, 0.f, 0.f};
        cur = nxt; cA = nA; cB = nB; ++ui;
        if constexpr (ALIGN_EPI) { if (wr == 1) PG8_BAR; }
    }
    PG8_WAIT_V(0);
    if constexpr (!ALIGN_EPI) { if (wr == 0) PG8_BAR; }
    PG8_BAR;
    if constexpr (Epi::AFTER_DRAIN) { E.fused(acc, cur, wr, wc, fr, fq, lds, wid, lane); S.done(cur); }
#undef PG8_SA
#undef PG8_SB
#undef PG8_STAGE
#undef PG8_LDA
#undef PG8_LDB
#undef PG8_MMA
#undef PG8_WAIT_V
#undef PG8_WAIT_L
#undef PG8_BAR
#undef PG8_SCHED
}
}

namespace pg8 {
struct EpiMlpIn {
  static constexpr bool PERM = true, AFTER_DRAIN = false, KHOOK = false; static constexpr int KH_T = 0;
  ::bf16_t* O; const float* sb2; const float* ss1;
  __device__ __forceinline__ void operator()(const f32x4 (&acc)[2][2][4][2], const Unit& u, int wr, int wc, int fr, int fq, int) const {
    const int row0 = u.pm * BM + wr * 64 + fr, col0 = u.pn * BM + wc * 32 + 8 * fq;
    const float* bias = sb2 + batch_of(u.pm * BM) * 4096;
    f32x4 bv[2][2];
#pragma unroll
    for (int bj = 0; bj < 2; ++bj)
#pragma unroll
      for (int n = 0; n < 2; ++n) bv[bj][n] = *(const f32x4*)(bias + col0 + bj * HALF + 4 * n);
    float r2[2][4];
#pragma unroll
    for (int ai = 0; ai < 2; ++ai)
#pragma unroll
      for (int m = 0; m < 4; ++m) r2[ai][m] = rsqrtf(ss1[row0 + ai * HALF + m * 16] * (1.f / 1024.f) + EPSV);
#pragma unroll
    for (int ai = 0; ai < 2; ++ai)
#pragma unroll
      for (int m = 0; m < 4; ++m) {
        ::bf16_t* rowp = O + (size_t)(row0 + ai * HALF + m * 16) * 4096 + col0;
#pragma unroll
        for (int bj = 0; bj < 2; ++bj) {
          f32x4 v0 = acc[ai][bj][m][0] * r2[ai][m] + bv[bj][0], v1 = acc[ai][bj][m][1] * r2[ai][m] + bv[bj][1];
#pragma unroll
          for (int e = 0; e < 4; ++e) { const float a = fmaxf(v0[e], 0.f), b = fmaxf(v1[e], 0.f); v0[e] = a * a; v1[e] = b * b; }
          u32x4 w; w.x = pk2(v0[0], v0[1]); w.y = pk2(v0[2], v0[3]); w.z = pk2(v1[0], v1[1]); w.w = pk2(v1[2], v1[3]);
          *(u32x4*)(rowp + bj * HALF) = w;
        }
      }
  }
};
struct EpiMlpOut {
  static constexpr bool PERM = true, AFTER_DRAIN = false, KHOOK = false; static constexpr int KH_T = 0;
  const ::bf16_t* x1; ::bf16_t* x2; const float* mod; const float* bias;
  __device__ __forceinline__ void operator()(const f32x4 (&acc)[2][2][4][2], const Unit& u, int wr, int wc, int fr, int fq, int) const {
    const int col0 = u.pn * BM + wc * 32 + 8 * fq;
    const float* g2 = mod + batch_of(u.pm * BM) * 6144 + 5120;
    f32x4 bb[2][2], gv[2][2];
#pragma unroll
    for (int bj = 0; bj < 2; ++bj)
#pragma unroll
      for (int n = 0; n < 2; ++n) { bb[bj][n] = *(const f32x4*)(bias + col0 + bj * HALF + n * 4); gv[bj][n] = *(const f32x4*)(g2 + col0 + bj * HALF + n * 4); }
#pragma unroll
    for (int ai = 0; ai < 2; ++ai) {
      u32x4 xr[4][2];
#pragma unroll
      for (int m = 0; m < 4; ++m) {
        const int row = u.pm * BM + ai * HALF + wr * 64 + m * 16 + fr;
#pragma unroll
        for (int bj = 0; bj < 2; ++bj) xr[m][bj] = *(const u32x4*)(x1 + (size_t)row * 1024 + col0 + bj * HALF);
      }
      asm volatile("" ::: "memory");
#pragma unroll
      for (int m = 0; m < 4; ++m) {
        const int row = u.pm * BM + ai * HALF + wr * 64 + m * 16 + fr;
#pragma unroll
        for (int bj = 0; bj < 2; ++bj) {
          const u32x4 xx = xr[m][bj];
          f32x4 x0, x1v;
          x0[0] = bflo(xx.x); x0[1] = bfhi(xx.x); x0[2] = bflo(xx.y); x0[3] = bfhi(xx.y);
          x1v[0] = bflo(xx.z); x1v[1] = bfhi(xx.z); x1v[2] = bflo(xx.w); x1v[3] = bfhi(xx.w);
          const f32x4 o0 = x0 + gv[bj][0] * (acc[ai][bj][m][0] + bb[bj][0]), o1 = x1v + gv[bj][1] * (acc[ai][bj][m][1] + bb[bj][1]);
          u32x4 w; w.x = pk2(o0[0], o0[1]); w.y = pk2(o0[2], o0[3]); w.z = pk2(o1[0], o1[1]); w.w = pk2(o1[2], o1[3]);
          *(u32x4*)(x2 + (size_t)row * 1024 + col0 + bj * HALF) = w;
        }
      }
    }
  }
};
struct EpiYf {
  static constexpr bool PERM = true, AFTER_DRAIN = false, KHOOK = false; static constexpr int KH_T = 0;
  ::bf16_t* O; const float* bias; float* ss;
  __device__ __forceinline__ void operator()(const f32x4 (&acc)[2][2][4][2], const Unit& u, int wr, int wc, int fr, int fq, int) const {
    const int row0 = u.pm * BM + wr * 64 + fr, col0 = u.pn * BM + wc * 32 + 8 * fq;
    f32x4 bv[2][2];
#pragma unroll
    for (int bj = 0; bj < 2; ++bj)
#pragma unroll
      for (int n = 0; n < 2; ++n) bv[bj][n] = *(const f32x4*)(bias + col0 + bj * HALF + 4 * n);
#pragma unroll
    for (int ai = 0; ai < 2; ++ai)
#pragma unroll
      for (int m = 0; m < 4; ++m) {
        const int row = row0 + ai * HALF + m * 16;
        const float scale = row < LPR ? 3.4526698300124393e-4f : 6.905339660024879e-4f;
        ::bf16_t* rowp = O + (size_t)row * 1024 + col0;
        float s = 0.f;
#pragma unroll
        for (int bj = 0; bj < 2; ++bj) {
          const f32x4 v0 = acc[ai][bj][m][0] * scale + bv[bj][0], v1 = acc[ai][bj][m][1] * scale + bv[bj][1];
          s += (v0[0] * v0[0] + v0[1] * v0[1]) + (v0[2] * v0[2] + v0[3] * v0[3]) + (v1[0] * v1[0] + v1[1] * v1[1]) + (v1[2] * v1[2] + v1[3] * v1[3]);
          u32x4 w; w.x = pk2(v0[0], v0[1]); w.y = pk2(v0[2], v0[3]); w.z = pk2(v1[0], v1[1]); w.w = pk2(v1[2], v1[3]);
          *(u32x4*)(rowp + bj * HALF) = w;
        }
        s += __shfl_xor(s, 16); s += __shfl_xor(s, 32);
        if (fq == 0) ss[row * 8 + u.pn * 4 + wc] = s;
      }
  }
};
struct EpiGlu {
  static constexpr bool PERM = true, AFTER_DRAIN = false, KHOOK = false; static constexpr int KH_T = 0;
  ::bf16_t* O; const float* bias; float* ss;
  __device__ __forceinline__ void operator()(const f32x4 (&acc)[2][2][4][2], const Unit& u, int wr, int wc, int fr, int fq, int) const {
    const int row0 = u.pm * BM + wr * 64 + fr, j0 = u.pn * 128 + wc * 32 + 8 * fq;
    f32x4 bv[2][2];
#pragma unroll
    for (int bj = 0; bj < 2; ++bj)
#pragma unroll
      for (int n = 0; n < 2; ++n) bv[bj][n] = *(const f32x4*)(bias + bj * 512 + j0 + 4 * n);
#pragma unroll
    for (int ai = 0; ai < 2; ++ai)
#pragma unroll
      for (int m = 0; m < 4; ++m) {
        const int row = row0 + ai * HALF + m * 16;
        float o[8], s = 0.f;
#pragma unroll
        for (int n = 0; n < 2; ++n)
#pragma unroll
          for (int e = 0; e < 4; ++e) {
            const float val = acc[ai][0][m][n][e] + bv[0][n][e], gate = acc[ai][1][m][n][e] + bv[1][n][e];
            const float y = val / (1.f + __expf(-gate));
            o[4 * n + e] = y; s += y * y;
          }
        u32x4 w; w.x = pk2(o[0], o[1]); w.y = pk2(o[2], o[3]); w.z = pk2(o[4], o[5]); w.w = pk2(o[6], o[7]);
        *(u32x4*)(O + (size_t)row * 1024 + 512 + j0) = w;
        s += __shfl_xor(s, 16); s += __shfl_xor(s, 32);
        if (fq == 0) ss[row * 16 + u.pn * 4 + wc] = s;
      }
  }
};
struct EpiZt {
  static constexpr bool PERM = true, AFTER_DRAIN = false, KHOOK = false; static constexpr int KH_T = 0;
  ::bf16_t* O;
  __device__ __forceinline__ void operator()(const f32x4 (&acc)[2][2][4][2], const Unit& u, int wr, int wc, int fr, int fq, int) const {
    const int v0 = u.pn * BM;
    ::bf16_t* base; size_t ld;
    if (v0 < LPR) { base = O + v0; ld = LPR; }
    else { const int vs = v0 - LPR; base = O + (size_t)512 * LPR + (size_t)(vs >> 12) * 512 * 4096 + (vs & 4095); ld = 4096; }
    const int c0 = u.pm * BM + wr * 64 + fr, col0 = wc * 32 + 8 * fq;
#pragma unroll
    for (int ai = 0; ai < 2; ++ai)
#pragma unroll
      for (int m = 0; m < 4; ++m) {
        ::bf16_t* rowp = base + (size_t)(c0 + ai * HALF + m * 16) * ld + col0;
#pragma unroll
        for (int bj = 0; bj < 2; ++bj) {
          const f32x4 a = acc[ai][bj][m][0], b = acc[ai][bj][m][1];
          u32x4 w; w.x = pk2(a[0], a[1]); w.y = pk2(a[2], a[3]); w.z = pk2(b[0], b[1]); w.w = pk2(b[2], b[3]);
          *(u32x4*)(rowp + bj * HALF) = w;
        }
      }
  }
};
struct EpiZs {
  static constexpr bool PERM = true, AFTER_DRAIN = false, KHOOK = false; static constexpr int KH_T = 0;
  ::bf16_t* O;
  __device__ __forceinline__ void operator()(const f32x4 (&acc)[2][2][4][2], const Unit& u, int wr, int wc, int fr, int fq, int) const {
    const int r0 = u.pm * BM + wr * 64 + fr, col0 = u.pn * BM + wc * 32 + 8 * fq;
#pragma unroll
    for (int ai = 0; ai < 2; ++ai)
#pragma unroll
      for (int m = 0; m < 4; ++m) {
        const int tok = v2tok(r0 + ai * HALF + m * 16);
#pragma unroll
        for (int bj = 0; bj < 2; ++bj) {
          const int col = col0 + bj * HALF;
          const f32x4 a = acc[ai][bj][m][0], b = acc[ai][bj][m][1];
          u32x4 w; w.x = pk2(a[0], a[1]); w.y = pk2(a[2], a[3]); w.z = pk2(b[0], b[1]); w.w = pk2(b[2], b[3]);
          *(u32x4*)(O + ((size_t)(col >> 4) * 1280 + (tok >> 6)) * 1280 + (tok & 63) * 16 + (col & 15)) = w;
        }
      }
  }
};
struct EpiS {
  static constexpr bool PERM = false, AFTER_DRAIN = false, KHOOK = false; static constexpr int KH_T = 0;
  float* O;
  __device__ __forceinline__ void operator()(const f32x4 (&acc)[2][2][4][2], const Unit& u, int wr, int wc, int fr, int fq, int) const {
#pragma unroll
    for (int ai = 0; ai < 2; ++ai)
#pragma unroll
      for (int m = 0; m < 4; ++m) {
        float* rowp = O + (size_t)(u.pm * BM + ai * HALF + wr * 64 + m * 16 + fr) * 256 + wc * 32 + 4 * fq;
#pragma unroll
        for (int bj = 0; bj < 2; ++bj)
#pragma unroll
          for (int n = 0; n < 2; ++n) *(f32x4*)(rowp + bj * HALF + n * 16) = acc[ai][bj][m][n];
      }
  }
};
struct EpiGelu {
  static constexpr bool PERM = true, AFTER_DRAIN = false, KHOOK = false; static constexpr int KH_T = 0;
  ::bf16_t* O;
  __device__ __forceinline__ void operator()(const f32x4 (&acc)[2][2][4][2], const Unit& u, int wr, int wc, int fr, int fq, int) const {
    const int gi = u.pn >> 2, n0 = (u.pn & 3) * BM + wc * 32 + 8 * fq, ch0 = u.pm * BM - gi * 1280 + wr * 64 + fr;
#pragma unroll
    for (int ai = 0; ai < 2; ++ai)
#pragma unroll
      for (int m = 0; m < 4; ++m) {
        const int ch = ch0 + ai * HALF + m * 16;
#pragma unroll
        for (int bj = 0; bj < 2; ++bj) {
          const int n = n0 + bj * HALF;
          float o[8];
#pragma unroll
          for (int e = 0; e < 4; ++e) { o[e] = gelu_tanh(acc[ai][bj][m][0][e]); o[4 + e] = gelu_tanh(acc[ai][bj][m][1][e]); }
          u32x4 w; w.x = pk2(o[0], o[1]); w.y = pk2(o[2], o[3]); w.z = pk2(o[4], o[5]); w.w = pk2(o[6], o[7]);
          *(u32x4*)(O + (size_t)(ch * 64 + (n >> 4)) * 512 + gi * 16 + (n & 15)) = w;
        }
      }
  }
};
struct EpiFft1 {
  static constexpr bool PERM = true, AFTER_DRAIN = false, KHOOK = false; static constexpr int KH_T = 0;
  ::bf16_t* Tt; const float2* twp; const float2* tws;
  __device__ __forceinline__ void operator()(const f32x4 (&acc)[2][2][4][2], const Unit& u, int wr, int wc, int fr, int fq, int) const {
    const bool pr = u.pn < 128;
    const int r0b = u.pn * BM + wc * 32 + 8 * fq;
    const float2* tw = pr ? twp : tws;
    const int mask = pr ? 16383 : 4095;
    float2 stv[4], w0v[4];
#pragma unroll
    for (int m = 0; m < 4; ++m) {
      const int idx = ((u.pm & 1) << 7) | (wr * 64 + m * 16 + fr);
      const int k1 = pr ? (idx & 127) : (idx & 63), l2loc = pr ? (idx >> 7) : (idx >> 6);
      const int l20 = pr ? (l2loc * 64 + (r0b & 63)) : (l2loc * 16 + (r0b & 15));
      stv[m] = tw[(unsigned)(k1 & mask)]; w0v[m] = tw[(unsigned)((k1 * l20) & mask)];
    }
    asm volatile("" ::: "memory");
#pragma unroll
    for (int m = 0; m < 4; ++m) {
      const int idx = ((u.pm & 1) << 7) | (wr * 64 + m * 16 + fr);
      const int k1 = pr ? (idx & 127) : (idx & 63), l2loc = pr ? (idx >> 7) : (idx >> 6);
      const int l20 = pr ? (l2loc * 64 + (r0b & 63)) : (l2loc * 16 + (r0b & 15));
      const float2 st = stv[m], w0 = w0v[m];
#pragma unroll
      for (int bj = 0; bj < 2; ++bj) {
        const int r0 = r0b + bj * HALF;
        size_t off; int pstride;
        if (pr) { off = ((size_t)(k1 * 512 + (r0 >> 6))) * 256 + l20; pstride = 128; }
        else { const int bc = (r0 - 32768) >> 4; off = (size_t)65536 * 256 + ((size_t)(((bc >> 9) * 32 + (k1 >> 1)) * 512 + (bc & 511))) * 256 + (k1 & 1) * 128 + l20; pstride = 64; }
        float ore[8], oim[8];
        float2 wv = w0;
#pragma unroll
        for (int e = 0; e < 8; ++e) {
          const float re = acc[0][bj][m][e >> 2][e & 3], im = acc[1][bj][m][e >> 2][e & 3];
          ore[e] = re * wv.x + im * wv.y; oim[e] = im * wv.x - re * wv.y;
          wv = make_float2(wv.x * st.x - wv.y * st.y, wv.y * st.x + wv.x * st.y);
        }
        u32x4 w; w.x = pk2(ore[0], ore[1]); w.y = pk2(ore[2], ore[3]); w.z = pk2(ore[4], ore[5]); w.w = pk2(ore[6], ore[7]);
        *(u32x4*)(Tt + off) = w;
        w.x = pk2(oim[0], oim[1]); w.y = pk2(oim[2], oim[3]); w.z = pk2(oim[4], oim[5]); w.w = pk2(oim[6], oim[7]);
        *(u32x4*)(Tt + off + pstride) = w;
      }
    }
  }
};
struct EpiFft2 {
  static constexpr bool PERM = true, AFTER_DRAIN = false, KHOOK = false; static constexpr int KH_T = 0;
  ::bf16_t* AF;
  __device__ __forceinline__ void operator()(const f32x4 (&acc)[2][2][4][2], const Unit& u, int wr, int wc, int fr, int fq, int) const {
    const bool pr = u.pn < 256;
    const int pnl = pr ? u.pn : u.pn - 256, c0 = (pnl & 1) * 256 + wc * 32 + 8 * fq;
#pragma unroll
    for (int ai = 0; ai < 2; ++ai)
#pragma unroll
      for (int m = 0; m < 4; ++m) {
        int part, tok;
        if (pr) { part = ai; tok = (pnl >> 1) + 128 * (wr * 64 + m * 16 + fr); }
        else { const int bk = pnl >> 1; part = wr; tok = LPR + (bk >> 5) * 4096 + (bk & 31) * 2 + ai + 64 * (m * 16 + fr); }
        ::bf16_t* rowp = AF + (size_t)tok * 1024 + part * 512 + c0;
#pragma unroll
        for (int bj = 0; bj < 2; ++bj) {
          const f32x4 a = acc[ai][bj][m][0], b = acc[ai][bj][m][1];
          u32x4 w; w.x = pk2(a[0], a[1]); w.y = pk2(a[2], a[3]); w.z = pk2(b[0], b[1]); w.w = pk2(b[2], b[3]);
          *(u32x4*)(rowp + bj * HALF) = w;
        }
      }
  }
};
struct EpiWout {
  static constexpr bool PERM = true, AFTER_DRAIN = false, KHOOK = true; static constexpr int KH_T = 8;
  float* out; const float* xp; const float* xs; const float* mod; const float* g2; ::bf16_t* h2; float* ss1;
  __device__ __forceinline__ void khook(f32x4 (&acc)[2][2][4][2], int ui, int wr, int fr, PG8_LAS unsigned char* lds) const {
    typedef float f32x2t __attribute__((ext_vector_type(2)));
    const PG8_LAS f32x2t* tab = (const PG8_LAS f32x2t*)(lds + 131072) + ui * 256;
#pragma unroll
    for (int ai = 0; ai < 2; ++ai)
#pragma unroll
      for (int m = 0; m < 4; ++m) {
        const float r = tab[ai * HALF + wr * 64 + m * 16 + fr].x;
#pragma unroll
        for (int bj = 0; bj < 2; ++bj)
#pragma unroll
          for (int n = 0; n < 2; ++n) acc[ai][bj][m][n] *= r;
      }
  }
  __device__ __forceinline__ void operator()(const f32x4 (&acc)[2][2][4][2], const Unit& u, int wr, int wc, int fr, int fq, int ui) const {
    typedef float f32x2t __attribute__((ext_vector_type(2)));
    const PG8_LAS f32x2t* tab = (const PG8_LAS f32x2t*)((PG8_LAS unsigned char*)dyn_smem + 131072) + ui * 256;
    const int col0 = u.pn * BM + wc * 32 + 8 * fq;
    const float* md = mod + batch_of(u.pm * BM) * 6144;
    f32x4 gv[2][2], hv[2][2];
#pragma unroll
    for (int bj = 0; bj < 2; ++bj)
#pragma unroll
      for (int n = 0; n < 2; ++n) {
        const int col = col0 + bj * HALF + n * 4;
        gv[bj][n] = *(const f32x4*)(md + 2048 + col);
        hv[bj][n] = *(const f32x4*)(g2 + col) * (*(const f32x4*)(md + 4096 + col) + 1.f);
      }
#pragma unroll
    for (int ai = 0; ai < 2; ++ai)
#pragma unroll
      for (int mp = 0; mp < 2; ++mp) {
        f32x4 xv[2][2][2]; float rs[2];
#pragma unroll
        for (int mm = 0; mm < 2; ++mm) {
          const int m = mp * 2 + mm, rl = ai * HALF + wr * 64 + m * 16 + fr, row = u.pm * BM + rl;
          rs[mm] = tab[rl].y;
          const float* xr = row < LPR ? xp + (size_t)row * 1024 : xs + (size_t)(row - LPR) * 1024;
#pragma unroll
          for (int bj = 0; bj < 2; ++bj)
#pragma unroll
            for (int n = 0; n < 2; ++n) xv[mm][bj][n] = *(const f32x4*)(xr + col0 + bj * HALF + n * 4);
        }
        asm volatile("" ::: "memory");
#pragma unroll
        for (int mm = 0; mm < 2; ++mm) {
          const int m = mp * 2 + mm, row = u.pm * BM + ai * HALF + wr * 64 + m * 16 + fr;
          ::bf16_t* orow = (::bf16_t*)out + (size_t)row * 1024 + col0;
          ::bf16_t* hrow = h2 + (size_t)row * 1024 + col0;
          float sq = 0.f;
#pragma unroll
          for (int bj = 0; bj < 2; ++bj) {
            const f32x4 o0 = xv[mm][bj][0] + gv[bj][0] * (acc[ai][bj][m][0] * rs[mm]), o1 = xv[mm][bj][1] + gv[bj][1] * (acc[ai][bj][m][1] * rs[mm]);
            sq += (o0[0] * o0[0] + o0[1] * o0[1]) + (o0[2] * o0[2] + o0[3] * o0[3]) + (o1[0] * o1[0] + o1[1] * o1[1]) + (o1[2] * o1[2] + o1[3] * o1[3]);
            u32x4 w; w.x = pk2(o0[0], o0[1]); w.y = pk2(o0[2], o0[3]); w.z = pk2(o1[0], o1[1]); w.w = pk2(o1[2], o1[3]);
            *(u32x4*)(orow + bj * HALF) = w;
            const f32x4 h0 = o0 * hv[bj][0], h1 = o1 * hv[bj][1];
            w.x = pk2(h0[0], h0[1]); w.y = pk2(h0[2], h0[3]); w.z = pk2(h1[0], h1[1]); w.w = pk2(h1[2], h1[3]);
            *(u32x4*)(hrow + bj * HALF) = w;
          }
          sq += __shfl_xor(sq, 16); sq += __shfl_xor(sq, 32);
          if (fq == 0) atomicAdd(ss1 + row, sq);
        }
      }
  }
};
}

DI void phase2(const P& p, const int wv) {
  {
    const pg8::Gemm g{p.wint(), p.hb(), 512, NTOK, 1024, 1024, 1024};
    pg8::StaticOrder S; S.init(512, NTOK, (int)gridDim.x, (int)blockIdx.x);
    const pg8::EpiZt E{p.zT()};
    pg8::gemm_phase<pg8::EpiZt, pg8::StaticOrder, true, true>((PG8_LAS unsigned char*)dyn_smem, otid(wv), g, S, E);
  }
  {
    const pg8::Gemm g{p.hb(), p.wint() + (size_t)512 * 1024, NTOK, 512, 1024, 1024, 1024};
    pg8::StaticOrder S; S.init(NTOK, 512, (int)gridDim.x, (int)(gridDim.x - 1 - blockIdx.x));
    const pg8::EpiZs E{p.Ucat()};
    pg8::gemm_phase<pg8::EpiZs, pg8::StaticOrder, true, true>((PG8_LAS unsigned char*)dyn_smem, otid(wv), g, S, E);
  }
}
DI void phase3(const P& p, const int wv) {
  {
    const pg8::Gemm g{p.Ucat(), p.Bs(), 32 * 1280, 32 * 256, 1024, 1280, 1024};
    pg8::GroupOrder S; S.init(32, 5, 1, (int)gridDim.x, (int)blockIdx.x);
    const pg8::EpiS E{p.S()};
    pg8::gemm_phase<pg8::EpiS, pg8::GroupOrder, true, true>((PG8_LAS unsigned char*)dyn_smem, otid(wv), g, S, E);
  }
  {
    const pg8::Gemm g{p.Fb1(), p.zT(), 1024, 163840, 256, 256, 256};
    pg8::Fft1Order S; S.init((int)gridDim.x, (int)blockIdx.x);
    const pg8::EpiFft1 E{p.Tt(), p.twp(), p.tws()};
    pg8::gemm_phase<pg8::EpiFft1, pg8::Fft1Order, true, true>((PG8_LAS unsigned char*)dyn_smem, otid(wv), g, S, E);
  }
}
DI void phase4(const P& p, const int wv) {
  {
    const int tix = otid(wv), pp = tix & 63, G = (int)gridDim.x;
    for (int task = (int)blockIdx.x + G * wv; task < 17 * 64; task += G * 8) {
      const int seq = task >> 6, g = (task >> 1) & 31, dir = task & 1;
      const int c0 = seq == 0 ? 0 : 256 + (seq - 1) * 64, nc = seq == 0 ? 256 : 64;
      const float ar = p.AT()[((g * 2 + dir) * 64 + pp) * 2], ai = p.AT()[((g * 2 + dir) * 64 + pp) * 2 + 1];
      float hr = 0.f, hi = 0.f;
      const float* Sg = p.S() + (size_t)g * 1280 * 256 + dir * 128 + pp;
      bf16_t* Hg = p.Ucat() + (size_t)g * 1280 * 1280 + 1024 + dir * 128 + pp;
      for (int i0 = 0; i0 < nc; i0 += 32) {
        float sr[32], si[32];
#pragma unroll
        for (int j = 0; j < 32; j++) {
          const int c = c0 + (dir == 0 ? i0 + j : nc - 1 - i0 - j);
          sr[j] = Sg[(size_t)c * 256]; si[j] = Sg[(size_t)c * 256 + 64];
        }
#pragma unroll
        for (int j = 0; j < 32; j++) {
          const int c = c0 + (dir == 0 ? i0 + j : nc - 1 - i0 - j);
          Hg[(size_t)c * 1280] = f2bf(hr); Hg[(size_t)c * 1280 + 64] = f2bf(hi);
          const float nr = ar * hr - ai * hi + sr[j], ni = ar * hi + ai * hr + si[j];
          hr = nr; hi = ni;
        }
      }
    }
  }
  {
    const pg8::Gemm g{p.Fb2(), p.Tt(), 512, 327680, 256, 256, 256};
    pg8::Fft2Order S; S.init((int)gridDim.x, (int)blockIdx.x);
    const pg8::EpiFft2 E{p.AF()};
    pg8::gemm_phase<pg8::EpiFft2, pg8::Fft2Order, true, true>((PG8_LAS unsigned char*)dyn_smem, otid(wv), g, S, E);
  }
}
DI void phase5(const P& p, const int wv) {
  const pg8::Gemm g{p.Ucat(), p.Tcat(), 32 * 1280, 32 * 1024, 1280, 1280, 1280};
  pg8::GroupOrder S; S.init(32, 5, 4, (int)gridDim.x, (int)blockIdx.x);
  const pg8::EpiGelu E{p.gact()};
  pg8::gemm_phase<pg8::EpiGelu, pg8::GroupOrder, true, true>((PG8_LAS unsigned char*)dyn_smem, otid(wv), g, S, E);
  {
    const pg8::Gemm g{p.AF(), p.Mf(), NTOK, 512, 1024, 1024, 1024};
    pg8::YfOrder S; S.init((int)gridDim.x, (int)blockIdx.x);
    const pg8::EpiYf E{p.mg(), p.b_f, p.ssf()};
    pg8::gemm_phase<pg8::EpiYf, pg8::YfOrder, true, true>((PG8_LAS unsigned char*)dyn_smem, otid(wv), g, S, E);
  }
}
DI void phase6(const P& p, const int wv) {
  {
    const pg8::Gemm g{p.gact(), p.wglut(), NTOK, 1024, 512, 512, 512};
    pg8::StaticOrder S; S.init(NTOK, 1024, (int)gridDim.x, (int)blockIdx.x);
    const pg8::EpiGlu E{p.mg(), p.b_glu, p.sss()};
    pg8::gemm_phase<pg8::EpiGlu, pg8::StaticOrder, true, true>((PG8_LAS unsigned char*)dyn_smem, otid(wv), g, S, E);
  }
}
DI void phase7(const P& p, const int wv) {
  const pg8::Gemm g{p.mg(), p.woutt(), NTOK, 1024, 1024, 1024, 1024};
  pg8::StaticOrder S; S.init(NTOK, 1024, (int)gridDim.x, (int)blockIdx.x);
  {
    typedef float f32x2t __attribute__((ext_vector_type(2)));
    PG8_LAS f32x2t* tab = (PG8_LAS f32x2t*)((PG8_LAS unsigned char*)dyn_smem + 131072);
    const int tix7 = otid(wv);
    pg8::Unit u;
    for (int i = 0; i < 8 && S.next(i, u); ++i) {
      if (tix7 < 256) {
        const int tok = u.pm * 256 + tix7;
        float sf = 0.f, s2 = 0.f;
#pragma unroll
        for (int j = 0; j < 8; j++) sf += p.ssf()[tok * 8 + j];
#pragma unroll
        for (int j = 0; j < 16; j++) s2 += p.sss()[tok * 16 + j];
        const float rf = rsqrtf(sf * (1.f / 512.f) + EPSV), rs = rsqrtf(s2 * (1.f / 512.f) + EPSV);
        tab[i * 256 + tix7] = (f32x2t){rf / rs, rs};
      }
    }
    __syncthreads();
  }
  const pg8::EpiWout E{p.out, p.xp, p.xs, p.mod(), p.g_mlp, p.hb(), p.ss1()};
  pg8::gemm_phase<pg8::EpiWout, pg8::StaticOrder, true, true>((PG8_LAS unsigned char*)dyn_smem, otid(wv), g, S, E);
}
DI void phase8(const P& p, const int wv) {
  const pg8::Gemm g{p.hb(), p.w1t(), NTOK, 4096, 1024, 1024, 1024};
  pg8::StaticOrder S; S.init(NTOK, 4096, (int)gridDim.x, (int)blockIdx.x);
  const pg8::EpiMlpIn E{p.hid(), p.sb2(), p.ss1()};
  pg8::gemm_phase<pg8::EpiMlpIn, pg8::StaticOrder, true, true>((PG8_LAS unsigned char*)dyn_smem, otid(wv), g, S, E);
}
DI void phase9(const P& p, const int wv) {
  const pg8::Gemm g{p.hid(), p.w2t(), NTOK, 1024, 4096, 4096, 4096};
  pg8::StaticOrder S; S.init(NTOK, 1024, (int)gridDim.x, (int)blockIdx.x);
  const pg8::EpiMlpOut E{(const bf16_t*)p.out, p.hb(), p.mod(), p.b2};
  pg8::gemm_phase<pg8::EpiMlpOut, pg8::StaticOrder, true, true>((PG8_LAS unsigned char*)dyn_smem, otid(wv), g, S, E);
}

__global__ void __launch_bounds__(512, 2) k_mega(P p) {
  cg::grid_group grid = cg::this_grid();
  const int wv = __builtin_amdgcn_readfirstlane((int)threadIdx.x >> 6);
  {
    const int t0 = otid(wv);
    volatile XB_LAS unsigned* st = (volatile XB_LAS unsigned*)((XB_LAS unsigned char*)dyn_smem + XB_LDS_OFF);
    if (t0 == 0) { st[0] = 0u; st[1] = 0u; }
    __syncthreads();
    if (t0 == 0) (void)xb_add((unsigned*)(p.ws + O_bar) + XB_XCNT(xb_xcc_id()), 1u);
  }
#define GSYNC() xcd_barrier((unsigned*)(p.ws + O_bar), otid(wv))
  if (p.ws == nullptr) grid.sync();
  phase0(p, wv); GSYNC();
  rownorm_mod<true>(p, wv, p.g_mix, 0, 1024); GSYNC();
  phase2(p, wv); GSYNC();
  phase3(p, wv); GSYNC();
  phase4(p, wv); GSYNC();
  phase5(p, wv); GSYNC();
  phase6(p, wv); GSYNC();
  phase7(p, wv); GSYNC();
  phase8(p, wv); GSYNC();
  phase9(p, wv); GSYNC();
  final_norm(p, wv);
}

extern "C" void kernel_launch(void* const* d_in, const int* in_sizes, int n_in, void* d_out, int out_size, void* d_ws, size_t ws_size,
                              hipStream_t stream) {
  P p{};
  const float** f = (const float**)&p;
  for (int i = 0; i < 29; i++) f[i] = (const float*)d_in[i];
  p.out = (float*)d_out;
  p.ws = (char*)d_ws;
  if (WS_NEED > ws_size) { fprintf(stderr, "workspace too small: need %zu have %zu\n", (size_t)WS_NEED, ws_size); return; }
  static int grid_blocks = 0;
  if (!grid_blocks) {
    int dev = 0, cus = 0, per_cu = 0;
    (void)hipGetDevice(&dev);
    (void)hipDeviceGetAttribute(&cus, hipDeviceAttributeMultiprocessorCount, dev);
    (void)hipFuncSetAttribute((const void*)k_mega, hipFuncAttributeMaxDynamicSharedMemorySize, SMEM_BYTES);
    (void)hipOccupancyMaxActiveBlocksPerMultiprocessor(&per_cu, k_mega, 512, SMEM_BYTES);
    if (per_cu < 1) per_cu = 1;
    grid_blocks = cus * per_cu;
  }
  (void)hipMemsetAsync((char*)d_ws + O_mod, 0, O_AT - O_mod, stream);
  void* args[] = {&p};
  hipError_t e = hipLaunchCooperativeKernel((void*)k_mega, dim3(grid_blocks), dim3(512), args, SMEM_BYTES, stream);
  if (e != hipSuccess) fprintf(stderr, "cooperative launch failed: %s (grid %d)\n", hipGetErrorString(e), grid_blocks);
}
```

```cpp
#include <hip/hip_runtime.h>
#include <hip/hip_cooperative_groups.h>
#include <stdint.h>
#include <stdio.h>
namespace cg = cooperative_groups;


#define DI __device__ __forceinline__
typedef unsigned short bf16_t;
typedef short bf16x8 __attribute__((ext_vector_type(8)));
typedef float f32x16 __attribute__((ext_vector_type(16)));
typedef float f32x4 __attribute__((ext_vector_type(4)));

constexpr int NTOK = 81920, LPR = 16384, LSM = 4096;
constexpr int SMEM_HALF = 73728;
constexpr int SMEM_BYTES = 2 * SMEM_HALF;
constexpr float EPSV = 1e-6f;

constexpr size_t al256(size_t x) { return (x + 255) & ~(size_t)255; }
constexpr size_t O_mod = 0;
constexpr size_t O_bar = O_mod + al256(17 * 6144 * 4);
constexpr size_t O_ss1 = O_bar + al256(3456 * 4);
constexpr size_t O_sb2 = O_ss1 + al256((size_t)NTOK * 4);
constexpr size_t O_AT = O_sb2 + al256(17 * 4096 * 4);
constexpr size_t O_ssf = O_AT + al256(32 * 2 * 64 * 2 * 4);
constexpr size_t O_sss = O_ssf + al256((size_t)NTOK * 8 * 4);
constexpr size_t O_twp = O_sss + al256((size_t)NTOK * 16 * 4);
constexpr size_t O_tws = O_twp + al256(LPR * 8);
constexpr size_t O_wint = O_tws + al256(LSM * 8);
constexpr size_t O_wglut = O_wint + al256(1024 * 1024 * 2);
constexpr size_t O_woutt = O_wglut + al256(1024 * 512 * 2);
constexpr size_t O_w1t = O_woutt + al256(1024 * 1024 * 2);
constexpr size_t O_w2t = O_w1t + al256((size_t)4096 * 1024 * 2);
constexpr size_t O_Mf = O_w2t + al256((size_t)4096 * 1024 * 2);
constexpr size_t O_Fb1 = O_Mf + al256(512 * 1024 * 2);
constexpr size_t O_Fb2 = O_Fb1 + al256(1024 * 256 * 2);
constexpr size_t O_Bs = O_Fb2 + al256(512 * 256 * 2);
constexpr size_t O_Tcat = O_Bs + al256((size_t)32 * 256 * 1024 * 2);
constexpr size_t O_hb = O_Tcat + al256((size_t)32 * 1024 * 1280 * 2);
constexpr size_t O_zT = O_hb + al256((size_t)NTOK * 1024 * 2);
constexpr size_t O_Ucat = O_zT + al256((size_t)NTOK * 512 * 2);
constexpr size_t O_AF = O_Ucat + al256((size_t)32 * 1280 * 1280 * 2);
constexpr size_t O_S = O_AF + al256((size_t)NTOK * 1024 * 2);
constexpr size_t O_gact = O_S + al256((size_t)1280 * 32 * 256 * 4);
constexpr size_t O_mg = O_gact + al256((size_t)NTOK * 512 * 2);
constexpr size_t O_END = O_mg + al256((size_t)NTOK * 1024 * 2);
constexpr size_t O_Tt = O_hb;
constexpr size_t O_hid = O_zT;
constexpr size_t WS_NEED = (O_hid + (size_t)NTOK * 4096 * 2 > O_END ? O_hid + (size_t)NTOK * 4096 * 2 : O_END);
struct P {
  const float *xp, *xs, *cp, *cs, *w_ada, *b_ada, *g_mix, *w_in, *w_f, *b_f, *a_re, *a_im, *log_dt, *b_re, *b_im, *c_re, *c_im,
      *ssm_d, *w_glu, *b_glu, *g_fo, *g_so, *w_out, *g_mlp, *w1, *b1, *w2, *b2, *g_final;
  float* out;
  char* ws;
  __device__ __forceinline__ float* mod() const { return (float*)(ws + O_mod); }
  __device__ __forceinline__ float* ss1() const { return (float*)(ws + O_ss1); }
  __device__ __forceinline__ float* sb2() const { return (float*)(ws + O_sb2); }
  __device__ __forceinline__ float* AT() const { return (float*)(ws + O_AT); }
  __device__ __forceinline__ float* ssf() const { return (float*)(ws + O_ssf); }
  __device__ __forceinline__ float* sss() const { return (float*)(ws + O_sss); }
  __device__ __forceinline__ float2* twp() const { return (float2*)(ws + O_twp); }
  __device__ __forceinline__ float2* tws() const { return (float2*)(ws + O_tws); }
  __device__ __forceinline__ bf16_t* wint() const { return (bf16_t*)(ws + O_wint); }
  __device__ __forceinline__ bf16_t* wglut() const { return (bf16_t*)(ws + O_wglut); }
  __device__ __forceinline__ bf16_t* woutt() const { return (bf16_t*)(ws + O_woutt); }
  __device__ __forceinline__ bf16_t* w1t() const { return (bf16_t*)(ws + O_w1t); }
  __device__ __forceinline__ bf16_t* w2t() const { return (bf16_t*)(ws + O_w2t); }
  __device__ __forceinline__ bf16_t* Mf() const { return (bf16_t*)(ws + O_Mf); }
  __device__ __forceinline__ bf16_t* Fb1() const { return (bf16_t*)(ws + O_Fb1); }
  __device__ __forceinline__ bf16_t* Fb2() const { return (bf16_t*)(ws + O_Fb2); }
  __device__ __forceinline__ bf16_t* Bs() const { return (bf16_t*)(ws + O_Bs); }
  __device__ __forceinline__ bf16_t* Tcat() const { return (bf16_t*)(ws + O_Tcat); }
  __device__ __forceinline__ bf16_t* Ucat() const { return (bf16_t*)(ws + O_Ucat); }
  __device__ __forceinline__ bf16_t* hb() const { return (bf16_t*)(ws + O_hb); }
  __device__ __forceinline__ bf16_t* zT() const { return (bf16_t*)(ws + O_zT); }
  __device__ __forceinline__ bf16_t* AF() const { return (bf16_t*)(ws + O_AF); }
  __device__ __forceinline__ float* S() const { return (float*)(ws + O_S); }
  __device__ __forceinline__ bf16_t* mg() const { return (bf16_t*)(ws + O_mg); }
  __device__ __forceinline__ bf16_t* gact() const { return (bf16_t*)(ws + O_gact); }
  __device__ __forceinline__ bf16_t* Tt() const { return (bf16_t*)(ws + O_Tt); }
  __device__ __forceinline__ bf16_t* hid() const { return (bf16_t*)(ws + O_hid); }
};

typedef float f32x2v __attribute__((ext_vector_type(2)));
typedef __bf16 bf16x2v __attribute__((ext_vector_type(2)));
DI uint32_t pk2(float lo, float hi) { const f32x2v v = {lo, hi}; const bf16x2v r = __builtin_convertvector(v, bf16x2v); return __builtin_bit_cast(uint32_t, r); }
DI bf16_t f2bf(float f) { return (bf16_t)(pk2(f, 0.f) & 0xffffu); }
extern __shared__ __attribute__((aligned(16))) unsigned char dyn_smem[];
DI int otid(int wv) {
  unsigned m = ~0u; asm volatile("" : "+s"(m));
  const int lane = (int)__builtin_amdgcn_mbcnt_hi(m, __builtin_amdgcn_mbcnt_lo(m, 0u));
  int t = (wv << 6) | lane; asm volatile("" : "+v"(t)); return t;
}
#define XB_TMO      128
#define XB_XCNT(j)  (256  + 64 * (j))
#define XB_XSUB(j)  (1280 + 64 * (j))
#define XB_XGEN(j)  (2304 + 64 * (j))
#define XB_TOP      3328
#define XB_TOPGEN   3392
#define XCD_BAR_WORDS 3456
#define XB_SPIN_CAP (1u << 18)
#define XB_LAS __attribute__((address_space(3)))
constexpr int XB_LDS_OFF = 147440;
DI unsigned xb_ld(unsigned* p) { return __hip_atomic_load(p, __ATOMIC_RELAXED, __HIP_MEMORY_SCOPE_AGENT); }
DI unsigned xb_add(unsigned* p, unsigned v) { return __hip_atomic_fetch_add(p, v, __ATOMIC_RELAXED, __HIP_MEMORY_SCOPE_AGENT); }
DI unsigned xb_xcc_id() { return (unsigned)__builtin_amdgcn_s_getreg((3 << 11) | 20) & 0xFu; }
#define XB_SPIN(cond, bar) do { unsigned _sp = 0; while (cond) { __builtin_amdgcn_s_sleep(1); \
    if ((++_sp & 255u) == 0u) { if (xb_ld(&(bar)[XB_TMO])) break; if (_sp > XB_SPIN_CAP) { atomicAdd(&(bar)[XB_TMO], 1u); break; } } } } while (0)
DI void xcd_barrier_complete(unsigned* bar, unsigned x, unsigned& nloc, unsigned& nx) {
  const unsigned G = gridDim.x * gridDim.y * gridDim.z;
  unsigned sum, cnt, mine, sp = 0u;
  for (;;) {
    sum = 0u; cnt = 0u; mine = 0u;
#pragma unroll
    for (unsigned j = 0; j < 16; ++j) { const unsigned c = xb_ld(&bar[XB_XCNT(j)]); sum += c; cnt += (c > 0u) ? 1u : 0u; mine = (j == x) ? c : mine; }
    if (sum == G) break;
    __builtin_amdgcn_s_sleep(1);
    if ((++sp & 255u) == 0u) { if (xb_ld(&bar[XB_TMO])) break; if (sp > XB_SPIN_CAP) { atomicAdd(&bar[XB_TMO], 1u); break; } }
  }
  nloc = mine > 0u ? mine : 1u; nx = cnt > 0u ? cnt : 1u;
}
DI void xcd_barrier(unsigned* bar, const int tix) {
  asm volatile("s_waitcnt vmcnt(0)" ::: "memory");
  __syncthreads();
  if (tix == 0) {
    volatile XB_LAS unsigned* st = (volatile XB_LAS unsigned*)((XB_LAS unsigned char*)dyn_smem + XB_LDS_OFF);
    const unsigned x = xb_xcc_id();
    __builtin_amdgcn_s_waitcnt(0);
    unsigned nloc = st[0], nx = st[1];
    if (nloc == 0u) { xcd_barrier_complete(bar, x, nloc, nx); st[0] = nloc; st[1] = nx; }
    const unsigned old = xb_add(&bar[XB_XSUB(x)], 1u);
    const unsigned gen = old / nloc;
    if (old + 1u == (gen + 1u) * nloc) {
      __builtin_amdgcn_fence(__ATOMIC_RELEASE, "agent");
      asm volatile("s_waitcnt vmcnt(0)" ::: "memory");
      const unsigned og = xb_add(&bar[XB_TOP], 1u);
      const unsigned tg = og / nx;
      if (og + 1u == (tg + 1u) * nx) xb_add(&bar[XB_TOPGEN], 1u);
      else XB_SPIN(xb_ld(&bar[XB_TOPGEN]) == tg, bar);
      __builtin_amdgcn_fence(__ATOMIC_ACQUIRE, "agent");
      xb_add(&bar[XB_XGEN(x)], 1u);
      asm volatile("s_waitcnt vmcnt(0)" ::: "memory");
    } else {
      XB_SPIN(xb_ld(&bar[XB_XGEN(x)]) == gen, bar);
      __builtin_amdgcn_fence(__ATOMIC_ACQUIRE, "agent");
      asm volatile("s_waitcnt vmcnt(0)" ::: "memory");
    }
  }
  __syncthreads();
}

DI int tok2v(int tok) {
  if (tok < LPR) { const int l1 = tok >> 7, l2 = tok & 127; return ((l2 & 63) << 8) | ((l2 >> 6) << 7) | l1; }
  const int ts = tok - LPR, w = ts & 4095, l1 = w >> 6, l2 = w & 63;
  return LPR + (ts & ~4095) + (((l2 & 15) << 8) | ((l2 >> 4) << 6) | l1);
}
DI int v2tok(int v) {
  if (v < LPR) return ((v & 127) << 7) | (((v >> 7) & 1) << 6) | (v >> 8);
  const int vs = v - LPR, w = vs & 4095;
  return LPR + (vs & ~4095) + (((w & 63) << 6) | (((w >> 6) & 3) << 4) | (w >> 8));
}
DI int batch_of(int tok) { return tok < LPR ? 0 : 1 + ((tok - LPR) >> 12); }
DI float gelu_tanh(float x) {
  const float u = 0.7978845608028654f * (x + 0.044715f * x * x * x);
  return x / (1.f + __expf(-2.f * u));
}
DI float wave_sum(float v) {
  v += __shfl_xor(v, 32); v += __shfl_xor(v, 16); v += __shfl_xor(v, 8); v += __shfl_xor(v, 4); v += __shfl_xor(v, 2); v += __shfl_xor(v, 1);
  return v;
}

DI void ssm_pow(const P& p, int g, int dir, int pp, int j, float& re, float& im) {
  const int ia = (dir * 32 + g) * 64 + pp;
  const float lr = fminf(p.a_re[ia], -1e-4f), li = p.a_im[ia], dt = expf(p.log_dt[dir * 32 + g]);
  const float mag = expf(lr * dt * (float)j);
  double t = (double)li * (double)dt * (double)j * 0.15915494309189535;
  t -= rint(t);
  const float ang = (float)(t * 6.283185307179586);
  float s, c; sincosf(ang, &s, &c);
  re = mag * c; im = mag * s;
}
DI void ssm_coef(const P& p, int g, int dir, int pp, float& cr, float& ci) {
  const int ia = (dir * 32 + g) * 64 + pp;
  const float lr = fminf(p.a_re[ia], -1e-4f), li = p.a_im[ia];
  float ar, ai; ssm_pow(p, g, dir, pp, 1, ar, ai);
  const float nr = ar - 1.f, ni = ai, den = 1.f / (lr * lr + li * li);
  cr = (nr * lr + ni * li) * den; ci = (ni * lr - nr * li) * den;
}

template <class CM>
DI void transpose_job(float* tile, const int tid, bool act, int item2, const float* in, int ld, int Kdim, bf16_t* out, const CM& colmap, const float* sc0, const float* sc1) {
  const int nkt = Kdim / 64;
  __syncthreads();
  if (act) {
    float v[16];
#pragma unroll
    for (int u = 0; u < 2; u++) {
      const int item = 2 * item2 + u, nt = item / nkt, kt = item % nkt;
      const int c = tid & 31, kr = tid >> 5, col = colmap(nt * 32 + c);
#pragma unroll
      for (int i = 0; i < 8; i++) v[u * 8 + i] = in[(size_t)(kt * 64 + kr + 8 * i) * ld + col];
    }
#pragma unroll
    for (int u = 0; u < 2; u++) {
      const int item = 2 * item2 + u, kt = item % nkt;
      const int c = tid & 31, kr = tid >> 5;
#pragma unroll
      for (int i = 0; i < 8; i++) {
        const int kl = kr + 8 * i, k = kt * 64 + kl;
        float x = v[u * 8 + i];
        if (sc0) x *= (k < 512 ? sc0[k] : sc1[k - 512]);
        tile[u * 64 * 33 + kl * 33 + c] = x;
      }
    }
  }
  __syncthreads();
  if (act) {
#pragma unroll
    for (int u = 0; u < 2; u++) {
      const int item = 2 * item2 + u, nt = item / nkt, kt = item % nkt;
      const int nl = tid >> 3, kc = tid & 7;
      float x[8];
#pragma unroll
      for (int j = 0; j < 8; j++) x[j] = tile[u * 64 * 33 + (kc * 8 + j) * 33 + nl];
      uint4 w; w.x = pk2(x[0], x[1]); w.y = pk2(x[2], x[3]); w.z = pk2(x[4], x[5]); w.w = pk2(x[6], x[7]);
      *(uint4*)(out + (size_t)(nt * 32 + nl) * Kdim + kt * 64 + kc * 8) = w;
    }
  }
}

DI void phase0(const P& p, const int wv) {
  const int tix = otid(wv);
  unsigned char* smraw = dyn_smem + (tix >> 8) * SMEM_HALF;
  float* smf = (float*)smraw;
  const int tid = tix & 255, nb = gridDim.x * 2, bid = blockIdx.x * 2 + (tix >> 8);
  for (int base = 0; base < 384; base += nb) {
    const int item = base + bid; const bool act = item < 384;
    const int cg = act ? item % 96 : 0, ks = act ? item / 96 : 0;
    __syncthreads();
    if (act)
      for (int i = tid; i < 17 * 256; i += 256) {
        const int b = i >> 8, k = ks * 256 + (i & 255);
        const float c = b == 0 ? p.cp[k] : p.cs[(b - 1) * 1024 + k];
        smf[i] = c / (1.f + __expf(-c));
      }
    __syncthreads();
    const int col = tid & 63, sub = tid >> 6, j = cg * 64 + col;
    float a[17];
#pragma unroll
    for (int b = 0; b < 17; b++) a[b] = 0.f;
    if (act) {
#pragma unroll 1
      for (int bt = 0; bt < 4; bt++) {
        const int k0 = sub * 64 + bt * 16;
        float w[16];
#pragma unroll
        for (int i = 0; i < 16; i++) w[i] = p.w_ada[(size_t)(ks * 256 + k0 + i) * 6144 + j];
#pragma unroll
        for (int i = 0; i < 16; i++)
#pragma unroll
          for (int b = 0; b < 17; b++) a[b] += smf[b * 256 + k0 + i] * w[i];
      }
    }
    float* red = smf + 17 * 256;
#pragma unroll
    for (int b = 0; b < 17; b++) red[(sub * 17 + b) * 64 + col] = a[b];
    __syncthreads();
    if (act)
      for (int i = tid; i < 17 * 64; i += 256) {
        const int b = i >> 6, c2 = i & 63;
        float sum = red[(0 * 17 + b) * 64 + c2] + red[(1 * 17 + b) * 64 + c2] + red[(2 * 17 + b) * 64 + c2] + red[(3 * 17 + b) * 64 + c2];
        if (ks == 0) sum += p.b_ada[cg * 64 + c2];
        atomicAdd(p.mod() + b * 6144 + cg * 64 + c2, sum);
      }
  }
  {
    auto ident = [](int n) { return n; };
    auto glumap = [](int n) { return ((n >> 7) & 1) * 512 + (n >> 8) * 128 + (n & 127); };
    const int n0 = 256, n1 = n0 + 128, n2 = n1 + 256, n3 = n2 + 1024, n4 = n3 + 1024;
    for (int base = 0; base < n4; base += nb) {
      const int item = base + bid; const bool act = item < n4;
      if (item < n0) transpose_job(smf, tid, act, item, p.w_in, 1024, 1024, p.wint(), ident, nullptr, nullptr);
      else if (item < n1) transpose_job(smf, tid, act, item - n0, p.w_glu, 1024, 512, p.wglut(), glumap, nullptr, nullptr);
      else if (item < n2) transpose_job(smf, tid, act, item - n1, p.w_out, 1024, 1024, p.woutt(), ident, p.g_fo, p.g_so);
      else if (item < n3) transpose_job(smf, tid, act, item - n2, p.w1, 4096, 1024, p.w1t(), ident, nullptr, nullptr);
      else transpose_job(smf, tid, act, item - n3, p.w2, 1024, 4096, p.w2t(), ident, nullptr, nullptr);
    }
  }
  {
    __syncthreads();
    float2* cs = (float2*)smraw;
    for (int i = tid; i < 512; i += 256) { float s, c; sincosf((float)i * (6.283185307179586f / 512.f), &s, &c); cs[i] = make_float2(c, s); }
    __syncthreads();
    for (int item = bid; item < 128; item += nb) {
      const int idx = item * 256 + tid, k = idx & 1023, he = idx >> 10, h = he >> 3, e0 = (he & 7) * 16, c = k & 511;
      const bool is_sin = k >= 512;
      const float* wf = p.w_f + (size_t)h * 128 * 128 + e0;
      float a[16];
#pragma unroll
      for (int e = 0; e < 16; e++) a[e] = 0.f;
#pragma unroll 4
      for (int d = 0; d < 128; d++) {
        const float2 t = cs[((h * 128 + d) * c) & 511];
        const float tv = is_sin ? t.y : t.x;
        const f32x4 w0 = *(const f32x4*)(wf + d * 128), w1 = *(const f32x4*)(wf + d * 128 + 4), w2 = *(const f32x4*)(wf + d * 128 + 8), w3 = *(const f32x4*)(wf + d * 128 + 12);
#pragma unroll
        for (int e = 0; e < 4; e++) { a[e] += tv * w0[e]; a[4 + e] += tv * w1[e]; a[8 + e] += tv * w2[e]; a[12 + e] += tv * w3[e]; }
      }
#pragma unroll
      for (int e = 0; e < 16; e++) p.Mf()[(size_t)(h * 128 + e0 + e) * 1024 + k] = f2bf(a[e]);
    }
  }
  {
    const int gsz = nb * 256, gt = bid * 256 + tid;
    for (int i = gt; i < 1024 * 256; i += gsz) {
      const int nrg = i >> 8, k = i & 255, tb = nrg >> 9, nr = nrg & 511, part = (nr >> 7) & 1, idx8 = ((nr >> 8) << 7) | (nr & 127);
      const int R = tb ? 64 : 128, sh = tb ? 6 : 7, l2p = idx8 >> sh, k1 = idx8 & (R - 1), l2k = k >> sh, l1 = k & (R - 1);
      float sv, cv; sincosf((float)((k1 * l1) & (R - 1)) * (6.283185307179586f / (float)R), &sv, &cv);
      p.Fb1()[i] = f2bf(l2k == l2p ? (part ? -sv : cv) : 0.f);
    }
    for (int i = gt; i < 512 * 256; i += gsz) {
      const int nrg = i >> 8, k = i & 255, tb = nrg >> 8, nr = nrg & 255;
      float v;
      if (tb == 0) {
        const int part = nr >> 7, k2 = nr & 127, ki = k >> 7, l2 = k & 127;
        float sv, cv; sincosf((float)((k2 * l2) & 127) * (6.283185307179586f / 128.f), &sv, &cv);
        v = part == 0 ? (ki == 0 ? cv : sv) : (ki == 0 ? -sv : cv);
      } else {
        const int blk = nr >> 7, n2 = nr & 127, part = n2 >> 6, k2 = n2 & 63, kb = k >> 7, kk = k & 127, ki = kk >> 6, l2 = kk & 63;
        float sv, cv; sincosf((float)((k2 * l2) & 63) * (6.283185307179586f / 64.f), &sv, &cv);
        v = blk == kb ? (part == 0 ? (ki == 0 ? cv : sv) : (ki == 0 ? -sv : cv)) : 0.f;
      }
      p.Fb2()[i] = f2bf(v);
    }
    for (int i = gt; i < LPR; i += gsz) { float s, c; sincosf((float)i * (6.283185307179586f / 16384.f), &s, &c); p.twp()[i] = make_float2(c, s); }
    for (int i = gt; i < LSM; i += gsz) { float s, c; sincosf((float)i * (6.283185307179586f / 4096.f), &s, &c); p.tws()[i] = make_float2(c, s); }
    for (int i = gt; i < 32 * 2 * 64 * 64; i += gsz) {
      const int s = i & 63, pp = (i >> 6) & 63, dir = (i >> 12) & 1, g = i >> 13;
      float pr, pi, cr, ci; ssm_pow(p, g, dir, pp, dir == 0 ? 63 - s : s, pr, pi); ssm_coef(p, g, dir, pp, cr, ci);
      const float qr = pr * cr - pi * ci, qi = pr * ci + pi * cr;
      const int ib = ((dir * 32 + g) * 64 + pp) * 16;
      float vr[16], vi[16];
#pragma unroll
      for (int h = 0; h < 16; h++) { const float br = p.b_re[ib + h], bi = p.b_im[ib + h]; vr[h] = qr * br - qi * bi; vi[h] = qr * bi + qi * br; }
      bf16_t* d0 = p.Bs() + ((size_t)(g * 256 + dir * 128 + pp)) * 1024 + s * 16;
      bf16_t* d1 = d0 + 64 * 1024;
      uint4 w;
      w.x = pk2(vr[0], vr[1]); w.y = pk2(vr[2], vr[3]); w.z = pk2(vr[4], vr[5]); w.w = pk2(vr[6], vr[7]); *(uint4*)d0 = w;
      w.x = pk2(vr[8], vr[9]); w.y = pk2(vr[10], vr[11]); w.z = pk2(vr[12], vr[13]); w.w = pk2(vr[14], vr[15]); *(uint4*)(d0 + 8) = w;
      w.x = pk2(vi[0], vi[1]); w.y = pk2(vi[2], vi[3]); w.z = pk2(vi[4], vi[5]); w.w = pk2(vi[6], vi[7]); *(uint4*)d1 = w;
      w.x = pk2(vi[8], vi[9]); w.y = pk2(vi[10], vi[11]); w.z = pk2(vi[12], vi[13]); w.w = pk2(vi[14], vi[15]); *(uint4*)(d1 + 8) = w;
    }
    for (int i = gt; i < 32 * 64 * 2 * 64; i += gsz) {
      const int pp = i & 63, dir = (i >> 6) & 1, t = (i >> 7) & 63, g = i >> 13;
      float pr, pi; ssm_pow(p, g, dir, pp, dir == 0 ? t + 1 : 64 - t, pr, pi);
#pragma unroll
      for (int h = 0; h < 16; h++) {
        const int ic = ((dir * 32 + g) * 16 + h) * 64 + pp;
        const float cr = p.c_re[ic], ci = p.c_im[ic];
        bf16_t* d = p.Tcat() + ((size_t)(g * 1024 + t * 16 + h)) * 1280 + 1024 + dir * 128 + pp;
        d[0] = f2bf(cr * pr - ci * pi);
        d[64] = f2bf(-(cr * pi + ci * pr));
      }
    }
    for (int i = gt; i < 32 * 2 * 64; i += gsz) {
      const int pp = i & 63, dir = (i >> 6) & 1, g = i >> 7;
      float pr, pi; ssm_pow(p, g, dir, pp, 64, pr, pi);
      p.AT()[i * 2] = pr; p.AT()[i * 2 + 1] = pi;
    }
  }
  {
    float2* q = (float2*)smraw;
    float2* q1 = q + 512;
    float2* Cs = q + 576;
    float2* Bm = Cs + 2048;
    float2* E = Bm + 2048;
    for (int base = 0; base < 512; base += nb) {
      const int item = base + bid; const bool act = item < 512;
      const int g = act ? item >> 4 : 0, ch = act ? item & 15 : 0;
      __syncthreads();
      for (int e = tid; e < 512; e += 256) {
        const int j = e >> 6, pp = e & 63, jj = ch * 8 + j, lag = jj - 63;
        float2 v = make_float2(0.f, 0.f);
        if (jj < 127) {
          const int dir = lag >= 0 ? 0 : 1;
          float pr, pi, cr, ci; ssm_pow(p, g, dir, pp, lag < 0 ? -lag : lag, pr, pi); ssm_coef(p, g, dir, pp, cr, ci);
          v = make_float2(pr * cr - pi * ci, pr * ci + pi * cr);
        }
        q[e] = v;
      }
      if (tid < 64) { float cr, ci; ssm_coef(p, g, 1, tid, cr, ci); q1[tid] = make_float2(cr, ci); }
      for (int i = tid; i < 2048; i += 256) {
        const int dir = i >> 10, j = i & 1023, src = (dir * 32 + g) * 1024 + j;
        Cs[i] = make_float2(p.c_re[src], p.c_im[src]); Bm[i] = make_float2(p.b_re[src], p.b_im[src]);
      }
      const int hp = tid >> 4, h = tid & 15;
      float a0 = 0.f;
#pragma unroll 1
      for (int ps = 0; ps < 9; ps++) {
        const int j = ps < 8 ? ps : 7, jj = ch * 8 + j, lag = jj - 63;
        const bool valid = ps < 8 ? (jj < 127) : (jj == 63);
        const int dir = ps < 8 ? (lag >= 0 ? 0 : 1) : 1;
        const float2* qs = ps < 8 ? q + j * 64 : q1;
        __syncthreads();
        for (int i = tid; i < 1024; i += 256) {
          const float2 cc = Cs[dir * 1024 + i], qq = qs[i & 63];
          E[i] = make_float2(cc.x * qq.x - cc.y * qq.y, cc.x * qq.y + cc.y * qq.x);
        }
        __syncthreads();
        float a = 0.f;
        if (valid) {
#pragma unroll 8
          for (int pp = 0; pp < 64; pp++) { const float2 ee = E[hp * 64 + pp], bb = Bm[dir * 1024 + pp * 16 + h]; a += ee.x * bb.x - ee.y * bb.y; }
        }
        bool st = valid && act;
        if (ps < 8 && lag == 0) { a0 = a; st = false; }
        if (ps == 8) { a += a0; if (hp == h) a += p.ssm_d[g * 16 + h]; }
        if (st) {
          const bf16_t kv = f2bf(a);
          const int t0 = lag > 0 ? lag : 0, t1 = lag > 0 ? 64 : 64 + lag;
          bf16_t* d = p.Tcat() + ((size_t)(g * 1024 + hp)) * 1280 + h;
          for (int t = t0; t < t1; t++) d[(size_t)t * 16 * 1280 + (t - lag) * 16] = kv;
        }
      }
    }
  }
}

constexpr int RIF = 2;
DI float bflo(uint32_t u) { return __uint_as_float(u << 16); }
DI float bfhi(uint32_t u) { return __uint_as_float(u & 0xffff0000u); }
template <bool FROMX>
DI void rownorm_mod(const P& p, const int wv, const float* g, int sh_off, int sc_off) {
  const int tix = otid(wv), lane = tix & 63, wrow = blockIdx.x * 8 + (tix >> 6), nw = gridDim.x * 8;
  if (FROMX) {
    for (int i = blockIdx.x * 512 + tix; i < 4096 * 32; i += gridDim.x * 512) {
      const int col = i & 4095, ks = i >> 12;
      float a[17];
#pragma unroll
      for (int b = 0; b < 17; b++) a[b] = 0.f;
#pragma unroll 8
      for (int k = ks * 32; k < ks * 32 + 32; k++) {
        const float w = p.w1[(size_t)k * 4096 + col];
#pragma unroll
        for (int b = 0; b < 17; b++) a[b] += p.mod()[b * 6144 + 3072 + k] * w;
      }
      const float b1v = ks == 0 ? p.b1[col] : 0.f;
#pragma unroll
      for (int b = 0; b < 17; b++) atomicAdd(p.sb2() + b * 4096 + col, a[b] + b1v);
    }
  }
  auto load = [&](int tok0, float (&v)[RIF][16]) {
#pragma unroll
    for (int rr = 0; rr < RIF; rr++) {
      const int tok = tok0 + rr * nw;
      if (tok < NTOK) {
        if (FROMX) {
          const float* src = tok < LPR ? p.xp + (size_t)tok * 1024 : p.xs + (size_t)(tok - LPR) * 1024;
#pragma unroll
          for (int i = 0; i < 4; i++) { const f32x4 t = *(const f32x4*)(src + (i * 64 + lane) * 4); v[rr][4 * i] = t[0]; v[rr][4 * i + 1] = t[1]; v[rr][4 * i + 2] = t[2]; v[rr][4 * i + 3] = t[3]; }
        } else {
          const bf16_t* src = (const bf16_t*)p.out + (size_t)tok * 1024;
#pragma unroll
          for (int i = 0; i < 2; i++) { const uint4 t = *(const uint4*)(src + (i * 64 + lane) * 8);
            v[rr][8 * i] = bflo(t.x); v[rr][8 * i + 1] = bfhi(t.x); v[rr][8 * i + 2] = bflo(t.y); v[rr][8 * i + 3] = bfhi(t.y);
            v[rr][8 * i + 4] = bflo(t.z); v[rr][8 * i + 5] = bfhi(t.z); v[rr][8 * i + 6] = bflo(t.w); v[rr][8 * i + 7] = bfhi(t.w); }
        }
      } else {
#pragma unroll
        for (int e = 0; e < 16; e++) v[rr][e] = 0.f;
      }
    }
  };
  auto process = [&](int tok0, const float (&v)[RIF][16]) {
    float ss[RIF];
#pragma unroll
    for (int rr = 0; rr < RIF; rr++) {
      ss[rr] = 0.f;
#pragma unroll
      for (int e = 0; e < 16; e++) ss[rr] += v[rr][e] * v[rr][e];
      ss[rr] = wave_sum(ss[rr]);
    }
#pragma unroll
    for (int rr = 0; rr < RIF; rr++) {
      const int tok = tok0 + rr * nw;
      if (tok >= NTOK) continue;
      const float r = rsqrtf(ss[rr] * (1.f / 1024.f) + EPSV);
      const float* md = p.mod() + batch_of(tok) * 6144;
      bf16_t* drow = p.hb() + (size_t)(FROMX ? tok2v(tok) : tok) * 1024;
      float o[16];
#pragma unroll
      for (int q = 0; q < 4; q++) {
        const int c = FROMX ? (q * 64 + lane) * 4 : ((q >> 1) * 64 + lane) * 8 + (q & 1) * 4;
        const f32x4 gg = *(const f32x4*)(g + c);
        f32x4 sc = *(const f32x4*)(md + sc_off + c), sh = *(const f32x4*)(md + sh_off + c);
#pragma unroll
        for (int e = 0; e < 4; e++) o[4 * q + e] = v[rr][4 * q + e] * r * gg[e] * (1.f + sc[e]) + sh[e];
      }
      if (FROMX) {
#pragma unroll
        for (int q = 0; q < 4; q++) { uint2 w; w.x = pk2(o[4 * q], o[4 * q + 1]); w.y = pk2(o[4 * q + 2], o[4 * q + 3]); *(uint2*)(drow + (q * 64 + lane) * 4) = w; }
      } else {
#pragma unroll
        for (int i = 0; i < 2; i++) { uint4 w; w.x = pk2(o[8 * i], o[8 * i + 1]); w.y = pk2(o[8 * i + 2], o[8 * i + 3]); w.z = pk2(o[8 * i + 4], o[8 * i + 5]); w.w = pk2(o[8 * i + 6], o[8 * i + 7]);
          *(uint4*)(drow + (i * 64 + lane) * 8) = w; }
      }
    }
  };
  float va[RIF][16], vb[RIF][16];
  load(wrow, va);
  for (int tok0 = wrow; tok0 < NTOK; tok0 += 2 * RIF * nw) {
    load(tok0 + RIF * nw, vb);
    process(tok0, va);
    load(tok0 + 2 * RIF * nw, va);
    process(tok0 + RIF * nw, vb);
  }
}
DI void final_norm(const P& p, const int wv) {
  const int tix = otid(wv), lane = tix & 63, wrow = blockIdx.x * 8 + (tix >> 6), nw = gridDim.x * 8;
  auto load = [&](int tok0, uint4 (&v)[RIF][2]) {
#pragma unroll
    for (int rr = 0; rr < RIF; rr++) {
      const int tok = tok0 + rr * nw;
      if (tok < NTOK) {
        const bf16_t* src = p.hb() + (size_t)tok * 1024;
#pragma unroll
        for (int i = 0; i < 2; i++) v[rr][i] = *(const uint4*)(src + (i * 64 + lane) * 8);
      } else {
#pragma unroll
        for (int i = 0; i < 2; i++) v[rr][i] = make_uint4(0u, 0u, 0u, 0u);
      }
    }
  };
  auto process = [&](int tok0, const uint4 (&vr)[RIF][2]) {
    float v[RIF][16], ss[RIF];
#pragma unroll
    for (int rr = 0; rr < RIF; rr++) {
#pragma unroll
      for (int i = 0; i < 2; i++) { const uint4 t = vr[rr][i];
        v[rr][8 * i] = bflo(t.x); v[rr][8 * i + 1] = bfhi(t.x); v[rr][8 * i + 2] = bflo(t.y); v[rr][8 * i + 3] = bfhi(t.y);
        v[rr][8 * i + 4] = bflo(t.z); v[rr][8 * i + 5] = bfhi(t.z); v[rr][8 * i + 6] = bflo(t.w); v[rr][8 * i + 7] = bfhi(t.w); }
      ss[rr] = 0.f;
#pragma unroll
      for (int e = 0; e < 16; e++) ss[rr] += v[rr][e] * v[rr][e];
      ss[rr] = wave_sum(ss[rr]);
    }
#pragma unroll
    for (int rr = 0; rr < RIF; rr++) {
      const int tok = tok0 + rr * nw;
      if (tok >= NTOK) continue;
      const float r = rsqrtf(ss[rr] * (1.f / 1024.f) + EPSV);
      float* drow = p.out + (size_t)tok * 1024;
#pragma unroll
      for (int q = 0; q < 4; q++) {
        const int c = ((q >> 1) * 64 + lane) * 8 + (q & 1) * 4;
        const f32x4 gg = *(const f32x4*)(p.g_final + c);
        f32x4 o;
#pragma unroll
        for (int e = 0; e < 4; e++) o[e] = v[rr][4 * q + e] * r * gg[e];
        *(f32x4*)(drow + c) = o;
      }
    }
  };
  uint4 va[RIF][2], vb[RIF][2];
  load(wrow, va);
  for (int tok0 = wrow; tok0 < NTOK; tok0 += 2 * RIF * nw) {
    load(tok0 + RIF * nw, vb);
    process(tok0, va);
    load(tok0 + 2 * RIF * nw, va);
    process(tok0 + RIF * nw, vb);
  }
}

namespace pg8 {
#define PG8_LAS __attribute__((address_space(3)))
typedef unsigned short bf16_t;
typedef short bf16x8 __attribute__((ext_vector_type(8)));
typedef float f32x4 __attribute__((ext_vector_type(4)));
typedef unsigned u32x4 __attribute__((ext_vector_type(4)));
constexpr int BM = 256, BK = 64, HALF = 128, HTB = HALF * BK * 2  , STAGE_BYTES = 8 * HTB, NXCD = 8, WGM = 8;

__host__ __device__ __forceinline__ int lds_byte(int r, int c) { const int st = (r >> 4) * 2 + (c >> 5), rr = r & 15, cc = c & 31, ob = rr * 64 + cc * 2; return st * 1024 + (ob ^ (((ob >> 9) & 1) << 5)); }
__host__ __device__ __forceinline__ void stage_rc(int b, int& R, int& C) { const int st = b / 1024, sb = b % 1024, swz = sb ^ (((sb >> 9) & 1) << 5); R = (st >> 1) * 16 + swz / 64; C = (st & 1) * 32 + (swz % 64) / 2; }
__host__ __device__ __forceinline__ int perm32(int rho) { const int n = rho >> 4, i = rho & 15; return 8 * (i >> 2) + 4 * n + (i & 3); }

struct Unit { int pm, pn; };
struct Gemm { const bf16_t* A; const bf16_t* Bt; int M, N, K, lda, ldb; };

struct StaticOrder {
    int nM, nN, nwg, G, c;
    __host__ __device__ void init(int M, int N, int G_, int c_) { nM = M / BM; nN = N / BM; nwg = nM * nN; G = G_; c = c_; }
    __host__ __device__ bool next(int i, Unit& u) const {
        const long L = (long)i * G + c; if (L >= nwg) return false;
        int wgid = (int)L; { const int q = nwg / NXCD, r = nwg % NXCD, xcd = wgid % NXCD, off = wgid / NXCD; wgid = (xcd < r ? xcd * (q + 1) : r * (q + 1) + (xcd - r) * q) + off; }
        const int nig = WGM * nN, gid = wgid / nig, fm = gid * WGM, gsz = (nM - fm) < WGM ? (nM - fm) : WGM;
        u.pm = fm + ((wgid % nig) % gsz); u.pn = (wgid % nig) / gsz; return true;
    }
    __device__ __forceinline__ void a_ready(const Unit&) const {}
    __device__ __forceinline__ void done(const Unit&) const {}
};

struct GroupOrder {
    int nwg, G, c, um, un;
    __host__ __device__ void init(int ngroups, int um_, int un_, int G_, int c_) { um = um_; un = un_; nwg = ngroups * um * un; G = G_; c = (c_ & 7) * (G_ >> 3) + (c_ >> 3); }
    __host__ __device__ bool next(int i, Unit& u) const {
        const int L = i * G + c; if (L >= nwg) return false;
        const int gi = L / (um * un), r = L % (um * un); u.pm = gi * um + r / un; u.pn = gi * un + r % un; return true;
    }
    __device__ __forceinline__ void a_ready(const Unit&) const {}
    __device__ __forceinline__ void done(const Unit&) const {}
};
struct Fft1Order {
    int q0, qs, qe;
    __host__ __device__ void init(int G, int bidx) {
        const int slot = (bidx & 7) * (G >> 3) + (bidx >> 3), nbusy = 160 < G ? 160 : G, nfree = G - nbusy;
        if (nfree <= 0) { q0 = slot; qs = G; qe = 1280; }
        else if (slot < nbusy) { q0 = slot; qs = nbusy; qe = 560; }
        else { q0 = 560 + (slot - nbusy); qs = nfree; qe = 1280; }
    }
    __host__ __device__ bool next(int i, Unit& u) const { const int L = q0 + i * qs; if (L >= qe) return false; u.pn = L >> 1; u.pm = (L & 1) + (u.pn >= 128 ? 2 : 0); return true; }
    __device__ __forceinline__ void a_ready(const Unit&) const {}
    __device__ __forceinline__ void done(const Unit&) const {}
};
struct Fft2Order {
    int G, c;
    __host__ __device__ void init(int G_, int c_) { G = G_; c = c_; }
    __host__ __device__ bool next(int i, Unit& u) const { const int L = i * G + c; if (L >= 1280) return false; u.pn = L; u.pm = L < 256 ? 0 : 1; return true; }
    __device__ __forceinline__ void a_ready(const Unit&) const {}
    __device__ __forceinline__ void done(const Unit&) const {}
};
struct YfOrder {
    int G, c;
    __host__ __device__ void init(int G_, int bidx) { G = G_; const int slot = (bidx & 7) * (G_ >> 3) + (bidx >> 3); c = (slot + (G_ >> 1)) % G_; }
    __host__ __device__ bool next(int i, Unit& u) const { const int L = i * G + c; if (L >= 640) return false; u.pm = L >> 1; u.pn = L & 1; return true; }
    __device__ __forceinline__ void a_ready(const Unit&) const {}
    __device__ __forceinline__ void done(const Unit&) const {}
};
template <class Epi, class Sched, bool ALIGN_EPI = false, bool SP2 = false>
__device__ __forceinline__ void gemm_phase(PG8_LAS unsigned char* lds, const int tix, const Gemm g, const Sched& S, const Epi& E) {
    const int tid = tix, wid = __builtin_amdgcn_readfirstlane(tid >> 6), lane = tid & 63, wr = wid >> 2, wc = wid & 3, fr = lane & 15, fq = lane >> 4;
    const int K = g.K, nt = K / BK;
    unsigned voffA[2], voffB[2];
#pragma unroll
    for (int i = 0; i < 2; ++i) { int R, C; stage_rc(tid * 16 + i * 8192, R, C); const int Rb = Epi::PERM ? ((R & ~31) + perm32(R & 31)) : R;
        voffA[i] = (unsigned)(R * g.lda + C) * 2u; voffB[i] = (unsigned)(Rb * g.ldb + C) * 2u; }
    const size_t kstep = (size_t)(BK * 2);
    const size_t hstepA = (size_t)HALF * g.lda * 2, hstepB = (size_t)HALF * g.ldb * 2;
    const size_t tstepA = 2 * hstepA, tstepB = 2 * hstepB;
    const unsigned ldsw = (unsigned)wid * 1024u;
    const int aoff = lds_byte(wr * 64 + fr, fq * 8), boff = lds_byte(wc * 32 + fr, fq * 8);
#define PG8_SA(b, h) (((b) * 2 + (h)) * HTB)
#define PG8_SB(b, h) ((4 + (b) * 2 + (h)) * HTB)
#define PG8_STAGE(bufoff, gbase, voff) do { _Pragma("unroll") for (int _i = 0; _i < 2; ++_i) \
        __builtin_amdgcn_global_load_lds((const unsigned*)((const char*)(gbase) + (voff)[_i]), (PG8_LAS unsigned*)(lds + (bufoff) + ldsw + _i * 8192), 16, 0, 0); } while (0)
#define PG8_LDA(dst, b, h) do { _Pragma("unroll") for (int m = 0; m < 4; ++m) _Pragma("unroll") for (int k = 0; k < 2; ++k) dst[m][k] = *(const PG8_LAS bf16x8*)(lds + PG8_SA(b, h) + aoff + m * 2048 + k * 1024); } while (0)
#define PG8_LDB(dst, b, h) do { _Pragma("unroll") for (int n = 0; n < 2; ++n) _Pragma("unroll") for (int k = 0; k < 2; ++k) dst[n][k] = *(const PG8_LAS bf16x8*)(lds + PG8_SB(b, h) + boff + n * 2048 + k * 1024); } while (0)
#define PG8_MMA(ai, bj, At, Bt) do { __builtin_amdgcn_s_setprio(1); _Pragma("unroll") for (int m = 0; m < 4; ++m) _Pragma("unroll") for (int n = 0; n < 2; ++n) _Pragma("unroll") for (int k = 0; k < 2; ++k) \
        acc[ai][bj][m][n] = __builtin_amdgcn_mfma_f32_16x16x32_bf16(Bt[n][k], At[m][k], acc[ai][bj][m][n], 0, 0, 0); __builtin_amdgcn_s_setprio(0); } while (0)
#define PG8_WAIT_V(n) asm volatile("s_waitcnt vmcnt(" #n ")" ::: "memory")
#define PG8_WAIT_L(n) asm volatile("s_waitcnt lgkmcnt(" #n ")" ::: "memory")
#define PG8_BAR __builtin_amdgcn_s_barrier()
#define PG8_SCHED __builtin_amdgcn_sched_barrier(0)
    Unit cur, nxt; int ui = 0;
    if (!S.next(0, cur)) return;
    f32x4 acc[2][2][4][2];
#pragma unroll
    for (int a = 0; a < 2; ++a)
#pragma unroll
        for (int b = 0; b < 2; ++b)
#pragma unroll
            for (int m = 0; m < 4; ++m)
#pragma unroll
                for (int n = 0; n < 2; ++n) acc[a][b][m][n] = (f32x4){0.f, 0.f, 0.f, 0.f};
    bf16x8 At[4][2], B0[2][2], B1[2][2];
    const char* cA = (const char*)g.A + (size_t)cur.pm * tstepA; const char* cB = (const char*)g.Bt + (size_t)cur.pn * tstepB;
    S.a_ready(cur);
    if constexpr (SP2) {
        PG8_STAGE(PG8_SB(0, 0), cB, voffB); PG8_STAGE(PG8_SB(0, 1), cB + hstepB, voffB); PG8_STAGE(PG8_SA(0, 0), cA, voffA); PG8_STAGE(PG8_SA(0, 1), cA + hstepA, voffA);
        if (wr == 1) PG8_BAR;
        PG8_WAIT_V(2); PG8_BAR;
        PG8_STAGE(PG8_SB(1, 0), cB + kstep, voffB); PG8_STAGE(PG8_SA(1, 0), cA + kstep, voffA); PG8_STAGE(PG8_SB(1, 1), cB + hstepB + kstep, voffB);
        PG8_WAIT_V(6); PG8_BAR;
    } else {
        PG8_STAGE(PG8_SB(0, 0), cB, voffB); PG8_STAGE(PG8_SA(0, 0), cA, voffA); PG8_STAGE(PG8_SB(0, 1), cB + hstepB, voffB); PG8_STAGE(PG8_SA(0, 1), cA + hstepA, voffA);
        if (wr == 1) PG8_BAR;
        PG8_WAIT_V(4); PG8_BAR;
        PG8_STAGE(PG8_SB(1, 0), cB + kstep, voffB); PG8_STAGE(PG8_SA(1, 0), cA + kstep, voffA); PG8_STAGE(PG8_SB(1, 1), cB + hstepB + kstep, voffB);
        PG8_WAIT_V(6); PG8_BAR;
    }
    for (;;) {
        const bool has_next = S.next(ui + 1, nxt);
        const char* nA = has_next ? (const char*)g.A + (size_t)nxt.pm * tstepA : cA; const char* nB = has_next ? (const char*)g.Bt + (size_t)nxt.pn * tstepB : cB;
        for (int t = 0; t < nt; t += 2) {
            if constexpr (Epi::KHOOK) { if (t == Epi::KH_T) E.khook(acc, ui, wr, fr, lds); }
            const bool last = (t == nt - 2);
            const char* a1 = cA + (size_t)(t + 1) * kstep;
            const char* a2 = last ? nA : cA + (size_t)(t + 2) * kstep; const char* b2 = last ? nB : cB + (size_t)(t + 2) * kstep;
            const char* a3 = a2 + kstep; const char* b3 = b2 + kstep;
            if (last && has_next) S.a_ready(nxt);
            if constexpr (SP2) {
            PG8_LDB(B0, 0, 0); PG8_LDB(B1, 0, 1); PG8_SCHED; PG8_LDA(At, 0, 0); PG8_STAGE(PG8_SA(1, 1), a1 + hstepA, voffA);
            PG8_WAIT_V(8); PG8_WAIT_L(0); PG8_BAR; PG8_MMA(0, 0, At, B0); PG8_MMA(0, 1, At, B1); PG8_BAR; PG8_SCHED;
            PG8_LDA(At, 0, 1); PG8_STAGE(PG8_SB(0, 0), b2, voffB); PG8_STAGE(PG8_SB(0, 1), b2 + hstepB, voffB); PG8_STAGE(PG8_SA(0, 0), a2, voffA);
            PG8_WAIT_V(8); PG8_WAIT_L(0); PG8_BAR; PG8_MMA(1, 0, At, B0); PG8_MMA(1, 1, At, B1); PG8_BAR; PG8_SCHED;
            PG8_LDB(B0, 1, 0); PG8_LDB(B1, 1, 1); PG8_SCHED; PG8_LDA(At, 1, 0); PG8_STAGE(PG8_SA(0, 1), a2 + hstepA, voffA);
            PG8_WAIT_V(8); PG8_WAIT_L(0); PG8_BAR; PG8_MMA(0, 0, At, B0); PG8_MMA(0, 1, At, B1); PG8_BAR; PG8_SCHED;
            PG8_LDA(At, 1, 1); PG8_STAGE(PG8_SB(1, 0), b3, voffB); PG8_STAGE(PG8_SB(1, 1), b3 + hstepB, voffB); PG8_STAGE(PG8_SA(1, 0), a3, voffA);
            PG8_WAIT_V(8); PG8_WAIT_L(0); PG8_BAR; PG8_MMA(1, 0, At, B0); PG8_MMA(1, 1, At, B1); PG8_BAR; PG8_SCHED;
            } else {
            PG8_LDB(B0, 0, 0); PG8_SCHED; PG8_LDA(At, 0, 0); PG8_STAGE(PG8_SA(1, 1), a1 + hstepA, voffA);
            PG8_WAIT_L(8); PG8_BAR; PG8_WAIT_L(0); PG8_MMA(0, 0, At, B0); PG8_BAR; PG8_SCHED;
            PG8_LDB(B1, 0, 1); PG8_STAGE(PG8_SB(0, 0), b2, voffB);
            PG8_BAR; PG8_WAIT_L(0); PG8_MMA(0, 1, At, B1); PG8_BAR;
            PG8_LDA(At, 0, 1); PG8_STAGE(PG8_SA(0, 0), a2, voffA);
            PG8_BAR; PG8_WAIT_L(0); PG8_MMA(1, 0, At, B0); PG8_BAR; PG8_SCHED;
            PG8_STAGE(PG8_SB(0, 1), b2 + hstepB, voffB);
            PG8_WAIT_V(6); PG8_BAR; PG8_MMA(1, 1, At, B1); PG8_BAR;
            PG8_LDB(B0, 1, 0); PG8_SCHED; PG8_LDA(At, 1, 0); PG8_STAGE(PG8_SA(0, 1), a2 + hstepA, voffA);
            PG8_WAIT_L(8); PG8_BAR; PG8_WAIT_L(0); PG8_MMA(0, 0, At, B0); PG8_BAR; PG8_SCHED;
            PG8_LDB(B1, 1, 1); PG8_STAGE(PG8_SB(1, 0), b3, voffB);
            PG8_BAR; PG8_WAIT_L(0); PG8_MMA(0, 1, At, B1); PG8_BAR;
            PG8_LDA(At, 1, 1); PG8_STAGE(PG8_SA(1, 0), a3, voffA);
            PG8_BAR; PG8_WAIT_L(0); PG8_MMA(1, 0, At, B0); PG8_BAR; PG8_SCHED;
            PG8_STAGE(PG8_SB(1, 1), b3 + hstepB, voffB);
            PG8_WAIT_V(6); PG8_BAR; PG8_MMA(1, 1, At, B1); PG8_BAR;
            }
        }
        if constexpr (ALIGN_EPI) { if (wr == 0) PG8_BAR; }
        if constexpr (!Epi::AFTER_DRAIN) { E(acc, cur, wr, wc, fr, fq, ui); S.done(cur); }
        if (!has_next) break;
#pragma unroll
        for (int a = 0; a < 2; ++a)
#pragma unroll
            for (int b = 0; b < 2; ++b)
#pragma unroll
                for (int m = 0; m < 4; ++m)
#pragma unroll
                    for (int n = 0; n < 2; ++n) acc[a][b][m][n] = (f32x4){0.f, 0.f, 0.f, 0.f};
        cur = nxt; cA = nA; cB = nB; ++ui;
        if constexpr (ALIGN_EPI) { if (wr == 1) PG8_BAR; }
    }
    PG8_WAIT_V(0);
    if constexpr (!ALIGN_EPI) { if (wr == 0) PG8_BAR; }
    PG8_BAR;
    if constexpr (Epi::AFTER_DRAIN) { E.fused(acc, cur, wr, wc, fr, fq, lds, wid, lane); S.done(cur); }
#undef PG8_SA
#undef PG8_SB
#undef PG8_STAGE
#undef PG8_LDA
#undef PG8_LDB
#undef PG8_MMA
#undef PG8_WAIT_V
#undef PG8_WAIT_L
#undef PG8_BAR
#undef PG8_SCHED
}
}

namespace pg8 {
struct EpiMlpIn {
  static constexpr bool PERM = true, AFTER_DRAIN = false, KHOOK = false; static constexpr int KH_T = 0;
  ::bf16_t* O; const float* sb2; const float* ss1;
  __device__ __forceinline__ void operator()(const f32x4 (&acc)[2][2][4][2], const Unit& u, int wr, int wc, int fr, int fq, int) const {
    const int row0 = u.pm * BM + wr * 64 + fr, col0 = u.pn * BM + wc * 32 + 8 * fq;
    const float* bias = sb2 + batch_of(u.pm * BM) * 4096;
    f32x4 bv[2][2];
#pragma unroll
    for (int bj = 0; bj < 2; ++bj)
#pragma unroll
      for (int n = 0; n < 2; ++n) bv[bj][n] = *(const f32x4*)(bias + col0 + bj * HALF + 4 * n);
    float r2[2][4];
#pragma unroll
    for (int ai = 0; ai < 2; ++ai)
#pragma unroll
      for (int m = 0; m < 4; ++m) r2[ai][m] = rsqrtf(ss1[row0 + ai * HALF + m * 16] * (1.f / 1024.f) + EPSV);
#pragma unroll
    for (int ai = 0; ai < 2; ++ai)
#pragma unroll
      for (int m = 0; m < 4; ++m) {
        ::bf16_t* rowp = O + (size_t)(row0 + ai * HALF + m * 16) * 4096 + col0;
#pragma unroll
        for (int bj = 0; bj < 2; ++bj) {
          f32x4 v0 = acc[ai][bj][m][0] * r2[ai][m] + bv[bj][0], v1 = acc[ai][bj][m][1] * r2[ai][m] + bv[bj][1];
#pragma unroll
          for (int e = 0; e < 4; ++e) { const float a = fmaxf(v0[e], 0.f), b = fmaxf(v1[e], 0.f); v0[e] = a * a; v1[e] = b * b; }
          u32x4 w; w.x = pk2(v0[0], v0[1]); w.y = pk2(v0[2], v0[3]); w.z = pk2(v1[0], v1[1]); w.w = pk2(v1[2], v1[3]);
          *(u32x4*)(rowp + bj * HALF) = w;
        }
      }
  }
};
struct EpiMlpOut {
  static constexpr bool PERM = true, AFTER_DRAIN = false, KHOOK = false; static constexpr int KH_T = 0;
  const ::bf16_t* x1; ::bf16_t* x2; const float* mod; const float* bias;
  __device__ __forceinline__ void operator()(const f32x4 (&acc)[2][2][4][2], const Unit& u, int wr, int wc, int fr, int fq, int) const {
    const int col0 = u.pn * BM + wc * 32 + 8 * fq;
    const float* g2 = mod + batch_of(u.pm * BM) * 6144 + 5120;
    f32x4 bb[2][2], gv[2][2];
#pragma unroll
    for (int bj = 0; bj < 2; ++bj)
#pragma unroll
      for (int n = 0; n < 2; ++n) { bb[bj][n] = *(const f32x4*)(bias + col0 + bj * HALF + n * 4); gv[bj][n] = *(const f32x4*)(g2 + col0 + bj * HALF + n * 4); }
#pragma unroll
    for (int ai = 0; ai < 2; ++ai) {
      u32x4 xr[4][2];
#pragma unroll
      for (int m = 0; m < 4; ++m) {
        const int row = u.pm * BM + ai * HALF + wr * 64 + m * 16 + fr;
#pragma unroll
        for (int bj = 0; bj < 2; ++bj) xr[m][bj] = *(const u32x4*)(x1 + (size_t)row * 1024 + col0 + bj * HALF);
      }
      asm volatile("" ::: "memory");
#pragma unroll
      for (int m = 0; m < 4; ++m) {
        const int row = u.pm * BM + ai * HALF + wr * 64 + m * 16 + fr;
#pragma unroll
        for (int bj = 0; bj < 2; ++bj) {
          const u32x4 xx = xr[m][bj];
          f32x4 x0, x1v;
          x0[0] = bflo(xx.x); x0[1] = bfhi(xx.x); x0[2] = bflo(xx.y); x0[3] = bfhi(xx.y);
          x1v[0] = bflo(xx.z); x1v[1] = bfhi(xx.z); x1v[2] = bflo(xx.w); x1v[3] = bfhi(xx.w);
          const f32x4 o0 = x0 + gv[bj][0] * (acc[ai][bj][m][0] + bb[bj][0]), o1 = x1v + gv[bj][1] * (acc[ai][bj][m][1] + bb[bj][1]);
          u32x4 w; w.x = pk2(o0[0], o0[1]); w.y = pk2(o0[2], o0[3]); w.z = pk2(o1[0], o1[1]); w.w = pk2(o1[2], o1[3]);
          *(u32x4*)(x2 + (size_t)row * 1024 + col0 + bj * HALF) = w;
        }
      }
    }
  }
};
struct EpiYf {
  static constexpr bool PERM = true, AFTER_DRAIN = false, KHOOK = false; static constexpr int KH_T = 0;
  ::bf16_t* O; const float* bias; float* ss;
  __device__ __forceinline__ void operator()(const f32x4 (&acc)[2][2][4][2], const Unit& u, int wr, int wc, int fr, int fq, int) const {
    const int row0 = u.pm * BM + wr * 64 + fr, col0 = u.pn * BM + wc * 32 + 8 * fq;
    f32x4 bv[2][2];
#pragma unroll
    for (int bj = 0; bj < 2; ++bj)
#pragma unroll
      for (int n = 0; n < 2; ++n) bv[bj][n] = *(const f32x4*)(bias + col0 + bj * HALF + 4 * n);
#pragma unroll
    for (int ai = 0; ai < 2; ++ai)
#pragma unroll
      for (int m = 0; m < 4; ++m) {
        const int row = row0 + ai * HALF + m * 16;
        const float scale = row < LPR ? 3.4526698300124393e-4f : 6.905339660024879e-4f;
        ::bf16_t* rowp = O + (size_t)row * 1024 + col0;
        float s = 0.f;
#pragma unroll
        for (int bj = 0; bj < 2; ++bj) {
          const f32x4 v0 = acc[ai][bj][m][0] * scale + bv[bj][0], v1 = acc[ai][bj][m][1] * scale + bv[bj][1];
          s += (v0[0] * v0[0] + v0[1] * v0[1]) + (v0[2] * v0[2] + v0[3] * v0[3]) + (v1[0] * v1[0] + v1[1] * v1[1]) + (v1[2] * v1[2] + v1[3] * v1[3]);
          u32x4 w; w.x = pk2(v0[0], v0[1]); w.y = pk2(v0[2], v0[3]); w.z = pk2(v1[0], v1[1]); w.w = pk2(v1[2], v1[3]);
          *(u32x4*)(rowp + bj * HALF) = w;
        }
        s += __shfl_xor(s, 16); s += __shfl_xor(s, 32);
        if (fq == 0) ss[row * 8 + u.pn * 4 + wc] = s;
      }
  }
};
struct EpiGlu {
  static constexpr bool PERM = true, AFTER_DRAIN = false, KHOOK = false; static constexpr int KH_T = 0;
  ::bf16_t* O; const float* bias; float* ss;
  __device__ __forceinline__ void operator()(const f32x4 (&acc)[2][2][4][2], const Unit& u, int wr, int wc, int fr, int fq, int) const {
    const int row0 = u.pm * BM + wr * 64 + fr, j0 = u.pn * 128 + wc * 32 + 8 * fq;
    f32x4 bv[2][2];
#pragma unroll
    for (int bj = 0; bj < 2; ++bj)
#pragma unroll
      for (int n = 0; n < 2; ++n) bv[bj][n] = *(const f32x4*)(bias + bj * 512 + j0 + 4 * n);
#pragma unroll
    for (int ai = 0; ai < 2; ++ai)
#pragma unroll
      for (int m = 0; m < 4; ++m) {
        const int row = row0 + ai * HALF + m * 16;
        float o[8], s = 0.f;
#pragma unroll
        for (int n = 0; n < 2; ++n)
#pragma unroll
          for (int e = 0; e < 4; ++e) {
            const float val = acc[ai][0][m][n][e] + bv[0][n][e], gate = acc[ai][1][m][n][e] + bv[1][n][e];
            const float y = val / (1.f + __expf(-gate));
            o[4 * n + e] = y; s += y * y;
          }
        u32x4 w; w.x = pk2(o[0], o[1]); w.y = pk2(o[2], o[3]); w.z = pk2(o[4], o[5]); w.w = pk2(o[6], o[7]);
        *(u32x4*)(O + (size_t)row * 1024 + 512 + j0) = w;
        s += __shfl_xor(s, 16); s += __shfl_xor(s, 32);
        if (fq == 0) ss[row * 16 + u.pn * 4 + wc] = s;
      }
  }
};
struct EpiZt {
  static constexpr bool PERM = true, AFTER_DRAIN = false, KHOOK = false; static constexpr int KH_T = 0;
  ::bf16_t* O;
  __device__ __forceinline__ void operator()(const f32x4 (&acc)[2][2][4][2], const Unit& u, int wr, int wc, int fr, int fq, int) const {
    const int v0 = u.pn * BM;
    ::bf16_t* base; size_t ld;
    if (v0 < LPR) { base = O + v0; ld = LPR; }
    else { const int vs = v0 - LPR; base = O + (size_t)512 * LPR + (size_t)(vs >> 12) * 512 * 4096 + (vs & 4095); ld = 4096; }
    const int c0 = u.pm * BM + wr * 64 + fr, col0 = wc * 32 + 8 * fq;
#pragma unroll
    for (int ai = 0; ai < 2; ++ai)
#pragma unroll
      for (int m = 0; m < 4; ++m) {
        ::bf16_t* rowp = base + (size_t)(c0 + ai * HALF + m * 16) * ld + col0;
#pragma unroll
        for (int bj = 0; bj < 2; ++bj) {
          const f32x4 a = acc[ai][bj][m][0], b = acc[ai][bj][m][1];
          u32x4 w; w.x = pk2(a[0], a[1]); w.y = pk2(a[2], a[3]); w.z = pk2(b[0], b[1]); w.w = pk2(b[2], b[3]);
          *(u32x4*)(rowp + bj * HALF) = w;
        }
      }
  }
};
struct EpiZs {
  static constexpr bool PERM = true, AFTER_DRAIN = false, KHOOK = false; static constexpr int KH_T = 0;
  ::bf16_t* O;
  __device__ __forceinline__ void operator()(const f32x4 (&acc)[2][2][4][2], const Unit& u, int wr, int wc, int fr, int fq, int) const {
    const int r0 = u.pm * BM + wr * 64 + fr, col0 = u.pn * BM + wc * 32 + 8 * fq;
#pragma unroll
    for (int ai = 0; ai < 2; ++ai)
#pragma unroll
      for (int m = 0; m < 4; ++m) {
        const int tok = v2tok(r0 + ai * HALF + m * 16);
#pragma unroll
        for (int bj = 0; bj < 2; ++bj) {
          const int col = col0 + bj * HALF;
          const f32x4 a = acc[ai][bj][m][0], b = acc[ai][bj][m][1];
          u32x4 w; w.x = pk2(a[0], a[1]); w.y = pk2(a[2], a[3]); w.z = pk2(b[0], b[1]); w.w = pk2(b[2], b[3]);
          *(u32x4*)(O + ((size_t)(col >> 4) * 1280 + (tok >> 6)) * 1280 + (tok & 63) * 16 + (col & 15)) = w;
        }
      }
  }
};
struct EpiS {
  static constexpr bool PERM = false, AFTER_DRAIN = false, KHOOK = false; static constexpr int KH_T = 0;
  float* O;
  __device__ __forceinline__ void operator()(const f32x4 (&acc)[2][2][4][2], const Unit& u, int wr, int wc, int fr, int fq, int) const {
#pragma unroll
    for (int ai = 0; ai < 2; ++ai)
#pragma unroll
      for (int m = 0; m < 4; ++m) {
        float* rowp = O + (size_t)(u.pm * BM + ai * HALF + wr * 64 + m * 16 + fr) * 256 + wc * 32 + 4 * fq;
#pragma unroll
        for (int bj = 0; bj < 2; ++bj)
#pragma unroll
          for (int n = 0; n < 2; ++n) *(f32x4*)(rowp + bj * HALF + n * 16) = acc[ai][bj][m][n];
      }
  }
};
struct EpiGelu {
  static constexpr bool PERM = true, AFTER_DRAIN = false, KHOOK = false; static constexpr int KH_T = 0;
  ::bf16_t* O;
  __device__ __forceinline__ void operator()(const f32x4 (&acc)[2][2][4][2], const Unit& u, int wr, int wc, int fr, int fq, int) const {
    const int gi = u.pn >> 2, n0 = (u.pn & 3) * BM + wc * 32 + 8 * fq, ch0 = u.pm * BM - gi * 1280 + wr * 64 + fr;
#pragma unroll
    for (int ai = 0; ai < 2; ++ai)
#pragma unroll
      for (int m = 0; m < 4; ++m) {
        const int ch = ch0 + ai * HALF + m * 16;
#pragma unroll
        for (int bj = 0; bj < 2; ++bj) {
          const int n = n0 + bj * HALF;
          float o[8];
#pragma unroll
          for (int e = 0; e < 4; ++e) { o[e] = gelu_tanh(acc[ai][bj][m][0][e]); o[4 + e] = gelu_tanh(acc[ai][bj][m][1][e]); }
          u32x4 w; w.x = pk2(o[0], o[1]); w.y = pk2(o[2], o[3]); w.z = pk2(o[4], o[5]); w.w = pk2(o[6], o[7]);
          *(u32x4*)(O + (size_t)(ch * 64 + (n >> 4)) * 512 + gi * 16 + (n & 15)) = w;
        }
      }
  }
};
struct EpiFft1 {
  static constexpr bool PERM = true, AFTER_DRAIN = false, KHOOK = false; static constexpr int KH_T = 0;
  ::bf16_t* Tt; const float2* twp; const float2* tws;
  __device__ __forceinline__ void operator()(const f32x4 (&acc)[2][2][4][2], const Unit& u, int wr, int wc, int fr, int fq, int) const {
    const bool pr = u.pn < 128;
    const int r0b = u.pn * BM + wc * 32 + 8 * fq;
    const float2* tw = pr ? twp : tws;
    const int mask = pr ? 16383 : 4095;
    float2 stv[4], w0v[4];
#pragma unroll
    for (int m = 0; m < 4; ++m) {
      const int idx = ((u.pm & 1) << 7) | (wr * 64 + m * 16 + fr);
      const int k1 = pr ? (idx & 127) : (idx & 63), l2loc = pr ? (idx >> 7) : (idx >> 6);
      const int l20 = pr ? (l2loc * 64 + (r0b & 63)) : (l2loc * 16 + (r0b & 15));
      stv[m] = tw[(unsigned)(k1 & mask)]; w0v[m] = tw[(unsigned)((k1 * l20) & mask)];
    }
    asm volatile("" ::: "memory");
#pragma unroll
    for (int m = 0; m < 4; ++m) {
      const int idx = ((u.pm & 1) << 7) | (wr * 64 + m * 16 + fr);
      const int k1 = pr ? (idx & 127) : (idx & 63), l2loc = pr ? (idx >> 7) : (idx >> 6);
      const int l20 = pr ? (l2loc * 64 + (r0b & 63)) : (l2loc * 16 + (r0b & 15));
      const float2 st = stv[m], w0 = w0v[m];
#pragma unroll
      for (int bj = 0; bj < 2; ++bj) {
        const int r0 = r0b + bj * HALF;
        size_t off; int pstride;
        if (pr) { off = ((size_t)(k1 * 512 + (r0 >> 6))) * 256 + l20; pstride = 128; }
        else { const int bc = (r0 - 32768) >> 4; off = (size_t)65536 * 256 + ((size_t)(((bc >> 9) * 32 + (k1 >> 1)) * 512 + (bc & 511))) * 256 + (k1 & 1) * 128 + l20; pstride = 64; }
        float ore[8], oim[8];
        float2 wv = w0;
#pragma unroll
        for (int e = 0; e < 8; ++e) {
          const float re = acc[0][bj][m][e >> 2][e & 3], im = acc[1][bj][m][e >> 2][e & 3];
          ore[e] = re * wv.x + im * wv.y; oim[e] = im * wv.x - re * wv.y;
          wv = make_float2(wv.x * st.x - wv.y * st.y, wv.y * st.x + wv.x * st.y);
        }
        u32x4 w; w.x = pk2(ore[0], ore[1]); w.y = pk2(ore[2], ore[3]); w.z = pk2(ore[4], ore[5]); w.w = pk2(ore[6], ore[7]);
        *(u32x4*)(Tt + off) = w;
        w.x = pk2(oim[0], oim[1]); w.y = pk2(oim[2], oim[3]); w.z = pk2(oim[4], oim[5]); w.w = pk2(oim[6], oim[7]);
        *(u32x4*)(Tt + off + pstride) = w;
      }
    }
  }
};
struct EpiFft2 {
  static constexpr bool PERM = true, AFTER_DRAIN = false, KHOOK = false; static constexpr int KH_T = 0;
  ::bf16_t* AF;
  __device__ __forceinline__ void operator()(const f32x4 (&acc)[2][2][4][2], const Unit& u, int wr, int wc, int fr, int fq, int) const {
    const bool pr = u.pn < 256;
    const int pnl = pr ? u.pn : u.pn - 256, c0 = (pnl & 1) * 256 + wc * 32 + 8 * fq;
#pragma unroll
    for (int ai = 0; ai < 2; ++ai)
#pragma unroll
      for (int m = 0; m < 4; ++m) {
        int part, tok;
        if (pr) { part = ai; tok = (pnl >> 1) + 128 * (wr * 64 + m * 16 + fr); }
        else { const int bk = pnl >> 1; part = wr; tok = LPR + (bk >> 5) * 4096 + (bk & 31) * 2 + ai + 64 * (m * 16 + fr); }
        ::bf16_t* rowp = AF + (size_t)tok * 1024 + part * 512 + c0;
#pragma unroll
        for (int bj = 0; bj < 2; ++bj) {
          const f32x4 a = acc[ai][bj][m][0], b = acc[ai][bj][m][1];
          u32x4 w; w.x = pk2(a[0], a[1]); w.y = pk2(a[2], a[3]); w.z = pk2(b[0], b[1]); w.w = pk2(b[2], b[3]);
          *(u32x4*)(rowp + bj * HALF) = w;
        }
      }
  }
};
struct EpiWout {
  static constexpr bool PERM = true, AFTER_DRAIN = false, KHOOK = true; static constexpr int KH_T = 8;
  float* out; const float* xp; const float* xs; const float* mod; const float* g2; ::bf16_t* h2; float* ss1;
  __device__ __forceinline__ void khook(f32x4 (&acc)[2][2][4][2], int ui, int wr, int fr, PG8_LAS unsigned char* lds) const {
    typedef float f32x2t __attribute__((ext_vector_type(2)));
    const PG8_LAS f32x2t* tab = (const PG8_LAS f32x2t*)(lds + 131072) + ui * 256;
#pragma unroll
    for (int ai = 0; ai < 2; ++ai)
#pragma unroll
      for (int m = 0; m < 4; ++m) {
        const float r = tab[ai * HALF + wr * 64 + m * 16 + fr].x;
#pragma unroll
        for (int bj = 0; bj < 2; ++bj)
#pragma unroll
          for (int n = 0; n < 2; ++n) acc[ai][bj][m][n] *= r;
      }
  }
  __device__ __forceinline__ void operator()(const f32x4 (&acc)[2][2][4][2], const Unit& u, int wr, int wc, int fr, int fq, int ui) const {
    typedef float f32x2t __attribute__((ext_vector_type(2)));
    const PG8_LAS f32x2t* tab = (const PG8_LAS f32x2t*)((PG8_LAS unsigned char*)dyn_smem + 131072) + ui * 256;
    const int col0 = u.pn * BM + wc * 32 + 8 * fq;
    const float* md = mod + batch_of(u.pm * BM) * 6144;
    f32x4 gv[2][2], hv[2][2];
#pragma unroll
    for (int bj = 0; bj < 2; ++bj)
#pragma unroll
      for (int n = 0; n < 2; ++n) {
        const int col = col0 + bj * HALF + n * 4;
        gv[bj][n] = *(const f32x4*)(md + 2048 + col);
        hv[bj][n] = *(const f32x4*)(g2 + col) * (*(const f32x4*)(md + 4096 + col) + 1.f);
      }
#pragma unroll
    for (int ai = 0; ai < 2; ++ai)
#pragma unroll
      for (int mp = 0; mp < 2; ++mp) {
        f32x4 xv[2][2][2]; float rs[2];
#pragma unroll
        for (int mm = 0; mm < 2; ++mm) {
          const int m = mp * 2 + mm, rl = ai * HALF + wr * 64 + m * 16 + fr, row = u.pm * BM + rl;
          rs[mm] = tab[rl].y;
          const float* xr = row < LPR ? xp + (size_t)row * 1024 : xs + (size_t)(row - LPR) * 1024;
#pragma unroll
          for (int bj = 0; bj < 2; ++bj)
#pragma unroll
            for (int n = 0; n < 2; ++n) xv[mm][bj][n] = *(const f32x4*)(xr + col0 + bj * HALF + n * 4);
        }
        asm volatile("" ::: "memory");
#pragma unroll
        for (int mm = 0; mm < 2; ++mm) {
          const int m = mp * 2 + mm, row = u.pm * BM + ai * HALF + wr * 64 + m * 16 + fr;
          ::bf16_t* orow = (::bf16_t*)out + (size_t)row * 1024 + col0;
          ::bf16_t* hrow = h2 + (size_t)row * 1024 + col0;
          float sq = 0.f;
#pragma unroll
          for (int bj = 0; bj < 2; ++bj) {
            const f32x4 o0 = xv[mm][bj][0] + gv[bj][0] * (acc[ai][bj][m][0] * rs[mm]), o1 = xv[mm][bj][1] + gv[bj][1] * (acc[ai][bj][m][1] * rs[mm]);
            sq += (o0[0] * o0[0] + o0[1] * o0[1]) + (o0[2] * o0[2] + o0[3] * o0[3]) + (o1[0] * o1[0] + o1[1] * o1[1]) + (o1[2] * o1[2] + o1[3] * o1[3]);
            u32x4 w; w.x = pk2(o0[0], o0[1]); w.y = pk2(o0[2], o0[3]); w.z = pk2(o1[0], o1[1]); w.w = pk2(o1[2], o1[3]);
            *(u32x4*)(orow + bj * HALF) = w;
            const f32x4 h0 = o0 * hv[bj][0], h1 = o1 * hv[bj][1];
            w.x = pk2(h0[0], h0[1]); w.y = pk2(h0[2], h0[3]); w.z = pk2(h1[0], h1[1]); w.w = pk2(h1[2], h1[3]);
            *(u32x4*)(hrow + bj * HALF) = w;
          }
          sq += __shfl_xor(sq, 16); sq += __shfl_xor(sq, 32);
          if (fq == 0) atomicAdd(ss1 + row, sq);
        }
      }
  }
};
}

DI void phase2(const P& p, const int wv) {
  {
    const pg8::Gemm g{p.wint(), p.hb(), 512, NTOK, 1024, 1024, 1024};
    pg8::StaticOrder S; S.init(512, NTOK, (int)gridDim.x, (int)blockIdx.x);
    const pg8::EpiZt E{p.zT()};
    pg8::gemm_phase<pg8::EpiZt, pg8::StaticOrder, true, true>((PG8_LAS unsigned char*)dyn_smem, otid(wv), g, S, E);
  }
  {
    const pg8::Gemm g{p.hb(), p.wint() + (size_t)512 * 1024, NTOK, 512, 1024, 1024, 1024};
    pg8::StaticOrder S; S.init(NTOK, 512, (int)gridDim.x, (int)(gridDim.x - 1 - blockIdx.x));
    const pg8::EpiZs E{p.Ucat()};
    pg8::gemm_phase<pg8::EpiZs, pg8::StaticOrder, true, true>((PG8_LAS unsigned char*)dyn_smem, otid(wv), g, S, E);
  }
}
DI void phase3(const P& p, const int wv) {
  {
    const pg8::Gemm g{p.Ucat(), p.Bs(), 32 * 1280, 32 * 256, 1024, 1280, 1024};
    pg8::GroupOrder S; S.init(32, 5, 1, (int)gridDim.x, (int)blockIdx.x);
    const pg8::EpiS E{p.S()};
    pg8::gemm_phase<pg8::EpiS, pg8::GroupOrder, true, true>((PG8_LAS unsigned char*)dyn_smem, otid(wv), g, S, E);
  }
  {
    const pg8::Gemm g{p.Fb1(), p.zT(), 1024, 163840, 256, 256, 256};
    pg8::Fft1Order S; S.init((int)gridDim.x, (int)blockIdx.x);
    const pg8::EpiFft1 E{p.Tt(), p.twp(), p.tws()};
    pg8::gemm_phase<pg8::EpiFft1, pg8::Fft1Order, true, true>((PG8_LAS unsigned char*)dyn_smem, otid(wv), g, S, E);
  }
}
DI void phase4(const P& p, const int wv) {
  {
    const int tix = otid(wv), pp = tix & 63, G = (int)gridDim.x;
    for (int task = (int)blockIdx.x + G * wv; task < 17 * 64; task += G * 8) {
      const int seq = task >> 6, g = (task >> 1) & 31, dir = task & 1;
      const int c0 = seq == 0 ? 0 : 256 + (seq - 1) * 64, nc = seq == 0 ? 256 : 64;
      const float ar = p.AT()[((g * 2 + dir) * 64 + pp) * 2], ai = p.AT()[((g * 2 + dir) * 64 + pp) * 2 + 1];
      float hr = 0.f, hi = 0.f;
      const float* Sg = p.S() + (size_t)g * 1280 * 256 + dir * 128 + pp;
      bf16_t* Hg = p.Ucat() + (size_t)g * 1280 * 1280 + 1024 + dir * 128 + pp;
      for (int i0 = 0; i0 < nc; i0 += 32) {
        float sr[32], si[32];
#pragma unroll
        for (int j = 0; j < 32; j++) {
          const int c = c0 + (dir == 0 ? i0 + j : nc - 1 - i0 - j);
          sr[j] = Sg[(size_t)c * 256]; si[j] = Sg[(size_t)c * 256 + 64];
        }
#pragma unroll
        for (int j = 0; j < 32; j++) {
          const int c = c0 + (dir == 0 ? i0 + j : nc - 1 - i0 - j);
          Hg[(size_t)c * 1280] = f2bf(hr); Hg[(size_t)c * 1280 + 64] = f2bf(hi);
          const float nr = ar * hr - ai * hi + sr[j], ni = ar * hi + ai * hr + si[j];
          hr = nr; hi = ni;
        }
      }
    }
  }
  {
    const pg8::Gemm g{p.Fb2(), p.Tt(), 512, 327680, 256, 256, 256};
    pg8::Fft2Order S; S.init((int)gridDim.x, (int)blockIdx.x);
    const pg8::EpiFft2 E{p.AF()};
    pg8::gemm_phase<pg8::EpiFft2, pg8::Fft2Order, true, true>((PG8_LAS unsigned char*)dyn_smem, otid(wv), g, S, E);
  }
}
DI void phase5(const P& p, const int wv) {
  const pg8::Gemm g{p.Ucat(), p.Tcat(), 32 * 1280, 32 * 1024, 1280, 1280, 1280};
  pg8::GroupOrder S; S.init(32, 5, 4, (int)gridDim.x, (int)blockIdx.x);
  const pg8::EpiGelu E{p.gact()};
  pg8::gemm_phase<pg8::EpiGelu, pg8::GroupOrder, true, true>((PG8_LAS unsigned char*)dyn_smem, otid(wv), g, S, E);
  {
    const pg8::Gemm g{p.AF(), p.Mf(), NTOK, 512, 1024, 1024, 1024};
    pg8::YfOrder S; S.init((int)gridDim.x, (int)blockIdx.x);
    const pg8::EpiYf E{p.mg(), p.b_f, p.ssf()};
    pg8::gemm_phase<pg8::EpiYf, pg8::YfOrder, true, true>((PG8_LAS unsigned char*)dyn_smem, otid(wv), g, S, E);
  }
}
DI void phase6(const P& p, const int wv) {
  {
    const pg8::Gemm g{p.gact(), p.wglut(), NTOK, 1024, 512, 512, 512};
    pg8::StaticOrder S; S.init(NTOK, 1024, (int)gridDim.x, (int)blockIdx.x);
    const pg8::EpiGlu E{p.mg(), p.b_glu, p.sss()};
    pg8::gemm_phase<pg8::EpiGlu, pg8::StaticOrder, true, true>((PG8_LAS unsigned char*)dyn_smem, otid(wv), g, S, E);
  }
}
DI void phase7(const P& p, const int wv) {
  const pg8::Gemm g{p.mg(), p.woutt(), NTOK, 1024, 1024, 1024, 1024};
  pg8::StaticOrder S; S.init(NTOK, 1024, (int)gridDim.x, (int)blockIdx.x);
  {
    typedef float f32x2t __attribute__((ext_vector_type(2)));
    PG8_LAS f32x2t* tab = (PG8_LAS f32x2t*)((PG8_LAS unsigned char*)dyn_smem + 131072);
    const int tix7 = otid(wv);
    pg8::Unit u;
    for (int i = 0; i < 8 && S.next(i, u); ++i) {
      if (tix7 < 256) {
        const int tok = u.pm * 256 + tix7;
        float sf = 0.f, s2 = 0.f;
#pragma unroll
        for (int j = 0; j < 8; j++) sf += p.ssf()[tok * 8 + j];
#pragma unroll
        for (int j = 0; j < 16; j++) s2 += p.sss()[tok * 16 + j];
        const float rf = rsqrtf(sf * (1.f / 512.f) + EPSV), rs = rsqrtf(s2 * (1.f / 512.f) + EPSV);
        tab[i * 256 + tix7] = (f32x2t){rf / rs, rs};
      }
    }
    __syncthreads();
  }
  const pg8::EpiWout E{p.out, p.xp, p.xs, p.mod(), p.g_mlp, p.hb(), p.ss1()};
  pg8::gemm_phase<pg8::EpiWout, pg8::StaticOrder, true, true>((PG8_LAS unsigned char*)dyn_smem, otid(wv), g, S, E);
}
DI void phase8(const P& p, const int wv) {
  const pg8::Gemm g{p.hb(), p.w1t(), NTOK, 4096, 1024, 1024, 1024};
  pg8::StaticOrder S; S.init(NTOK, 4096, (int)gridDim.x, (int)blockIdx.x);
  const pg8::EpiMlpIn E{p.hid(), p.sb2(), p.ss1()};
  pg8::gemm_phase<pg8::EpiMlpIn, pg8::StaticOrder, true, true>((PG8_LAS unsigned char*)dyn_smem, otid(wv), g, S, E);
}
DI void phase9(const P& p, const int wv) {
  const pg8::Gemm g{p.hid(), p.w2t(), NTOK, 1024, 4096, 4096, 4096};
  pg8::StaticOrder S; S.init(NTOK, 1024, (int)gridDim.x, (int)blockIdx.x);
  const pg8::EpiMlpOut E{(const bf16_t*)p.out, p.hb(), p.mod(), p.b2};
  pg8::gemm_phase<pg8::EpiMlpOut, pg8::StaticOrder, true, true>((PG8_LAS unsigned char*)dyn_smem, otid(wv), g, S, E);
}

__global__ void __launch_bounds__(512, 2) k_mega(P p) {
  cg::grid_group grid = cg::this_grid();
  const int wv = __builtin_amdgcn_readfirstlane((int)threadIdx.x >> 6);
  {
    const int t0 = otid(wv);
    volatile XB_LAS unsigned* st = (volatile XB_LAS unsigned*)((XB_LAS unsigned char*)dyn_smem + XB_LDS_OFF);
    if (t0 == 0) { st[0] = 0u; st[1] = 0u; }
    __syncthreads();
    if (t0 == 0) (void)xb_add((unsigned*)(p.ws + O_bar) + XB_XCNT(xb_xcc_id()), 1u);
  }
#define GSYNC() xcd_barrier((unsigned*)(p.ws + O_bar), otid(wv))
  if (p.ws == nullptr) grid.sync();
  phase0(p, wv); GSYNC();
  rownorm_mod<true>(p, wv, p.g_mix, 0, 1024); GSYNC();
  phase2(p, wv); GSYNC();
  phase3(p, wv); GSYNC();
  phase4(p, wv); GSYNC();
  phase5(p, wv); GSYNC();
  phase6(p, wv); GSYNC();
  phase7(p, wv); GSYNC();
  phase8(p, wv); GSYNC();
  phase9(p, wv); GSYNC();
  final_norm(p, wv);
}

extern "C" void kernel_launch(void* const* d_in, const int* in_sizes, int n_in, void* d_out, int out_size, void* d_ws, size_t ws_size,
                              hipStream_t stream) {
  P p{};
  const float** f = (const float**)&p;
  for (int i = 0; i < 29; i++) f[i] = (const float*)d_in[i];
  p.out = (float*)d_out;
  p.ws = (char*)d_ws;
  if (WS_NEED > ws_size) { fprintf(stderr, "workspace too small: need %zu have %zu\n", (size_t)WS_NEED, ws_size); return; }
  static int grid_blocks = 0;
  if (!grid_blocks) {
    int dev = 0, cus = 0, per_cu = 0;
    (void)hipGetDevice(&dev);
    (void)hipDeviceGetAttribute(&cus, hipDeviceAttributeMultiprocessorCount, dev);
    (void)hipFuncSetAttribute((const void*)k_mega, hipFuncAttributeMaxDynamicSharedMemorySize, SMEM_BYTES);
    (void)hipOccupancyMaxActiveBlocksPerMultiprocessor(&per_cu, k_mega, 512, SMEM_BYTES);
    if (per_cu < 1) per_cu = 1;
    grid_blocks = cus * per_cu;
  }
  (void)hipMemsetAsync((char*)d_ws + O_mod, 0, O_AT - O_mod, stream);
  void* args[] = {&p};
  hipError_t e = hipLaunchCooperativeKernel((void*)k_mega, dim3(grid_blocks), dim3(512), args, SMEM_BYTES, stream);
  if (e != hipSuccess) fprintf(stderr, "cooperative launch failed: %s (grid %d)\n", hipGetErrorString(e), grid_blocks);
}
```

```cpp
#include <hip/hip_runtime.h>
#include <hip/hip_cooperative_groups.h>
#include <stdint.h>
#include <stdio.h>
namespace cg = cooperative_groups;


#define DI __device__ __forceinline__
typedef unsigned short bf16_t;
typedef short bf16x8 __attribute__((ext_vector_type(8)));
typedef float f32x16 __attribute__((ext_vector_type(16)));
typedef float f32x4 __attribute__((ext_vector_type(4)));

constexpr int NTOK = 81920, LPR = 16384, LSM = 4096;
constexpr int SMEM_HALF = 73728;
constexpr int SMEM_BYTES = 2 * SMEM_HALF;
constexpr float EPSV = 1e-6f;

constexpr size_t al256(size_t x) { return (x + 255) & ~(size_t)255; }
constexpr size_t O_mod = 0;
constexpr size_t O_bar = O_mod + al256(17 * 6144 * 4);
constexpr size_t O_ss1 = O_bar + al256(3456 * 4);
constexpr size_t O_sb2 = O_ss1 + al256((size_t)NTOK * 4);
constexpr size_t O_AT = O_sb2 + al256(17 * 4096 * 4);
constexpr size_t O_ssf = O_AT + al256(32 * 2 * 64 * 2 * 4);
constexpr size_t O_sss = O_ssf + al256((size_t)NTOK * 8 * 4);
constexpr size_t O_twp = O_sss + al256((size_t)NTOK * 16 * 4);
constexpr size_t O_tws = O_twp + al256(LPR * 8);
constexpr size_t O_wint = O_tws + al256(LSM * 8);
constexpr size_t O_wglut = O_wint + al256(1024 * 1024 * 2);
constexpr size_t O_woutt = O_wglut + al256(1024 * 512 * 2);
constexpr size_t O_w1t = O_woutt + al256(1024 * 1024 * 2);
constexpr size_t O_w2t = O_w1t + al256((size_t)4096 * 1024 * 2);
constexpr size_t O_Mf = O_w2t + al256((size_t)4096 * 1024 * 2);
constexpr size_t O_Fb1 = O_Mf + al256(512 * 1024 * 2);
constexpr size_t O_Fb2 = O_Fb1 + al256(1024 * 256 * 2);
constexpr size_t O_Bs = O_Fb2 + al256(512 * 256 * 2);
constexpr size_t O_Tcat = O_Bs + al256((size_t)32 * 256 * 1024 * 2);
constexpr size_t O_hb = O_Tcat + al256((size_t)32 * 1024 * 1280 * 2);
constexpr size_t O_zT = O_hb + al256((size_t)NTOK * 1024 * 2);
constexpr size_t O_Ucat = O_zT + al256((size_t)NTOK * 512 * 2);
constexpr size_t O_AF = O_Ucat + al256((size_t)32 * 1280 * 1280 * 2);
constexpr size_t O_S = O_AF + al256((size_t)NTOK * 1024 * 2);
constexpr size_t O_gact = O_S + al256((size_t)1280 * 32 * 256 * 4);
constexpr size_t O_mg = O_gact + al256((size_t)NTOK * 512 * 2);
constexpr size_t O_END = O_mg + al256((size_t)NTOK * 1024 * 2);
constexpr size_t O_Tt = O_hb;
constexpr size_t O_hid = O_zT;
constexpr size_t WS_NEED = (O_hid + (size_t)NTOK * 4096 * 2 > O_END ? O_hid + (size_t)NTOK * 4096 * 2 : O_END);
struct P {
  const float *xp, *xs, *cp, *cs, *w_ada, *b_ada, *g_mix, *w_in, *w_f, *b_f, *a_re, *a_im, *log_dt, *b_re, *b_im, *c_re, *c_im,
      *ssm_d, *w_glu, *b_glu, *g_fo, *g_so, *w_out, *g_mlp, *w1, *b1, *w2, *b2, *g_final;
  float* out;
  char* ws;
  __device__ __forceinline__ float* mod() const { return (float*)(ws + O_mod); }
  __device__ __forceinline__ float* ss1() const { return (float*)(ws + O_ss1); }
  __device__ __forceinline__ float* sb2() const { return (float*)(ws + O_sb2); }
  __device__ __forceinline__ float* AT() const { return (float*)(ws + O_AT); }
  __device__ __forceinline__ float* ssf() const { return (float*)(ws + O_ssf); }
  __device__ __forceinline__ float* sss() const { return (float*)(ws + O_sss); }
  __device__ __forceinline__ float2* twp() const { return (float2*)(ws + O_twp); }
  __device__ __forceinline__ float2* tws() const { return (float2*)(ws + O_tws); }
  __device__ __forceinline__ bf16_t* wint() const { return (bf16_t*)(ws + O_wint); }
  __device__ __forceinline__ bf16_t* wglut() const { return (bf16_t*)(ws + O_wglut); }
  __device__ __forceinline__ bf16_t* woutt() const { return (bf16_t*)(ws + O_woutt); }
  __device__ __forceinline__ bf16_t* w1t() const { return (bf16_t*)(ws + O_w1t); }
  __device__ __forceinline__ bf16_t* w2t() const { return (bf16_t*)(ws + O_w2t); }
  __device__ __forceinline__ bf16_t* Mf() const { return (bf16_t*)(ws + O_Mf); }
  __device__ __forceinline__ bf16_t* Fb1() const { return (bf16_t*)(ws + O_Fb1); }
  __device__ __forceinline__ bf16_t* Fb2() const { return (bf16_t*)(ws + O_Fb2); }
  __device__ __forceinline__ bf16_t* Bs() const { return (bf16_t*)(ws + O_Bs); }
  __device__ __forceinline__ bf16_t* Tcat() const { return (bf16_t*)(ws + O_Tcat); }
  __device__ __forceinline__ bf16_t* Ucat() const { return (bf16_t*)(ws + O_Ucat); }
  __device__ __forceinline__ bf16_t* hb() const { return (bf16_t*)(ws + O_hb); }
  __device__ __forceinline__ bf16_t* zT() const { return (bf16_t*)(ws + O_zT); }
  __device__ __forceinline__ bf16_t* AF() const { return (bf16_t*)(ws + O_AF); }
  __device__ __forceinline__ float* S() const { return (float*)(ws + O_S); }
  __device__ __forceinline__ bf16_t* mg() const { return (bf16_t*)(ws + O_mg); }
  __device__ __forceinline__ bf16_t* gact() const { return (bf16_t*)(ws + O_gact); }
  __device__ __forceinline__ bf16_t* Tt() const { return (bf16_t*)(ws + O_Tt); }
  __device__ __forceinline__ bf16_t* hid() const { return (bf16_t*)(ws + O_hid); }
};

typedef float f32x2v __attribute__((ext_vector_type(2)));
typedef __bf16 bf16x2v __attribute__((ext_vector_type(2)));
DI uint32_t pk2(float lo, float hi) { const f32x2v v = {lo, hi}; const bf16x2v r = __builtin_convertvector(v, bf16x2v); return __builtin_bit_cast(uint32_t, r); }
DI bf16_t f2bf(float f) { return (bf16_t)(pk2(f, 0.f) & 0xffffu); }
extern __shared__ __attribute__((aligned(16))) unsigned char dyn_smem[];
DI int otid(int wv) {
  unsigned m = ~0u; asm volatile("" : "+s"(m));
  const int lane = (int)__builtin_amdgcn_mbcnt_hi(m, __builtin_amdgcn_mbcnt_lo(m, 0u));
  int t = (wv << 6) | lane; asm volatile("" : "+v"(t)); return t;
}
#define XB_TMO      128
#define XB_XCNT(j)  (256  + 64 * (j))
#define XB_XSUB(j)  (1280 + 64 * (j))
#define XB_XGEN(j)  (2304 + 64 * (j))
#define XB_TOP      3328
#define XB_TOPGEN   3392
#define XCD_BAR_WORDS 3456
#define XB_SPIN_CAP (1u << 18)
#define XB_LAS __attribute__((address_space(3)))
constexpr int XB_LDS_OFF = 147440;
DI unsigned xb_ld(unsigned* p) { return __hip_atomic_load(p, __ATOMIC_RELAXED, __HIP_MEMORY_SCOPE_AGENT); }
DI unsigned xb_add(unsigned* p, unsigned v) { return __hip_atomic_fetch_add(p, v, __ATOMIC_RELAXED, __HIP_MEMORY_SCOPE_AGENT); }
DI unsigned xb_xcc_id() { return (unsigned)__builtin_amdgcn_s_getreg((3 << 11) | 20) & 0xFu; }
#define XB_SPIN(cond, bar) do { unsigned _sp = 0; while (cond) { __builtin_amdgcn_s_sleep(1); \
    if ((++_sp & 255u) == 0u) { if (xb_ld(&(bar)[XB_TMO])) break; if (_sp > XB_SPIN_CAP) { atomicAdd(&(bar)[XB_TMO], 1u); break; } } } } while (0)
DI void xcd_barrier_complete(unsigned* bar, unsigned x, unsigned& nloc, unsigned& nx) {
  const unsigned G = gridDim.x * gridDim.y * gridDim.z;
  unsigned sum, cnt, mine, sp = 0u;
  for (;;) {
    sum = 0u; cnt = 0u; mine = 0u;
#pragma unroll
    for (unsigned j = 0; j < 16; ++j) { const unsigned c = xb_ld(&bar[XB_XCNT(j)]); sum += c; cnt += (c > 0u) ? 1u : 0u; mine = (j == x) ? c : mine; }
    if (sum == G) break;
    __builtin_amdgcn_s_sleep(1);
    if ((++sp & 255u) == 0u) { if (xb_ld(&bar[XB_TMO])) break; if (sp > XB_SPIN_CAP) { atomicAdd(&bar[XB_TMO], 1u); break; } }
  }
  nloc = mine > 0u ? mine : 1u; nx = cnt > 0u ? cnt : 1u;
}
DI void xcd_barrier(unsigned* bar, const int tix) {
  asm volatile("s_waitcnt vmcnt(0)" ::: "memory");
  __syncthreads();
  if (tix == 0) {
    volatile XB_LAS unsigned* st = (volatile XB_LAS unsigned*)((XB_LAS unsigned char*)dyn_smem + XB_LDS_OFF);
    const unsigned x = xb_xcc_id();
    __builtin_amdgcn_s_waitcnt(0);
    unsigned nloc = st[0], nx = st[1];
    if (nloc == 0u) { xcd_barrier_complete(bar, x, nloc, nx); st[0] = nloc; st[1] = nx; }
    const unsigned old = xb_add(&bar[XB_XSUB(x)], 1u);
    const unsigned gen = old / nloc;
    if (old + 1u == (gen + 1u) * nloc) {
      __builtin_amdgcn_fence(__ATOMIC_RELEASE, "agent");
      asm volatile("s_waitcnt vmcnt(0)" ::: "memory");
      const unsigned og = xb_add(&bar[XB_TOP], 1u);
      const unsigned tg = og / nx;
      if (og + 1u == (tg + 1u) * nx) xb_add(&bar[XB_TOPGEN], 1u);
      else XB_SPIN(xb_ld(&bar[XB_TOPGEN]) == tg, bar);
      __builtin_amdgcn_fence(__ATOMIC_ACQUIRE, "agent");
      xb_add(&bar[XB_XGEN(x)], 1u);
      asm volatile("s_waitcnt vmcnt(0)" ::: "memory");
    } else {
      XB_SPIN(xb_ld(&bar[XB_XGEN(x)]) == gen, bar);
      __builtin_amdgcn_fence(__ATOMIC_ACQUIRE, "agent");
      asm volatile("s_waitcnt vmcnt(0)" ::: "memory");
    }
  }
  __syncthreads();
}

DI int tok2v(int tok) {
  if (tok < LPR) { const int l1 = tok >> 7, l2 = tok & 127; return ((l2 & 63) << 8) | ((l2 >> 6) << 7) | l1; }
  const int ts = tok - LPR, w = ts & 4095, l1 = w >> 6, l2 = w & 63;
  return LPR + (ts & ~4095) + (((l2 & 15) << 8) | ((l2 >> 4) << 6) | l1);
}
DI int v2tok(int v) {
  if (v < LPR) return ((v & 127) << 7) | (((v >> 7) & 1) << 6) | (v >> 8);
  const int vs = v - LPR, w = vs & 4095;
  return LPR + (vs & ~4095) + (((w & 63) << 6) | (((w >> 6) & 3) << 4) | (w >> 8));
}
DI int batch_of(int tok) { return tok < LPR ? 0 : 1 + ((tok - LPR) >> 12); }
DI float gelu_tanh(float x) {
  const float u = 0.7978845608028654f * (x + 0.044715f * x * x * x);
  return x / (1.f + __expf(-2.f * u));
}
DI float wave_sum(float v) {
  v += __shfl_xor(v, 32); v += __shfl_xor(v, 16); v += __shfl_xor(v, 8); v += __shfl_xor(v, 4); v += __shfl_xor(v, 2); v += __shfl_xor(v, 1);
  return v;
}

DI void ssm_pow(const P& p, int g, int dir, int pp, int j, float& re, float& im) {
  const int ia = (dir * 32 + g) * 64 + pp;
  const float lr = fminf(p.a_re[ia], -1e-4f), li = p.a_im[ia], dt = expf(p.log_dt[dir * 32 + g]);
  const float mag = expf(lr * dt * (float)j);
  double t = (double)li * (double)dt * (double)j * 0.15915494309189535;
  t -= rint(t);
  const float ang = (float)(t * 6.283185307179586);
  float s, c; sincosf(ang, &s, &c);
  re = mag * c; im = mag * s;
}
DI void ssm_coef(const P& p, int g, int dir, int pp, float& cr, float& ci) {
  const int ia = (dir * 32 + g) * 64 + pp;
  const float lr = fminf(p.a_re[ia], -1e-4f), li = p.a_im[ia];
  float ar, ai; ssm_pow(p, g, dir, pp, 1, ar, ai);
  const float nr = ar - 1.f, ni = ai, den = 1.f / (lr * lr + li * li);
  cr = (nr * lr + ni * li) * den; ci = (ni * lr - nr * li) * den;
}

template <class CM>
DI void transpose_job(float* tile, const int tid, bool act, int item2, const float* in, int ld, int Kdim, bf16_t* out, const CM& colmap, const float* sc0, const float* sc1) {
  const int nkt = Kdim / 64;
  __syncthreads();
  if (act) {
    float v[16];
#pragma unroll
    for (int u = 0; u < 2; u++) {
      const int item = 2 * item2 + u, nt = item / nkt, kt = item % nkt;
      const int c = tid & 31, kr = tid >> 5, col = colmap(nt * 32 + c);
#pragma unroll
      for (int i = 0; i < 8; i++) v[u * 8 + i] = in[(size_t)(kt * 64 + kr + 8 * i) * ld + col];
    }
#pragma unroll
    for (int u = 0; u < 2; u++) {
      const int item = 2 * item2 + u, kt = item % nkt;
      const int c = tid & 31, kr = tid >> 5;
#pragma unroll
      for (int i = 0; i < 8; i++) {
        const int kl = kr + 8 * i, k = kt * 64 + kl;
        float x = v[u * 8 + i];
        if (sc0) x *= (k < 512 ? sc0[k] : sc1[k - 512]);
        tile[u * 64 * 33 + kl * 33 + c] = x;
      }
    }
  }
  __syncthreads();
  if (act) {
#pragma unroll
    for (int u = 0; u < 2; u++) {
      const int item = 2 * item2 + u, nt = item / nkt, kt = item % nkt;
      const int nl = tid >> 3, kc = tid & 7;
      float x[8];
#pragma unroll
      for (int j = 0; j < 8; j++) x[j] = tile[u * 64 * 33 + (kc * 8 + j) * 33 + nl];
      uint4 w; w.x = pk2(x[0], x[1]); w.y = pk2(x[2], x[3]); w.z = pk2(x[4], x[5]); w.w = pk2(x[6], x[7]);
      *(uint4*)(out + (size_t)(nt * 32 + nl) * Kdim + kt * 64 + kc * 8) = w;
    }
  }
}

DI void phase0(const P& p, const int wv) {
  const int tix = otid(wv);
  unsigned char* smraw = dyn_smem + (tix >> 8) * SMEM_HALF;
  float* smf = (float*)smraw;
  const int tid = tix & 255, nb = gridDim.x * 2, bid = blockIdx.x * 2 + (tix >> 8);
  for (int i = blockIdx.x * 512 + tix; i < (int)((O_AT - O_ss1) / 4); i += gridDim.x * 512) ((float*)(p.ws + O_ss1))[i] = 0.f;
  for (int base = 0; base < 384; base += nb) {
    const int item = base + bid; const bool act = item < 384;
    const int cg = act ? item % 96 : 0, ks = act ? item / 96 : 0;
    __syncthreads();
    if (act)
      for (int i = tid; i < 17 * 256; i += 256) {
        const int b = i >> 8, k = ks * 256 + (i & 255);
        const float c = b == 0 ? p.cp[k] : p.cs[(b - 1) * 1024 + k];
        smf[i] = c / (1.f + __expf(-c));
      }
    __syncthreads();
    const int col = tid & 63, sub = tid >> 6, j = cg * 64 + col;
    float a[17];
#pragma unroll
    for (int b = 0; b < 17; b++) a[b] = 0.f;
    if (act) {
#pragma unroll 1
      for (int bt = 0; bt < 4; bt++) {
        const int k0 = sub * 64 + bt * 16;
        float w[16];
#pragma unroll
        for (int i = 0; i < 16; i++) w[i] = p.w_ada[(size_t)(ks * 256 + k0 + i) * 6144 + j];
#pragma unroll
        for (int i = 0; i < 16; i++)
#pragma unroll
          for (int b = 0; b < 17; b++) a[b] += smf[b * 256 + k0 + i] * w[i];
      }
    }
    float* red = smf + 17 * 256;
#pragma unroll
    for (int b = 0; b < 17; b++) red[(sub * 17 + b) * 64 + col] = a[b];
    __syncthreads();
    if (act)
      for (int i = tid; i < 17 * 64; i += 256) {
        const int b = i >> 6, c2 = i & 63;
        float sum = red[(0 * 17 + b) * 64 + c2] + red[(1 * 17 + b) * 64 + c2] + red[(2 * 17 + b) * 64 + c2] + red[(3 * 17 + b) * 64 + c2];
        if (ks == 0) sum += p.b_ada[cg * 64 + c2];
        atomicAdd(p.mod() + b * 6144 + cg * 64 + c2, sum);
      }
  }
  {
    auto ident = [](int n) { return n; };
    auto glumap = [](int n) { return ((n >> 7) & 1) * 512 + (n >> 8) * 128 + (n & 127); };
    const int n0 = 256, n1 = n0 + 128, n2 = n1 + 256, n3 = n2 + 1024, n4 = n3 + 1024;
    for (int base = 0; base < n4; base += nb) {
      const int item = base + bid; const bool act = item < n4;
      if (item < n0) transpose_job(smf, tid, act, item, p.w_in, 1024, 1024, p.wint(), ident, nullptr, nullptr);
      else if (item < n1) transpose_job(smf, tid, act, item - n0, p.w_glu, 1024, 512, p.wglut(), glumap, nullptr, nullptr);
      else if (item < n2) transpose_job(smf, tid, act, item - n1, p.w_out, 1024, 1024, p.woutt(), ident, p.g_fo, p.g_so);
      else if (item < n3) transpose_job(smf, tid, act, item - n2, p.w1, 4096, 1024, p.w1t(), ident, nullptr, nullptr);
      else transpose_job(smf, tid, act, item - n3, p.w2, 1024, 4096, p.w2t(), ident, nullptr, nullptr);
    }
  }
  {
    __syncthreads();
    float2* cs = (float2*)smraw;
    for (int i = tid; i < 512; i += 256) { float s, c; sincosf((float)i * (6.283185307179586f / 512.f), &s, &c); cs[i] = make_float2(c, s); }
    __syncthreads();
    for (int item = bid; item < 128; item += nb) {
      const int idx = item * 256 + tid, k = idx & 1023, he = idx >> 10, h = he >> 3, e0 = (he & 7) * 16, c = k & 511;
      const bool is_sin = k >= 512;
      const float* wf = p.w_f + (size_t)h * 128 * 128 + e0;
      float a[16];
#pragma unroll
      for (int e = 0; e < 16; e++) a[e] = 0.f;
#pragma unroll 4
      for (int d = 0; d < 128; d++) {
        const float2 t = cs[((h * 128 + d) * c) & 511];
        const float tv = is_sin ? t.y : t.x;
        const f32x4 w0 = *(const f32x4*)(wf + d * 128), w1 = *(const f32x4*)(wf + d * 128 + 4), w2 = *(const f32x4*)(wf + d * 128 + 8), w3 = *(const f32x4*)(wf + d * 128 + 12);
#pragma unroll
        for (int e = 0; e < 4; e++) { a[e] += tv * w0[e]; a[4 + e] += tv * w1[e]; a[8 + e] += tv * w2[e]; a[12 + e] += tv * w3[e]; }
      }
#pragma unroll
      for (int e = 0; e < 16; e++) p.Mf()[(size_t)(h * 128 + e0 + e) * 1024 + k] = f2bf(a[e]);
    }
  }
  {
    const int gsz = nb * 256, gt = bid * 256 + tid;
    for (int i = gt; i < 1024 * 256; i += gsz) {
      const int nrg = i >> 8, k = i & 255, tb = nrg >> 9, nr = nrg & 511, part = (nr >> 7) & 1, idx8 = ((nr >> 8) << 7) | (nr & 127);
      const int R = tb ? 64 : 128, sh = tb ? 6 : 7, l2p = idx8 >> sh, k1 = idx8 & (R - 1), l2k = k >> sh, l1 = k & (R - 1);
      float sv, cv; sincosf((float)((k1 * l1) & (R - 1)) * (6.283185307179586f / (float)R), &sv, &cv);
      p.Fb1()[i] = f2bf(l2k == l2p ? (part ? -sv : cv) : 0.f);
    }
    for (int i = gt; i < 512 * 256; i += gsz) {
      const int nrg = i >> 8, k = i & 255, tb = nrg >> 8, nr = nrg & 255;
      float v;
      if (tb == 0) {
        const int part = nr >> 7, k2 = nr & 127, ki = k >> 7, l2 = k & 127;
        float sv, cv; sincosf((float)((k2 * l2) & 127) * (6.283185307179586f / 128.f), &sv, &cv);
        v = part == 0 ? (ki == 0 ? cv : sv) : (ki == 0 ? -sv : cv);
      } else {
        const int blk = nr >> 7, n2 = nr & 127, part = n2 >> 6, k2 = n2 & 63, kb = k >> 7, kk = k & 127, ki = kk >> 6, l2 = kk & 63;
        float sv, cv; sincosf((float)((k2 * l2) & 63) * (6.283185307179586f / 64.f), &sv, &cv);
        v = blk == kb ? (part == 0 ? (ki == 0 ? cv : sv) : (ki == 0 ? -sv : cv)) : 0.f;
      }
      p.Fb2()[i] = f2bf(v);
    }
    for (int i = gt; i < LPR; i += gsz) { float s, c; sincosf((float)i * (6.283185307179586f / 16384.f), &s, &c); p.twp()[i] = make_float2(c, s); }
    for (int i = gt; i < LSM; i += gsz) { float s, c; sincosf((float)i * (6.283185307179586f / 4096.f), &s, &c); p.tws()[i] = make_float2(c, s); }
    for (int i = gt; i < 32 * 2 * 64 * 64; i += gsz) {
      const int s = i & 63, pp = (i >> 6) & 63, dir = (i >> 12) & 1, g = i >> 13;
      float pr, pi, cr, ci; ssm_pow(p, g, dir, pp, dir == 0 ? 63 - s : s, pr, pi); ssm_coef(p, g, dir, pp, cr, ci);
      const float qr = pr * cr - pi * ci, qi = pr * ci + pi * cr;
      const int ib = ((dir * 32 + g) * 64 + pp) * 16;
      float vr[16], vi[16];
#pragma unroll
      for (int h = 0; h < 16; h++) { const float br = p.b_re[ib + h], bi = p.b_im[ib + h]; vr[h] = qr * br - qi * bi; vi[h] = qr * bi + qi * br; }
      bf16_t* d0 = p.Bs() + ((size_t)(g * 256 + dir * 128 + pp)) * 1024 + s * 16;
      bf16_t* d1 = d0 + 64 * 1024;
      uint4 w;
      w.x = pk2(vr[0], vr[1]); w.y = pk2(vr[2], vr[3]); w.z = pk2(vr[4], vr[5]); w.w = pk2(vr[6], vr[7]); *(uint4*)d0 = w;
      w.x = pk2(vr[8], vr[9]); w.y = pk2(vr[10], vr[11]); w.z = pk2(vr[12], vr[13]); w.w = pk2(vr[14], vr[15]); *(uint4*)(d0 + 8) = w;
      w.x = pk2(vi[0], vi[1]); w.y = pk2(vi[2], vi[3]); w.z = pk2(vi[4], vi[5]); w.w = pk2(vi[6], vi[7]); *(uint4*)d1 = w;
      w.x = pk2(vi[8], vi[9]); w.y = pk2(vi[10], vi[11]); w.z = pk2(vi[12], vi[13]); w.w = pk2(vi[14], vi[15]); *(uint4*)(d1 + 8) = w;
    }
    for (int i = gt; i < 32 * 64 * 2 * 64; i += gsz) {
      const int pp = i & 63, dir = (i >> 6) & 1, t = (i >> 7) & 63, g = i >> 13;
      float pr, pi; ssm_pow(p, g, dir, pp, dir == 0 ? t + 1 : 64 - t, pr, pi);
#pragma unroll
      for (int h = 0; h < 16; h++) {
        const int ic = ((dir * 32 + g) * 16 + h) * 64 + pp;
        const float cr = p.c_re[ic], ci = p.c_im[ic];
        bf16_t* d = p.Tcat() + ((size_t)(g * 1024 + t * 16 + h)) * 1280 + 1024 + dir * 128 + pp;
        d[0] = f2bf(cr * pr - ci * pi);
        d[64] = f2bf(-(cr * pi + ci * pr));
      }
    }
    for (int i = gt; i < 32 * 2 * 64; i += gsz) {
      const int pp = i & 63, dir = (i >> 6) & 1, g = i >> 7;
      float pr, pi; ssm_pow(p, g, dir, pp, 64, pr, pi);
      p.AT()[i * 2] = pr; p.AT()[i * 2 + 1] = pi;
    }
  }
  {
    float2* q = (float2*)smraw;
    float2* q1 = q + 512;
    float2* Cs = q + 576;
    float2* Bm = Cs + 2048;
    float2* E = Bm + 2048;
    for (int base = 0; base < 512; base += nb) {
      const int item = base + bid; const bool act = item < 512;
      const int g = act ? item >> 4 : 0, ch = act ? item & 15 : 0;
      __syncthreads();
      for (int e = tid; e < 512; e += 256) {
        const int j = e >> 6, pp = e & 63, jj = ch * 8 + j, lag = jj - 63;
        float2 v = make_float2(0.f, 0.f);
        if (jj < 127) {
          const int dir = lag >= 0 ? 0 : 1;
          float pr, pi, cr, ci; ssm_pow(p, g, dir, pp, lag < 0 ? -lag : lag, pr, pi); ssm_coef(p, g, dir, pp, cr, ci);
          v = make_float2(pr * cr - pi * ci, pr * ci + pi * cr);
        }
        q[e] = v;
      }
      if (tid < 64) { float cr, ci; ssm_coef(p, g, 1, tid, cr, ci); q1[tid] = make_float2(cr, ci); }
      for (int i = tid; i < 2048; i += 256) {
        const int dir = i >> 10, j = i & 1023, src = (dir * 32 + g) * 1024 + j;
        Cs[i] = make_float2(p.c_re[src], p.c_im[src]); Bm[i] = make_float2(p.b_re[src], p.b_im[src]);
      }
      const int hp = tid >> 4, h = tid & 15;
      float a0 = 0.f;
#pragma unroll 1
      for (int ps = 0; ps < 9; ps++) {
        const int j = ps < 8 ? ps : 7, jj = ch * 8 + j, lag = jj - 63;
        const bool valid = ps < 8 ? (jj < 127) : (jj == 63);
        const int dir = ps < 8 ? (lag >= 0 ? 0 : 1) : 1;
        const float2* qs = ps < 8 ? q + j * 64 : q1;
        __syncthreads();
        for (int i = tid; i < 1024; i += 256) {
          const float2 cc = Cs[dir * 1024 + i], qq = qs[i & 63];
          E[i] = make_float2(cc.x * qq.x - cc.y * qq.y, cc.x * qq.y + cc.y * qq.x);
        }
        __syncthreads();
        float a = 0.f;
        if (valid) {
#pragma unroll 8
          for (int pp = 0; pp < 64; pp++) { const float2 ee = E[hp * 64 + pp], bb = Bm[dir * 1024 + pp * 16 + h]; a += ee.x * bb.x - ee.y * bb.y; }
        }
        bool st = valid && act;
        if (ps < 8 && lag == 0) { a0 = a; st = false; }
        if (ps == 8) { a += a0; if (hp == h) a += p.ssm_d[g * 16 + h]; }
        if (st) {
          const bf16_t kv = f2bf(a);
          const int t0 = lag > 0 ? lag : 0, t1 = lag > 0 ? 64 : 64 + lag;
          bf16_t* d = p.Tcat() + ((size_t)(g * 1024 + hp)) * 1280 + h;
          for (int t = t0; t < t1; t++) d[(size_t)t * 16 * 1280 + (t - lag) * 16] = kv;
        }
      }
    }
  }
}

constexpr int RIF = 2;
DI float bflo(uint32_t u) { return __uint_as_float(u << 16); }
DI float bfhi(uint32_t u) { return __uint_as_float(u & 0xffff0000u); }
template <bool FROMX>
DI void rownorm_mod(const P& p, const int wv, const float* g, int sh_off, int sc_off) {
  const int tix = otid(wv), lane = tix & 63, wrow = blockIdx.x * 8 + (tix >> 6), nw = gridDim.x * 8;
  if (FROMX) {
    for (int i = blockIdx.x * 512 + tix; i < 4096 * 32; i += gridDim.x * 512) {
      const int col = i & 4095, ks = i >> 12;
      float a[17];
#pragma unroll
      for (int b = 0; b < 17; b++) a[b] = 0.f;
#pragma unroll 8
      for (int k = ks * 32; k < ks * 32 + 32; k++) {
        const float w = p.w1[(size_t)k * 4096 + col];
#pragma unroll
        for (int b = 0; b < 17; b++) a[b] += p.mod()[b * 6144 + 3072 + k] * w;
      }
      const float b1v = ks == 0 ? p.b1[col] : 0.f;
#pragma unroll
      for (int b = 0; b < 17; b++) atomicAdd(p.sb2() + b * 4096 + col, a[b] + b1v);
    }
  }
  auto load = [&](int tok0, float (&v)[RIF][16]) {
#pragma unroll
    for (int rr = 0; rr < RIF; rr++) {
      const int tok = tok0 + rr * nw;
      if (tok < NTOK) {
        if (FROMX) {
          const float* src = tok < LPR ? p.xp + (size_t)tok * 1024 : p.xs + (size_t)(tok - LPR) * 1024;
#pragma unroll
          for (int i = 0; i < 4; i++) { const f32x4 t = *(const f32x4*)(src + (i * 64 + lane) * 4); v[rr][4 * i] = t[0]; v[rr][4 * i + 1] = t[1]; v[rr][4 * i + 2] = t[2]; v[rr][4 * i + 3] = t[3]; }
        } else {
          const bf16_t* src = (const bf16_t*)p.out + (size_t)tok * 1024;
#pragma unroll
          for (int i = 0; i < 2; i++) { const uint4 t = *(const uint4*)(src + (i * 64 + lane) * 8);
            v[rr][8 * i] = bflo(t.x); v[rr][8 * i + 1] = bfhi(t.x); v[rr][8 * i + 2] = bflo(t.y); v[rr][8 * i + 3] = bfhi(t.y);
            v[rr][8 * i + 4] = bflo(t.z); v[rr][8 * i + 5] = bfhi(t.z); v[rr][8 * i + 6] = bflo(t.w); v[rr][8 * i + 7] = bfhi(t.w); }
        }
      } else {
#pragma unroll
        for (int e = 0; e < 16; e++) v[rr][e] = 0.f;
      }
    }
  };
  auto process = [&](int tok0, const float (&v)[RIF][16]) {
    float ss[RIF];
#pragma unroll
    for (int rr = 0; rr < RIF; rr++) {
      ss[rr] = 0.f;
#pragma unroll
      for (int e = 0; e < 16; e++) ss[rr] += v[rr][e] * v[rr][e];
      ss[rr] = wave_sum(ss[rr]);
    }
#pragma unroll
    for (int rr = 0; rr < RIF; rr++) {
      const int tok = tok0 + rr * nw;
      if (tok >= NTOK) continue;
      const float r = rsqrtf(ss[rr] * (1.f / 1024.f) + EPSV);
      const float* md = p.mod() + batch_of(tok) * 6144;
      bf16_t* drow = p.hb() + (size_t)(FROMX ? tok2v(tok) : tok) * 1024;
      float o[16];
#pragma unroll
      for (int q = 0; q < 4; q++) {
        const int c = FROMX ? (q * 64 + lane) * 4 : ((q >> 1) * 64 + lane) * 8 + (q & 1) * 4;
        const f32x4 gg = *(const f32x4*)(g + c);
        f32x4 sc = *(const f32x4*)(md + sc_off + c), sh = *(const f32x4*)(md + sh_off + c);
#pragma unroll
        for (int e = 0; e < 4; e++) o[4 * q + e] = v[rr][4 * q + e] * r * gg[e] * (1.f + sc[e]) + sh[e];
      }
      if (FROMX) {
#pragma unroll
        for (int q = 0; q < 4; q++) { uint2 w; w.x = pk2(o[4 * q], o[4 * q + 1]); w.y = pk2(o[4 * q + 2], o[4 * q + 3]); *(uint2*)(drow + (q * 64 + lane) * 4) = w; }
      } else {
#pragma unroll
        for (int i = 0; i < 2; i++) { uint4 w; w.x = pk2(o[8 * i], o[8 * i + 1]); w.y = pk2(o[8 * i + 2], o[8 * i + 3]); w.z = pk2(o[8 * i + 4], o[8 * i + 5]); w.w = pk2(o[8 * i + 6], o[8 * i + 7]);
          *(uint4*)(drow + (i * 64 + lane) * 8) = w; }
      }
    }
  };
  float va[RIF][16], vb[RIF][16];
  load(wrow, va);
  for (int tok0 = wrow; tok0 < NTOK; tok0 += 2 * RIF * nw) {
    load(tok0 + RIF * nw, vb);
    process(tok0, va);
    load(tok0 + 2 * RIF * nw, va);
    process(tok0 + RIF * nw, vb);
  }
}
DI void final_norm(const P& p, const int wv) {
  const int tix = otid(wv), lane = tix & 63, wrow = blockIdx.x * 8 + (tix >> 6), nw = gridDim.x * 8;
  auto load = [&](int tok0, uint4 (&v)[RIF][2]) {
#pragma unroll
    for (int rr = 0; rr < RIF; rr++) {
      const int tok = tok0 + rr * nw;
      if (tok < NTOK) {
        const bf16_t* src = p.hb() + (size_t)tok * 1024;
#pragma unroll
        for (int i = 0; i < 2; i++) v[rr][i] = *(const uint4*)(src + (i * 64 + lane) * 8);
      } else {
#pragma unroll
        for (int i = 0; i < 2; i++) v[rr][i] = make_uint4(0u, 0u, 0u, 0u);
      }
    }
  };
  auto process = [&](int tok0, const uint4 (&vr)[RIF][2]) {
    float v[RIF][16], ss[RIF];
#pragma unroll
    for (int rr = 0; rr < RIF; rr++) {
#pragma unroll
      for (int i = 0; i < 2; i++) { const uint4 t = vr[rr][i];
        v[rr][8 * i] = bflo(t.x); v[rr][8 * i + 1] = bfhi(t.x); v[rr][8 * i + 2] = bflo(t.y); v[rr][8 * i + 3] = bfhi(t.y);
        v[rr][8 * i + 4] = bflo(t.z); v[rr][8 * i + 5] = bfhi(t.z); v[rr][8 * i + 6] = bflo(t.w); v[rr][8 * i + 7] = bfhi(t.w); }
      ss[rr] = 0.f;
#pragma unroll
      for (int e = 0; e < 16; e++) ss[rr] += v[rr][e] * v[rr][e];
      ss[rr] = wave_sum(ss[rr]);
    }
#pragma unroll
    for (int rr = 0; rr < RIF; rr++) {
      const int tok = tok0 + rr * nw;
      if (tok >= NTOK) continue;
      const float r = rsqrtf(ss[rr] * (1.f / 1024.f) + EPSV);
      float* drow = p.out + (size_t)tok * 1024;
#pragma unroll
      for (int q = 0; q < 4; q++) {
        const int c = ((q >> 1) * 64 + lane) * 8 + (q & 1) * 4;
        const f32x4 gg = *(const f32x4*)(p.g_final + c);
        f32x4 o;
#pragma unroll
        for (int e = 0; e < 4; e++) o[e] = v[rr][4 * q + e] * r * gg[e];
        *(f32x4*)(drow + c) = o;
      }
    }
  };
  uint4 va[RIF][2], vb[RIF][2];
  load(wrow, va);
  for (int tok0 = wrow; tok0 < NTOK; tok0 += 2 * RIF * nw) {
    load(tok0 + RIF * nw, vb);
    process(tok0, va);
    load(tok0 + 2 * RIF * nw, va);
    process(tok0 + RIF * nw, vb);
  }
}

namespace pg8 {
#define PG8_LAS __attribute__((address_space(3)))
typedef unsigned short bf16_t;
typedef short bf16x8 __attribute__((ext_vector_type(8)));
typedef float f32x4 __attribute__((ext_vector_type(4)));
typedef unsigned u32x4 __attribute__((ext_vector_type(4)));
constexpr int BM = 256, BK = 64, HALF = 128, HTB = HALF * BK * 2  , STAGE_BYTES = 8 * HTB, NXCD = 8, WGM = 8;

__host__ __device__ __forceinline__ int lds_byte(int r, int c) { const int st = (r >> 4) * 2 + (c >> 5), rr = r & 15, cc = c & 31, ob = rr * 64 + cc * 2; return st * 1024 + (ob ^ (((ob >> 9) & 1) << 5)); }
__host__ __device__ __forceinline__ void stage_rc(int b, int& R, int& C) { const int st = b / 1024, sb = b % 1024, swz = sb ^ (((sb >> 9) & 1) << 5); R = (st >> 1) * 16 + swz / 64; C = (st & 1) * 32 + (swz % 64) / 2; }
__host__ __device__ __forceinline__ int perm32(int rho) { const int n = rho >> 4, i = rho & 15; return 8 * (i >> 2) + 4 * n + (i & 3); }

struct Unit { int pm, pn; };
struct Gemm { const bf16_t* A; const bf16_t* Bt; int M, N, K, lda, ldb; };

struct StaticOrder {
    int nM, nN, nwg, G, c;
    __host__ __device__ void init(int M, int N, int G_, int c_) { nM = M / BM; nN = N / BM; nwg = nM * nN; G = G_; c = c_; }
    __host__ __device__ bool next(int i, Unit& u) const {
        const long L = (long)i * G + c; if (L >= nwg) return false;
        int wgid = (int)L; { const int q = nwg / NXCD, r = nwg % NXCD, xcd = wgid % NXCD, off = wgid / NXCD; wgid = (xcd < r ? xcd * (q + 1) : r * (q + 1) + (xcd - r) * q) + off; }
        const int nig = WGM * nN, gid = wgid / nig, fm = gid * WGM, gsz = (nM - fm) < WGM ? (nM - fm) : WGM;
        u.pm = fm + ((wgid % nig) % gsz); u.pn = (wgid % nig) / gsz; return true;
    }
    __device__ __forceinline__ void a_ready(const Unit&) const {}
    __device__ __forceinline__ void done(const Unit&) const {}
};

struct GroupOrder {
    int nwg, G, c, um, un;
    __host__ __device__ void init(int ngroups, int um_, int un_, int G_, int c_) { um = um_; un = un_; nwg = ngroups * um * un; G = G_; c = (c_ & 7) * (G_ >> 3) + (c_ >> 3); }
    __host__ __device__ bool next(int i, Unit& u) const {
        const int L = i * G + c; if (L >= nwg) return false;
        const int gi = L / (um * un), r = L % (um * un); u.pm = gi * um + r / un; u.pn = gi * un + r % un; return true;
    }
    __device__ __forceinline__ void a_ready(const Unit&) const {}
    __device__ __forceinline__ void done(const Unit&) const {}
};
struct Fft1Order {
    int q0, qs, qe;
    __host__ __device__ void init(int G, int bidx) {
        const int slot = (bidx & 7) * (G >> 3) + (bidx >> 3), nbusy = 160 < G ? 160 : G, nfree = G - nbusy;
        if (nfree <= 0) { q0 = slot; qs = G; qe = 1280; }
        else if (slot < nbusy) { q0 = slot; qs = nbusy; qe = 640; }
        else { q0 = 640 + (slot - nbusy); qs = nfree; qe = 1280; }
    }
    __host__ __device__ bool next(int i, Unit& u) const { const int L = q0 + i * qs; if (L >= qe) return false; u.pn = L >> 1; u.pm = (L & 1) + (u.pn >= 128 ? 2 : 0); return true; }
    __device__ __forceinline__ void a_ready(const Unit&) const {}
    __device__ __forceinline__ void done(const Unit&) const {}
};
struct Fft2Order {
    int G, c;
    __host__ __device__ void init(int G_, int c_) { G = G_; c = c_; }
    __host__ __device__ bool next(int i, Unit& u) const { const int L = i * G + c; if (L >= 1280) return false; u.pn = L; u.pm = L < 256 ? 0 : 1; return true; }
    __device__ __forceinline__ void a_ready(const Unit&) const {}
    __device__ __forceinline__ void done(const Unit&) const {}
};
struct YfOrder {
    int G, c;
    __host__ __device__ void init(int G_, int bidx) { G = G_; const int slot = (bidx & 7) * (G_ >> 3) + (bidx >> 3); c = (slot + (G_ >> 1)) % G_; }
    __host__ __device__ bool next(int i, Unit& u) const { const int L = i * G + c; if (L >= 640) return false; u.pm = L >> 1; u.pn = L & 1; return true; }
    __device__ __forceinline__ void a_ready(const Unit&) const {}
    __device__ __forceinline__ void done(const Unit&) const {}
};
template <class Epi, class Sched, bool ALIGN_EPI = false, bool SP2 = false>
__device__ __forceinline__ void gemm_phase(PG8_LAS unsigned char* lds, const int tix, const Gemm g, const Sched& S, const Epi& E) {
    const int tid = tix, wid = __builtin_amdgcn_readfirstlane(tid >> 6), lane = tid & 63, wr = wid >> 2, wc = wid & 3, fr = lane & 15, fq = lane >> 4;
    const int K = g.K, nt = K / BK;
    unsigned voffA[2], voffB[2];
#pragma unroll
    for (int i = 0; i < 2; ++i) { int R, C; stage_rc(tid * 16 + i * 8192, R, C); const int Rb = Epi::PERM ? ((R & ~31) + perm32(R & 31)) : R;
        voffA[i] = (unsigned)(R * g.lda + C) * 2u; voffB[i] = (unsigned)(Rb * g.ldb + C) * 2u; }
    const size_t kstep = (size_t)(BK * 2);
    const size_t hstepA = (size_t)HALF * g.lda * 2, hstepB = (size_t)HALF * g.ldb * 2;
    const size_t tstepA = 2 * hstepA, tstepB = 2 * hstepB;
    const unsigned ldsw = (unsigned)wid * 1024u;
    const int aoff = lds_byte(wr * 64 + fr, fq * 8), boff = lds_byte(wc * 32 + fr, fq * 8);
#define PG8_SA(b, h) (((b) * 2 + (h)) * HTB)
#define PG8_SB(b, h) ((4 + (b) * 2 + (h)) * HTB)
#define PG8_STAGE(bufoff, gbase, voff) do { _Pragma("unroll") for (int _i = 0; _i < 2; ++_i) \
        __builtin_amdgcn_global_load_lds((const unsigned*)((const char*)(gbase) + (voff)[_i]), (PG8_LAS unsigned*)(lds + (bufoff) + ldsw + _i * 8192), 16, 0, 0); } while (0)
#define PG8_LDA(dst, b, h) do { _Pragma("unroll") for (int m = 0; m < 4; ++m) _Pragma("unroll") for (int k = 0; k < 2; ++k) dst[m][k] = *(const PG8_LAS bf16x8*)(lds + PG8_SA(b, h) + aoff + m * 2048 + k * 1024); } while (0)
#define PG8_LDB(dst, b, h) do { _Pragma("unroll") for (int n = 0; n < 2; ++n) _Pragma("unroll") for (int k = 0; k < 2; ++k) dst[n][k] = *(const PG8_LAS bf16x8*)(lds + PG8_SB(b, h) + boff + n * 2048 + k * 1024); } while (0)
#define PG8_MMA(ai, bj, At, Bt) do { __builtin_amdgcn_s_setprio(1); _Pragma("unroll") for (int m = 0; m < 4; ++m) _Pragma("unroll") for (int n = 0; n < 2; ++n) _Pragma("unroll") for (int k = 0; k < 2; ++k) \
        acc[ai][bj][m][n] = __builtin_amdgcn_mfma_f32_16x16x32_bf16(Bt[n][k], At[m][k], acc[ai][bj][m][n], 0, 0, 0); __builtin_amdgcn_s_setprio(0); } while (0)
#define PG8_WAIT_V(n) asm volatile("s_waitcnt vmcnt(" #n ")" ::: "memory")
#define PG8_WAIT_L(n) asm volatile("s_waitcnt lgkmcnt(" #n ")" ::: "memory")
#define PG8_BAR __builtin_amdgcn_s_barrier()
#define PG8_SCHED __builtin_amdgcn_sched_barrier(0)
    Unit cur, nxt; int ui = 0;
    if (!S.next(0, cur)) return;
    f32x4 acc[2][2][4][2];
#pragma unroll
    for (int a = 0; a < 2; ++a)
#pragma unroll
        for (int b = 0; b < 2; ++b)
#pragma unroll
            for (int m = 0; m < 4; ++m)
#pragma unroll
                for (int n = 0; n < 2; ++n) acc[a][b][m][n] = (f32x4){0.f, 0.f, 0.f, 0.f};
    bf16x8 At[4][2], B0[2][2], B1[2][2];
    const char* cA = (const char*)g.A + (size_t)cur.pm * tstepA; const char* cB = (const char*)g.Bt + (size_t)cur.pn * tstepB;
    S.a_ready(cur);
    if constexpr (SP2) {
        PG8_STAGE(PG8_SB(0, 0), cB, voffB); PG8_STAGE(PG8_SB(0, 1), cB + hstepB, voffB); PG8_STAGE(PG8_SA(0, 0), cA, voffA); PG8_STAGE(PG8_SA(0, 1), cA + hstepA, voffA);
        if (wr == 1) PG8_BAR;
        PG8_WAIT_V(2); PG8_BAR;
        PG8_STAGE(PG8_SB(1, 0), cB + kstep, voffB); PG8_STAGE(PG8_SA(1, 0), cA + kstep, voffA); PG8_STAGE(PG8_SB(1, 1), cB + hstepB + kstep, voffB);
        PG8_WAIT_V(6); PG8_BAR;
    } else {
        PG8_STAGE(PG8_SB(0, 0), cB, voffB); PG8_STAGE(PG8_SA(0, 0), cA, voffA); PG8_STAGE(PG8_SB(0, 1), cB + hstepB, voffB); PG8_STAGE(PG8_SA(0, 1), cA + hstepA, voffA);
        if (wr == 1) PG8_BAR;
        PG8_WAIT_V(4); PG8_BAR;
        PG8_STAGE(PG8_SB(1, 0), cB + kstep, voffB); PG8_STAGE(PG8_SA(1, 0), cA + kstep, voffA); PG8_STAGE(PG8_SB(1, 1), cB + hstepB + kstep, voffB);
        PG8_WAIT_V(6); PG8_BAR;
    }
    for (;;) {
        const bool has_next = S.next(ui + 1, nxt);
        const char* nA = has_next ? (const char*)g.A + (size_t)nxt.pm * tstepA : cA; const char* nB = has_next ? (const char*)g.Bt + (size_t)nxt.pn * tstepB : cB;
        for (int t = 0; t < nt; t += 2) {
            if constexpr (Epi::KHOOK) { if (t == Epi::KH_T) E.khook(acc, ui, wr, fr, lds); }
            const bool last = (t == nt - 2);
            const char* a1 = cA + (size_t)(t + 1) * kstep;
            const char* a2 = last ? nA : cA + (size_t)(t + 2) * kstep; const char* b2 = last ? nB : cB + (size_t)(t + 2) * kstep;
            const char* a3 = a2 + kstep; const char* b3 = b2 + kstep;
            if (last && has_next) S.a_ready(nxt);
            if constexpr (SP2) {
            PG8_LDB(B0, 0, 0); PG8_LDB(B1, 0, 1); PG8_SCHED; PG8_LDA(At, 0, 0); PG8_STAGE(PG8_SA(1, 1), a1 + hstepA, voffA);
            PG8_WAIT_V(8); PG8_WAIT_L(0); PG8_BAR; PG8_MMA(0, 0, At, B0); PG8_MMA(0, 1, At, B1); PG8_BAR; PG8_SCHED;
            PG8_LDA(At, 0, 1); PG8_STAGE(PG8_SB(0, 0), b2, voffB); PG8_STAGE(PG8_SB(0, 1), b2 + hstepB, voffB); PG8_STAGE(PG8_SA(0, 0), a2, voffA);
            PG8_WAIT_V(8); PG8_WAIT_L(0); PG8_BAR; PG8_MMA(1, 0, At, B0); PG8_MMA(1, 1, At, B1); PG8_BAR; PG8_SCHED;
            PG8_LDB(B0, 1, 0); PG8_LDB(B1, 1, 1); PG8_SCHED; PG8_LDA(At, 1, 0); PG8_STAGE(PG8_SA(0, 1), a2 + hstepA, voffA);
            PG8_WAIT_V(8); PG8_WAIT_L(0); PG8_BAR; PG8_MMA(0, 0, At, B0); PG8_MMA(0, 1, At, B1); PG8_BAR; PG8_SCHED;
            PG8_LDA(At, 1, 1); PG8_STAGE(PG8_SB(1, 0), b3, voffB); PG8_STAGE(PG8_SB(1, 1), b3 + hstepB, voffB); PG8_STAGE(PG8_SA(1, 0), a3, voffA);
            PG8_WAIT_V(8); PG8_WAIT_L(0); PG8_BAR; PG8_MMA(1, 0, At, B0); PG8_MMA(1, 1, At, B1); PG8_BAR; PG8_SCHED;
            } else {
            PG8_LDB(B0, 0, 0); PG8_SCHED; PG8_LDA(At, 0, 0); PG8_STAGE(PG8_SA(1, 1), a1 + hstepA, voffA);
            PG8_WAIT_L(8); PG8_BAR; PG8_WAIT_L(0); PG8_MMA(0, 0, At, B0); PG8_BAR; PG8_SCHED;
            PG8_LDB(B1, 0, 1); PG8_STAGE(PG8_SB(0, 0), b2, voffB);
            PG8_BAR; PG8_WAIT_L(0); PG8_MMA(0, 1, At, B1); PG8_BAR;
            PG8_LDA(At, 0, 1); PG8_STAGE(PG8_SA(0, 0), a2, voffA);
            PG8_BAR; PG8_WAIT_L(0); PG8_MMA(1, 0, At, B0); PG8_BAR; PG8_SCHED;
            PG8_STAGE(PG8_SB(0, 1), b2 + hstepB, voffB);
            PG8_WAIT_V(6); PG8_BAR; PG8_MMA(1, 1, At, B1); PG8_BAR;
            PG8_LDB(B0, 1, 0); PG8_SCHED; PG8_LDA(At, 1, 0); PG8_STAGE(PG8_SA(0, 1), a2 + hstepA, voffA);
            PG8_WAIT_L(8); PG8_BAR; PG8_WAIT_L(0); PG8_MMA(0, 0, At, B0); PG8_BAR; PG8_SCHED;
            PG8_LDB(B1, 1, 1); PG8_STAGE(PG8_SB(1, 0), b3, voffB);
            PG8_BAR; PG8_WAIT_L(0); PG8_MMA(0, 1, At, B1); PG8_BAR;
            PG8_LDA(At, 1, 1); PG8_STAGE(PG8_SA(1, 0), a3, voffA);
            PG8_BAR; PG8_WAIT_L(0); PG8_MMA(1, 0, At, B0); PG8_BAR; PG8_SCHED;
            PG8_STAGE(PG8_SB(1, 1), b3 + hstepB, voffB);
            PG8_WAIT_V(6); PG8_BAR; PG8_MMA(1, 1, At, B1); PG8_BAR;
            }
        }
        if constexpr (ALIGN_EPI) { if (wr == 0) PG8_BAR; }
        if constexpr (!Epi::AFTER_DRAIN) { E(acc, cur, wr, wc, fr, fq, ui); S.done(cur); }
        if (!has_next) break;
#pragma unroll
        for (int a = 0; a < 2; ++a)
#pragma unroll
            for (int b = 0; b < 2; ++b)
#pragma unroll
                for (int m = 0; m < 4; ++m)
#pragma unroll
                    for (int n = 0; n < 2; ++n) acc[a][b][m][n] = (f32x4){0.f, 0.f, 0.f, 0.f};
        cur = nxt; cA = nA; cB = nB; ++ui;
        if constexpr (ALIGN_EPI) { if (wr == 1) PG8_BAR; }
    }
    PG8_WAIT_V(0);
    if constexpr (!ALIGN_EPI) { if (wr == 0) PG8_BAR; }
    PG8_BAR;
    if constexpr (Epi::AFTER_DRAIN) { E.fused(acc, cur, wr, wc, fr, fq, lds, wid, lane); S.done(cur); }
#undef PG8_SA
#undef PG8_SB
#undef PG8_STAGE
#undef PG8_LDA
#undef PG8_LDB
#undef PG8_MMA
#undef PG8_WAIT_V
#undef PG8_WAIT_L
#undef PG8_BAR
#undef PG8_SCHED
}
}

namespace pg8 {
struct EpiMlpIn {
  static constexpr bool PERM = true, AFTER_DRAIN = false, KHOOK = false; static constexpr int KH_T = 0;
  ::bf16_t* O; const float* sb2; const float* ss1;
  __device__ __forceinline__ void operator()(const f32x4 (&acc)[2][2][4][2], const Unit& u, int wr, int wc, int fr, int fq, int) const {
    const int row0 = u.pm * BM + wr * 64 + fr, col0 = u.pn * BM + wc * 32 + 8 * fq;
    const float* bias = sb2 + batch_of(u.pm * BM) * 4096;
    f32x4 bv[2][2];
#pragma unroll
    for (int bj = 0; bj < 2; ++bj)
#pragma unroll
      for (int n = 0; n < 2; ++n) bv[bj][n] = *(const f32x4*)(bias + col0 + bj * HALF + 4 * n);
    float r2[2][4];
#pragma unroll
    for (int ai = 0; ai < 2; ++ai)
#pragma unroll
      for (int m = 0; m < 4; ++m) r2[ai][m] = rsqrtf(ss1[row0 + ai * HALF + m * 16] * (1.f / 1024.f) + EPSV);
#pragma unroll
    for (int ai = 0; ai < 2; ++ai)
#pragma unroll
      for (int m = 0; m < 4; ++m) {
        ::bf16_t* rowp = O + (size_t)(row0 + ai * HALF + m * 16) * 4096 + col0;
#pragma unroll
        for (int bj = 0; bj < 2; ++bj) {
          f32x4 v0 = acc[ai][bj][m][0] * r2[ai][m] + bv[bj][0], v1 = acc[ai][bj][m][1] * r2[ai][m] + bv[bj][1];
#pragma unroll
          for (int e = 0; e < 4; ++e) { const float a = fmaxf(v0[e], 0.f), b = fmaxf(v1[e], 0.f); v0[e] = a * a; v1[e] = b * b; }
          u32x4 w; w.x = pk2(v0[0], v0[1]); w.y = pk2(v0[2], v0[3]); w.z = pk2(v1[0], v1[1]); w.w = pk2(v1[2], v1[3]);
          *(u32x4*)(rowp + bj * HALF) = w;
        }
      }
  }
};
struct EpiMlpOut {
  static constexpr bool PERM = true, AFTER_DRAIN = false, KHOOK = false; static constexpr int KH_T = 0;
  const ::bf16_t* x1; ::bf16_t* x2; const float* mod; const float* bias;
  __device__ __forceinline__ void operator()(const f32x4 (&acc)[2][2][4][2], const Unit& u, int wr, int wc, int fr, int fq, int) const {
    const int col0 = u.pn * BM + wc * 32 + 8 * fq;
    const float* g2 = mod + batch_of(u.pm * BM) * 6144 + 5120;
    f32x4 bb[2][2], gv[2][2];
#pragma unroll
    for (int bj = 0; bj < 2; ++bj)
#pragma unroll
      for (int n = 0; n < 2; ++n) { bb[bj][n] = *(const f32x4*)(bias + col0 + bj * HALF + n * 4); gv[bj][n] = *(const f32x4*)(g2 + col0 + bj * HALF + n * 4); }
#pragma unroll
    for (int ai = 0; ai < 2; ++ai) {
      u32x4 xr[4][2];
#pragma unroll
      for (int m = 0; m < 4; ++m) {
        const int row = u.pm * BM + ai * HALF + wr * 64 + m * 16 + fr;
#pragma unroll
        for (int bj = 0; bj < 2; ++bj) xr[m][bj] = *(const u32x4*)(x1 + (size_t)row * 1024 + col0 + bj * HALF);
      }
      asm volatile("" ::: "memory");
#pragma unroll
      for (int m = 0; m < 4; ++m) {
        const int row = u.pm * BM + ai * HALF + wr * 64 + m * 16 + fr;
#pragma unroll
        for (int bj = 0; bj < 2; ++bj) {
          const u32x4 xx = xr[m][bj];
          f32x4 x0, x1v;
          x0[0] = bflo(xx.x); x0[1] = bfhi(xx.x); x0[2] = bflo(xx.y); x0[3] = bfhi(xx.y);
          x1v[0] = bflo(xx.z); x1v[1] = bfhi(xx.z); x1v[2] = bflo(xx.w); x1v[3] = bfhi(xx.w);
          const f32x4 o0 = x0 + gv[bj][0] * (acc[ai][bj][m][0] + bb[bj][0]), o1 = x1v + gv[bj][1] * (acc[ai][bj][m][1] + bb[bj][1]);
          u32x4 w; w.x = pk2(o0[0], o0[1]); w.y = pk2(o0[2], o0[3]); w.z = pk2(o1[0], o1[1]); w.w = pk2(o1[2], o1[3]);
          *(u32x4*)(x2 + (size_t)row * 1024 + col0 + bj * HALF) = w;
        }
      }
    }
  }
};
struct EpiYf {
  static constexpr bool PERM = true, AFTER_DRAIN = false, KHOOK = false; static constexpr int KH_T = 0;
  ::bf16_t* O; const float* bias; float* ss;
  __device__ __forceinline__ void operator()(const f32x4 (&acc)[2][2][4][2], const Unit& u, int wr, int wc, int fr, int fq, int) const {
    const int row0 = u.pm * BM + wr * 64 + fr, col0 = u.pn * BM + wc * 32 + 8 * fq;
    f32x4 bv[2][2];
#pragma unroll
    for (int bj = 0; bj < 2; ++bj)
#pragma unroll
      for (int n = 0; n < 2; ++n) bv[bj][n] = *(const f32x4*)(bias + col0 + bj * HALF + 4 * n);
#pragma unroll
    for (int ai = 0; ai < 2; ++ai)
#pragma unroll
      for (int m = 0; m < 4; ++m) {
        const int row = row0 + ai * HALF + m * 16;
        const float scale = row < LPR ? 3.4526698300124393e-4f : 6.905339660024879e-4f;
        ::bf16_t* rowp = O + (size_t)row * 1024 + col0;
        float s = 0.f;
#pragma unroll
        for (int bj = 0; bj < 2; ++bj) {
          const f32x4 v0 = acc[ai][bj][m][0] * scale + bv[bj][0], v1 = acc[ai][bj][m][1] * scale + bv[bj][1];
          s += (v0[0] * v0[0] + v0[1] * v0[1]) + (v0[2] * v0[2] + v0[3] * v0[3]) + (v1[0] * v1[0] + v1[1] * v1[1]) + (v1[2] * v1[2] + v1[3] * v1[3]);
          u32x4 w; w.x = pk2(v0[0], v0[1]); w.y = pk2(v0[2], v0[3]); w.z = pk2(v1[0], v1[1]); w.w = pk2(v1[2], v1[3]);
          *(u32x4*)(rowp + bj * HALF) = w;
        }
        s += __shfl_xor(s, 16); s += __shfl_xor(s, 32);
        if (fq == 0) ss[row * 8 + u.pn * 4 + wc] = s;
      }
  }
};
struct EpiGlu {
  static constexpr bool PERM = true, AFTER_DRAIN = false, KHOOK = false; static constexpr int KH_T = 0;
  ::bf16_t* O; const float* bias; float* ss;
  __device__ __forceinline__ void operator()(const f32x4 (&acc)[2][2][4][2], const Unit& u, int wr, int wc, int fr, int fq, int) const {
    const int row0 = u.pm * BM + wr * 64 + fr, j0 = u.pn * 128 + wc * 32 + 8 * fq;
    f32x4 bv[2][2];
#pragma unroll
    for (int bj = 0; bj < 2; ++bj)
#pragma unroll
      for (int n = 0; n < 2; ++n) bv[bj][n] = *(const f32x4*)(bias + bj * 512 + j0 + 4 * n);
#pragma unroll
    for (int ai = 0; ai < 2; ++ai)
#pragma unroll
      for (int m = 0; m < 4; ++m) {
        const int row = row0 + ai * HALF + m * 16;
        float o[8], s = 0.f;
#pragma unroll
        for (int n = 0; n < 2; ++n)
#pragma unroll
          for (int e = 0; e < 4; ++e) {
            const float val = acc[ai][0][m][n][e] + bv[0][n][e], gate = acc[ai][1][m][n][e] + bv[1][n][e];
            const float y = val / (1.f + __expf(-gate));
            o[4 * n + e] = y; s += y * y;
          }
        u32x4 w; w.x = pk2(o[0], o[1]); w.y = pk2(o[2], o[3]); w.z = pk2(o[4], o[5]); w.w = pk2(o[6], o[7]);
        *(u32x4*)(O + (size_t)row * 1024 + 512 + j0) = w;
        s += __shfl_xor(s, 16); s += __shfl_xor(s, 32);
        if (fq == 0) ss[row * 16 + u.pn * 4 + wc] = s;
      }
  }
};
struct EpiZt {
  static constexpr bool PERM = true, AFTER_DRAIN = false, KHOOK = false; static constexpr int KH_T = 0;
  ::bf16_t* O;
  __device__ __forceinline__ void operator()(const f32x4 (&acc)[2][2][4][2], const Unit& u, int wr, int wc, int fr, int fq, int) const {
    const int v0 = u.pn * BM;
    ::bf16_t* base; size_t ld;
    if (v0 < LPR) { base = O + v0; ld = LPR; }
    else { const int vs = v0 - LPR; base = O + (size_t)512 * LPR + (size_t)(vs >> 12) * 512 * 4096 + (vs & 4095); ld = 4096; }
    const int c0 = u.pm * BM + wr * 64 + fr, col0 = wc * 32 + 8 * fq;
#pragma unroll
    for (int ai = 0; ai < 2; ++ai)
#pragma unroll
      for (int m = 0; m < 4; ++m) {
        ::bf16_t* rowp = base + (size_t)(c0 + ai * HALF + m * 16) * ld + col0;
#pragma unroll
        for (int bj = 0; bj < 2; ++bj) {
          const f32x4 a = acc[ai][bj][m][0], b = acc[ai][bj][m][1];
          u32x4 w; w.x = pk2(a[0], a[1]); w.y = pk2(a[2], a[3]); w.z = pk2(b[0], b[1]); w.w = pk2(b[2], b[3]);
          *(u32x4*)(rowp + bj * HALF) = w;
        }
      }
  }
};
struct EpiZs {
  static constexpr bool PERM = true, AFTER_DRAIN = false, KHOOK = false; static constexpr int KH_T = 0;
  ::bf16_t* O;
  __device__ __forceinline__ void operator()(const f32x4 (&acc)[2][2][4][2], const Unit& u, int wr, int wc, int fr, int fq, int) const {
    const int r0 = u.pm * BM + wr * 64 + fr, col0 = u.pn * BM + wc * 32 + 8 * fq;
#pragma unroll
    for (int ai = 0; ai < 2; ++ai)
#pragma unroll
      for (int m = 0; m < 4; ++m) {
        const int tok = v2tok(r0 + ai * HALF + m * 16);
#pragma unroll
        for (int bj = 0; bj < 2; ++bj) {
          const int col = col0 + bj * HALF;
          const f32x4 a = acc[ai][bj][m][0], b = acc[ai][bj][m][1];
          u32x4 w; w.x = pk2(a[0], a[1]); w.y = pk2(a[2], a[3]); w.z = pk2(b[0], b[1]); w.w = pk2(b[2], b[3]);
          *(u32x4*)(O + ((size_t)(col >> 4) * 1280 + (tok >> 6)) * 1280 + (tok & 63) * 16 + (col & 15)) = w;
        }
      }
  }
};
struct EpiS {
  static constexpr bool PERM = false, AFTER_DRAIN = false, KHOOK = false; static constexpr int KH_T = 0;
  float* O;
  __device__ __forceinline__ void operator()(const f32x4 (&acc)[2][2][4][2], const Unit& u, int wr, int wc, int fr, int fq, int) const {
#pragma unroll
    for (int ai = 0; ai < 2; ++ai)
#pragma unroll
      for (int m = 0; m < 4; ++m) {
        float* rowp = O + (size_t)(u.pm * BM + ai * HALF + wr * 64 + m * 16 + fr) * 256 + wc * 32 + 4 * fq;
#pragma unroll
        for (int bj = 0; bj < 2; ++bj)
#pragma unroll
          for (int n = 0; n < 2; ++n) *(f32x4*)(rowp + bj * HALF + n * 16) = acc[ai][bj][m][n];
      }
  }
};
struct EpiGelu {
  static constexpr bool PERM = true, AFTER_DRAIN = false, KHOOK = false; static constexpr int KH_T = 0;
  ::bf16_t* O;
  __device__ __forceinline__ void operator()(const f32x4 (&acc)[2][2][4][2], const Unit& u, int wr, int wc, int fr, int fq, int) const {
    const int gi = u.pn >> 2, n0 = (u.pn & 3) * BM + wc * 32 + 8 * fq, ch0 = u.pm * BM - gi * 1280 + wr * 64 + fr;
#pragma unroll
    for (int ai = 0; ai < 2; ++ai)
#pragma unroll
      for (int m = 0; m < 4; ++m) {
        const int ch = ch0 + ai * HALF + m * 16;
#pragma unroll
        for (int bj = 0; bj < 2; ++bj) {
          const int n = n0 + bj * HALF;
          float o[8];
#pragma unroll
          for (int e = 0; e < 4; ++e) { o[e] = gelu_tanh(acc[ai][bj][m][0][e]); o[4 + e] = gelu_tanh(acc[ai][bj][m][1][e]); }
          u32x4 w; w.x = pk2(o[0], o[1]); w.y = pk2(o[2], o[3]); w.z = pk2(o[4], o[5]); w.w = pk2(o[6], o[7]);
          *(u32x4*)(O + (size_t)(ch * 64 + (n >> 4)) * 512 + gi * 16 + (n & 15)) = w;
        }
      }
  }
};
struct EpiFft1 {
  static constexpr bool PERM = true, AFTER_DRAIN = false, KHOOK = false; static constexpr int KH_T = 0;
  ::bf16_t* Tt; const float2* twp; const float2* tws;
  __device__ __forceinline__ void operator()(const f32x4 (&acc)[2][2][4][2], const Unit& u, int wr, int wc, int fr, int fq, int) const {
    const bool pr = u.pn < 128;
    const int r0b = u.pn * BM + wc * 32 + 8 * fq;
    const float2* tw = pr ? twp : tws;
    const int mask = pr ? 16383 : 4095;
    float2 stv[4], w0v[4];
#pragma unroll
    for (int m = 0; m < 4; ++m) {
      const int idx = ((u.pm & 1) << 7) | (wr * 64 + m * 16 + fr);
      const int k1 = pr ? (idx & 127) : (idx & 63), l2loc = pr ? (idx >> 7) : (idx >> 6);
      const int l20 = pr ? (l2loc * 64 + (r0b & 63)) : (l2loc * 16 + (r0b & 15));
      stv[m] = tw[(unsigned)(k1 & mask)]; w0v[m] = tw[(unsigned)((k1 * l20) & mask)];
    }
    asm volatile("" ::: "memory");
#pragma unroll
    for (int m = 0; m < 4; ++m) {
      const int idx = ((u.pm & 1) << 7) | (wr * 64 + m * 16 + fr);
      const int k1 = pr ? (idx & 127) : (idx & 63), l2loc = pr ? (idx >> 7) : (idx >> 6);
      const int l20 = pr ? (l2loc * 64 + (r0b & 63)) : (l2loc * 16 + (r0b & 15));
      const float2 st = stv[m], w0 = w0v[m];
#pragma unroll
      for (int bj = 0; bj < 2; ++bj) {
        const int r0 = r0b + bj * HALF;
        size_t off; int pstride;
        if (pr) { off = ((size_t)(k1 * 512 + (r0 >> 6))) * 256 + l20; pstride = 128; }
        else { const int bc = (r0 - 32768) >> 4; off = (size_t)65536 * 256 + ((size_t)(((bc >> 9) * 32 + (k1 >> 1)) * 512 + (bc & 511))) * 256 + (k1 & 1) * 128 + l20; pstride = 64; }
        float ore[8], oim[8];
        float2 wv = w0;
#pragma unroll
        for (int e = 0; e < 8; ++e) {
          const float re = acc[0][bj][m][e >> 2][e & 3], im = acc[1][bj][m][e >> 2][e & 3];
          ore[e] = re * wv.x + im * wv.y; oim[e] = im * wv.x - re * wv.y;
          wv = make_float2(wv.x * st.x - wv.y * st.y, wv.y * st.x + wv.x * st.y);
        }
        u32x4 w; w.x = pk2(ore[0], ore[1]); w.y = pk2(ore[2], ore[3]); w.z = pk2(ore[4], ore[5]); w.w = pk2(ore[6], ore[7]);
        *(u32x4*)(Tt + off) = w;
        w.x = pk2(oim[0], oim[1]); w.y = pk2(oim[2], oim[3]); w.z = pk2(oim[4], oim[5]); w.w = pk2(oim[6], oim[7]);
        *(u32x4*)(Tt + off + pstride) = w;
      }
    }
  }
};
struct EpiFft2 {
  static constexpr bool PERM = true, AFTER_DRAIN = false, KHOOK = false; static constexpr int KH_T = 0;
  ::bf16_t* AF;
  __device__ __forceinline__ void operator()(const f32x4 (&acc)[2][2][4][2], const Unit& u, int wr, int wc, int fr, int fq, int) const {
    const bool pr = u.pn < 256;
    const int pnl = pr ? u.pn : u.pn - 256, c0 = (pnl & 1) * 256 + wc * 32 + 8 * fq;
#pragma unroll
    for (int ai = 0; ai < 2; ++ai)
#pragma unroll
      for (int m = 0; m < 4; ++m) {
        int part, tok;
        if (pr) { part = ai; tok = (pnl >> 1) + 128 * (wr * 64 + m * 16 + fr); }
        else { const int bk = pnl >> 1; part = wr; tok = LPR + (bk >> 5) * 4096 + (bk & 31) * 2 + ai + 64 * (m * 16 + fr); }
        ::bf16_t* rowp = AF + (size_t)tok * 1024 + part * 512 + c0;
#pragma unroll
        for (int bj = 0; bj < 2; ++bj) {
          const f32x4 a = acc[ai][bj][m][0], b = acc[ai][bj][m][1];
          u32x4 w; w.x = pk2(a[0], a[1]); w.y = pk2(a[2], a[3]); w.z = pk2(b[0], b[1]); w.w = pk2(b[2], b[3]);
          *(u32x4*)(rowp + bj * HALF) = w;
        }
      }
  }
};
struct EpiWout {
  static constexpr bool PERM = true, AFTER_DRAIN = false, KHOOK = true; static constexpr int KH_T = 8;
  float* out; const float* xp; const float* xs; const float* mod; const float* g2; ::bf16_t* h2; float* ss1;
  __device__ __forceinline__ void khook(f32x4 (&acc)[2][2][4][2], int ui, int wr, int fr, PG8_LAS unsigned char* lds) const {
    typedef float f32x2t __attribute__((ext_vector_type(2)));
    const PG8_LAS f32x2t* tab = (const PG8_LAS f32x2t*)(lds + 131072) + ui * 256;
#pragma unroll
    for (int ai = 0; ai < 2; ++ai)
#pragma unroll
      for (int m = 0; m < 4; ++m) {
        const float r = tab[ai * HALF + wr * 64 + m * 16 + fr].x;
#pragma unroll
        for (int bj = 0; bj < 2; ++bj)
#pragma unroll
          for (int n = 0; n < 2; ++n) acc[ai][bj][m][n] *= r;
      }
  }
  __device__ __forceinline__ void operator()(const f32x4 (&acc)[2][2][4][2], const Unit& u, int wr, int wc, int fr, int fq, int ui) const {
    typedef float f32x2t __attribute__((ext_vector_type(2)));
    const PG8_LAS f32x2t* tab = (const PG8_LAS f32x2t*)((PG8_LAS unsigned char*)dyn_smem + 131072) + ui * 256;
    const int col0 = u.pn * BM + wc * 32 + 8 * fq;
    const float* md = mod + batch_of(u.pm * BM) * 6144;
    f32x4 gv[2][2], hv[2][2];
#pragma unroll
    for (int bj = 0; bj < 2; ++bj)
#pragma unroll
      for (int n = 0; n < 2; ++n) {
        const int col = col0 + bj * HALF + n * 4;
        gv[bj][n] = *(const f32x4*)(md + 2048 + col);
        hv[bj][n] = *(const f32x4*)(g2 + col) * (*(const f32x4*)(md + 4096 + col) + 1.f);
      }
#pragma unroll
    for (int ai = 0; ai < 2; ++ai)
#pragma unroll
      for (int mp = 0; mp < 2; ++mp) {
        f32x4 xv[2][2][2]; float rs[2];
#pragma unroll
        for (int mm = 0; mm < 2; ++mm) {
          const int m = mp * 2 + mm, rl = ai * HALF + wr * 64 + m * 16 + fr, row = u.pm * BM + rl;
          rs[mm] = tab[rl].y;
          const float* xr = row < LPR ? xp + (size_t)row * 1024 : xs + (size_t)(row - LPR) * 1024;
#pragma unroll
          for (int bj = 0; bj < 2; ++bj)
#pragma unroll
            for (int n = 0; n < 2; ++n) xv[mm][bj][n] = *(const f32x4*)(xr + col0 + bj * HALF + n * 4);
        }
        asm volatile("" ::: "memory");
#pragma unroll
        for (int mm = 0; mm < 2; ++mm) {
          const int m = mp * 2 + mm, row = u.pm * BM + ai * HALF + wr * 64 + m * 16 + fr;
          ::bf16_t* orow = (::bf16_t*)out + (size_t)row * 1024 + col0;
          ::bf16_t* hrow = h2 + (size_t)row * 1024 + col0;
          float sq = 0.f;
#pragma unroll
          for (int bj = 0; bj < 2; ++bj) {
            const f32x4 o0 = xv[mm][bj][0] + gv[bj][0] * (acc[ai][bj][m][0] * rs[mm]), o1 = xv[mm][bj][1] + gv[bj][1] * (acc[ai][bj][m][1] * rs[mm]);
            sq += (o0[0] * o0[0] + o0[1] * o0[1]) + (o0[2] * o0[2] + o0[3] * o0[3]) + (o1[0] * o1[0] + o1[1] * o1[1]) + (o1[2] * o1[2] + o1[3] * o1[3]);
            u32x4 w; w.x = pk2(o0[0], o0[1]); w.y = pk2(o0[2], o0[3]); w.z = pk2(o1[0], o1[1]); w.w = pk2(o1[2], o1[3]);
            *(u32x4*)(orow + bj * HALF) = w;
            const f32x4 h0 = o0 * hv[bj][0], h1 = o1 * hv[bj][1];
            w.x = pk2(h0[0], h0[1]); w.y = pk2(h0[2], h0[3]); w.z = pk2(h1[0], h1[1]); w.w = pk2(h1[2], h1[3]);
            *(u32x4*)(hrow + bj * HALF) = w;
          }
          sq += __shfl_xor(sq, 16); sq += __shfl_xor(sq, 32);
          if (fq == 0) atomicAdd(ss1 + row, sq);
        }
      }
  }
};
}

DI void phase2(const P& p, const int wv) {
  {
    const pg8::Gemm g{p.wint(), p.hb(), 512, NTOK, 1024, 1024, 1024};
    pg8::StaticOrder S; S.init(512, NTOK, (int)gridDim.x, (int)blockIdx.x);
    const pg8::EpiZt E{p.zT()};
    pg8::gemm_phase<pg8::EpiZt, pg8::StaticOrder, true, true>((PG8_LAS unsigned char*)dyn_smem, otid(wv), g, S, E);
  }
  {
    const pg8::Gemm g{p.hb(), p.wint() + (size_t)512 * 1024, NTOK, 512, 1024, 1024, 1024};
    pg8::StaticOrder S; S.init(NTOK, 512, (int)gridDim.x, (int)(gridDim.x - 1 - blockIdx.x));
    const pg8::EpiZs E{p.Ucat()};
    pg8::gemm_phase<pg8::EpiZs, pg8::StaticOrder, true, true>((PG8_LAS unsigned char*)dyn_smem, otid(wv), g, S, E);
  }
}
DI void phase3(const P& p, const int wv) {
  {
    const pg8::Gemm g{p.Ucat(), p.Bs(), 32 * 1280, 32 * 256, 1024, 1280, 1024};
    pg8::GroupOrder S; S.init(32, 5, 1, (int)gridDim.x, (int)blockIdx.x);
    const pg8::EpiS E{p.S()};
    pg8::gemm_phase<pg8::EpiS, pg8::GroupOrder, true, true>((PG8_LAS unsigned char*)dyn_smem, otid(wv), g, S, E);
  }
  {
    const pg8::Gemm g{p.Fb1(), p.zT(), 1024, 163840, 256, 256, 256};
    pg8::Fft1Order S; S.init((int)gridDim.x, (int)blockIdx.x);
    const pg8::EpiFft1 E{p.Tt(), p.twp(), p.tws()};
    pg8::gemm_phase<pg8::EpiFft1, pg8::Fft1Order, true, true>((PG8_LAS unsigned char*)dyn_smem, otid(wv), g, S, E);
  }
}
DI void phase4(const P& p, const int wv) {
  {
    const int tix = otid(wv), pp = tix & 63, G = (int)gridDim.x;
    for (int task = (int)blockIdx.x + G * wv; task < 17 * 64; task += G * 8) {
      const int seq = task >> 6, g = (task >> 1) & 31, dir = task & 1;
      const int c0 = seq == 0 ? 0 : 256 + (seq - 1) * 64, nc = seq == 0 ? 256 : 64;
      const float ar = p.AT()[((g * 2 + dir) * 64 + pp) * 2], ai = p.AT()[((g * 2 + dir) * 64 + pp) * 2 + 1];
      float hr = 0.f, hi = 0.f;
      const float* Sg = p.S() + (size_t)g * 1280 * 256 + dir * 128 + pp;
      bf16_t* Hg = p.Ucat() + (size_t)g * 1280 * 1280 + 1024 + dir * 128 + pp;
      for (int i0 = 0; i0 < nc; i0 += 32) {
        float sr[32], si[32];
#pragma unroll
        for (int j = 0; j < 32; j++) {
          const int c = c0 + (dir == 0 ? i0 + j : nc - 1 - i0 - j);
          sr[j] = Sg[(size_t)c * 256]; si[j] = Sg[(size_t)c * 256 + 64];
        }
#pragma unroll
        for (int j = 0; j < 32; j++) {
          const int c = c0 + (dir == 0 ? i0 + j : nc - 1 - i0 - j);
          Hg[(size_t)c * 1280] = f2bf(hr); Hg[(size_t)c * 1280 + 64] = f2bf(hi);
          const float nr = ar * hr - ai * hi + sr[j], ni = ar * hi + ai * hr + si[j];
          hr = nr; hi = ni;
        }
      }
    }
  }
  {
    const pg8::Gemm g{p.Fb2(), p.Tt(), 512, 327680, 256, 256, 256};
    pg8::Fft2Order S; S.init((int)gridDim.x, (int)blockIdx.x);
    const pg8::EpiFft2 E{p.AF()};
    pg8::gemm_phase<pg8::EpiFft2, pg8::Fft2Order, true, true>((PG8_LAS unsigned char*)dyn_smem, otid(wv), g, S, E);
  }
}
DI void phase5(const P& p, const int wv) {
  const pg8::Gemm g{p.Ucat(), p.Tcat(), 32 * 1280, 32 * 1024, 1280, 1280, 1280};
  pg8::GroupOrder S; S.init(32, 5, 4, (int)gridDim.x, (int)blockIdx.x);
  const pg8::EpiGelu E{p.gact()};
  pg8::gemm_phase<pg8::EpiGelu, pg8::GroupOrder, true, true>((PG8_LAS unsigned char*)dyn_smem, otid(wv), g, S, E);
  {
    const pg8::Gemm g{p.AF(), p.Mf(), NTOK, 512, 1024, 1024, 1024};
    pg8::YfOrder S; S.init((int)gridDim.x, (int)blockIdx.x);
    const pg8::EpiYf E{p.mg(), p.b_f, p.ssf()};
    pg8::gemm_phase<pg8::EpiYf, pg8::YfOrder, true, true>((PG8_LAS unsigned char*)dyn_smem, otid(wv), g, S, E);
  }
}
DI void phase6(const P& p, const int wv) {
  {
    const pg8::Gemm g{p.gact(), p.wglut(), NTOK, 1024, 512, 512, 512};
    pg8::StaticOrder S; S.init(NTOK, 1024, (int)gridDim.x, (int)blockIdx.x);
    const pg8::EpiGlu E{p.mg(), p.b_glu, p.sss()};
    pg8::gemm_phase<pg8::EpiGlu, pg8::StaticOrder, true, true>((PG8_LAS unsigned char*)dyn_smem, otid(wv), g, S, E);
  }
}
DI void phase7(const P& p, const int wv) {
  const pg8::Gemm g{p.mg(), p.woutt(), NTOK, 1024, 1024, 1024, 1024};
  pg8::StaticOrder S; S.init(NTOK, 1024, (int)gridDim.x, (int)blockIdx.x);
  {
    typedef float f32x2t __attribute__((ext_vector_type(2)));
    PG8_LAS f32x2t* tab = (PG8_LAS f32x2t*)((PG8_LAS unsigned char*)dyn_smem + 131072);
    const int tix7 = otid(wv);
    pg8::Unit u;
    for (int i = 0; i < 8 && S.next(i, u); ++i) {
      if (tix7 < 256) {
        const int tok = u.pm * 256 + tix7;
        float sf = 0.f, s2 = 0.f;
#pragma unroll
        for (int j = 0; j < 8; j++) sf += p.ssf()[tok * 8 + j];
#pragma unroll
        for (int j = 0; j < 16; j++) s2 += p.sss()[tok * 16 + j];
        const float rf = rsqrtf(sf * (1.f / 512.f) + EPSV), rs = rsqrtf(s2 * (1.f / 512.f) + EPSV);
        tab[i * 256 + tix7] = (f32x2t){rf / rs, rs};
      }
    }
    __syncthreads();
  }
  const pg8::EpiWout E{p.out, p.xp, p.xs, p.mod(), p.g_mlp, p.hb(), p.ss1()};
  pg8::gemm_phase<pg8::EpiWout, pg8::StaticOrder, true, true>((PG8_LAS unsigned char*)dyn_smem, otid(wv), g, S, E);
}
DI void phase8(const P& p, const int wv) {
  const pg8::Gemm g{p.hb(), p.w1t(), NTOK, 4096, 1024, 1024, 1024};
  pg8::StaticOrder S; S.init(NTOK, 4096, (int)gridDim.x, (int)blockIdx.x);
  const pg8::EpiMlpIn E{p.hid(), p.sb2(), p.ss1()};
  pg8::gemm_phase<pg8::EpiMlpIn, pg8::StaticOrder, true, true>((PG8_LAS unsigned char*)dyn_smem, otid(wv), g, S, E);
}
DI void phase9(const P& p, const int wv) {
  const pg8::Gemm g{p.hid(), p.w2t(), NTOK, 1024, 4096, 4096, 4096};
  pg8::StaticOrder S; S.init(NTOK, 1024, (int)gridDim.x, (int)blockIdx.x);
  const pg8::EpiMlpOut E{(const bf16_t*)p.out, p.hb(), p.mod(), p.b2};
  pg8::gemm_phase<pg8::EpiMlpOut, pg8::StaticOrder, true, true>((PG8_LAS unsigned char*)dyn_smem, otid(wv), g, S, E);
}

__global__ void __launch_bounds__(512, 2) k_mega(P p) {
  cg::grid_group grid = cg::this_grid();
  const int wv = __builtin_amdgcn_readfirstlane((int)threadIdx.x >> 6);
  {
    const int t0 = otid(wv);
    volatile XB_LAS unsigned* st = (volatile XB_LAS unsigned*)((XB_LAS unsigned char*)dyn_smem + XB_LDS_OFF);
    if (t0 == 0) { st[0] = 0u; st[1] = 0u; }
    __syncthreads();
    if (t0 == 0) (void)xb_add((unsigned*)(p.ws + O_bar) + XB_XCNT(xb_xcc_id()), 1u);
  }
#define GSYNC() xcd_barrier((unsigned*)(p.ws + O_bar), otid(wv))
  if (p.ws == nullptr) grid.sync();
  phase0(p, wv); GSYNC();
  rownorm_mod<true>(p, wv, p.g_mix, 0, 1024); GSYNC();
  phase2(p, wv); GSYNC();
  phase3(p, wv); GSYNC();
  phase4(p, wv); GSYNC();
  phase5(p, wv); GSYNC();
  phase6(p, wv); GSYNC();
  phase7(p, wv); GSYNC();
  phase8(p, wv); GSYNC();
  phase9(p, wv); GSYNC();
  final_norm(p, wv);
}

extern "C" void kernel_launch(void* const* d_in, const int* in_sizes, int n_in, void* d_out, int out_size, void* d_ws, size_t ws_size,
                              hipStream_t stream) {
  P p{};
  const float** f = (const float**)&p;
  for (int i = 0; i < 29; i++) f[i] = (const float*)d_in[i];
  p.out = (float*)d_out;
  p.ws = (char*)d_ws;
  if (WS_NEED > ws_size) { fprintf(stderr, "workspace too small: need %zu have %zu\n", (size_t)WS_NEED, ws_size); return; }
  static int grid_blocks = 0;
  if (!grid_blocks) {
    int dev = 0, cus = 0, per_cu = 0;
    (void)hipGetDevice(&dev);
    (void)hipDeviceGetAttribute(&cus, hipDeviceAttributeMultiprocessorCount, dev);
    (void)hipFuncSetAttribute((const void*)k_mega, hipFuncAttributeMaxDynamicSharedMemorySize, SMEM_BYTES);
    (void)hipOccupancyMaxActiveBlocksPerMultiprocessor(&per_cu, k_mega, 512, SMEM_BYTES);
    if (per_cu < 1) per_cu = 1;
    grid_blocks = cus * per_cu;
  }
  (void)hipMemsetAsync((char*)d_ws + O_mod, 0, O_ss1 - O_mod, stream);
  void* args[] = {&p};
  hipError_t e = hipLaunchCooperativeKernel((void*)k_mega, dim3(grid_blocks), dim3(512), args, SMEM_BYTES, stream);
  if (e != hipSuccess) fprintf(stderr, "cooperative launch failed: %s (grid %d)\n", hipGetErrorString(e), grid_blocks);
}
```

```cpp
#include <hip/hip_runtime.h>
#include <hip/hip_cooperative_groups.h>
#include <stdint.h>
#include <stdio.h>
namespace cg = cooperative_groups;


#define DI __device__ __forceinline__
typedef unsigned short bf16_t;
typedef short bf16x8 __attribute__((ext_vector_type(8)));
typedef float f32x16 __attribute__((ext_vector_type(16)));
typedef float f32x4 __attribute__((ext_vector_type(4)));

constexpr int NTOK = 81920, LPR = 16384, LSM = 4096;
constexpr int SMEM_HALF = 73728;
constexpr int SMEM_BYTES = 2 * SMEM_HALF;
constexpr float EPSV = 1e-6f;

constexpr size_t al256(size_t x) { return (x + 255) & ~(size_t)255; }
constexpr size_t O_mod = 0;
constexpr size_t O_bar = O_mod + al256(17 * 6144 * 4);
constexpr size_t O_ss1 = O_bar + al256(3456 * 4);
constexpr size_t O_sb2 = O_ss1 + al256((size_t)NTOK * 4);
constexpr size_t O_AT = O_sb2 + al256(17 * 4096 * 4);
constexpr size_t O_ssf = O_AT + al256(32 * 2 * 64 * 2 * 4);
constexpr size_t O_sss = O_ssf + al256((size_t)NTOK * 8 * 4);
constexpr size_t O_twp = O_sss + al256((size_t)NTOK * 16 * 4);
constexpr size_t O_tws = O_twp + al256(LPR * 8);
constexpr size_t O_wint = O_tws + al256(LSM * 8);
constexpr size_t O_wglut = O_wint + al256(1024 * 1024 * 2);
constexpr size_t O_woutt = O_wglut + al256(1024 * 512 * 2);
constexpr size_t O_w1t = O_woutt + al256(1024 * 1024 * 2);
constexpr size_t O_w2t = O_w1t + al256((size_t)4096 * 1024 * 2);
constexpr size_t O_Mf = O_w2t + al256((size_t)4096 * 1024 * 2);
constexpr size_t O_Fb1 = O_Mf + al256(512 * 1024 * 2);
constexpr size_t O_Fb2 = O_Fb1 + al256(1024 * 256 * 2);
constexpr size_t O_Bs = O_Fb2 + al256(512 * 256 * 2);
constexpr size_t O_Tcat = O_Bs + al256((size_t)32 * 256 * 1024 * 2);
constexpr size_t O_hb = O_Tcat + al256((size_t)32 * 1024 * 1280 * 2);
constexpr size_t O_zT = O_hb + al256((size_t)NTOK * 1024 * 2);
constexpr size_t O_Ucat = O_zT + al256((size_t)NTOK * 512 * 2);
constexpr size_t O_AF = O_Ucat + al256((size_t)32 * 1280 * 1280 * 2);
constexpr size_t O_S = O_AF + al256((size_t)NTOK * 1024 * 2);
constexpr size_t O_gact = O_S + al256((size_t)1280 * 32 * 256 * 4);
constexpr size_t O_mg = O_gact + al256((size_t)NTOK * 512 * 2);
constexpr size_t O_END = O_mg + al256((size_t)NTOK * 1024 * 2);
constexpr size_t O_Tt = O_hb;
constexpr size_t O_hid = O_zT;
constexpr size_t WS_NEED = (O_hid + (size_t)NTOK * 4096 * 2 > O_END ? O_hid + (size_t)NTOK * 4096 * 2 : O_END);
struct P {
  const float *xp, *xs, *cp, *cs, *w_ada, *b_ada, *g_mix, *w_in, *w_f, *b_f, *a_re, *a_im, *log_dt, *b_re, *b_im, *c_re, *c_im,
      *ssm_d, *w_glu, *b_glu, *g_fo, *g_so, *w_out, *g_mlp, *w1, *b1, *w2, *b2, *g_final;
  float* out;
  char* ws;
  __device__ __forceinline__ float* mod() const { return (float*)(ws + O_mod); }
  __device__ __forceinline__ float* ss1() const { return (float*)(ws + O_ss1); }
  __device__ __forceinline__ float* sb2() const { return (float*)(ws + O_sb2); }
  __device__ __forceinline__ float* AT() const { return (float*)(ws + O_AT); }
  __device__ __forceinline__ float* ssf() const { return (float*)(ws + O_ssf); }
  __device__ __forceinline__ float* sss() const { return (float*)(ws + O_sss); }
  __device__ __forceinline__ float2* twp() const { return (float2*)(ws + O_twp); }
  __device__ __forceinline__ float2* tws() const { return (float2*)(ws + O_tws); }
  __device__ __forceinline__ bf16_t* wint() const { return (bf16_t*)(ws + O_wint); }
  __device__ __forceinline__ bf16_t* wglut() const { return (bf16_t*)(ws + O_wglut); }
  __device__ __forceinline__ bf16_t* woutt() const { return (bf16_t*)(ws + O_woutt); }
  __device__ __forceinline__ bf16_t* w1t() const { return (bf16_t*)(ws + O_w1t); }
  __device__ __forceinline__ bf16_t* w2t() const { return (bf16_t*)(ws + O_w2t); }
  __device__ __forceinline__ bf16_t* Mf() const { return (bf16_t*)(ws + O_Mf); }
  __device__ __forceinline__ bf16_t* Fb1() const { return (bf16_t*)(ws + O_Fb1); }
  __device__ __forceinline__ bf16_t* Fb2() const { return (bf16_t*)(ws + O_Fb2); }
  __device__ __forceinline__ bf16_t* Bs() const { return (bf16_t*)(ws + O_Bs); }
  __device__ __forceinline__ bf16_t* Tcat() const { return (bf16_t*)(ws + O_Tcat); }
  __device__ __forceinline__ bf16_t* Ucat() const { return (bf16_t*)(ws + O_Ucat); }
  __device__ __forceinline__ bf16_t* hb() const { return (bf16_t*)(ws + O_hb); }
  __device__ __forceinline__ bf16_t* zT() const { return (bf16_t*)(ws + O_zT); }
  __device__ __forceinline__ bf16_t* AF() const { return (bf16_t*)(ws + O_AF); }
  __device__ __forceinline__ float* S() const { return (float*)(ws + O_S); }
  __device__ __forceinline__ bf16_t* mg() const { return (bf16_t*)(ws + O_mg); }
  __device__ __forceinline__ bf16_t* gact() const { return (bf16_t*)(ws + O_gact); }
  __device__ __forceinline__ bf16_t* Tt() const { return (bf16_t*)(ws + O_Tt); }
  __device__ __forceinline__ bf16_t* hid() const { return (bf16_t*)(ws + O_hid); }
};

typedef float f32x2v __attribute__((ext_vector_type(2)));
typedef __bf16 bf16x2v __attribute__((ext_vector_type(2)));
DI uint32_t pk2(float lo, float hi) { const f32x2v v = {lo, hi}; const bf16x2v r = __builtin_convertvector(v, bf16x2v); return __builtin_bit_cast(uint32_t, r); }
DI bf16_t f2bf(float f) { return (bf16_t)(pk2(f, 0.f) & 0xffffu); }
extern __shared__ __attribute__((aligned(16))) unsigned char dyn_smem[];
DI int otid(int wv) {
  unsigned m = ~0u; asm volatile("" : "+s"(m));
  const int lane = (int)__builtin_amdgcn_mbcnt_hi(m, __builtin_amdgcn_mbcnt_lo(m, 0u));
  int t = (wv << 6) | lane; asm volatile("" : "+v"(t)); return t;
}
#define XB_TMO      128
#define XB_XCNT(j)  (256  + 64 * (j))
#define XB_XSUB(j)  (1280 + 64 * (j))
#define XB_XGEN(j)  (2304 + 64 * (j))
#define XB_TOP      3328
#define XB_TOPGEN   3392
#define XCD_BAR_WORDS 3456
#define XB_SPIN_CAP (1u << 18)
#define XB_LAS __attribute__((address_space(3)))
constexpr int XB_LDS_OFF = 147440;
DI unsigned xb_ld(unsigned* p) { return __hip_atomic_load(p, __ATOMIC_RELAXED, __HIP_MEMORY_SCOPE_AGENT); }
DI unsigned xb_add(unsigned* p, unsigned v) { return __hip_atomic_fetch_add(p, v, __ATOMIC_RELAXED, __HIP_MEMORY_SCOPE_AGENT); }
DI unsigned xb_xcc_id() { return (unsigned)__builtin_amdgcn_s_getreg((3 << 11) | 20) & 0xFu; }
#define XB_SPIN(cond, bar) do { unsigned _sp = 0; while (cond) { __builtin_amdgcn_s_sleep(1); \
    if ((++_sp & 255u) == 0u) { if (xb_ld(&(bar)[XB_TMO])) break; if (_sp > XB_SPIN_CAP) { atomicAdd(&(bar)[XB_TMO], 1u); break; } } } } while (0)
DI void xcd_barrier_complete(unsigned* bar, unsigned x, unsigned& nloc, unsigned& nx) {
  const unsigned G = gridDim.x * gridDim.y * gridDim.z;
  unsigned sum, cnt, mine, sp = 0u;
  for (;;) {
    sum = 0u; cnt = 0u; mine = 0u;
#pragma unroll
    for (unsigned j = 0; j < 16; ++j) { const unsigned c = xb_ld(&bar[XB_XCNT(j)]); sum += c; cnt += (c > 0u) ? 1u : 0u; mine = (j == x) ? c : mine; }
    if (sum == G) break;
    __builtin_amdgcn_s_sleep(1);
    if ((++sp & 255u) == 0u) { if (xb_ld(&bar[XB_TMO])) break; if (sp > XB_SPIN_CAP) { atomicAdd(&bar[XB_TMO], 1u); break; } }
  }
  nloc = mine > 0u ? mine : 1u; nx = cnt > 0u ? cnt : 1u;
}
DI void xcd_barrier(unsigned* bar, const int tix) {
  asm volatile("s_waitcnt vmcnt(0)" ::: "memory");
  __syncthreads();
  if (tix == 0) {
    volatile XB_LAS unsigned* st = (volatile XB_LAS unsigned*)((XB_LAS unsigned char*)dyn_smem + XB_LDS_OFF);
    const unsigned x = xb_xcc_id();
    __builtin_amdgcn_s_waitcnt(0);
    unsigned nloc = st[0], nx = st[1];
    if (nloc == 0u) { xcd_barrier_complete(bar, x, nloc, nx); st[0] = nloc; st[1] = nx; }
    const unsigned old = xb_add(&bar[XB_XSUB(x)], 1u);
    const unsigned gen = old / nloc;
    if (old + 1u == (gen + 1u) * nloc) {
      __builtin_amdgcn_fence(__ATOMIC_RELEASE, "agent");
      asm volatile("s_waitcnt vmcnt(0)" ::: "memory");
      const unsigned og = xb_add(&bar[XB_TOP], 1u);
      const unsigned tg = og / nx;
      if (og + 1u == (tg + 1u) * nx) xb_add(&bar[XB_TOPGEN], 1u);
      else XB_SPIN(xb_ld(&bar[XB_TOPGEN]) == tg, bar);
      __builtin_amdgcn_fence(__ATOMIC_ACQUIRE, "agent");
      xb_add(&bar[XB_XGEN(x)], 1u);
      asm volatile("s_waitcnt vmcnt(0)" ::: "memory");
    } else {
      XB_SPIN(xb_ld(&bar[XB_XGEN(x)]) == gen, bar);
      __builtin_amdgcn_fence(__ATOMIC_ACQUIRE, "agent");
      asm volatile("s_waitcnt vmcnt(0)" ::: "memory");
    }
  }
  __syncthreads();
}

DI int tok2v(int tok) {
  if (tok < LPR) { const int l1 = tok >> 7, l2 = tok & 127; return ((l2 & 63) << 8) | ((l2 >> 6) << 7) | l1; }
  const int ts = tok - LPR, w = ts & 4095, l1 = w >> 6, l2 = w & 63;
  return LPR + (ts & ~4095) + (((l2 & 15) << 8) | ((l2 >> 4) << 6) | l1);
}
DI int v2tok(int v) {
  if (v < LPR) return ((v & 127) << 7) | (((v >> 7) & 1) << 6) | (v >> 8);
  const int vs = v - LPR, w = vs & 4095;
  return LPR + (vs & ~4095) + (((w & 63) << 6) | (((w >> 6) & 3) << 4) | (w >> 8));
}
DI int batch_of(int tok) { return tok < LPR ? 0 : 1 + ((tok - LPR) >> 12); }
DI float gelu_tanh(float x) {
  const float u = 0.7978845608028654f * (x + 0.044715f * x * x * x);
  return x / (1.f + __expf(-2.f * u));
}
DI float wave_sum(float v) {
  v += __shfl_xor(v, 32); v += __shfl_xor(v, 16); v += __shfl_xor(v, 8); v += __shfl_xor(v, 4); v += __shfl_xor(v, 2); v += __shfl_xor(v, 1);
  return v;
}

DI void ssm_pow(const P& p, int g, int dir, int pp, int j, float& re, float& im) {
  const int ia = (dir * 32 + g) * 64 + pp;
  const float lr = fminf(p.a_re[ia], -1e-4f), li = p.a_im[ia], dt = expf(p.log_dt[dir * 32 + g]);
  const float mag = expf(lr * dt * (float)j);
  double t = (double)li * (double)dt * (double)j * 0.15915494309189535;
  t -= rint(t);
  const float ang = (float)(t * 6.283185307179586);
  float s, c; sincosf(ang, &s, &c);
  re = mag * c; im = mag * s;
}
DI void ssm_coef(const P& p, int g, int dir, int pp, float& cr, float& ci) {
  const int ia = (dir * 32 + g) * 64 + pp;
  const float lr = fminf(p.a_re[ia], -1e-4f), li = p.a_im[ia];
  float ar, ai; ssm_pow(p, g, dir, pp, 1, ar, ai);
  const float nr = ar - 1.f, ni = ai, den = 1.f / (lr * lr + li * li);
  cr = (nr * lr + ni * li) * den; ci = (ni * lr - nr * li) * den;
}

template <class CM>
DI void transpose_job(float* tile, const int tid, bool act, int item2, const float* in, int ld, int Kdim, bf16_t* out, const CM& colmap, const float* sc0, const float* sc1) {
  const int nkt = Kdim / 64;
  __syncthreads();
  if (act) {
    float v[16];
#pragma unroll
    for (int u = 0; u < 2; u++) {
      const int item = 2 * item2 + u, nt = item / nkt, kt = item % nkt;
      const int c = tid & 31, kr = tid >> 5, col = colmap(nt * 32 + c);
#pragma unroll
      for (int i = 0; i < 8; i++) v[u * 8 + i] = in[(size_t)(kt * 64 + kr + 8 * i) * ld + col];
    }
#pragma unroll
    for (int u = 0; u < 2; u++) {
      const int item = 2 * item2 + u, kt = item % nkt;
      const int c = tid & 31, kr = tid >> 5;
#pragma unroll
      for (int i = 0; i < 8; i++) {
        const int kl = kr + 8 * i, k = kt * 64 + kl;
        float x = v[u * 8 + i];
        if (sc0) x *= (k < 512 ? sc0[k] : sc1[k - 512]);
        tile[u * 64 * 33 + kl * 33 + c] = x;
      }
    }
  }
  __syncthreads();
  if (act) {
#pragma unroll
    for (int u = 0; u < 2; u++) {
      const int item = 2 * item2 + u, nt = item / nkt, kt = item % nkt;
      const int nl = tid >> 3, kc = tid & 7;
      float x[8];
#pragma unroll
      for (int j = 0; j < 8; j++) x[j] = tile[u * 64 * 33 + (kc * 8 + j) * 33 + nl];
      uint4 w; w.x = pk2(x[0], x[1]); w.y = pk2(x[2], x[3]); w.z = pk2(x[4], x[5]); w.w = pk2(x[6], x[7]);
      *(uint4*)(out + (size_t)(nt * 32 + nl) * Kdim + kt * 64 + kc * 8) = w;
    }
  }
}

DI void phase0(const P& p, const int wv) {
  const int tix = otid(wv);
  unsigned char* smraw = dyn_smem + (tix >> 8) * SMEM_HALF;
  float* smf = (float*)smraw;
  const int tid = tix & 255, nb = gridDim.x * 2, bid = blockIdx.x * 2 + (tix >> 8);
  for (int base = 0; base < 384; base += nb) {
    const int item = base + bid; const bool act = item < 384;
    const int cg = act ? item % 96 : 0, ks = act ? item / 96 : 0;
    __syncthreads();
    if (act)
      for (int i = tid; i < 17 * 256; i += 256) {
        const int b = i >> 8, k = ks * 256 + (i & 255);
        const float c = b == 0 ? p.cp[k] : p.cs[(b - 1) * 1024 + k];
        smf[i] = c / (1.f + __expf(-c));
      }
    __syncthreads();
    const int col = tid & 63, sub = tid >> 6, j = cg * 64 + col;
    float a[17];
#pragma unroll
    for (int b = 0; b < 17; b++) a[b] = 0.f;
    if (act) {
#pragma unroll 1
      for (int bt = 0; bt < 4; bt++) {
        const int k0 = sub * 64 + bt * 16;
        float w[16];
#pragma unroll
        for (int i = 0; i < 16; i++) w[i] = p.w_ada[(size_t)(ks * 256 + k0 + i) * 6144 + j];
#pragma unroll
        for (int i = 0; i < 16; i++)
#pragma unroll
          for (int b = 0; b < 17; b++) a[b] += smf[b * 256 + k0 + i] * w[i];
      }
    }
    float* red = smf + 17 * 256;
#pragma unroll
    for (int b = 0; b < 17; b++) red[(sub * 17 + b) * 64 + col] = a[b];
    __syncthreads();
    if (act)
      for (int i = tid; i < 17 * 64; i += 256) {
        const int b = i >> 6, c2 = i & 63;
        float sum = red[(0 * 17 + b) * 64 + c2] + red[(1 * 17 + b) * 64 + c2] + red[(2 * 17 + b) * 64 + c2] + red[(3 * 17 + b) * 64 + c2];
        if (ks == 0) sum += p.b_ada[cg * 64 + c2];
        atomicAdd(p.mod() + b * 6144 + cg * 64 + c2, sum);
      }
  }
  {
    auto ident = [](int n) { return n; };
    auto glumap = [](int n) { return ((n >> 7) & 1) * 512 + (n >> 8) * 128 + (n & 127); };
    const int n0 = 256, n1 = n0 + 128, n2 = n1 + 256, n3 = n2 + 1024, n4 = n3 + 1024;
    for (int base = 0; base < n4; base += nb) {
      const int item = base + bid; const bool act = item < n4;
      if (item < n0) transpose_job(smf, tid, act, item, p.w_in, 1024, 1024, p.wint(), ident, nullptr, nullptr);
      else if (item < n1) transpose_job(smf, tid, act, item - n0, p.w_glu, 1024, 512, p.wglut(), glumap, nullptr, nullptr);
      else if (item < n2) transpose_job(smf, tid, act, item - n1, p.w_out, 1024, 1024, p.woutt(), ident, p.g_fo, p.g_so);
      else if (item < n3) transpose_job(smf, tid, act, item - n2, p.w1, 4096, 1024, p.w1t(), ident, nullptr, nullptr);
      else transpose_job(smf, tid, act, item - n3, p.w2, 1024, 4096, p.w2t(), ident, nullptr, nullptr);
    }
  }
  {
    __syncthreads();
    float2* cs = (float2*)smraw;
    for (int i = tid; i < 512; i += 256) { float s, c; sincosf((float)i * (6.283185307179586f / 512.f), &s, &c); cs[i] = make_float2(c, s); }
    __syncthreads();
    for (int item = bid; item < 128; item += nb) {
      const int idx = item * 256 + tid, k = idx & 1023, he = idx >> 10, h = he >> 3, e0 = (he & 7) * 16, c = k & 511;
      const bool is_sin = k >= 512;
      const float* wf = p.w_f + (size_t)h * 128 * 128 + e0;
      float a[16];
#pragma unroll
      for (int e = 0; e < 16; e++) a[e] = 0.f;
#pragma unroll 4
      for (int d = 0; d < 128; d++) {
        const float2 t = cs[((h * 128 + d) * c) & 511];
        const float tv = is_sin ? t.y : t.x;
        const f32x4 w0 = *(const f32x4*)(wf + d * 128), w1 = *(const f32x4*)(wf + d * 128 + 4), w2 = *(const f32x4*)(wf + d * 128 + 8), w3 = *(const f32x4*)(wf + d * 128 + 12);
#pragma unroll
        for (int e = 0; e < 4; e++) { a[e] += tv * w0[e]; a[4 + e] += tv * w1[e]; a[8 + e] += tv * w2[e]; a[12 + e] += tv * w3[e]; }
      }
#pragma unroll
      for (int e = 0; e < 16; e++) p.Mf()[(size_t)(h * 128 + e0 + e) * 1024 + k] = f2bf(a[e]);
    }
  }
  {
    const int gsz = nb * 256, gt = bid * 256 + tid;
    for (int i = gt; i < 1024 * 256; i += gsz) {
      const int nrg = i >> 8, k = i & 255, tb = nrg >> 9, nr = nrg & 511, part = (nr >> 7) & 1, idx8 = ((nr >> 8) << 7) | (nr & 127);
      const int R = tb ? 64 : 128, sh = tb ? 6 : 7, l2p = idx8 >> sh, k1 = idx8 & (R - 1), l2k = k >> sh, l1 = k & (R - 1);
      float sv, cv; sincosf((float)((k1 * l1) & (R - 1)) * (6.283185307179586f / (float)R), &sv, &cv);
      p.Fb1()[i] = f2bf(l2k == l2p ? (part ? -sv : cv) : 0.f);
    }
    for (int i = gt; i < 512 * 256; i += gsz) {
      const int nrg = i >> 8, k = i & 255, tb = nrg >> 8, nr = nrg & 255;
      float v;
      if (tb == 0) {
        const int part = nr >> 7, k2 = nr & 127, ki = k >> 7, l2 = k & 127;
        float sv, cv; sincosf((float)((k2 * l2) & 127) * (6.283185307179586f / 128.f), &sv, &cv);
        v = part == 0 ? (ki == 0 ? cv : sv) : (ki == 0 ? -sv : cv);
      } else {
        const int blk = nr >> 7, n2 = nr & 127, part = n2 >> 6, k2 = n2 & 63, kb = k >> 7, kk = k & 127, ki = kk >> 6, l2 = kk & 63;
        float sv, cv; sincosf((float)((k2 * l2) & 63) * (6.283185307179586f / 64.f), &sv, &cv);
        v = blk == kb ? (part == 0 ? (ki == 0 ? cv : sv) : (ki == 0 ? -sv : cv)) : 0.f;
      }
      p.Fb2()[i] = f2bf(v);
    }
    for (int i = gt; i < LPR; i += gsz) { float s, c; sincosf((float)i * (6.283185307179586f / 16384.f), &s, &c); p.twp()[i] = make_float2(c, s); }
    for (int i = gt; i < LSM; i += gsz) { float s, c; sincosf((float)i * (6.283185307179586f / 4096.f), &s, &c); p.tws()[i] = make_float2(c, s); }
    for (int i = gt; i < 32 * 2 * 64 * 64; i += gsz) {
      const int s = i & 63, pp = (i >> 6) & 63, dir = (i >> 12) & 1, g = i >> 13;
      float pr, pi, cr, ci; ssm_pow(p, g, dir, pp, dir == 0 ? 63 - s : s, pr, pi); ssm_coef(p, g, dir, pp, cr, ci);
      const float qr = pr * cr - pi * ci, qi = pr * ci + pi * cr;
      const int ib = ((dir * 32 + g) * 64 + pp) * 16;
      float vr[16], vi[16];
#pragma unroll
      for (int h = 0; h < 16; h++) { const float br = p.b_re[ib + h], bi = p.b_im[ib + h]; vr[h] = qr * br - qi * bi; vi[h] = qr * bi + qi * br; }
      bf16_t* d0 = p.Bs() + ((size_t)(g * 256 + dir * 128 + pp)) * 1024 + s * 16;
      bf16_t* d1 = d0 + 64 * 1024;
      uint4 w;
      w.x = pk2(vr[0], vr[1]); w.y = pk2(vr[2], vr[3]); w.z = pk2(vr[4], vr[5]); w.w = pk2(vr[6], vr[7]); *(uint4*)d0 = w;
      w.x = pk2(vr[8], vr[9]); w.y = pk2(vr[10], vr[11]); w.z = pk2(vr[12], vr[13]); w.w = pk2(vr[14], vr[15]); *(uint4*)(d0 + 8) = w;
      w.x = pk2(vi[0], vi[1]); w.y = pk2(vi[2], vi[3]); w.z = pk2(vi[4], vi[5]); w.w = pk2(vi[6], vi[7]); *(uint4*)d1 = w;
      w.x = pk2(vi[8], vi[9]); w.y = pk2(vi[10], vi[11]); w.z = pk2(vi[12], vi[13]); w.w = pk2(vi[14], vi[15]); *(uint4*)(d1 + 8) = w;
    }
    for (int i = gt; i < 32 * 64 * 2 * 64; i += gsz) {
      const int pp = i & 63, dir = (i >> 6) & 1, t = (i >> 7) & 63, g = i >> 13;
      float pr, pi; ssm_pow(p, g, dir, pp, dir == 0 ? t + 1 : 64 - t, pr, pi);
#pragma unroll
      for (int h = 0; h < 16; h++) {
        const int ic = ((dir * 32 + g) * 16 + h) * 64 + pp;
        const float cr = p.c_re[ic], ci = p.c_im[ic];
        bf16_t* d = p.Tcat() + ((size_t)(g * 1024 + t * 16 + h)) * 1280 + 1024 + dir * 128 + pp;
        d[0] = f2bf(cr * pr - ci * pi);
        d[64] = f2bf(-(cr * pi + ci * pr));
      }
    }
    for (int i = gt; i < 32 * 2 * 64; i += gsz) {
      const int pp = i & 63, dir = (i >> 6) & 1, g = i >> 7;
      float pr, pi; ssm_pow(p, g, dir, pp, 64, pr, pi);
      p.AT()[i * 2] = pr; p.AT()[i * 2 + 1] = pi;
    }
  }
  {
    float2* q = (float2*)smraw;
    float2* q1 = q + 512;
    float2* Cs = q + 576;
    float2* Bm = Cs + 2048;
    float2* E = Bm + 2048;
    for (int base = 0; base < 512; base += nb) {
      const int item = base + bid; const bool act = item < 512;
      const int g = act ? item >> 4 : 0, ch = act ? item & 15 : 0;
      __syncthreads();
      for (int e = tid; e < 512; e += 256) {
        const int j = e >> 6, pp = e & 63, jj = ch * 8 + j, lag = jj - 63;
        float2 v = make_float2(0.f, 0.f);
        if (jj < 127) {
          const int dir = lag >= 0 ? 0 : 1;
          float pr, pi, cr, ci; ssm_pow(p, g, dir, pp, lag < 0 ? -lag : lag, pr, pi); ssm_coef(p, g, dir, pp, cr, ci);
          v = make_float2(pr * cr - pi * ci, pr * ci + pi * cr);
        }
        q[e] = v;
      }
      if (tid < 64) { float cr, ci; ssm_coef(p, g, 1, tid, cr, ci); q1[tid] = make_float2(cr, ci); }
      for (int i = tid; i < 2048; i += 256) {
        const int dir = i >> 10, j = i & 1023, src = (dir * 32 + g) * 1024 + j;
        Cs[i] = make_float2(p.c_re[src], p.c_im[src]); Bm[i] = make_float2(p.b_re[src], p.b_im[src]);
      }
      const int hp = tid >> 4, h = tid & 15;
      float a0 = 0.f;
#pragma unroll 1
      for (int ps = 0; ps < 9; ps++) {
        const int j = ps < 8 ? ps : 7, jj = ch * 8 + j, lag = jj - 63;
        const bool valid = ps < 8 ? (jj < 127) : (jj == 63);
        const int dir = ps < 8 ? (lag >= 0 ? 0 : 1) : 1;
        const float2* qs = ps < 8 ? q + j * 64 : q1;
        __syncthreads();
        for (int i = tid; i < 1024; i += 256) {
          const float2 cc = Cs[dir * 1024 + i], qq = qs[i & 63];
          E[i] = make_float2(cc.x * qq.x - cc.y * qq.y, cc.x * qq.y + cc.y * qq.x);
        }
        __syncthreads();
        float a = 0.f;
        if (valid) {
#pragma unroll 8
          for (int pp = 0; pp < 64; pp++) { const float2 ee = E[hp * 64 + pp], bb = Bm[dir * 1024 + pp * 16 + h]; a += ee.x * bb.x - ee.y * bb.y; }
        }
        bool st = valid && act;
        if (ps < 8 && lag == 0) { a0 = a; st = false; }
        if (ps == 8) { a += a0; if (hp == h) a += p.ssm_d[g * 16 + h]; }
        if (st) {
          const bf16_t kv = f2bf(a);
          const int t0 = lag > 0 ? lag : 0, t1 = lag > 0 ? 64 : 64 + lag;
          bf16_t* d = p.Tcat() + ((size_t)(g * 1024 + hp)) * 1280 + h;
          for (int t = t0; t < t1; t++) d[(size_t)t * 16 * 1280 + (t - lag) * 16] = kv;
        }
      }
    }
  }
}

constexpr int RIF = 2;
DI float bflo(uint32_t u) { return __uint_as_float(u << 16); }
DI float bfhi(uint32_t u) { return __uint_as_float(u & 0xffff0000u); }
template <bool FROMX>
DI void rownorm_mod(const P& p, const int wv, const float* g, int sh_off, int sc_off) {
  const int tix = otid(wv), lane = tix & 63, wrow = blockIdx.x * 8 + (tix >> 6), nw = gridDim.x * 8;
  if (FROMX) {
    float* shl = (float*)dyn_smem;
    const int nitems = 8 * 32;
    for (int base = 0; base < nitems; base += (int)gridDim.x) {
      const int item = base + (int)blockIdx.x; const bool act = item < nitems;
      const int chunk = act ? (item & 7) : 0, ks = act ? (item >> 3) : 0;
      __syncthreads();
      for (int i = tix; i < 17 * 32; i += 512) shl[i] = p.mod()[(i >> 5) * 6144 + 3072 + ks * 32 + (i & 31)];
      __syncthreads();
      if (act) {
        const int col = chunk * 512 + tix;
        float a[17];
#pragma unroll
        for (int b = 0; b < 17; b++) a[b] = 0.f;
#pragma unroll 8
        for (int k = 0; k < 32; k++) {
          const float w = p.w1[(size_t)(ks * 32 + k) * 4096 + col];
#pragma unroll
          for (int b = 0; b < 17; b++) a[b] += shl[b * 32 + k] * w;
        }
        const float b1v = ks == 0 ? p.b1[col] : 0.f;
#pragma unroll
        for (int b = 0; b < 17; b++) atomicAdd(p.sb2() + b * 4096 + col, a[b] + b1v);
      }
    }
    __syncthreads();
  }
  auto load = [&](int tok0, float (&v)[RIF][16]) {
#pragma unroll
    for (int rr = 0; rr < RIF; rr++) {
      const int tok = tok0 + rr * nw;
      if (tok < NTOK) {
        if (FROMX) {
          const float* src = tok < LPR ? p.xp + (size_t)tok * 1024 : p.xs + (size_t)(tok - LPR) * 1024;
#pragma unroll
          for (int i = 0; i < 4; i++) { const f32x4 t = *(const f32x4*)(src + (i * 64 + lane) * 4); v[rr][4 * i] = t[0]; v[rr][4 * i + 1] = t[1]; v[rr][4 * i + 2] = t[2]; v[rr][4 * i + 3] = t[3]; }
        } else {
          const bf16_t* src = (const bf16_t*)p.out + (size_t)tok * 1024;
#pragma unroll
          for (int i = 0; i < 2; i++) { const uint4 t = *(const uint4*)(src + (i * 64 + lane) * 8);
            v[rr][8 * i] = bflo(t.x); v[rr][8 * i + 1] = bfhi(t.x); v[rr][8 * i + 2] = bflo(t.y); v[rr][8 * i + 3] = bfhi(t.y);
            v[rr][8 * i + 4] = bflo(t.z); v[rr][8 * i + 5] = bfhi(t.z); v[rr][8 * i + 6] = bflo(t.w); v[rr][8 * i + 7] = bfhi(t.w); }
        }
      } else {
#pragma unroll
        for (int e = 0; e < 16; e++) v[rr][e] = 0.f;
      }
    }
  };
  auto process = [&](int tok0, const float (&v)[RIF][16]) {
    float ss[RIF];
#pragma unroll
    for (int rr = 0; rr < RIF; rr++) {
      ss[rr] = 0.f;
#pragma unroll
      for (int e = 0; e < 16; e++) ss[rr] += v[rr][e] * v[rr][e];
      ss[rr] = wave_sum(ss[rr]);
    }
#pragma unroll
    for (int rr = 0; rr < RIF; rr++) {
      const int tok = tok0 + rr * nw;
      if (tok >= NTOK) continue;
      const float r = rsqrtf(ss[rr] * (1.f / 1024.f) + EPSV);
      const float* md = p.mod() + batch_of(tok) * 6144;
      bf16_t* drow = p.hb() + (size_t)(FROMX ? tok2v(tok) : tok) * 1024;
      float o[16];
#pragma unroll
      for (int q = 0; q < 4; q++) {
        const int c = FROMX ? (q * 64 + lane) * 4 : ((q >> 1) * 64 + lane) * 8 + (q & 1) * 4;
        const f32x4 gg = *(const f32x4*)(g + c);
        f32x4 sc = *(const f32x4*)(md + sc_off + c), sh = *(const f32x4*)(md + sh_off + c);
#pragma unroll
        for (int e = 0; e < 4; e++) o[4 * q + e] = v[rr][4 * q + e] * r * gg[e] * (1.f + sc[e]) + sh[e];
      }
      if (FROMX) {
#pragma unroll
        for (int q = 0; q < 4; q++) { uint2 w; w.x = pk2(o[4 * q], o[4 * q + 1]); w.y = pk2(o[4 * q + 2], o[4 * q + 3]); *(uint2*)(drow + (q * 64 + lane) * 4) = w; }
      } else {
#pragma unroll
        for (int i = 0; i < 2; i++) { uint4 w; w.x = pk2(o[8 * i], o[8 * i + 1]); w.y = pk2(o[8 * i + 2], o[8 * i + 3]); w.z = pk2(o[8 * i + 4], o[8 * i + 5]); w.w = pk2(o[8 * i + 6], o[8 * i + 7]);
          *(uint4*)(drow + (i * 64 + lane) * 8) = w; }
      }
    }
  };
  float va[RIF][16], vb[RIF][16];
  load(wrow, va);
  for (int tok0 = wrow; tok0 < NTOK; tok0 += 2 * RIF * nw) {
    load(tok0 + RIF * nw, vb);
    process(tok0, va);
    load(tok0 + 2 * RIF * nw, va);
    process(tok0 + RIF * nw, vb);
  }
}
DI void final_norm(const P& p, const int wv) {
  const int tix = otid(wv), lane = tix & 63, wrow = blockIdx.x * 8 + (tix >> 6), nw = gridDim.x * 8;
  auto load = [&](int tok0, uint4 (&v)[RIF][2]) {
#pragma unroll
    for (int rr = 0; rr < RIF; rr++) {
      const int tok = tok0 + rr * nw;
      if (tok < NTOK) {
        const bf16_t* src = p.hb() + (size_t)tok * 1024;
#pragma unroll
        for (int i = 0; i < 2; i++) v[rr][i] = *(const uint4*)(src + (i * 64 + lane) * 8);
      } else {
#pragma unroll
        for (int i = 0; i < 2; i++) v[rr][i] = make_uint4(0u, 0u, 0u, 0u);
      }
    }
  };
  auto process = [&](int tok0, const uint4 (&vr)[RIF][2]) {
    float v[RIF][16], ss[RIF];
#pragma unroll
    for (int rr = 0; rr < RIF; rr++) {
#pragma unroll
      for (int i = 0; i < 2; i++) { const uint4 t = vr[rr][i];
        v[rr][8 * i] = bflo(t.x); v[rr][8 * i + 1] = bfhi(t.x); v[rr][8 * i + 2] = bflo(t.y); v[rr][8 * i + 3] = bfhi(t.y);
        v[rr][8 * i + 4] = bflo(t.z); v[rr][8 * i + 5] = bfhi(t.z); v[rr][8 * i + 6] = bflo(t.w); v[rr][8 * i + 7] = bfhi(t.w); }
      ss[rr] = 0.f;
#pragma unroll
      for (int e = 0; e < 16; e++) ss[rr] += v[rr][e] * v[rr][e];
      ss[rr] = wave_sum(ss[rr]);
    }
#pragma unroll
    for (int rr = 0; rr < RIF; rr++) {
      const int tok = tok0 + rr * nw;
      if (tok >= NTOK) continue;
      const float r = rsqrtf(ss[rr] * (1.f / 1024.f) + EPSV);
      float* drow = p.out + (size_t)tok * 1024;
#pragma unroll
      for (int q = 0; q < 4; q++) {
        const int c = ((q >> 1) * 64 + lane) * 8 + (q & 1) * 4;
        const f32x4 gg = *(const f32x4*)(p.g_final + c);
        f32x4 o;
#pragma unroll
        for (int e = 0; e < 4; e++) o[e] = v[rr][4 * q + e] * r * gg[e];
        *(f32x4*)(drow + c) = o;
      }
    }
  };
  uint4 va[RIF][2], vb[RIF][2];
  load(wrow, va);
  for (int tok0 = wrow; tok0 < NTOK; tok0 += 2 * RIF * nw) {
    load(tok0 + RIF * nw, vb);
    process(tok0, va);
    load(tok0 + 2 * RIF * nw, va);
    process(tok0 + RIF * nw, vb);
  }
}

namespace pg8 {
#define PG8_LAS __attribute__((address_space(3)))
typedef unsigned short bf16_t;
typedef short bf16x8 __attribute__((ext_vector_type(8)));
typedef float f32x4 __attribute__((ext_vector_type(4)));
typedef unsigned u32x4 __attribute__((ext_vector_type(4)));
constexpr int BM = 256, BK = 64, HALF = 128, HTB = HALF * BK * 2  , STAGE_BYTES = 8 * HTB, NXCD = 8, WGM = 8;

__host__ __device__ __forceinline__ int lds_byte(int r, int c) { const int st = (r >> 4) * 2 + (c >> 5), rr = r & 15, cc = c & 31, ob = rr * 64 + cc * 2; return st * 1024 + (ob ^ (((ob >> 9) & 1) << 5)); }
__host__ __device__ __forceinline__ void stage_rc(int b, int& R, int& C) { const int st = b / 1024, sb = b % 1024, swz = sb ^ (((sb >> 9) & 1) << 5); R = (st >> 1) * 16 + swz / 64; C = (st & 1) * 32 + (swz % 64) / 2; }
__host__ __device__ __forceinline__ int perm32(int rho) { const int n = rho >> 4, i = rho & 15; return 8 * (i >> 2) + 4 * n + (i & 3); }

struct Unit { int pm, pn; };
struct Gemm { const bf16_t* A; const bf16_t* Bt; int M, N, K, lda, ldb; };

struct StaticOrder {
    int nM, nN, nwg, G, c;
    __host__ __device__ void init(int M, int N, int G_, int c_) { nM = M / BM; nN = N / BM; nwg = nM * nN; G = G_; c = c_; }
    __host__ __device__ bool next(int i, Unit& u) const {
        const long L = (long)i * G + c; if (L >= nwg) return false;
        int wgid = (int)L; { const int q = nwg / NXCD, r = nwg % NXCD, xcd = wgid % NXCD, off = wgid / NXCD; wgid = (xcd < r ? xcd * (q + 1) : r * (q + 1) + (xcd - r) * q) + off; }
        const int nig = WGM * nN, gid = wgid / nig, fm = gid * WGM, gsz = (nM - fm) < WGM ? (nM - fm) : WGM;
        u.pm = fm + ((wgid % nig) % gsz); u.pn = (wgid % nig) / gsz; return true;
    }
    __device__ __forceinline__ void a_ready(const Unit&) const {}
    __device__ __forceinline__ void done(const Unit&) const {}
};

struct GroupOrder {
    int nwg, G, c, um, un;
    __host__ __device__ void init(int ngroups, int um_, int un_, int G_, int c_) { um = um_; un = un_; nwg = ngroups * um * un; G = G_; c = (c_ & 7) * (G_ >> 3) + (c_ >> 3); }
    __host__ __device__ bool next(int i, Unit& u) const {
        const int L = i * G + c; if (L >= nwg) return false;
        const int gi = L / (um * un), r = L % (um * un); u.pm = gi * um + r / un; u.pn = gi * un + r % un; return true;
    }
    __device__ __forceinline__ void a_ready(const Unit&) const {}
    __device__ __forceinline__ void done(const Unit&) const {}
};
struct Fft1Order {
    int q0, qs, qe;
    __host__ __device__ void init(int G, int bidx) {
        const int slot = (bidx & 7) * (G >> 3) + (bidx >> 3), nbusy = 160 < G ? 160 : G, nfree = G - nbusy;
        if (nfree <= 0) { q0 = slot; qs = G; qe = 1280; }
        else if (slot < nbusy) { q0 = slot; qs = nbusy; qe = 640; }
        else { q0 = 640 + (slot - nbusy); qs = nfree; qe = 1280; }
    }
    __host__ __device__ bool next(int i, Unit& u) const { const int L = q0 + i * qs; if (L >= qe) return false; u.pn = L >> 1; u.pm = (L & 1) + (u.pn >= 128 ? 2 : 0); return true; }
    __device__ __forceinline__ void a_ready(const Unit&) const {}
    __device__ __forceinline__ void done(const Unit&) const {}
};
struct Fft2Order {
    int G, c;
    __host__ __device__ void init(int G_, int c_) { G = G_; c = c_; }
    __host__ __device__ bool next(int i, Unit& u) const { const int L = i * G + c; if (L >= 1280) return false; u.pn = L; u.pm = L < 256 ? 0 : 1; return true; }
    __device__ __forceinline__ void a_ready(const Unit&) const {}
    __device__ __forceinline__ void done(const Unit&) const {}
};
struct YfOrder {
    int G, c;
    __host__ __device__ void init(int G_, int bidx) { G = G_; const int slot = (bidx & 7) * (G_ >> 3) + (bidx >> 3); c = (slot + (G_ >> 1)) % G_; }
    __host__ __device__ bool next(int i, Unit& u) const { const int L = i * G + c; if (L >= 640) return false; u.pm = L >> 1; u.pn = L & 1; return true; }
    __device__ __forceinline__ void a_ready(const Unit&) const {}
    __device__ __forceinline__ void done(const Unit&) const {}
};
template <class Epi, class Sched, bool ALIGN_EPI = false, bool SP2 = false>
__device__ __forceinline__ void gemm_phase(PG8_LAS unsigned char* lds, const int tix, const Gemm g, const Sched& S, const Epi& E) {
    const int tid = tix, wid = __builtin_amdgcn_readfirstlane(tid >> 6), lane = tid & 63, wr = wid >> 2, wc = wid & 3, fr = lane & 15, fq = lane >> 4;
    const int K = g.K, nt = K / BK;
    unsigned voffA[2], voffB[2];
#pragma unroll
    for (int i = 0; i < 2; ++i) { int R, C; stage_rc(tid * 16 + i * 8192, R, C); const int Rb = Epi::PERM ? ((R & ~31) + perm32(R & 31)) : R;
        voffA[i] = (unsigned)(R * g.lda + C) * 2u; voffB[i] = (unsigned)(Rb * g.ldb + C) * 2u; }
    const size_t kstep = (size_t)(BK * 2);
    const size_t hstepA = (size_t)HALF * g.lda * 2, hstepB = (size_t)HALF * g.ldb * 2;
    const size_t tstepA = 2 * hstepA, tstepB = 2 * hstepB;
    const unsigned ldsw = (unsigned)wid * 1024u;
    const int aoff = lds_byte(wr * 64 + fr, fq * 8), boff = lds_byte(wc * 32 + fr, fq * 8);
#define PG8_SA(b, h) (((b) * 2 + (h)) * HTB)
#define PG8_SB(b, h) ((4 + (b) * 2 + (h)) * HTB)
#define PG8_STAGE(bufoff, gbase, voff) do { _Pragma("unroll") for (int _i = 0; _i < 2; ++_i) \
        __builtin_amdgcn_global_load_lds((const unsigned*)((const char*)(gbase) + (voff)[_i]), (PG8_LAS unsigned*)(lds + (bufoff) + ldsw + _i * 8192), 16, 0, 0); } while (0)
#define PG8_LDA(dst, b, h) do { _Pragma("unroll") for (int m = 0; m < 4; ++m) _Pragma("unroll") for (int k = 0; k < 2; ++k) dst[m][k] = *(const PG8_LAS bf16x8*)(lds + PG8_SA(b, h) + aoff + m * 2048 + k * 1024); } while (0)
#define PG8_LDB(dst, b, h) do { _Pragma("unroll") for (int n = 0; n < 2; ++n) _Pragma("unroll") for (int k = 0; k < 2; ++k) dst[n][k] = *(const PG8_LAS bf16x8*)(lds + PG8_SB(b, h) + boff + n * 2048 + k * 1024); } while (0)
#define PG8_MMA(ai, bj, At, Bt) do { __builtin_amdgcn_s_setprio(1); _Pragma("unroll") for (int m = 0; m < 4; ++m) _Pragma("unroll") for (int n = 0; n < 2; ++n) _Pragma("unroll") for (int k = 0; k < 2; ++k) \
        acc[ai][bj][m][n] = __builtin_amdgcn_mfma_f32_16x16x32_bf16(Bt[n][k], At[m][k], acc[ai][bj][m][n], 0, 0, 0); __builtin_amdgcn_s_setprio(0); } while (0)
#define PG8_WAIT_V(n) asm volatile("s_waitcnt vmcnt(" #n ")" ::: "memory")
#define PG8_WAIT_L(n) asm volatile("s_waitcnt lgkmcnt(" #n ")" ::: "memory")
#define PG8_BAR __builtin_amdgcn_s_barrier()
#define PG8_SCHED __builtin_amdgcn_sched_barrier(0)
    Unit cur, nxt; int ui = 0;
    if (!S.next(0, cur)) return;
    f32x4 acc[2][2][4][2];
#pragma unroll
    for (int a = 0; a < 2; ++a)
#pragma unroll
        for (int b = 0; b < 2; ++b)
#pragma unroll
            for (int m = 0; m < 4; ++m)
#pragma unroll
                for (int n = 0; n < 2; ++n) acc[a][b][m][n] = (f32x4){0.f, 0.f, 0.f, 0.f};
    bf16x8 At[4][2], B0[2][2], B1[2][2];
    const char* cA = (const char*)g.A + (size_t)cur.pm * tstepA; const char* cB = (const char*)g.Bt + (size_t)cur.pn * tstepB;
    S.a_ready(cur);
    if constexpr (SP2) {
        PG8_STAGE(PG8_SB(0, 0), cB, voffB); PG8_STAGE(PG8_SB(0, 1), cB + hstepB, voffB); PG8_STAGE(PG8_SA(0, 0), cA, voffA); PG8_STAGE(PG8_SA(0, 1), cA + hstepA, voffA);
        if (wr == 1) PG8_BAR;
        PG8_WAIT_V(2); PG8_BAR;
        PG8_STAGE(PG8_SB(1, 0), cB + kstep, voffB); PG8_STAGE(PG8_SA(1, 0), cA + kstep, voffA); PG8_STAGE(PG8_SB(1, 1), cB + hstepB + kstep, voffB);
        PG8_WAIT_V(6); PG8_BAR;
    } else {
        PG8_STAGE(PG8_SB(0, 0), cB, voffB); PG8_STAGE(PG8_SA(0, 0), cA, voffA); PG8_STAGE(PG8_SB(0, 1), cB + hstepB, voffB); PG8_STAGE(PG8_SA(0, 1), cA + hstepA, voffA);
        if (wr == 1) PG8_BAR;
        PG8_WAIT_V(4); PG8_BAR;
        PG8_STAGE(PG8_SB(1, 0), cB + kstep, voffB); PG8_STAGE(PG8_SA(1, 0), cA + kstep, voffA); PG8_STAGE(PG8_SB(1, 1), cB + hstepB + kstep, voffB);
        PG8_WAIT_V(6); PG8_BAR;
    }
    for (;;) {
        const bool has_next = S.next(ui + 1, nxt);
        const char* nA = has_next ? (const char*)g.A + (size_t)nxt.pm * tstepA : cA; const char* nB = has_next ? (const char*)g.Bt + (size_t)nxt.pn * tstepB : cB;
        for (int t = 0; t < nt; t += 2) {
            if constexpr (Epi::KHOOK) { if (t == Epi::KH_T) E.khook(acc, ui, wr, fr, lds); }
            const bool last = (t == nt - 2);
            const char* a1 = cA + (size_t)(t + 1) * kstep;
            const char* a2 = last ? nA : cA + (size_t)(t + 2) * kstep; const char* b2 = last ? nB : cB + (size_t)(t + 2) * kstep;
            const char* a3 = a2 + kstep; const char* b3 = b2 + kstep;
            if (last && has_next) S.a_ready(nxt);
            if constexpr (SP2) {
            PG8_LDB(B0, 0, 0); PG8_LDB(B1, 0, 1); PG8_SCHED; PG8_LDA(At, 0, 0); PG8_STAGE(PG8_SA(1, 1), a1 + hstepA, voffA);
            PG8_WAIT_V(8); PG8_WAIT_L(0); PG8_BAR; PG8_MMA(0, 0, At, B0); PG8_MMA(0, 1, At, B1); PG8_BAR; PG8_SCHED;
            PG8_LDA(At, 0, 1); PG8_STAGE(PG8_SB(0, 0), b2, voffB); PG8_STAGE(PG8_SB(0, 1), b2 + hstepB, voffB); PG8_STAGE(PG8_SA(0, 0), a2, voffA);
            PG8_WAIT_V(8); PG8_WAIT_L(0); PG8_BAR; PG8_MMA(1, 0, At, B0); PG8_MMA(1, 1, At, B1); PG8_BAR; PG8_SCHED;
            PG8_LDB(B0, 1, 0); PG8_LDB(B1, 1, 1); PG8_SCHED; PG8_LDA(At, 1, 0); PG8_STAGE(PG8_SA(0, 1), a2 + hstepA, voffA);
            PG8_WAIT_V(8); PG8_WAIT_L(0); PG8_BAR; PG8_MMA(0, 0, At, B0); PG8_MMA(0, 1, At, B1); PG8_BAR; PG8_SCHED;
            PG8_LDA(At, 1, 1); PG8_STAGE(PG8_SB(1, 0), b3, voffB); PG8_STAGE(PG8_SB(1, 1), b3 + hstepB, voffB); PG8_STAGE(PG8_SA(1, 0), a3, voffA);
            PG8_WAIT_V(8); PG8_WAIT_L(0); PG8_BAR; PG8_MMA(1, 0, At, B0); PG8_MMA(1, 1, At, B1); PG8_BAR; PG8_SCHED;
            } else {
            PG8_LDB(B0, 0, 0); PG8_SCHED; PG8_LDA(At, 0, 0); PG8_STAGE(PG8_SA(1, 1), a1 + hstepA, voffA);
            PG8_WAIT_L(8); PG8_BAR; PG8_WAIT_L(0); PG8_MMA(0, 0, At, B0); PG8_BAR; PG8_SCHED;
            PG8_LDB(B1, 0, 1); PG8_STAGE(PG8_SB(0, 0), b2, voffB);
            PG8_BAR; PG8_WAIT_L(0); PG8_MMA(0, 1, At, B1); PG8_BAR;
            PG8_LDA(At, 0, 1); PG8_STAGE(PG8_SA(0, 0), a2, voffA);
            PG8_BAR; PG8_WAIT_L(0); PG8_MMA(1, 0, At, B0); PG8_BAR; PG8_SCHED;
            PG8_STAGE(PG8_SB(0, 1), b2 + hstepB, voffB);
            PG8_WAIT_V(6); PG8_BAR; PG8_MMA(1, 1, At, B1); PG8_BAR;
            PG8_LDB(B0, 1, 0); PG8_SCHED; PG8_LDA(At, 1, 0); PG8_STAGE(PG8_SA(0, 1), a2 + hstepA, voffA);
            PG8_WAIT_L(8); PG8_BAR; PG8_WAIT_L(0); PG8_MMA(0, 0, At, B0); PG8_BAR; PG8_SCHED;
            PG8_LDB(B1, 1, 1); PG8_STAGE(PG8_SB(1, 0), b3, voffB);
            PG8_BAR; PG8_WAIT_L(0); PG8_MMA(0, 1, At, B1); PG8_BAR;
            PG8_LDA(At, 1, 1); PG8_STAGE(PG8_SA(1, 0), a3, voffA);
            PG8_BAR; PG8_WAIT_L(0); PG8_MMA(1, 0, At, B0); PG8_BAR; PG8_SCHED;
            PG8_STAGE(PG8_SB(1, 1), b3 + hstepB, voffB);
            PG8_WAIT_V(6); PG8_BAR; PG8_MMA(1, 1, At, B1); PG8_BAR;
            }
        }
        if constexpr (ALIGN_EPI) { if (wr == 0) PG8_BAR; }
        if constexpr (!Epi::AFTER_DRAIN) { E(acc, cur, wr, wc, fr, fq, ui); S.done(cur); }
        if (!has_next) break;
#pragma unroll
        for (int a = 0; a < 2; ++a)
#pragma unroll
            for (int b = 0; b < 2; ++b)
#pragma unroll
                for (int m = 0; m < 4; ++m)
#pragma unroll
                    for (int n = 0; n < 2; ++n) acc[a][b][m][n] = (f32x4){0.f, 0.f, 0.f, 0.f};
        cur = nxt; cA = nA; cB = nB; ++ui;
        if constexpr (ALIGN_EPI) { if (wr == 1) PG8_BAR; }
    }
    PG8_WAIT_V(0);
    if constexpr (!ALIGN_EPI) { if (wr == 0) PG8_BAR; }
    PG8_BAR;
    if constexpr (Epi::AFTER_DRAIN) { E.fused(acc, cur, wr, wc, fr, fq, lds, wid, lane); S.done(cur); }
#undef PG8_SA
#undef PG8_SB
#undef PG8_STAGE
#undef PG8_LDA
#undef PG8_LDB
#undef PG8_MMA
#undef PG8_WAIT_V
#undef PG8_WAIT_L
#undef PG8_BAR
#undef PG8_SCHED
}
}

namespace pg8 {
struct EpiMlpIn {
  static constexpr bool PERM = true, AFTER_DRAIN = false, KHOOK = false; static constexpr int KH_T = 0;
  ::bf16_t* O; const float* sb2; const float* ss1;
  __device__ __forceinline__ void operator()(const f32x4 (&acc)[2][2][4][2], const Unit& u, int wr, int wc, int fr, int fq, int) const {
    const int row0 = u.pm * BM + wr * 64 + fr, col0 = u.pn * BM + wc * 32 + 8 * fq;
    const float* bias = sb2 + batch_of(u.pm * BM) * 4096;
    f32x4 bv[2][2];
#pragma unroll
    for (int bj = 0; bj < 2; ++bj)
#pragma unroll
      for (int n = 0; n < 2; ++n) bv[bj][n] = *(const f32x4*)(bias + col0 + bj * HALF + 4 * n);
    float r2[2][4];
#pragma unroll
    for (int ai = 0; ai < 2; ++ai)
#pragma unroll
      for (int m = 0; m < 4; ++m) r2[ai][m] = rsqrtf(ss1[row0 + ai * HALF + m * 16] * (1.f / 1024.f) + EPSV);
#pragma unroll
    for (int ai = 0; ai < 2; ++ai)
#pragma unroll
      for (int m = 0; m < 4; ++m) {
        ::bf16_t* rowp = O + (size_t)(row0 + ai * HALF + m * 16) * 4096 + col0;
#pragma unroll
        for (int bj = 0; bj < 2; ++bj) {
          f32x4 v0 = acc[ai][bj][m][0] * r2[ai][m] + bv[bj][0], v1 = acc[ai][bj][m][1] * r2[ai][m] + bv[bj][1];
#pragma unroll
          for (int e = 0; e < 4; ++e) { const float a = fmaxf(v0[e], 0.f), b = fmaxf(v1[e], 0.f); v0[e] = a * a; v1[e] = b * b; }
          u32x4 w; w.x = pk2(v0[0], v0[1]); w.y = pk2(v0[2], v0[3]); w.z = pk2(v1[0], v1[1]); w.w = pk2(v1[2], v1[3]);
          *(u32x4*)(rowp + bj * HALF) = w;
        }
      }
  }
};
struct EpiMlpOut {
  static constexpr bool PERM = true, AFTER_DRAIN = false, KHOOK = false; static constexpr int KH_T = 0;
  const ::bf16_t* x1; ::bf16_t* x2; const float* mod; const float* bias;
  __device__ __forceinline__ void operator()(const f32x4 (&acc)[2][2][4][2], const Unit& u, int wr, int wc, int fr, int fq, int) const {
    const int col0 = u.pn * BM + wc * 32 + 8 * fq;
    const float* g2 = mod + batch_of(u.pm * BM) * 6144 + 5120;
    f32x4 bb[2][2], gv[2][2];
#pragma unroll
    for (int bj = 0; bj < 2; ++bj)
#pragma unroll
      for (int n = 0; n < 2; ++n) { bb[bj][n] = *(const f32x4*)(bias + col0 + bj * HALF + n * 4); gv[bj][n] = *(const f32x4*)(g2 + col0 + bj * HALF + n * 4); }
#pragma unroll
    for (int ai = 0; ai < 2; ++ai) {
      u32x4 xr[4][2];
#pragma unroll
      for (int m = 0; m < 4; ++m) {
        const int row = u.pm * BM + ai * HALF + wr * 64 + m * 16 + fr;
#pragma unroll
        for (int bj = 0; bj < 2; ++bj) xr[m][bj] = *(const u32x4*)(x1 + (size_t)row * 1024 + col0 + bj * HALF);
      }
      asm volatile("" ::: "memory");
#pragma unroll
      for (int m = 0; m < 4; ++m) {
        const int row = u.pm * BM + ai * HALF + wr * 64 + m * 16 + fr;
#pragma unroll
        for (int bj = 0; bj < 2; ++bj) {
          const u32x4 xx = xr[m][bj];
          f32x4 x0, x1v;
          x0[0] = bflo(xx.x); x0[1] = bfhi(xx.x); x0[2] = bflo(xx.y); x0[3] = bfhi(xx.y);
          x1v[0] = bflo(xx.z); x1v[1] = bfhi(xx.z); x1v[2] = bflo(xx.w); x1v[3] = bfhi(xx.w);
          const f32x4 o0 = x0 + gv[bj][0] * (acc[ai][bj][m][0] + bb[bj][0]), o1 = x1v + gv[bj][1] * (acc[ai][bj][m][1] + bb[bj][1]);
          u32x4 w; w.x = pk2(o0[0], o0[1]); w.y = pk2(o0[2], o0[3]); w.z = pk2(o1[0], o1[1]); w.w = pk2(o1[2], o1[3]);
          *(u32x4*)(x2 + (size_t)row * 1024 + col0 + bj * HALF) = w;
        }
      }
    }
  }
};
struct EpiYf {
  static constexpr bool PERM = true, AFTER_DRAIN = false, KHOOK = false; static constexpr int KH_T = 0;
  ::bf16_t* O; const float* bias; float* ss;
  __device__ __forceinline__ void operator()(const f32x4 (&acc)[2][2][4][2], const Unit& u, int wr, int wc, int fr, int fq, int) const {
    const int row0 = u.pm * BM + wr * 64 + fr, col0 = u.pn * BM + wc * 32 + 8 * fq;
    f32x4 bv[2][2];
#pragma unroll
    for (int bj = 0; bj < 2; ++bj)
#pragma unroll
      for (int n = 0; n < 2; ++n) bv[bj][n] = *(const f32x4*)(bias + col0 + bj * HALF + 4 * n);
#pragma unroll
    for (int ai = 0; ai < 2; ++ai)
#pragma unroll
      for (int m = 0; m < 4; ++m) {
        const int row = row0 + ai * HALF + m * 16;
        const float scale = row < LPR ? 3.4526698300124393e-4f : 6.905339660024879e-4f;
        ::bf16_t* rowp = O + (size_t)row * 1024 + col0;
        float s = 0.f;
#pragma unroll
        for (int bj = 0; bj < 2; ++bj) {
          const f32x4 v0 = acc[ai][bj][m][0] * scale + bv[bj][0], v1 = acc[ai][bj][m][1] * scale + bv[bj][1];
          s += (v0[0] * v0[0] + v0[1] * v0[1]) + (v0[2] * v0[2] + v0[3] * v0[3]) + (v1[0] * v1[0] + v1[1] * v1[1]) + (v1[2] * v1[2] + v1[3] * v1[3]);
          u32x4 w; w.x = pk2(v0[0], v0[1]); w.y = pk2(v0[2], v0[3]); w.z = pk2(v1[0], v1[1]); w.w = pk2(v1[2], v1[3]);
          *(u32x4*)(rowp + bj * HALF) = w;
        }
        s += __shfl_xor(s, 16); s += __shfl_xor(s, 32);
        if (fq == 0) ss[row * 8 + u.pn * 4 + wc] = s;
      }
  }
};
struct EpiGlu {
  static constexpr bool PERM = true, AFTER_DRAIN = false, KHOOK = false; static constexpr int KH_T = 0;
  ::bf16_t* O; const float* bias; float* ss;
  __device__ __forceinline__ void operator()(const f32x4 (&acc)[2][2][4][2], const Unit& u, int wr, int wc, int fr, int fq, int) const {
    const int row0 = u.pm * BM + wr * 64 + fr, j0 = u.pn * 128 + wc * 32 + 8 * fq;
    f32x4 bv[2][2];
#pragma unroll
    for (int bj = 0; bj < 2; ++bj)
#pragma unroll
      for (int n = 0; n < 2; ++n) bv[bj][n] = *(const f32x4*)(bias + bj * 512 + j0 + 4 * n);
#pragma unroll
    for (int ai = 0; ai < 2; ++ai)
#pragma unroll
      for (int m = 0; m < 4; ++m) {
        const int row = row0 + ai * HALF + m * 16;
        float o[8], s = 0.f;
#pragma unroll
        for (int n = 0; n < 2; ++n)
#pragma unroll
          for (int e = 0; e < 4; ++e) {
            const float val = acc[ai][0][m][n][e] + bv[0][n][e], gate = acc[ai][1][m][n][e] + bv[1][n][e];
            const float y = val / (1.f + __expf(-gate));
            o[4 * n + e] = y; s += y * y;
          }
        u32x4 w; w.x = pk2(o[0], o[1]); w.y = pk2(o[2], o[3]); w.z = pk2(o[4], o[5]); w.w = pk2(o[6], o[7]);
        *(u32x4*)(O + (size_t)row * 1024 + 512 + j0) = w;
        s += __shfl_xor(s, 16); s += __shfl_xor(s, 32);
        if (fq == 0) ss[row * 16 + u.pn * 4 + wc] = s;
      }
  }
};
struct EpiZt {
  static constexpr bool PERM = true, AFTER_DRAIN = false, KHOOK = false; static constexpr int KH_T = 0;
  ::bf16_t* O;
  __device__ __forceinline__ void operator()(const f32x4 (&acc)[2][2][4][2], const Unit& u, int wr, int wc, int fr, int fq, int) const {
    const int v0 = u.pn * BM;
    ::bf16_t* base; size_t ld;
    if (v0 < LPR) { base = O + v0; ld = LPR; }
    else { const int vs = v0 - LPR; base = O + (size_t)512 * LPR + (size_t)(vs >> 12) * 512 * 4096 + (vs & 4095); ld = 4096; }
    const int c0 = u.pm * BM + wr * 64 + fr, col0 = wc * 32 + 8 * fq;
#pragma unroll
    for (int ai = 0; ai < 2; ++ai)
#pragma unroll
      for (int m = 0; m < 4; ++m) {
        ::bf16_t* rowp = base + (size_t)(c0 + ai * HALF + m * 16) * ld + col0;
#pragma unroll
        for (int bj = 0; bj < 2; ++bj) {
          const f32x4 a = acc[ai][bj][m][0], b = acc[ai][bj][m][1];
          u32x4 w; w.x = pk2(a[0], a[1]); w.y = pk2(a[2], a[3]); w.z = pk2(b[0], b[1]); w.w = pk2(b[2], b[3]);
          *(u32x4*)(rowp + bj * HALF) = w;
        }
      }
  }
};
struct EpiZs {
  static constexpr bool PERM = true, AFTER_DRAIN = false, KHOOK = false; static constexpr int KH_T = 0;
  ::bf16_t* O;
  __device__ __forceinline__ void operator()(const f32x4 (&acc)[2][2][4][2], const Unit& u, int wr, int wc, int fr, int fq, int) const {
    const int r0 = u.pm * BM + wr * 64 + fr, col0 = u.pn * BM + wc * 32 + 8 * fq;
#pragma unroll
    for (int ai = 0; ai < 2; ++ai)
#pragma unroll
      for (int m = 0; m < 4; ++m) {
        const int tok = v2tok(r0 + ai * HALF + m * 16);
#pragma unroll
        for (int bj = 0; bj < 2; ++bj) {
          const int col = col0 + bj * HALF;
          const f32x4 a = acc[ai][bj][m][0], b = acc[ai][bj][m][1];
          u32x4 w; w.x = pk2(a[0], a[1]); w.y = pk2(a[2], a[3]); w.z = pk2(b[0], b[1]); w.w = pk2(b[2], b[3]);
          *(u32x4*)(O + ((size_t)(col >> 4) * 1280 + (tok >> 6)) * 1280 + (tok & 63) * 16 + (col & 15)) = w;
        }
      }
  }
};
struct EpiS {
  static constexpr bool PERM = false, AFTER_DRAIN = false, KHOOK = false; static constexpr int KH_T = 0;
  float* O;
  __device__ __forceinline__ void operator()(const f32x4 (&acc)[2][2][4][2], const Unit& u, int wr, int wc, int fr, int fq, int) const {
#pragma unroll
    for (int ai = 0; ai < 2; ++ai)
#pragma unroll
      for (int m = 0; m < 4; ++m) {
        float* rowp = O + (size_t)(u.pm * BM + ai * HALF + wr * 64 + m * 16 + fr) * 256 + wc * 32 + 4 * fq;
#pragma unroll
        for (int bj = 0; bj < 2; ++bj)
#pragma unroll
          for (int n = 0; n < 2; ++n) *(f32x4*)(rowp + bj * HALF + n * 16) = acc[ai][bj][m][n];
      }
  }
};
struct EpiGelu {
  static constexpr bool PERM = true, AFTER_DRAIN = false, KHOOK = false; static constexpr int KH_T = 0;
  ::bf16_t* O;
  __device__ __forceinline__ void operator()(const f32x4 (&acc)[2][2][4][2], const Unit& u, int wr, int wc, int fr, int fq, int) const {
    const int gi = u.pn >> 2, n0 = (u.pn & 3) * BM + wc * 32 + 8 * fq, ch0 = u.pm * BM - gi * 1280 + wr * 64 + fr;
#pragma unroll
    for (int ai = 0; ai < 2; ++ai)
#pragma unroll
      for (int m = 0; m < 4; ++m) {
        const int ch = ch0 + ai * HALF + m * 16;
#pragma unroll
        for (int bj = 0; bj < 2; ++bj) {
          const int n = n0 + bj * HALF;
          float o[8];
#pragma unroll
          for (int e = 0; e < 4; ++e) { o[e] = gelu_tanh(acc[ai][bj][m][0][e]); o[4 + e] = gelu_tanh(acc[ai][bj][m][1][e]); }
          u32x4 w; w.x = pk2(o[0], o[1]); w.y = pk2(o[2], o[3]); w.z = pk2(o[4], o[5]); w.w = pk2(o[6], o[7]);
          *(u32x4*)(O + (size_t)(ch * 64 + (n >> 4)) * 512 + gi * 16 + (n & 15)) = w;
        }
      }
  }
};
struct EpiFft1 {
  static constexpr bool PERM = true, AFTER_DRAIN = false, KHOOK = false; static constexpr int KH_T = 0;
  ::bf16_t* Tt; const float2* twp; const float2* tws;
  __device__ __forceinline__ void operator()(const f32x4 (&acc)[2][2][4][2], const Unit& u, int wr, int wc, int fr, int fq, int) const {
    const bool pr = u.pn < 128;
    const int r0b = u.pn * BM + wc * 32 + 8 * fq;
    const float2* tw = pr ? twp : tws;
    const int mask = pr ? 16383 : 4095;
    float2 stv[4], w0v[4];
#pragma unroll
    for (int m = 0; m < 4; ++m) {
      const int idx = ((u.pm & 1) << 7) | (wr * 64 + m * 16 + fr);
      const int k1 = pr ? (idx & 127) : (idx & 63), l2loc = pr ? (idx >> 7) : (idx >> 6);
      const int l20 = pr ? (l2loc * 64 + (r0b & 63)) : (l2loc * 16 + (r0b & 15));
      stv[m] = tw[(unsigned)(k1 & mask)]; w0v[m] = tw[(unsigned)((k1 * l20) & mask)];
    }
    asm volatile("" ::: "memory");
#pragma unroll
    for (int m = 0; m < 4; ++m) {
      const int idx = ((u.pm & 1) << 7) | (wr * 64 + m * 16 + fr);
      const int k1 = pr ? (idx & 127) : (idx & 63), l2loc = pr ? (idx >> 7) : (idx >> 6);
      const int l20 = pr ? (l2loc * 64 + (r0b & 63)) : (l2loc * 16 + (r0b & 15));
      const float2 st = stv[m], w0 = w0v[m];
#pragma unroll
      for (int bj = 0; bj < 2; ++bj) {
        const int r0 = r0b + bj * HALF;
        size_t off; int pstride;
        if (pr) { off = ((size_t)(k1 * 512 + (r0 >> 6))) * 256 + l20; pstride = 128; }
        else { const int bc = (r0 - 32768) >> 4; off = (size_t)65536 * 256 + ((size_t)(((bc >> 9) * 32 + (k1 >> 1)) * 512 + (bc & 511))) * 256 + (k1 & 1) * 128 + l20; pstride = 64; }
        float ore[8], oim[8];
        float2 wv = w0;
#pragma unroll
        for (int e = 0; e < 8; ++e) {
          const float re = acc[0][bj][m][e >> 2][e & 3], im = acc[1][bj][m][e >> 2][e & 3];
          ore[e] = re * wv.x + im * wv.y; oim[e] = im * wv.x - re * wv.y;
          wv = make_float2(wv.x * st.x - wv.y * st.y, wv.y * st.x + wv.x * st.y);
        }
        u32x4 w; w.x = pk2(ore[0], ore[1]); w.y = pk2(ore[2], ore[3]); w.z = pk2(ore[4], ore[5]); w.w = pk2(ore[6], ore[7]);
        *(u32x4*)(Tt + off) = w;
        w.x = pk2(oim[0], oim[1]); w.y = pk2(oim[2], oim[3]); w.z = pk2(oim[4], oim[5]); w.w = pk2(oim[6], oim[7]);
        *(u32x4*)(Tt + off + pstride) = w;
      }
    }
  }
};
struct EpiFft2 {
  static constexpr bool PERM = true, AFTER_DRAIN = false, KHOOK = false; static constexpr int KH_T = 0;
  ::bf16_t* AF;
  __device__ __forceinline__ void operator()(const f32x4 (&acc)[2][2][4][2], const Unit& u, int wr, int wc, int fr, int fq, int) const {
    const bool pr = u.pn < 256;
    const int pnl = pr ? u.pn : u.pn - 256, c0 = (pnl & 1) * 256 + wc * 32 + 8 * fq;
#pragma unroll
    for (int ai = 0; ai < 2; ++ai)
#pragma unroll
      for (int m = 0; m < 4; ++m) {
        int part, tok;
        if (pr) { part = ai; tok = (pnl >> 1) + 128 * (wr * 64 + m * 16 + fr); }
        else { const int bk = pnl >> 1; part = wr; tok = LPR + (bk >> 5) * 4096 + (bk & 31) * 2 + ai + 64 * (m * 16 + fr); }
        ::bf16_t* rowp = AF + (size_t)tok * 1024 + part * 512 + c0;
#pragma unroll
        for (int bj = 0; bj < 2; ++bj) {
          const f32x4 a = acc[ai][bj][m][0], b = acc[ai][bj][m][1];
          u32x4 w; w.x = pk2(a[0], a[1]); w.y = pk2(a[2], a[3]); w.z = pk2(b[0], b[1]); w.w = pk2(b[2], b[3]);
          *(u32x4*)(rowp + bj * HALF) = w;
        }
      }
  }
};
struct EpiWout {
  static constexpr bool PERM = true, AFTER_DRAIN = false, KHOOK = true; static constexpr int KH_T = 8;
  float* out; const float* xp; const float* xs; const float* mod; const float* g2; ::bf16_t* h2; float* ss1;
  __device__ __forceinline__ void khook(f32x4 (&acc)[2][2][4][2], int ui, int wr, int fr, PG8_LAS unsigned char* lds) const {
    typedef float f32x2t __attribute__((ext_vector_type(2)));
    const PG8_LAS f32x2t* tab = (const PG8_LAS f32x2t*)(lds + 131072) + ui * 256;
#pragma unroll
    for (int ai = 0; ai < 2; ++ai)
#pragma unroll
      for (int m = 0; m < 4; ++m) {
        const float r = tab[ai * HALF + wr * 64 + m * 16 + fr].x;
#pragma unroll
        for (int bj = 0; bj < 2; ++bj)
#pragma unroll
          for (int n = 0; n < 2; ++n) acc[ai][bj][m][n] *= r;
      }
  }
  __device__ __forceinline__ void operator()(const f32x4 (&acc)[2][2][4][2], const Unit& u, int wr, int wc, int fr, int fq, int ui) const {
    typedef float f32x2t __attribute__((ext_vector_type(2)));
    const PG8_LAS f32x2t* tab = (const PG8_LAS f32x2t*)((PG8_LAS unsigned char*)dyn_smem + 131072) + ui * 256;
    const int col0 = u.pn * BM + wc * 32 + 8 * fq;
    const float* md = mod + batch_of(u.pm * BM) * 6144;
    f32x4 gv[2][2], hv[2][2];
#pragma unroll
    for (int bj = 0; bj < 2; ++bj)
#pragma unroll
      for (int n = 0; n < 2; ++n) {
        const int col = col0 + bj * HALF + n * 4;
        gv[bj][n] = *(const f32x4*)(md + 2048 + col);
        hv[bj][n] = *(const f32x4*)(g2 + col) * (*(const f32x4*)(md + 4096 + col) + 1.f);
      }
#pragma unroll
    for (int ai = 0; ai < 2; ++ai)
#pragma unroll
      for (int mp = 0; mp < 2; ++mp) {
        f32x4 xv[2][2][2]; float rs[2];
#pragma unroll
        for (int mm = 0; mm < 2; ++mm) {
          const int m = mp * 2 + mm, rl = ai * HALF + wr * 64 + m * 16 + fr, row = u.pm * BM + rl;
          rs[mm] = tab[rl].y;
          const float* xr = row < LPR ? xp + (size_t)row * 1024 : xs + (size_t)(row - LPR) * 1024;
#pragma unroll
          for (int bj = 0; bj < 2; ++bj)
#pragma unroll
            for (int n = 0; n < 2; ++n) xv[mm][bj][n] = *(const f32x4*)(xr + col0 + bj * HALF + n * 4);
        }
        asm volatile("" ::: "memory");
#pragma unroll
        for (int mm = 0; mm < 2; ++mm) {
          const int m = mp * 2 + mm, row = u.pm * BM + ai * HALF + wr * 64 + m * 16 + fr;
          ::bf16_t* orow = (::bf16_t*)out + (size_t)row * 1024 + col0;
          ::bf16_t* hrow = h2 + (size_t)row * 1024 + col0;
          float sq = 0.f;
#pragma unroll
          for (int bj = 0; bj < 2; ++bj) {
            const f32x4 o0 = xv[mm][bj][0] + gv[bj][0] * (acc[ai][bj][m][0] * rs[mm]), o1 = xv[mm][bj][1] + gv[bj][1] * (acc[ai][bj][m][1] * rs[mm]);
            sq += (o0[0] * o0[0] + o0[1] * o0[1]) + (o0[2] * o0[2] + o0[3] * o0[3]) + (o1[0] * o1[0] + o1[1] * o1[1]) + (o1[2] * o1[2] + o1[3] * o1[3]);
            u32x4 w; w.x = pk2(o0[0], o0[1]); w.y = pk2(o0[2], o0[3]); w.z = pk2(o1[0], o1[1]); w.w = pk2(o1[2], o1[3]);
            *(u32x4*)(orow + bj * HALF) = w;
            const f32x4 h0 = o0 * hv[bj][0], h1 = o1 * hv[bj][1];
            w.x = pk2(h0[0], h0[1]); w.y = pk2(h0[2], h0[3]); w.z = pk2(h1[0], h1[1]); w.w = pk2(h1[2], h1[3]);
            *(u32x4*)(hrow + bj * HALF) = w;
          }
          sq += __shfl_xor(sq, 16); sq += __shfl_xor(sq, 32);
          if (fq == 0) atomicAdd(ss1 + row, sq);
        }
      }
  }
};
}

DI void phase2(const P& p, const int wv) {
  {
    const pg8::Gemm g{p.wint(), p.hb(), 512, NTOK, 1024, 1024, 1024};
    pg8::StaticOrder S; S.init(512, NTOK, (int)gridDim.x, (int)blockIdx.x);
    const pg8::EpiZt E{p.zT()};
    pg8::gemm_phase<pg8::EpiZt, pg8::StaticOrder, true, true>((PG8_LAS unsigned char*)dyn_smem, otid(wv), g, S, E);
  }
  {
    const pg8::Gemm g{p.hb(), p.wint() + (size_t)512 * 1024, NTOK, 512, 1024, 1024, 1024};
    pg8::StaticOrder S; S.init(NTOK, 512, (int)gridDim.x, (int)(gridDim.x - 1 - blockIdx.x));
    const pg8::EpiZs E{p.Ucat()};
    pg8::gemm_phase<pg8::EpiZs, pg8::StaticOrder, true, true>((PG8_LAS unsigned char*)dyn_smem, otid(wv), g, S, E);
  }
}
DI void phase3(const P& p, const int wv) {
  {
    const pg8::Gemm g{p.Ucat(), p.Bs(), 32 * 1280, 32 * 256, 1024, 1280, 1024};
    pg8::GroupOrder S; S.init(32, 5, 1, (int)gridDim.x, (int)blockIdx.x);
    const pg8::EpiS E{p.S()};
    pg8::gemm_phase<pg8::EpiS, pg8::GroupOrder, true, true>((PG8_LAS unsigned char*)dyn_smem, otid(wv), g, S, E);
  }
  {
    const pg8::Gemm g{p.Fb1(), p.zT(), 1024, 163840, 256, 256, 256};
    pg8::Fft1Order S; S.init((int)gridDim.x, (int)blockIdx.x);
    const pg8::EpiFft1 E{p.Tt(), p.twp(), p.tws()};
    pg8::gemm_phase<pg8::EpiFft1, pg8::Fft1Order, true, true>((PG8_LAS unsigned char*)dyn_smem, otid(wv), g, S, E);
  }
}
DI void phase4(const P& p, const int wv) {
  {
    const int tix = otid(wv), pp = tix & 63, G = (int)gridDim.x;
    for (int task = (int)blockIdx.x + G * wv; task < 17 * 64; task += G * 8) {
      const int seq = task >> 6, g = (task >> 1) & 31, dir = task & 1;
      const int c0 = seq == 0 ? 0 : 256 + (seq - 1) * 64, nc = seq == 0 ? 256 : 64;
      const float ar = p.AT()[((g * 2 + dir) * 64 + pp) * 2], ai = p.AT()[((g * 2 + dir) * 64 + pp) * 2 + 1];
      float hr = 0.f, hi = 0.f;
      const float* Sg = p.S() + (size_t)g * 1280 * 256 + dir * 128 + pp;
      bf16_t* Hg = p.Ucat() + (size_t)g * 1280 * 1280 + 1024 + dir * 128 + pp;
      for (int i0 = 0; i0 < nc; i0 += 32) {
        float sr[32], si[32];
#pragma unroll
        for (int j = 0; j < 32; j++) {
          const int c = c0 + (dir == 0 ? i0 + j : nc - 1 - i0 - j);
          sr[j] = Sg[(size_t)c * 256]; si[j] = Sg[(size_t)c * 256 + 64];
        }
#pragma unroll
        for (int j = 0; j < 32; j++) {
          const int c = c0 + (dir == 0 ? i0 + j : nc - 1 - i0 - j);
          Hg[(size_t)c * 1280] = f2bf(hr); Hg[(size_t)c * 1280 + 64] = f2bf(hi);
          const float nr = ar * hr - ai * hi + sr[j], ni = ar * hi + ai * hr + si[j];
          hr = nr; hi = ni;
        }
      }
    }
  }
  {
    const pg8::Gemm g{p.Fb2(), p.Tt(), 512, 327680, 256, 256, 256};
    pg8::Fft2Order S; S.init((int)gridDim.x, (int)blockIdx.x);
    const pg8::EpiFft2 E{p.AF()};
    pg8::gemm_phase<pg8::EpiFft2, pg8::Fft2Order, true, true>((PG8_LAS unsigned char*)dyn_smem, otid(wv), g, S, E);
  }
}
DI void phase5(const P& p, const int wv) {
  const pg8::Gemm g{p.Ucat(), p.Tcat(), 32 * 1280, 32 * 1024, 1280, 1280, 1280};
  pg8::GroupOrder S; S.init(32, 5, 4, (int)gridDim.x, (int)blockIdx.x);
  const pg8::EpiGelu E{p.gact()};
  pg8::gemm_phase<pg8::EpiGelu, pg8::GroupOrder, true, true>((PG8_LAS unsigned char*)dyn_smem, otid(wv), g, S, E);
  {
    const pg8::Gemm g{p.AF(), p.Mf(), NTOK, 512, 1024, 1024, 1024};
    pg8::YfOrder S; S.init((int)gridDim.x, (int)blockIdx.x);
    const pg8::EpiYf E{p.mg(), p.b_f, p.ssf()};
    pg8::gemm_phase<pg8::EpiYf, pg8::YfOrder, true, true>((PG8_LAS unsigned char*)dyn_smem, otid(wv), g, S, E);
  }
}
DI void phase6(const P& p, const int wv) {
  {
    const pg8::Gemm g{p.gact(), p.wglut(), NTOK, 1024, 512, 512, 512};
    pg8::StaticOrder S; S.init(NTOK, 1024, (int)gridDim.x, (int)blockIdx.x);
    const pg8::EpiGlu E{p.mg(), p.b_glu, p.sss()};
    pg8::gemm_phase<pg8::EpiGlu, pg8::StaticOrder, true, true>((PG8_LAS unsigned char*)dyn_smem, otid(wv), g, S, E);
  }
}
DI void phase7(const P& p, const int wv) {
  const pg8::Gemm g{p.mg(), p.woutt(), NTOK, 1024, 1024, 1024, 1024};
  pg8::StaticOrder S; S.init(NTOK, 1024, (int)gridDim.x, (int)blockIdx.x);
  {
    typedef float f32x2t __attribute__((ext_vector_type(2)));
    PG8_LAS f32x2t* tab = (PG8_LAS f32x2t*)((PG8_LAS unsigned char*)dyn_smem + 131072);
    const int tix7 = otid(wv);
    pg8::Unit u;
    for (int i = 0; i < 8 && S.next(i, u); ++i) {
      if (tix7 < 256) {
        const int tok = u.pm * 256 + tix7;
        float sf = 0.f, s2 = 0.f;
#pragma unroll
        for (int j = 0; j < 8; j++) sf += p.ssf()[tok * 8 + j];
#pragma unroll
        for (int j = 0; j < 16; j++) s2 += p.sss()[tok * 16 + j];
        const float rf = rsqrtf(sf * (1.f / 512.f) + EPSV), rs = rsqrtf(s2 * (1.f / 512.f) + EPSV);
        tab[i * 256 + tix7] = (f32x2t){rf / rs, rs};
      }
    }
    __syncthreads();
  }
  const pg8::EpiWout E{p.out, p.xp, p.xs, p.mod(), p.g_mlp, p.hb(), p.ss1()};
  pg8::gemm_phase<pg8::EpiWout, pg8::StaticOrder, true, true>((PG8_LAS unsigned char*)dyn_smem, otid(wv), g, S, E);
}
DI void phase8(const P& p, const int wv) {
  const pg8::Gemm g{p.hb(), p.w1t(), NTOK, 4096, 1024, 1024, 1024};
  pg8::StaticOrder S; S.init(NTOK, 4096, (int)gridDim.x, (int)blockIdx.x);
  const pg8::EpiMlpIn E{p.hid(), p.sb2(), p.ss1()};
  pg8::gemm_phase<pg8::EpiMlpIn, pg8::StaticOrder, true, true>((PG8_LAS unsigned char*)dyn_smem, otid(wv), g, S, E);
}
DI void phase9(const P& p, const int wv) {
  const pg8::Gemm g{p.hid(), p.w2t(), NTOK, 1024, 4096, 4096, 4096};
  pg8::StaticOrder S; S.init(NTOK, 1024, (int)gridDim.x, (int)blockIdx.x);
  const pg8::EpiMlpOut E{(const bf16_t*)p.out, p.hb(), p.mod(), p.b2};
  pg8::gemm_phase<pg8::EpiMlpOut, pg8::StaticOrder, true, true>((PG8_LAS unsigned char*)dyn_smem, otid(wv), g, S, E);
}

__global__ void __launch_bounds__(512, 2) k_mega(P p) {
  cg::grid_group grid = cg::this_grid();
  const int wv = __builtin_amdgcn_readfirstlane((int)threadIdx.x >> 6);
  {
    const int t0 = otid(wv);
    volatile XB_LAS unsigned* st = (volatile XB_LAS unsigned*)((XB_LAS unsigned char*)dyn_smem + XB_LDS_OFF);
    if (t0 == 0) { st[0] = 0u; st[1] = 0u; }
    __syncthreads();
    if (t0 == 0) (void)xb_add((unsigned*)(p.ws + O_bar) + XB_XCNT(xb_xcc_id()), 1u);
  }
#define GSYNC() xcd_barrier((unsigned*)(p.ws + O_bar), otid(wv))
  if (p.ws == nullptr) grid.sync();
  phase0(p, wv); GSYNC();
  rownorm_mod<true>(p, wv, p.g_mix, 0, 1024); GSYNC();
  phase2(p, wv); GSYNC();
  phase3(p, wv); GSYNC();
  phase4(p, wv); GSYNC();
  phase5(p, wv); GSYNC();
  phase6(p, wv); GSYNC();
  phase7(p, wv); GSYNC();
  phase8(p, wv); GSYNC();
  phase9(p, wv); GSYNC();
  final_norm(p, wv);
}

extern "C" void kernel_launch(void* const* d_in, const int* in_sizes, int n_in, void* d_out, int out_size, void* d_ws, size_t ws_size,
                              hipStream_t stream) {
  P p{};
  const float** f = (const float**)&p;
  for (int i = 0; i < 29; i++) f[i] = (const float*)d_in[i];
  p.out = (float*)d_out;
  p.ws = (char*)d_ws;
  if (WS_NEED > ws_size) { fprintf(stderr, "workspace too small: need %zu have %zu\n", (size_t)WS_NEED, ws_size); return; }
  static int grid_blocks = 0;
  if (!grid_blocks) {
    int dev = 0, cus = 0, per_cu = 0;
    (void)hipGetDevice(&dev);
    (void)hipDeviceGetAttribute(&cus, hipDeviceAttributeMultiprocessorCount, dev);
    (void)hipFuncSetAttribute((const void*)k_mega, hipFuncAttributeMaxDynamicSharedMemorySize, SMEM_BYTES);
    (void)hipOccupancyMaxActiveBlocksPerMultiprocessor(&per_cu, k_mega, 512, SMEM_BYTES);
    if (per_cu < 1) per_cu = 1;
    grid_blocks = cus * per_cu;
  }
  (void)hipMemsetAsync((char*)d_ws + O_mod, 0, O_AT - O_mod, stream);
  void* args[] = {&p};
  hipError_t e = hipLaunchCooperativeKernel((void*)k_mega, dim3(grid_blocks), dim3(512), args, SMEM_BYTES, stream);
  if (e != hipSuccess) fprintf(stderr, "cooperative launch failed: %s (grid %d)\n", hipGetErrorString(e), grid_blocks);
}
```
